# Optimizing an MI355X kernel written in HIP

```python
import math
import jax
import jax.numpy as jnp
from jax import lax
import numpy as np

D_MODEL = 2048
BATCH = 2
SEQ = 8192
DEPTH = 4

GRID_W = 64
CTX_LEN = 256
EPS = 1e-6
N_MOD = 6

DIFF_HEADS = 12
DIFF_DIM = 64
DIFF_V = 2 * DIFF_DIM
EV_Q = DIFF_HEADS * 2 * DIFF_DIM
EV_V = DIFF_HEADS * DIFF_V
FOURIER_GROUPS = 4
FOURIER_DIM = 128
FOURIER_WIDTH = FOURIER_GROUPS * FOURIER_DIM
EV_IN = 2 * EV_Q + EV_V + FOURIER_WIDTH
EV_MIX = EV_V + FOURIER_WIDTH
ROPE_BASE = 10000.0
Q_BLOCK = 128

CONV_WIDTH = 1024
CONV_K = 3
NA_HEADS = 8
NA_DIM = 128
NA_WIDTH = NA_HEADS * NA_DIM
NA_WIN_ROWS = 8
NA_WIN_COLS = 16
OD_IN = 3 * CONV_WIDTH + 3 * NA_WIDTH
OD_MIX = CONV_WIDTH + NA_WIDTH

FFN_HIDDEN = -(-8 * D_MODEL // (3 * 256)) * 256
N_EVEN = (DEPTH + 1) // 2
N_ODD = DEPTH // 2

kernel_name = "hybrid_diffattn_fourier_shortconv_natten_dit"


def rms_norm(x, g):
    xf = x.astype(jnp.float32)
    y = xf * lax.rsqrt(jnp.mean(xf * xf, axis=-1, keepdims=True) + EPS)
    return (y * g.astype(jnp.float32)).astype(x.dtype)


def modulate(h, shift, scale):
    return h * (1.0 + scale) + shift


def swiglu(u, w_in, w_out):
    gu = u @ w_in
    return (jax.nn.silu(gu[..., :FFN_HIDDEN]) * gu[..., FFN_HIDDEN:]) @ w_out


def axial_rope(n_tok):
    t = jnp.arange(n_tok)
    rows = (t // GRID_W).astype(jnp.float32)
    cols = (t % GRID_W).astype(jnp.float32)
    n_freq = DIFF_DIM // 4
    inv = ROPE_BASE ** (-jnp.arange(n_freq, dtype=jnp.float32) / n_freq)
    ang = jnp.stack([rows[:, None] * inv, cols[:, None] * inv], axis=1)
    return jnp.cos(ang), jnp.sin(ang)


def apply_rope(x, cos, sin):
    xr = x.astype(jnp.float32).reshape(x.shape[:-1] + (2, 2, DIFF_DIM // 4))
    x1, x2 = xr[..., 0, :], xr[..., 1, :]
    bshape = (cos.shape[0],) + (1,) * (x.ndim - 3) + cos.shape[1:]
    c, s = cos.reshape(bshape), sin.reshape(bshape)
    out = jnp.stack([x1 * c - x2 * s, x2 * c + x1 * s], axis=-2)
    return out.reshape(x.shape).astype(x.dtype)


def diff_weights(s, lam, v, scale):
    p = jax.nn.softmax(s.astype(jnp.float32) * scale, axis=-1)
    a = p[:, :, 0] - lam * p[:, :, 1]
    return jnp.einsum("bhqk,bkhd->bqhd", a.astype(v.dtype), v)


def fourier_mix(u):
    b, n, _ = u.shape
    ug = u.astype(jnp.float32).reshape(b, n, FOURIER_GROUPS, FOURIER_DIM)
    out = jnp.fft.fft2(ug, axes=(1, 3), norm="ortho").real
    return out.reshape(b, n, FOURIER_WIDTH).astype(u.dtype)


def short_conv(u, w):
    n = u.shape[1]
    pad = CONV_K // 2
    up = jnp.pad(u, ((0, 0), (pad, pad), (0, 0)))
    out = up[:, 0:n] * w[0]
    for j in range(1, CONV_K):
        out = out + up[:, j:j + n] * w[j]
    return out


def even_mixer(a_lat, a_ctx, w_in, w_out, qk_gain, lam_vec, subln_gain, lam_init, ctx_out):
    b, n, _ = a_lat.shape
    n_ctx = a_ctx.shape[1]
    scale = DIFF_DIM ** -0.5
    lamf = lam_vec.astype(jnp.float32)
    lam = jnp.exp(jnp.sum(lamf[0] * lamf[1])) - jnp.exp(jnp.sum(lamf[2] * lamf[3])) + lam_init

    def qk(t, g, m):
        return rms_norm(t.reshape(b, m, DIFF_HEADS, 2, DIFF_DIM), g)

    def vv(t, m):
        return t.reshape(b, m, DIFF_HEADS, DIFF_V)

    def head_out(o):
        return (rms_norm(o, subln_gain) * (1.0 - lam_init)).reshape(o.shape[0], o.shape[1], EV_V)

    p = a_lat @ w_in
    q = qk(p[..., :EV_Q], qk_gain[0], n)
    k = qk(p[..., EV_Q:2 * EV_Q], qk_gain[1], n)
    v = vv(p[..., 2 * EV_Q:2 * EV_Q + EV_V], n)
    f = p[..., 2 * EV_Q + EV_V:]
    cos, sin = axial_rope(n)
    q_rot = apply_rope(q, cos, sin)
    k_rot = apply_rope(k, cos, sin)

    if ctx_out:
        pc = a_ctx @ w_in
        kvc = pc[..., EV_Q:2 * EV_Q + EV_V]
    else:
        kvc = a_ctx @ w_in[:, EV_Q:2 * EV_Q + EV_V]
    kc = qk(kvc[..., :EV_Q], qk_gain[1], n_ctx)
    vc = vv(kvc[..., EV_Q:], n_ctx)
    v_all = jnp.concatenate([vc, v], axis=1)

    nb = n // Q_BLOCK

    def to_blocks(t):
        return jnp.moveaxis(t.reshape((b, nb, Q_BLOCK) + t.shape[2:]), 1, 0)

    def block(args):
        qr, qp = args
        s = jnp.concatenate([
            jnp.einsum("bqhcd,bkhcd->bhcqk", qp, kc),
            jnp.einsum("bqhcd,bkhcd->bhcqk", qr, k_rot)], axis=-1)
        return diff_weights(s, lam, v_all, scale)

    o = lax.map(block, (to_blocks(q_rot), to_blocks(q)))
    o = jnp.moveaxis(o, 0, 1).reshape(b, n, DIFF_HEADS, DIFF_V)
    y = jnp.concatenate([head_out(o), fourier_mix(f)], axis=-1) @ w_out
    if not ctx_out:
        return y, None
    qc = qk(pc[..., :EV_Q], qk_gain[0], n_ctx)
    oc = diff_weights(jnp.einsum("bqhcd,bkhcd->bhcqk", qc, kc), lam, vc, scale)
    yc = jnp.concatenate([head_out(oc), fourier_mix(pc[..., 2 * EV_Q + EV_V:])], axis=-1) @ w_out
    return y, yc


def neighborhood_attention(q, k, v, kc, vc, rpb):
    b, n, nh, d = q.shape
    n_ctx = kc.shape[1]
    rows = n // GRID_W
    wr = min(NA_WIN_ROWS, rows)
    scale = d ** -0.5
    qg = q.reshape(b, rows, GRID_W, nh, d)
    kg = k.reshape(b, rows, GRID_W, nh, d)
    vg = v.reshape(b, rows, GRID_W, nh, d)
    col = jnp.arange(GRID_W)
    cs = jnp.clip(col - NA_WIN_COLS // 2, 0, GRID_W - NA_WIN_COLS)
    col_idx = cs[:, None] + jnp.arange(NA_WIN_COLS)
    dc = col_idx - col[:, None] + (NA_WIN_COLS - 1)
    rpbf = rpb.astype(jnp.float32)

    def row_fn(r):
        rs = jnp.clip(r - wr // 2, 0, rows - wr)
        q_r = lax.dynamic_index_in_dim(qg, r, axis=1, keepdims=False)
        k_r = lax.dynamic_slice_in_dim(kg, rs, wr, axis=1)[:, :, col_idx]
        v_r = lax.dynamic_slice_in_dim(vg, rs, wr, axis=1)[:, :, col_idx]
        dr = rs + jnp.arange(wr) - r + (NA_WIN_ROWS - 1)
        bias = rpbf[:, dr[None, :, None], dc[:, None, :]]
        s_nb = jnp.einsum("bchd,bwcjhd->bhcwj", q_r, k_r).astype(jnp.float32) * scale + bias
        s_cx = jnp.einsum("bchd,bkhd->bhck", q_r, kc).astype(jnp.float32) * scale
        s = jnp.concatenate([s_cx, s_nb.reshape(b, nh, GRID_W, wr * NA_WIN_COLS)], axis=-1)
        p = jax.nn.softmax(s, axis=-1).astype(v.dtype)
        p_cx = p[..., :n_ctx]
        p_nb = p[..., n_ctx:].reshape(b, nh, GRID_W, wr, NA_WIN_COLS)
        return (jnp.einsum("bhcwj,bwcjhd->bchd", p_nb, v_r)
                + jnp.einsum("bhck,bkhd->bchd", p_cx, vc))

    out = lax.map(row_fn, jnp.arange(rows))
    return jnp.moveaxis(out, 0, 1).reshape(b, n, nh * d)


def odd_mixer(a_lat, a_ctx, w_in, w_out, qk_gain, conv_w, rpb, ctx_out):
    b, n, _ = a_lat.shape
    n_ctx = a_ctx.shape[1]
    o_q = 3 * CONV_WIDTH
    o_kv = o_q + NA_WIDTH
    scale = NA_DIM ** -0.5

    def conv_branch(p):
        gb = p[..., :CONV_WIDTH]
        gc = p[..., CONV_WIDTH:2 * CONV_WIDTH]
        hh = p[..., 2 * CONV_WIDTH:o_q]
        return gb * short_conv(gc * hh, conv_w)

    def heads(t, m):
        return t.reshape(b, m, NA_HEADS, NA_DIM)

    p = a_lat @ w_in
    q = rms_norm(heads(p[..., o_q:o_kv], n), qk_gain[0])
    k = rms_norm(heads(p[..., o_kv:o_kv + NA_WIDTH], n), qk_gain[1])
    v = heads(p[..., o_kv + NA_WIDTH:], n)
    if ctx_out:
        pc = a_ctx @ w_in
        kvc = pc[..., o_kv:]
    else:
        kvc = a_ctx @ w_in[:, o_kv:]
    kc = rms_norm(heads(kvc[..., :NA_WIDTH], n_ctx), qk_gain[1])
    vc = heads(kvc[..., NA_WIDTH:], n_ctx)
    na = neighborhood_attention(q, k, v, kc, vc, rpb)
    y = jnp.concatenate([conv_branch(p), na], axis=-1) @ w_out
    if not ctx_out:
        return y, None
    qc = rms_norm(heads(pc[..., o_q:o_kv], n_ctx), qk_gain[0])
    pcx = jax.nn.softmax(jnp.einsum("bqhd,bkhd->bhqk", qc, kc).astype(jnp.float32) * scale, axis=-1)
    oc = jnp.einsum("bhqk,bkhd->bqhd", pcx.astype(vc.dtype), vc).reshape(b, n_ctx, NA_WIDTH)
    yc = jnp.concatenate([conv_branch(pc), oc], axis=-1) @ w_out
    return y, yc


def setup_inputs(seed: int = 0) -> dict:
    key = jax.random.key(seed)
    ks = jax.random.split(key, 20)

    def nrm(k, shape, scale):
        return jax.random.normal(k, shape, jnp.float32) * scale

    return {
        "x": nrm(ks[0], (BATCH, SEQ, D_MODEL), 1.0),
        "c": nrm(ks[1], (BATCH, D_MODEL), 1.0),
        "ctx": nrm(ks[2], (BATCH, CTX_LEN, D_MODEL), 1.0),
        "c_ctx": nrm(ks[3], (D_MODEL,), 1.0),
        "w_mod": nrm(ks[4], (DEPTH, D_MODEL, N_MOD * D_MODEL), D_MODEL ** -0.5),
        "b_mod": nrm(ks[5], (DEPTH, N_MOD * D_MODEL), 0.02),
        "norm_gain": 1.0 + nrm(ks[6], (DEPTH, 2, D_MODEL), 0.02),
        "w_ffn_in": nrm(ks[7], (DEPTH, D_MODEL, 2 * FFN_HIDDEN), D_MODEL ** -0.5),
        "w_ffn_out": nrm(ks[8], (DEPTH, FFN_HIDDEN, D_MODEL), FFN_HIDDEN ** -0.5),
        "ev_w_in": nrm(ks[9], (N_EVEN, D_MODEL, EV_IN), D_MODEL ** -0.5),
        "ev_w_out": nrm(ks[10], (N_EVEN, EV_MIX, D_MODEL), EV_MIX ** -0.5),
        "ev_qk_gain": 1.0 + nrm(ks[11], (N_EVEN, 2, DIFF_DIM), 0.02),
        "ev_lambda": nrm(ks[12], (N_EVEN, 4, DIFF_DIM), 0.1),
        "ev_subln_gain": 1.0 + nrm(ks[13], (N_EVEN, DIFF_V), 0.02),
        "od_w_in": nrm(ks[14], (N_ODD, D_MODEL, OD_IN), D_MODEL ** -0.5),
        "od_w_out": nrm(ks[15], (N_ODD, OD_MIX, D_MODEL), OD_MIX ** -0.5),
        "od_qk_gain": 1.0 + nrm(ks[16], (N_ODD, 2, NA_DIM), 0.02),
        "od_conv_w": nrm(ks[17], (N_ODD, CONV_K, CONV_WIDTH), CONV_K ** -0.5),
        "od_rpb": nrm(ks[18], (N_ODD, NA_HEADS, 2 * NA_WIN_ROWS - 1, 2 * NA_WIN_COLS - 1), 0.1),
    }


def reference(x, c, ctx, c_ctx, w_mod, b_mod, norm_gain, w_ffn_in, w_ffn_out,
              ev_w_in, ev_w_out, ev_qk_gain, ev_lambda, ev_subln_gain,
              od_w_in, od_w_out, od_qk_gain, od_conv_w, od_rpb):
    b = x.shape[0]
    h, hc = x, ctx
    s_lat = jax.nn.silu(c)
    s_ctx = jax.nn.silu(c_ctx)
    for i in range(DEPTH):
        ctx_out = i < DEPTH - 1
        m = (s_lat @ w_mod[i] + b_mod[i]).reshape(b, N_MOD, 1, D_MODEL)
        mc = (s_ctx @ w_mod[i] + b_mod[i]).reshape(N_MOD, D_MODEL)
        a_lat = modulate(rms_norm(h, norm_gain[i, 0]), m[:, 0], m[:, 1])
        a_ctx = modulate(rms_norm(hc, norm_gain[i, 0]), mc[0], mc[1])
        j = i // 2
        if i % 2 == 0:
            lam_init = 0.8 - 0.6 * math.exp(-0.3 * i)
            y, yc = even_mixer(a_lat, a_ctx, ev_w_in[j], ev_w_out[j], ev_qk_gain[j],
                               ev_lambda[j], ev_subln_gain[j], lam_init, ctx_out)
        else:
            y, yc = odd_mixer(a_lat, a_ctx, od_w_in[j], od_w_out[j], od_qk_gain[j],
                              od_conv_w[j], od_rpb[j], ctx_out)
        h = h + m[:, 2] * y
        h = h + m[:, 5] * swiglu(modulate(rms_norm(h, norm_gain[i, 1]), m[:, 3], m[:, 4]),
                                 w_ffn_in[i], w_ffn_out[i])
        if ctx_out:
            hc = hc + mc[2] * yc
            hc = hc + mc[5] * swiglu(modulate(rms_norm(hc, norm_gain[i, 1]), mc[3], mc[4]),
                                     w_ffn_in[i], w_ffn_out[i])
    return h
```

```cpp
#include <hip/hip_runtime.h>
#include <cstdio>
#include <cstdint>
#include <cstddef>
#ifndef DUP
#define DUP 0
#endif
namespace pg8 {
#define PG8_LAS __attribute__((address_space(3)))
typedef unsigned short bf16_t;
typedef short bf16x8 __attribute__((ext_vector_type(8)));
typedef float f32x4 __attribute__((ext_vector_type(4)));
typedef unsigned u32x4 __attribute__((ext_vector_type(4)));
constexpr int BM = 256, BK = 64, HALF = 128, HTB = HALF * BK * 2  , STAGE_BYTES = 8 * HTB, NXCD = 8, WGM = 8;

__host__ __device__ __forceinline__ int lds_byte(int r, int c) { const int st = (r >> 4) * 2 + (c >> 5), rr = r & 15, cc = c & 31, ob = rr * 64 + cc * 2; return st * 1024 + (ob ^ (((ob >> 9) & 1) << 5)); }
__host__ __device__ __forceinline__ void stage_rc(int b, int& R, int& C) { const int st = b / 1024, sb = b % 1024, swz = sb ^ (((sb >> 9) & 1) << 5); R = (st >> 1) * 16 + swz / 64; C = (st & 1) * 32 + (swz % 64) / 2; }
__host__ __device__ __forceinline__ int perm32(int rho) { const int n = rho >> 4, i = rho & 15; return 8 * (i >> 2) + 4 * n + (i & 3); }

struct Unit { int pm, pn; int kb, nt; };
struct Gemm { const bf16_t* A; const bf16_t* Bt; int M, N, K; };

struct StaticOrder {
    int nM, nN, nwg, G, c;
    __host__ __device__ void init(int M, int N, int G_, int c_) { nM = M / BM; nN = N / BM; nwg = nM * nN; G = G_; c = c_; }
    __host__ __device__ bool next(int i, Unit& u) const {
        const long L = (long)i * G + c; if (L >= nwg) return false;
        int wgid = (int)L; { const int q = nwg / NXCD, r = nwg % NXCD, xcd = wgid % NXCD, off = wgid / NXCD; wgid = (xcd < r ? xcd * (q + 1) : r * (q + 1) + (xcd - r) * q) + off; }
        const int nig = WGM * nN, gid = wgid / nig, fm = gid * WGM, gsz = (nM - fm) < WGM ? (nM - fm) : WGM;
        u.pm = fm + ((wgid % nig) % gsz); u.pn = (wgid % nig) / gsz; return true;
    }
    static constexpr bool SPLITK = false;
    __device__ __forceinline__ void a_ready(const Unit&) const {}
    __device__ __forceinline__ void done(const Unit&) const {}
};

__device__ __forceinline__ unsigned cvt_pk_bf16(float lo, float hi) { unsigned r; asm volatile("v_cvt_pk_bf16_f32 %0, %1, %2" : "=v"(r) : "v"(lo), "v"(hi)); return r; }
typedef float f32x2 __attribute__((ext_vector_type(2)));
__device__ __forceinline__ f32x2 gelu_pk(f32x2 v) {
    const f32x2 av = __builtin_elementwise_abs(v), d = av * 0.2316418882f + 1.0f;
    f32x2 t; t.x = __builtin_amdgcn_rcpf(d.x); t.y = __builtin_amdgcn_rcpf(d.y);
    f32x2 q = t * 0.5307027145f + (-0.7265760135f); q = q * t + 0.7107068705f; q = q * t + (-0.142248368f); q = q * t + 0.127414796f; q = q * t;
    const f32x2 s = (v * v) * (-0.72134752044f);
    f32x2 e; e.x = __builtin_amdgcn_exp2f(s.x); e.y = __builtin_amdgcn_exp2f(s.y);
    const f32x2 m = v * (q * e), r = v - m;
    f32x2 o; o.x = v.x < 0.f ? m.x : r.x; o.y = v.y < 0.f ? m.y : r.y; return o;
}

template <int ACT  > struct EpiBf16 {
    static constexpr bool PERM = true, AFTER_DRAIN = false; static_assert(ACT == 0 || ACT == 1, "EpiBf16: ACT is 0 (none) or 1 (gelu_pk)");
    bf16_t* O; int ldc; const float* bias; int split_cols; size_t split_stride; float scale0;
    __device__ __forceinline__ void operator()(const f32x4 (&acc)[2][2][4][2], const Unit& u, int wr, int wc, int fr, int fq) const {
        const int row0 = u.pm * BM + wr * 64 + fr; int colt = u.pn * BM; bf16_t* base = O;
        float sc = 1.f; if (split_cols) { const int t = colt / split_cols; base += (size_t)t * split_stride; colt -= t * split_cols; if (t == 0) sc = scale0; }
        const int col0 = colt + wc * 32 + 8 * fq, bcol0 = u.pn * BM + wc * 32 + 8 * fq;
        f32x4 bv[2][2];
#pragma unroll
        for (int bj = 0; bj < 2; ++bj)
#pragma unroll
            for (int n = 0; n < 2; ++n) bv[bj][n] = bias ? *(const f32x4*)(bias + bcol0 + bj * HALF + 4 * n) : (f32x4){0.f, 0.f, 0.f, 0.f};
#pragma unroll
        for (int ai = 0; ai < 2; ++ai)
#pragma unroll
            for (int m = 0; m < 4; ++m) { bf16_t* rowp = base + (size_t)(row0 + ai * HALF + m * 16) * ldc + col0;
#pragma unroll
                for (int bj = 0; bj < 2; ++bj) { f32x4 v0 = acc[ai][bj][m][0] + bv[bj][0], v1 = acc[ai][bj][m][1] + bv[bj][1];
                    if (ACT == 1) { f32x2 a = gelu_pk((f32x2){v0[0], v0[1]}), b = gelu_pk((f32x2){v0[2], v0[3]}), c = gelu_pk((f32x2){v1[0], v1[1]}), d = gelu_pk((f32x2){v1[2], v1[3]});
                        v0 = (f32x4){a.x, a.y, b.x, b.y}; v1 = (f32x4){c.x, c.y, d.x, d.y}; }
                    v0 = v0 * sc; v1 = v1 * sc; u32x4 w; w.x = cvt_pk_bf16(v0[0], v0[1]); w.y = cvt_pk_bf16(v0[2], v0[3]); w.z = cvt_pk_bf16(v1[0], v1[1]); w.w = cvt_pk_bf16(v1[2], v1[3]);
                    *(u32x4*)(rowp + bj * HALF) = w; } }
    }
};

struct EpiGate {
    static constexpr bool PERM = false, AFTER_DRAIN = false;
    const float* base_l; float* out_l; float* slab; const float* gate;
    __device__ __forceinline__ void operator()(const f32x4 (&acc)[2][2][4][2], const Unit& u, int wr, int wc, int fr, int fq) const {
        const bool isc = u.pm >= 64; const int grp = u.pm < 32 ? 0 : (u.pm < 64 ? 1 : 2);
        const float* bp = base_l; float* op = out_l;
        const int rowt = (isc ? (u.pm - 64) : u.pm) * BM + wr * 64 + fr;
        const int col0 = u.pn * BM + wc * 32 + 4 * fq;
        if (isc) {
            const int kc = u.kb / (u.nt * BK * 2); float* sp = slab + (size_t)kc * (512 * 2048);
#pragma unroll
            for (int ai = 0; ai < 2; ++ai)
#pragma unroll
                for (int m = 0; m < 4; ++m) { const size_t off = (size_t)(rowt + ai * HALF + m * 16) * 2048 + col0;
#pragma unroll
                    for (int bj = 0; bj < 2; ++bj)
#pragma unroll
                        for (int n = 0; n < 2; ++n) *(f32x4*)(sp + off + bj * HALF + n * 16) = acc[ai][bj][m][n]; }
            return; }
        f32x4 gv[2][2];
#pragma unroll
        for (int bj = 0; bj < 2; ++bj)
#pragma unroll
            for (int n = 0; n < 2; ++n) gv[bj][n] = *(const f32x4*)(gate + grp * 12288 + col0 + bj * HALF + n * 16);
#pragma unroll
        for (int ai = 0; ai < 2; ++ai) {
            f32x4 pre[4][2][2];
#pragma unroll
            for (int m = 0; m < 4; ++m) { const size_t off = (size_t)(rowt + ai * HALF + m * 16) * 2048 + col0;
#pragma unroll
                for (int bj = 0; bj < 2; ++bj)
#pragma unroll
                    for (int n = 0; n < 2; ++n) pre[m][bj][n] = *(const f32x4*)(bp + off + bj * HALF + n * 16); }
            asm volatile("" ::: "memory");
#pragma unroll
            for (int m = 0; m < 4; ++m) { const size_t off = (size_t)(rowt + ai * HALF + m * 16) * 2048 + col0;
#pragma unroll
                for (int bj = 0; bj < 2; ++bj)
#pragma unroll
                    for (int n = 0; n < 2; ++n) *(f32x4*)(op + off + bj * HALF + n * 16) = pre[m][bj][n] + gv[bj][n] * acc[ai][bj][m][n]; }
            asm volatile("" ::: "memory");
        }
    }
};
template <int KS> struct SplitOrder {
    static constexpr bool SPLITK = true;
    StaticOrder so; int G, c, ntc, ntf, nctx;
    __device__ void init(int Mlat, int N, int K, int G_, int c_, bool with_ctx) { so.init(Mlat, N, G_, c_); G = G_; c = c_; ntf = K / BK; ntc = ntf / KS; nctx = with_ctx ? 16 * KS : 0; }
    __device__ bool next(int i, Unit& u) const {
        const long L = (long)i * G + c;
        if (L < so.nwg) { so.next(i, u); u.kb = 0; u.nt = ntf; return true; }
        const int x = (int)(L - so.nwg); if (x >= nctx) return false;
        const int kc = x % KS, tile = x / KS; u.pn = tile & 7; u.pm = so.nM + (tile >> 3); u.kb = kc * ntc * BK * 2; u.nt = ntc; return true;
    }
    __device__ __forceinline__ void a_ready(const Unit&) const {}
    __device__ __forceinline__ void done(const Unit&) const {}
};
struct EpiEvenIn {
    static constexpr bool PERM = true, AFTER_DRAIN = false;
    bf16_t* P; bf16_t* QR; int ldc; const float* gains; const float* rope; PG8_LAS float* part;
    __device__ __forceinline__ void operator()(const f32x4 (&acc)[2][2][4][2], const Unit& u, int wr, int wc, int fr, int fq) const {
        const int row0 = u.pm * BM + wr * 64 + fr; const int col0 = u.pn * BM + wc * 32 + 8 * fq;
        if (u.pn >= 12) {
#pragma unroll
            for (int ai = 0; ai < 2; ++ai)
#pragma unroll
                for (int m = 0; m < 4; ++m) { bf16_t* rowp = P + (size_t)(row0 + ai * HALF + m * 16) * ldc + col0;
#pragma unroll
                    for (int bj = 0; bj < 2; ++bj) { const f32x4 v0 = acc[ai][bj][m][0], v1 = acc[ai][bj][m][1];
                        u32x4 w; w.x = cvt_pk_bf16(v0[0], v0[1]); w.y = cvt_pk_bf16(v0[2], v0[3]); w.z = cvt_pk_bf16(v1[0], v1[1]); w.w = cvt_pk_bf16(v1[2], v1[3]);
                        *(u32x4*)(rowp + bj * HALF) = w; } }
            return; }
        const bool isq = u.pn < 6, lat = u.pm < 64;
        int rb_ = wr * 64 + fr; asm volatile("" : "+v"(rb_));
#pragma unroll
        for (int ai = 0; ai < 2; ++ai)
#pragma unroll
            for (int m = 0; m < 4; ++m)
#pragma unroll
                for (int bj = 0; bj < 2; ++bj) { const f32x4 a = acc[ai][bj][m][0], b = acc[ai][bj][m][1];
                    float s = (a[0] * a[0] + a[1] * a[1]) + (a[2] * a[2] + a[3] * a[3]) + (b[0] * b[0] + b[1] * b[1]) + (b[2] * b[2] + b[3] * b[3]);
                    s += __shfl_xor(s, 16); s += __shfl_xor(s, 32);
                    if (fq == 0) part[((ai * HALF + m * 16 + rb_) * 2 + bj) * 4 + wc] = s; }
        asm volatile("s_waitcnt lgkmcnt(0)" ::: "memory"); __builtin_amdgcn_s_barrier(); asm volatile("" ::: "memory");
        const float* gp = gains + (isq ? 0 : 64) + 32 * (wc & 1) + 8 * fq; const float qs = isq ? 0.18033688011112042f : 1.0f;
        float gn[8];
#pragma unroll
        for (int e = 0; e < 8; ++e) gn[e] = gp[e] * qs;
#pragma unroll
        for (int ai = 0; ai < 2; ++ai)
#pragma unroll
            for (int m = 0; m < 4; ++m) { const int rl = ai * HALF + m * 16 + rb_; const int row = u.pm * BM + rl;
                f32x4 cs0 = {1.f, 0.f, 1.f, 0.f}, cs1 = cs0, cs2 = cs0, cs3 = cs0;
                if (lat) { const int t = row & 8191; const int pos = (wc & 1) ? (t & 63) : (t >> 6); const float* rp = rope + (size_t)(pos * 16 + 8 * (fq & 1)) * 2;
                    cs0 = *(const f32x4*)rp; cs1 = *(const f32x4*)(rp + 4); cs2 = *(const f32x4*)(rp + 8); cs3 = *(const f32x4*)(rp + 12); }
                const float c8[8] = {cs0[0], cs0[2], cs1[0], cs1[2], cs2[0], cs2[2], cs3[0], cs3[2]}, s8[8] = {cs0[1], cs0[3], cs1[1], cs1[3], cs2[1], cs2[3], cs3[1], cs3[3]};
#pragma unroll
                for (int bj = 0; bj < 2; ++bj) {
                    const float ss = part[(rl * 2 + bj) * 4 + wc] + part[(rl * 2 + bj) * 4 + (wc ^ 1)];
                    const float rstd = rsqrtf(ss * (1.0f / 64.0f) + 1e-6f);
                    float y[8], yr[8];
#pragma unroll
                    for (int e = 0; e < 8; ++e) y[e] = acc[ai][bj][m][e >> 2][e & 3] * rstd * gn[e];
#pragma unroll
                    for (int e = 0; e < 8; ++e) { const float yp = __shfl_xor(y[e], 32); yr[e] = (fq & 2) ? (y[e] * c8[e] + yp * s8[e]) : (y[e] * c8[e] - yp * s8[e]); }
                    u32x4 wn, wrot;
                    wn.x = cvt_pk_bf16(y[0], y[1]); wn.y = cvt_pk_bf16(y[2], y[3]); wn.z = cvt_pk_bf16(y[4], y[5]); wn.w = cvt_pk_bf16(y[6], y[7]);
                    wrot.x = cvt_pk_bf16(yr[0], yr[1]); wrot.y = cvt_pk_bf16(yr[2], yr[3]); wrot.z = cvt_pk_bf16(yr[4], yr[5]); wrot.w = cvt_pk_bf16(yr[6], yr[7]);
                    bf16_t* pp = P + (size_t)row * ldc + col0 + bj * HALF;
                    if (isq) { *(u32x4*)pp = wn; if (lat) *(u32x4*)(QR + (size_t)row * 1536 + col0 + bj * HALF) = wrot; }
                    else     { *(u32x4*)pp = lat ? wrot : wn; }
                }
                asm volatile("" ::: "memory"); }
    }
};
struct EpiOddIn {
    static constexpr bool PERM = true, AFTER_DRAIN = false;
    bf16_t* P; int ldc; const float* gains; PG8_LAS float* part;
    __device__ __forceinline__ void operator()(const f32x4 (&acc)[2][2][4][2], const Unit& u, int wr, int wc, int fr, int fq) const {
        const int row0 = u.pm * BM + wr * 64 + fr; const int col0 = u.pn * BM + wc * 32 + 8 * fq;
        const bool isqk = u.pn >= 12 && u.pn < 20;
        float rs[2][4][2];
        if (isqk) {
            int rb_ = wr * 64 + fr; asm volatile("" : "+v"(rb_));
#pragma unroll
            for (int ai = 0; ai < 2; ++ai)
#pragma unroll
                for (int m = 0; m < 4; ++m)
#pragma unroll
                    for (int bj = 0; bj < 2; ++bj) { const f32x4 a = acc[ai][bj][m][0], b = acc[ai][bj][m][1];
                        float s = (a[0] * a[0] + a[1] * a[1]) + (a[2] * a[2] + a[3] * a[3]) + (b[0] * b[0] + b[1] * b[1]) + (b[2] * b[2] + b[3] * b[3]);
                        s += __shfl_xor(s, 16); s += __shfl_xor(s, 32);
                        if (fq == 0) part[((ai * HALF + m * 16 + rb_) * 2 + bj) * 4 + wc] = s; }
            asm volatile("s_waitcnt lgkmcnt(0)" ::: "memory"); __builtin_amdgcn_s_barrier(); asm volatile("" ::: "memory");
#pragma unroll
            for (int ai = 0; ai < 2; ++ai)
#pragma unroll
                for (int m = 0; m < 4; ++m)
#pragma unroll
                    for (int bj = 0; bj < 2; ++bj) { const f32x4 t = *(const PG8_LAS f32x4*)(part + ((ai * HALF + m * 16 + rb_) * 2 + bj) * 4);
                        rs[ai][m][bj] = rsqrtf(((t[0] + t[1]) + (t[2] + t[3])) * (1.0f / 128.0f) + 1e-6f); }
        }
        float gn[8];
        { const float* gp = gains + (u.pn >= 16 ? 128 : 0) + 32 * wc + 8 * fq;
#pragma unroll
          for (int e = 0; e < 8; ++e) gn[e] = isqk ? gp[e] : 1.0f; }
#pragma unroll
        for (int ai = 0; ai < 2; ++ai)
#pragma unroll
            for (int m = 0; m < 4; ++m) { bf16_t* rowp = P + (size_t)(row0 + ai * HALF + m * 16) * ldc + col0;
#pragma unroll
                for (int bj = 0; bj < 2; ++bj) { const float r = isqk ? rs[ai][m][bj] : 1.0f; const f32x4 v0 = acc[ai][bj][m][0], v1 = acc[ai][bj][m][1];
                    u32x4 w; w.x = cvt_pk_bf16(v0[0] * r * gn[0], v0[1] * r * gn[1]); w.y = cvt_pk_bf16(v0[2] * r * gn[2], v0[3] * r * gn[3]);
                    w.z = cvt_pk_bf16(v1[0] * r * gn[4], v1[1] * r * gn[5]); w.w = cvt_pk_bf16(v1[2] * r * gn[6], v1[3] * r * gn[7]);
                    *(u32x4*)(rowp + bj * HALF) = w; } }
    }
};
struct EpiSwiglu {
    static constexpr bool PERM = true, AFTER_DRAIN = false;
    bf16_t* O; int ldc;
    __device__ __forceinline__ void operator()(const f32x4 (&acc)[2][2][4][2], const Unit& u, int wr, int wc, int fr, int fq) const {
        const int row0 = u.pm * BM + wr * 64 + fr; const int col0 = u.pn * HALF + wc * 32 + 8 * fq;
#pragma unroll
        for (int ai = 0; ai < 2; ++ai)
#pragma unroll
            for (int m = 0; m < 4; ++m) { bf16_t* rowp = O + (size_t)(row0 + ai * HALF + m * 16) * ldc + col0;
                float hv[8];
#pragma unroll
                for (int n = 0; n < 2; ++n)
#pragma unroll
                    for (int e = 0; e < 4; ++e) { const float g = acc[ai][0][m][n][e], up = acc[ai][1][m][n][e];
                        hv[n * 4 + e] = g * __builtin_amdgcn_rcpf(1.0f + __expf(-g)) * up; }
                u32x4 w; w.x = cvt_pk_bf16(hv[0], hv[1]); w.y = cvt_pk_bf16(hv[2], hv[3]); w.z = cvt_pk_bf16(hv[4], hv[5]); w.w = cvt_pk_bf16(hv[6], hv[7]);
                *(u32x4*)rowp = w; }
    }
};

template <class Epi, class Sched, bool ALIGN_EPI = false, bool SP2 = false>
__device__ __forceinline__ void gemm_phase(PG8_LAS unsigned char* lds, const Gemm g, const Sched& S, const Epi& E) {
    int tid_ = threadIdx.x; asm volatile("" : "+v"(tid_));
    const int tid = tid_, wid = __builtin_amdgcn_readfirstlane(tid >> 6), lane = tid & 63, wr = wid >> 2, wc = wid & 3, fr = lane & 15, fq = lane >> 4;
    const int K = g.K, ntf = K / BK;
    unsigned voffA[2], voffB[2];
#pragma unroll
    for (int i = 0; i < 2; ++i) { int R, C; stage_rc(tid * 16 + i * 8192, R, C); const int Rb = Epi::PERM ? ((R & ~31) + perm32(R & 31)) : R;
        voffA[i] = (unsigned)(R * K + C) * 2u; voffB[i] = (unsigned)(Rb * K + C) * 2u; }
    const size_t kstep = (size_t)(BK * 2);
    const size_t hstep = (size_t)HALF * K * 2;
    const size_t tstep = 2 * hstep;
    const unsigned ldsw = (unsigned)wid * 1024u;
    const int aoff = lds_byte(wr * 64 + fr, fq * 8), boff = lds_byte(wc * 32 + fr, fq * 8);
#define PG8_SA(b, h) (((b) * 2 + (h)) * HTB)
#define PG8_SB(b, h) ((4 + (b) * 2 + (h)) * HTB)
#define PG8_STAGE(bufoff, gbase, voff) do { _Pragma("unroll") for (int _i = 0; _i < 2; ++_i) \
        __builtin_amdgcn_global_load_lds((const unsigned*)((const char*)(gbase) + (voff)[_i]), (PG8_LAS unsigned*)(lds + (bufoff) + ldsw + _i * 8192), 16, 0, 0); } while (0)
#define PG8_LDA(dst, b, h) do { _Pragma("unroll") for (int m = 0; m < 4; ++m) _Pragma("unroll") for (int k = 0; k < 2; ++k) dst[m][k] = *(const PG8_LAS bf16x8*)(lds + PG8_SA(b, h) + aoff + m * 2048 + k * 1024); } while (0)
#define PG8_LDB(dst, b, h) do { _Pragma("unroll") for (int n = 0; n < 2; ++n) _Pragma("unroll") for (int k = 0; k < 2; ++k) dst[n][k] = *(const PG8_LAS bf16x8*)(lds + PG8_SB(b, h) + boff + n * 2048 + k * 1024); } while (0)
#define PG8_MMA(ai, bj, At, Bt) do { __builtin_amdgcn_s_setprio(1); _Pragma("unroll") for (int m = 0; m < 4; ++m) _Pragma("unroll") for (int n = 0; n < 2; ++n) _Pragma("unroll") for (int k = 0; k < 2; ++k) \
        acc[ai][bj][m][n] = __builtin_amdgcn_mfma_f32_16x16x32_bf16(Bt[n][k], At[m][k], acc[ai][bj][m][n], 0, 0, 0); __builtin_amdgcn_s_setprio(0); } while (0)
#define PG8_WAIT_V(n) asm volatile("s_waitcnt vmcnt(" #n ")" ::: "memory")
#define PG8_WAIT_L(n) asm volatile("s_waitcnt lgkmcnt(" #n ")" ::: "memory")
#define PG8_BAR __builtin_amdgcn_s_barrier()
#define PG8_SCHED __builtin_amdgcn_sched_barrier(0)
    Unit cur, nxt; int ui = 0;
    if (!S.next(0, cur)) return;
    f32x4 acc[2][2][4][2];
#pragma unroll
    for (int a = 0; a < 2; ++a)
#pragma unroll
        for (int b = 0; b < 2; ++b)
#pragma unroll
            for (int m = 0; m < 4; ++m)
#pragma unroll
                for (int n = 0; n < 2; ++n) acc[a][b][m][n] = (f32x4){0.f, 0.f, 0.f, 0.f};
    bf16x8 At[4][2], B0[2][2], B1[2][2];
    const char* cA = (const char*)g.A + (size_t)cur.pm * tstep + (Sched::SPLITK ? cur.kb : 0); const char* cB = (const char*)g.Bt + (size_t)cur.pn * tstep + (Sched::SPLITK ? cur.kb : 0);
    S.a_ready(cur);
    if constexpr (SP2) {
        PG8_STAGE(PG8_SB(0, 0), cB, voffB); PG8_STAGE(PG8_SB(0, 1), cB + hstep, voffB); PG8_STAGE(PG8_SA(0, 0), cA, voffA); PG8_STAGE(PG8_SA(0, 1), cA + hstep, voffA);
        if (wr == 1) PG8_BAR;
        PG8_WAIT_V(2); PG8_BAR;
        PG8_STAGE(PG8_SB(1, 0), cB + kstep, voffB); PG8_STAGE(PG8_SA(1, 0), cA + kstep, voffA); PG8_STAGE(PG8_SB(1, 1), cB + hstep + kstep, voffB);
        PG8_WAIT_V(6); PG8_BAR;
    } else {
        PG8_STAGE(PG8_SB(0, 0), cB, voffB); PG8_STAGE(PG8_SA(0, 0), cA, voffA); PG8_STAGE(PG8_SB(0, 1), cB + hstep, voffB); PG8_STAGE(PG8_SA(0, 1), cA + hstep, voffA);
        if (wr == 1) PG8_BAR;
        PG8_WAIT_V(4); PG8_BAR;
        PG8_STAGE(PG8_SB(1, 0), cB + kstep, voffB); PG8_STAGE(PG8_SA(1, 0), cA + kstep, voffA); PG8_STAGE(PG8_SB(1, 1), cB + hstep + kstep, voffB);
        PG8_WAIT_V(6); PG8_BAR;
    }
    for (;;) {
        const bool has_next = S.next(ui + 1, nxt);
        const char* nA = has_next ? (const char*)g.A + (size_t)nxt.pm * tstep + (Sched::SPLITK ? nxt.kb : 0) : cA; const char* nB = has_next ? (const char*)g.Bt + (size_t)nxt.pn * tstep + (Sched::SPLITK ? nxt.kb : 0) : cB;
        const int nt = Sched::SPLITK ? cur.nt : ntf;
        for (int t = 0; t < nt; t += 2) {
            const bool last = (t == nt - 2);
            const char* a1 = cA + (size_t)(t + 1) * kstep;
            const char* a2 = last ? nA : cA + (size_t)(t + 2) * kstep; const char* b2 = last ? nB : cB + (size_t)(t + 2) * kstep;
            const char* a3 = a2 + kstep; const char* b3 = b2 + kstep;
            if (last && has_next) S.a_ready(nxt);
            if constexpr (SP2) {
            PG8_LDB(B0, 0, 0); PG8_LDB(B1, 0, 1); PG8_SCHED; PG8_LDA(At, 0, 0); PG8_STAGE(PG8_SA(1, 1), a1 + hstep, voffA);
            PG8_WAIT_V(8); PG8_WAIT_L(0); PG8_BAR; PG8_MMA(0, 0, At, B0); PG8_MMA(0, 1, At, B1); PG8_BAR; PG8_SCHED;
            PG8_LDA(At, 0, 1); PG8_STAGE(PG8_SB(0, 0), b2, voffB); PG8_STAGE(PG8_SB(0, 1), b2 + hstep, voffB); PG8_STAGE(PG8_SA(0, 0), a2, voffA);
            PG8_WAIT_V(8); PG8_WAIT_L(0); PG8_BAR; PG8_MMA(1, 0, At, B0); PG8_MMA(1, 1, At, B1); PG8_BAR; PG8_SCHED;
            PG8_LDB(B0, 1, 0); PG8_LDB(B1, 1, 1); PG8_SCHED; PG8_LDA(At, 1, 0); PG8_STAGE(PG8_SA(0, 1), a2 + hstep, voffA);
            PG8_WAIT_V(8); PG8_WAIT_L(0); PG8_BAR; PG8_MMA(0, 0, At, B0); PG8_MMA(0, 1, At, B1); PG8_BAR; PG8_SCHED;
            PG8_LDA(At, 1, 1); PG8_STAGE(PG8_SB(1, 0), b3, voffB); PG8_STAGE(PG8_SB(1, 1), b3 + hstep, voffB); PG8_STAGE(PG8_SA(1, 0), a3, voffA);
            PG8_WAIT_V(8); PG8_WAIT_L(0); PG8_BAR; PG8_MMA(1, 0, At, B0); PG8_MMA(1, 1, At, B1); PG8_BAR; PG8_SCHED;
            } else {
            PG8_LDB(B0, 0, 0); PG8_SCHED; PG8_LDA(At, 0, 0); PG8_STAGE(PG8_SA(1, 1), a1 + hstep, voffA);
            PG8_WAIT_L(8); PG8_BAR; PG8_WAIT_L(0); PG8_MMA(0, 0, At, B0); PG8_BAR; PG8_SCHED;
            PG8_LDB(B1, 0, 1); PG8_STAGE(PG8_SB(0, 0), b2, voffB);
            PG8_BAR; PG8_WAIT_L(0); PG8_MMA(0, 1, At, B1); PG8_BAR;
            PG8_LDA(At, 0, 1); PG8_STAGE(PG8_SA(0, 0), a2, voffA);
            PG8_BAR; PG8_WAIT_L(0); PG8_MMA(1, 0, At, B0); PG8_BAR; PG8_SCHED;
            PG8_STAGE(PG8_SB(0, 1), b2 + hstep, voffB);
            PG8_WAIT_V(6); PG8_BAR; PG8_MMA(1, 1, At, B1); PG8_BAR;
            PG8_LDB(B0, 1, 0); PG8_SCHED; PG8_LDA(At, 1, 0); PG8_STAGE(PG8_SA(0, 1), a2 + hstep, voffA);
            PG8_WAIT_L(8); PG8_BAR; PG8_WAIT_L(0); PG8_MMA(0, 0, At, B0); PG8_BAR; PG8_SCHED;
            PG8_LDB(B1, 1, 1); PG8_STAGE(PG8_SB(1, 0), b3, voffB);
            PG8_BAR; PG8_WAIT_L(0); PG8_MMA(0, 1, At, B1); PG8_BAR;
            PG8_LDA(At, 1, 1); PG8_STAGE(PG8_SA(1, 0), a3, voffA);
            PG8_BAR; PG8_WAIT_L(0); PG8_MMA(1, 0, At, B0); PG8_BAR; PG8_SCHED;
            PG8_STAGE(PG8_SB(1, 1), b3 + hstep, voffB);
            PG8_WAIT_V(6); PG8_BAR; PG8_MMA(1, 1, At, B1); PG8_BAR;
            }
        }
        if constexpr (ALIGN_EPI) { if (wr == 0) PG8_BAR; }
        if constexpr (!Epi::AFTER_DRAIN) { E(acc, cur, wr, wc, fr, fq); S.done(cur); }
        if (!has_next) break;
#pragma unroll
        for (int a = 0; a < 2; ++a)
#pragma unroll
            for (int b = 0; b < 2; ++b)
#pragma unroll
                for (int m = 0; m < 4; ++m)
#pragma unroll
                    for (int n = 0; n < 2; ++n) acc[a][b][m][n] = (f32x4){0.f, 0.f, 0.f, 0.f};
        cur = nxt; cA = nA; cB = nB; ++ui;
        if constexpr (ALIGN_EPI) { if (wr == 1) PG8_BAR; }
    }
    PG8_WAIT_V(0);
    if constexpr (!ALIGN_EPI) { if (wr == 0) PG8_BAR; }
    PG8_BAR;
    if constexpr (Epi::AFTER_DRAIN) { E.fused(acc, cur, wr, wc, fr, fq, lds, wid, lane); S.done(cur); }
#undef PG8_SA
#undef PG8_SB
#undef PG8_STAGE
#undef PG8_LDA
#undef PG8_LDB
#undef PG8_MMA
#undef PG8_WAIT_V
#undef PG8_WAIT_L
#undef PG8_BAR
#undef PG8_SCHED
}
}

#ifndef PG8_SP2
#define PG8_SP2 true
#endif
#ifndef PG8_ALIGN
#define PG8_ALIGN true
#endif

namespace att {
using bf16 = unsigned short;
using bf16x8 = __attribute__((ext_vector_type(8))) short;
using s16x4  = __attribute__((ext_vector_type(4))) short;
using f32x16 = __attribute__((ext_vector_type(16))) float;
using u32x4  = __attribute__((ext_vector_type(4))) unsigned;
constexpr int NW = 8, QBLK = 32, KVBLK = 64, DV = 128;
constexpr float THR = 8.f;
constexpr int SHM_V = KVBLK * DV * 2;
constexpr int LDS_WS_OFF = 2 * SHM_V + 2 * (KVBLK * 128 * 2);
constexpr int LDS_BT_OFF = LDS_WS_OFF + NW * 64 * 4;
constexpr int LDS_Q_OFF = LDS_BT_OFF + 2048;
constexpr int LDS_END = LDS_Q_OFF + NW * 8192;
#define ATT_KSWZ128(row, colB) ((row) * 256 + ((colB) ^ (((row) & 7) << 4)))
#define ATT_KSWZ64(row, colB)  ((row) * 128 + ((colB) ^ ((((row) >> 1) & 7) << 4)))
#define ATT_SBAR() __builtin_amdgcn_sched_barrier(0)
__device__ __forceinline__ int crow(int r, int hi) { return (r & 3) + 8 * (r >> 2) + 4 * hi; }
__device__ __forceinline__ unsigned cvtpk(float lo, float hi) { unsigned r; asm volatile("v_cvt_pk_bf16_f32 %0, %1, %2" : "=v"(r) : "v"(lo), "v"(hi)); return r; }
__device__ __forceinline__ bf16x8 ld8(const bf16* p) { return *reinterpret_cast<const bf16x8*>(p); }

template <int DQK> __device__ __forceinline__ void partialSM(f32x16& p0, f32x16& p1, float& m_reg, float& mn, float& alpha) {
  constexpr float SCALE = (DQK == 64) ? 0.125f : 0.088388347648318440f;
  constexpr float C = SCALE * 1.4426950408889634f;
  float pmax = p0[0];
#pragma unroll
  for (int r = 1; r < 16; ++r) pmax = fmaxf(pmax, p0[r]);
#pragma unroll
  for (int r = 0; r < 16; ++r) pmax = fmaxf(pmax, p1[r]);
  { auto rr = __builtin_amdgcn_permlane32_swap(__float_as_uint(pmax), __float_as_uint(pmax), false, false);
    pmax = fmaxf(__uint_as_float(rr[0]), __uint_as_float(rr[1])); }
  if (__builtin_expect(__all(pmax - m_reg <= THR / SCALE), 1)) { mn = m_reg; alpha = 1.f; }
  else { mn = fmaxf(m_reg, pmax); alpha = __builtin_amdgcn_exp2f((m_reg - mn) * C); m_reg = mn; }
  float mnC = -mn * C;
#pragma unroll
  for (int r = 0; r < 16; ++r) p0[r] = fmaf(p0[r], C, mnC);
#pragma unroll
  for (int r = 0; r < 16; ++r) p1[r] = fmaf(p1[r], C, mnC);
#pragma unroll
  for (int r = 0; r < 16; ++r) p0[r] = __builtin_amdgcn_exp2f(p0[r]);
}
__device__ __forceinline__ void finishSM(f32x16& p0, f32x16& p1, float alpha, float& l_reg, bf16x8& pa0, bf16x8& pa1, bf16x8& pa2, bf16x8& pa3) {
#pragma unroll
  for (int r = 0; r < 16; ++r) p1[r] = __builtin_amdgcn_exp2f(p1[r]);
  float ps = 0;
#pragma unroll
  for (int r = 0; r < 16; ++r) ps += p0[r];
#pragma unroll
  for (int r = 0; r < 16; ++r) ps += p1[r];
  { auto rr = __builtin_amdgcn_permlane32_swap(__float_as_uint(ps), __float_as_uint(ps), false, false);
    ps = __uint_as_float(rr[0]) + __uint_as_float(rr[1]); }
  l_reg = l_reg * alpha + ps;
#define ATT_PK4(P, BASE, OUT) do { unsigned a0 = cvtpk(P[BASE + 0], P[BASE + 1]), a1 = cvtpk(P[BASE + 2], P[BASE + 3]);   \
    unsigned b0 = cvtpk(P[BASE + 4], P[BASE + 5]), b1 = cvtpk(P[BASE + 6], P[BASE + 7]);                              \
    auto r0 = __builtin_amdgcn_permlane32_swap(a0, b0, false, false); auto r1 = __builtin_amdgcn_permlane32_swap(a1, b1, false, false); \
    u32x4 w = {r0[0], r1[0], r0[1], r1[1]}; OUT = *reinterpret_cast<bf16x8*>(&w); } while (0)
  ATT_PK4(p0, 0, pa0); ATT_PK4(p0, 8, pa1); ATT_PK4(p1, 0, pa2); ATT_PK4(p1, 8, pa3);
#undef ATT_PK4
}
__device__ __forceinline__ void expSM(f32x16& p) {
#pragma unroll
  for (int r = 0; r < 16; ++r) p[r] = __builtin_amdgcn_exp2f(p[r]);
}
__device__ __forceinline__ void packSM(f32x16& p0, f32x16& p1, float& l_reg, bf16x8& pa0, bf16x8& pa1, bf16x8& pa2, bf16x8& pa3) {
  float ps = 0;
#pragma unroll
  for (int r = 0; r < 16; ++r) ps += p0[r];
#pragma unroll
  for (int r = 0; r < 16; ++r) ps += p1[r];
  l_reg += ps; asm volatile("" : "+v"(l_reg));
#define ATT_PK4(P, BASE, OUT) do { unsigned a0 = cvtpk(P[BASE + 0], P[BASE + 1]), a1 = cvtpk(P[BASE + 2], P[BASE + 3]);   \
    unsigned b0 = cvtpk(P[BASE + 4], P[BASE + 5]), b1 = cvtpk(P[BASE + 6], P[BASE + 7]);                              \
    auto r0 = __builtin_amdgcn_permlane32_swap(a0, b0, false, false); auto r1 = __builtin_amdgcn_permlane32_swap(a1, b1, false, false); \
    u32x4 w = {r0[0], r1[0], r0[1], r1[1]}; OUT = *reinterpret_cast<bf16x8*>(&w); } while (0)
  ATT_PK4(p0, 0, pa0); ATT_PK4(p0, 8, pa1); ATT_PK4(p1, 0, pa2); ATT_PK4(p1, 8, pa3);
#undef ATT_PK4
}
__device__ __forceinline__ void finish_l(float l_reg, float* li_l, int r32, int hi, float (&rli)[16]) {
  { auto rr = __builtin_amdgcn_permlane32_swap(__float_as_uint(l_reg), __float_as_uint(l_reg), false, false); l_reg = __uint_as_float(rr[0]) + __uint_as_float(rr[1]); }
  if (hi == 0) li_l[r32] = l_reg; asm volatile("s_waitcnt lgkmcnt(0)" ::: "memory");
#pragma unroll
  for (int r = 0; r < 16; ++r) rli[r] = __builtin_amdgcn_rcpf(li_l[crow(r, hi)]);
}
template <int DQK, bool QLDS, int KW> __device__ __forceinline__ void qkt(f32x16& p0, f32x16& p1, const char* Ks, const bf16x8* qr, const char* Qs, int r32, int hi, int kcb) {
  p0 = f32x16{}; p1 = f32x16{};
#pragma unroll
  for (int d0 = 0; d0 < DQK / 16; ++d0) { const int cb = (d0 * 16 + hi * 8) * 2;
    bf16x8 b0, b1, qv;
    if constexpr (QLDS) qv = *reinterpret_cast<const bf16x8*>(Qs + ATT_KSWZ128(r32, cb)); else qv = qr[d0];
    if constexpr (KW == 128) { b0 = *reinterpret_cast<const bf16x8*>(Ks + ATT_KSWZ128(r32, kcb + cb)); b1 = *reinterpret_cast<const bf16x8*>(Ks + ATT_KSWZ128(32 + r32, kcb + cb)); }
    else                      { b0 = *reinterpret_cast<const bf16x8*>(Ks + ATT_KSWZ64(r32, cb));  b1 = *reinterpret_cast<const bf16x8*>(Ks + ATT_KSWZ64(32 + r32, cb)); }
    p0 = __builtin_amdgcn_mfma_f32_32x32x16_bf16(b0, qv, p0, 0, 0, 0);
    p1 = __builtin_amdgcn_mfma_f32_32x32x16_bf16(b1, qv, p1, 0, 0, 0); }
}
__device__ __forceinline__ int v_st(int k, int c) { const int kk = (k & ~0xC) | ((k & 4) << 1) | ((k & 8) >> 1); return ((kk >> 3) * 4 + (c >> 5)) * 512 + ((kk & 7) * 32 + (c & 31)) * 2; }
__device__ __forceinline__ int v_rd_base(int lane) { return ((lane & 3) << 3) | (((lane >> 2) & 3) << 6) | (((lane >> 4) & 1) << 5) | (((lane >> 5) & 1) << 8); }
constexpr int v_rd_off(int d0, int ks, int half) { return d0 * 512 + ks * 4096 + half * 2048; }
template <int OFF> __device__ __forceinline__ s16x4 tr_read(int vb) {
  s16x4 r; asm volatile("ds_read_b64_tr_b16 %0, %1 offset:%2" : "=&v"(r) : "v"(vb), "i"(OFF) : "memory"); return r;
}
template <int D0> __device__ __forceinline__ void pv_one(f32x16& od, int vb, bf16x8 pa0, bf16x8 pa1, bf16x8 pa2, bf16x8 pa3) {
  const s16x4 l0 = tr_read<v_rd_off(D0, 0, 0)>(vb), h0 = tr_read<v_rd_off(D0, 0, 1)>(vb), l1 = tr_read<v_rd_off(D0, 1, 0)>(vb), h1 = tr_read<v_rd_off(D0, 1, 1)>(vb);
  const s16x4 l2 = tr_read<v_rd_off(D0, 2, 0)>(vb), h2 = tr_read<v_rd_off(D0, 2, 1)>(vb), l3 = tr_read<v_rd_off(D0, 3, 0)>(vb), h3 = tr_read<v_rd_off(D0, 3, 1)>(vb);
  asm volatile("s_waitcnt lgkmcnt(0)" ::: "memory"); ATT_SBAR();
#define ATT_PK(L, H) (bf16x8){L[0], L[1], L[2], L[3], H[0], H[1], H[2], H[3]}
  od = __builtin_amdgcn_mfma_f32_32x32x16_bf16(pa0, ATT_PK(l0, h0), od, 0, 0, 0);
  od = __builtin_amdgcn_mfma_f32_32x32x16_bf16(pa1, ATT_PK(l1, h1), od, 0, 0, 0);
  od = __builtin_amdgcn_mfma_f32_32x32x16_bf16(pa2, ATT_PK(l2, h2), od, 0, 0, 0);
  od = __builtin_amdgcn_mfma_f32_32x32x16_bf16(pa3, ATT_PK(l3, h3), od, 0, 0, 0);
#undef ATT_PK
}
__device__ __forceinline__ void pv_d0(f32x16* o, int vb, bf16x8 pa0, bf16x8 pa1, bf16x8 pa2, bf16x8 pa3) {
  pv_one<0>(o[0], vb, pa0, pa1, pa2, pa3); pv_one<1>(o[1], vb, pa0, pa1, pa2, pa3); pv_one<2>(o[2], vb, pa0, pa1, pa2, pa3); pv_one<3>(o[3], vb, pa0, pa1, pa2, pa3);
}

#define ATT_TR8(D0, A) do { A##0 = tr_read<v_rd_off(D0, 0, 0)>(vb); A##1 = tr_read<v_rd_off(D0, 0, 1)>(vb); A##2 = tr_read<v_rd_off(D0, 1, 0)>(vb); A##3 = tr_read<v_rd_off(D0, 1, 1)>(vb); \
    A##4 = tr_read<v_rd_off(D0, 2, 0)>(vb); A##5 = tr_read<v_rd_off(D0, 2, 1)>(vb); A##6 = tr_read<v_rd_off(D0, 3, 0)>(vb); A##7 = tr_read<v_rd_off(D0, 3, 1)>(vb); } while (0)
#define ATT_PK2(L, H) (bf16x8){L[0], L[1], L[2], L[3], H[0], H[1], H[2], H[3]}
#define ATT_MM4(OD, A) do { OD = __builtin_amdgcn_mfma_f32_32x32x16_bf16(pa0, ATT_PK2(A##0, A##1), OD, 0, 0, 0); OD = __builtin_amdgcn_mfma_f32_32x32x16_bf16(pa1, ATT_PK2(A##2, A##3), OD, 0, 0, 0); \
    OD = __builtin_amdgcn_mfma_f32_32x32x16_bf16(pa2, ATT_PK2(A##4, A##5), OD, 0, 0, 0); OD = __builtin_amdgcn_mfma_f32_32x32x16_bf16(pa3, ATT_PK2(A##6, A##7), OD, 0, 0, 0); } while (0)
struct VFrag { s16x4 a0, a1, a2, a3, a4, a5, a6, a7, b0, b1, b2, b3, b4, b5, b6, b7; };
__device__ __forceinline__ void pv_issue(VFrag& f, int vb) { ATT_TR8(0, f.a); ATT_TR8(1, f.b); }
__device__ __forceinline__ void pv_pipe(VFrag& f, f32x16* o, int vb, bf16x8 pa0, bf16x8 pa1, bf16x8 pa2, bf16x8 pa3) {
  asm volatile("s_waitcnt lgkmcnt(0)" ::: "memory"); ATT_SBAR(); ATT_MM4(o[0], f.a);
  ATT_SBAR(); ATT_TR8(2, f.a); ATT_SBAR(); ATT_MM4(o[1], f.b);
  ATT_SBAR(); ATT_TR8(3, f.b);
  asm volatile("s_waitcnt lgkmcnt(8)" ::: "memory"); ATT_SBAR(); ATT_MM4(o[2], f.a);
  asm volatile("s_waitcnt lgkmcnt(0)" ::: "memory"); ATT_SBAR(); ATT_MM4(o[3], f.b);
}

struct NoMask { __device__ __forceinline__ void operator()(f32x16&, f32x16&, int) const {} };

template <int DQK, int LDQ, int LDQ2, int LDKV, int SDEPTH, bool DUAL, class TileRow, class Mask>
__device__ __forceinline__ void attn_core(const bf16* __restrict__ Qa, const bf16* __restrict__ Qalt, int nswitch,
                                          const bf16* __restrict__ Kb, const bf16* __restrict__ Vb,
                                          const TileRow& trow, const int NT, const Mask& mask, char* lds, f32x16 (&o)[4], float (&rli)[16]) {
  static_assert(!DUAL || DQK == 64, "DUAL is the differential-attention form");
  constexpr int KW = DUAL ? 128 : DQK;
  constexpr int SHM_K = KVBLK * KW * 2;
  constexpr int NQ = DQK / 16;
  int tid_ = threadIdx.x; asm volatile("" : "+v"(tid_));
  const int tid = tid_, wid = tid >> 6, lane = tid & 63, r32 = lane & 31, hi = lane >> 5;
  const int wq = DUAL ? (wid & 3) : wid, comp = DUAL ? (wid >> 2) : 0, kcb = comp * 128;
  char* V_lds = lds; char* K_lds = lds + 2 * SHM_V;
  float* wsf = (float*)(lds + LDS_WS_OFF) + wid * 64; float* li_l = wsf; float* al_l = wsf + 32;
  float m_reg = -1e30f, l_reg = 0;
#pragma unroll
  for (int d = 0; d < 4; ++d) o[d] = f32x16{};
  constexpr bool QLDS = (DQK == 128);
  char* Qs = lds + LDS_Q_OFF + wid * 8192;
  bf16x8 qr[NQ];
  { const bf16* Qw = Qa + (long)(wq * QBLK + r32) * LDQ + comp * 64 + hi * 8;
#pragma unroll
    for (int d0 = 0; d0 < NQ; ++d0) qr[d0] = ld8(Qw + d0 * 16);
    if constexpr (QLDS) {
#pragma unroll
      for (int d0 = 0; d0 < NQ; ++d0) *reinterpret_cast<bf16x8*>(Qs + ATT_KSWZ128(r32, (d0 * 16 + hi * 8) * 2)) = qr[d0];
      asm volatile("s_waitcnt lgkmcnt(0)" ::: "memory"); } }
  const int sr = tid >> 4, sc = (tid & 15) * 8, vst0 = v_st(sr, sc), vst1 = v_st(32 + sr, sc);
  const int k64r = tid >> 3, k64c = (tid & 7) * 8;
  const unsigned voffV = (unsigned)(sr * LDKV + sc) * 2u, voffK = (KW == 128) ? voffV : (unsigned)(k64r * LDKV + k64c) * 2u;
  const int vb0 = (int)(unsigned)(uintptr_t)V_lds + v_rd_base(lane);
  struct { bf16x8 vs0, vs1, ks0, ks1; } sr_[SDEPTH];
#define ATT_SLOAD(i, jt) do { const long row0_ = (long)__builtin_amdgcn_readfirstlane(trow(jt)); const char* vt_ = (const char*)(Vb + row0_ * LDKV); const char* kt_ = (const char*)(Kb + row0_ * LDKV); \
    sr_[i].vs0 = *(const bf16x8*)(vt_ + voffV); sr_[i].vs1 = *(const bf16x8*)(vt_ + 64 * LDKV + voffV); \
    if constexpr (KW == 128) { sr_[i].ks0 = *(const bf16x8*)(kt_ + voffK); sr_[i].ks1 = *(const bf16x8*)(kt_ + 64 * LDKV + voffK); } \
    else { sr_[i].ks0 = *(const bf16x8*)(kt_ + voffK); } } while (0)
#define ATT_SWRITE(b, i) do { *(bf16x8*)(V_lds + (b) * SHM_V + vst0) = sr_[i].vs0; *(bf16x8*)(V_lds + (b) * SHM_V + vst1) = sr_[i].vs1; \
    if constexpr (KW == 128) { const int kc_ = sc * 2; *(bf16x8*)(K_lds + (b) * SHM_K + ATT_KSWZ128(sr, kc_)) = sr_[i].ks0; *(bf16x8*)(K_lds + (b) * SHM_K + ATT_KSWZ128(32 + sr, kc_)) = sr_[i].ks1; } \
    else { *(bf16x8*)(K_lds + (b) * SHM_K + ATT_KSWZ64(k64r, k64c * 2)) = sr_[i].ks0; } } while (0)
#define ATT_SWAIT() do { if constexpr (SDEPTH == 1) asm volatile("s_waitcnt vmcnt(0)" ::: "memory"); else if constexpr (KW == 128) asm volatile("s_waitcnt vmcnt(4)" ::: "memory"); else asm volatile("s_waitcnt vmcnt(3)" ::: "memory"); } while (0)
#define ATT_RESC(a) do { if (__any((a) < 1.f)) { if (hi == 0) al_l[r32] = (a); asm volatile("s_waitcnt lgkmcnt(0)" ::: "memory"); \
    _Pragma("unroll") for (int d = 0; d < 4; ++d) _Pragma("unroll") for (int r = 0; r < 16; ++r) o[d][r] *= al_l[crow(r, hi)]; } } while (0)
  f32x16 pA0, pA1, pB0, pB1; float mnA, mnB, alA, alB; bf16x8 pa0, pa1, pa2, pa3;
  constexpr int SE = 0, SO = SDEPTH - 1;
  ATT_SLOAD(SE, 0); asm volatile("s_waitcnt vmcnt(0)" ::: "memory"); ATT_SWRITE(0, SE); __syncthreads();
  qkt<DQK, QLDS, KW>(pA0, pA1, K_lds, qr, Qs, r32, hi, kcb); mask(pA0, pA1, 0); partialSM<DQK>(pA0, pA1, m_reg, mnA, alA);
  ATT_SLOAD(SO, 1); if constexpr (SDEPTH == 2) { if (2 < NT) ATT_SLOAD(SE, 2); }
  ATT_SWAIT(); ATT_SWRITE(1, SO); __syncthreads();
  for (int j = 1; j + 1 < NT; j += 2) {
    ATT_SBAR(); qkt<DQK, QLDS, KW>(pB0, pB1, K_lds + SHM_K, qr, Qs, r32, hi, kcb);
    finishSM(pA0, pA1, alA, l_reg, pa0, pa1, pa2, pa3); ATT_SBAR();
    ATT_SLOAD(SO, j + SDEPTH); ATT_SBAR();
    pv_d0(o, vb0, pa0, pa1, pa2, pa3); mask(pB0, pB1, j); partialSM<DQK>(pB0, pB1, m_reg, mnB, alB);
    __syncthreads(); ATT_SWAIT(); ATT_SWRITE(0, SE);
    ATT_RESC(alB); __syncthreads();
    if constexpr (DQK == 64) { if (j + 1 == nswitch) { const bf16* Qw = Qalt + (long)(wq * QBLK + r32) * LDQ2 + comp * 64 + hi * 8;
#pragma unroll
        for (int d0 = 0; d0 < NQ; ++d0) qr[d0] = ld8(Qw + d0 * 16); } }
    ATT_SBAR(); qkt<DQK, QLDS, KW>(pA0, pA1, K_lds, qr, Qs, r32, hi, kcb);
    finishSM(pB0, pB1, alB, l_reg, pa0, pa1, pa2, pa3); ATT_SBAR();
    if (SDEPTH == 1 || j + 3 < NT) ATT_SLOAD(SE, j + 1 + SDEPTH); ATT_SBAR();
    pv_d0(o, vb0 + SHM_V, pa0, pa1, pa2, pa3); mask(pA0, pA1, j + 1); partialSM<DQK>(pA0, pA1, m_reg, mnA, alA);
    __syncthreads(); ATT_SWAIT(); ATT_SWRITE(1, SO);
    ATT_RESC(alA); __syncthreads();
  }
  ATT_SBAR(); qkt<DQK, QLDS, KW>(pB0, pB1, K_lds + SHM_K, qr, Qs, r32, hi, kcb);
  finishSM(pA0, pA1, alA, l_reg, pa0, pa1, pa2, pa3); ATT_SBAR();
  pv_d0(o, vb0, pa0, pa1, pa2, pa3); mask(pB0, pB1, NT - 1); partialSM<DQK>(pB0, pB1, m_reg, mnB, alB);
  __syncthreads(); ATT_RESC(alB);
  finishSM(pB0, pB1, alB, l_reg, pa0, pa1, pa2, pa3); ATT_SBAR();
  pv_d0(o, vb0 + SHM_V, pa0, pa1, pa2, pa3);
  if (hi == 0) li_l[r32] = l_reg; asm volatile("s_waitcnt lgkmcnt(0)" ::: "memory");
#pragma unroll
  for (int r = 0; r < 16; ++r) rli[r] = __builtin_amdgcn_rcpf(li_l[crow(r, hi)]);
#undef ATT_SLOAD
#undef ATT_SWRITE
#undef ATT_SWAIT
#undef ATT_RESC
}

constexpr int DS_V = 0, DS_K = 3 * 16384, DS_WS = 6 * 16384, DS_Q = DS_WS + NW * 64 * 4, DS_END = DS_Q + NW * 4096;
template <int OFF> __device__ __forceinline__ bf16x8 lds_rd128(int addr) { bf16x8 r; asm volatile("ds_read_b128 %0, %1 offset:%2" : "=&v"(r) : "v"(addr), "i"(OFF) : "memory"); return r; }
template <int LDQ, int LDQ2, int LDKV, class TileRow>
__device__ __forceinline__ void attn_dual_stag(const bf16* __restrict__ Qa, const bf16* __restrict__ Qalt, int nswitch,
                                               const bf16* __restrict__ Kb, const bf16* __restrict__ Vb,
                                               const TileRow& trow, const int NT, char* lds, f32x16 (&o)[4], float (&rli)[16]) {
  int tid_ = threadIdx.x; asm volatile("" : "+v"(tid_));
  const int tid = tid_, wid = tid >> 6, lane = tid & 63, r32 = lane & 31, hi = lane >> 5;
  const int wq = wid & 3, g = __builtin_amdgcn_readfirstlane(wid >> 2), kcb = g * 128;
  char* V_lds = lds + DS_V; char* K_lds = lds + DS_K;
  float* wsf = (float*)(lds + DS_WS) + wid * 64; float* li_l = wsf;
  float l_reg = 0;
#pragma unroll
  for (int d = 0; d < 4; ++d) o[d] = f32x16{};
  bf16x8 qr[4];
  char* Qsw = lds + DS_Q + wid * 4096 + lane * 16;
  { const bf16* Qw = Qa + (long)(wq * QBLK + r32) * LDQ + g * 64 + hi * 8;
    const bf16* Qw2 = Qalt + (long)(wq * QBLK + r32) * LDQ2 + g * 64 + hi * 8;
#pragma unroll
    for (int d0 = 0; d0 < 4; ++d0) { qr[d0] = ld8(Qw + d0 * 16); *(bf16x8*)(Qsw + d0 * 1024) = ld8(Qw2 + d0 * 16); } }
  const int tg = tid & 255, sr = 32 * g + (tg >> 4), sc = (tg & 15) * 8;
  const int vst0 = v_st(sr, sc), vst1 = v_st(sr + 16, sc), kst0 = ATT_KSWZ128(sr, sc * 2), kst1 = ATT_KSWZ128(sr + 16, sc * 2);
  const unsigned voff = (unsigned)(sr * LDKV + sc) * 2u;
  const bf16* kbu = (const bf16*)(((unsigned long long)(unsigned)__builtin_amdgcn_readfirstlane((int)((unsigned long long)Kb >> 32)) << 32) | (unsigned)__builtin_amdgcn_readfirstlane((int)(unsigned long long)Kb));
  const int vdelta = __builtin_amdgcn_readfirstlane((int)((const char*)Vb - (const char*)Kb));
  const __amdgpu_buffer_rsrc_t kvrs = __builtin_amdgcn_make_buffer_rsrc((void*)kbu, 0, 0x7fffffff, 0x00020000);
  const int vb0 = (int)(unsigned)(uintptr_t)V_lds + v_rd_base(lane);
  const int kb0 = (int)(unsigned)(uintptr_t)K_lds;
  const int ka0 = kb0 + ATT_KSWZ128(r32, kcb + (0 * 16 + hi * 8) * 2), ka1 = kb0 + ATT_KSWZ128(r32, kcb + (1 * 16 + hi * 8) * 2);
  const int ka2 = kb0 + ATT_KSWZ128(r32, kcb + (2 * 16 + hi * 8) * 2), ka3 = kb0 + ATT_KSWZ128(r32, kcb + (3 * 16 + hi * 8) * 2);
  bf16x8 svA0, svA1, skA0, skA1, svB0, svB1, skB0, skB1;
#define DS_BL(dst, so) asm volatile("buffer_load_dwordx4 %0, %1, %2, %3 offen" : "=v"(dst) : "v"(voff), "s"(kvrs), "s"(so))
#define DS_SLOAD(S, jt) do { const int so_ = __builtin_amdgcn_readfirstlane(trow(jt)) * (LDKV * 2);   \
      \
    DS_BL(sk##S##0, so_); DS_BL(sk##S##1, so_ + 32 * LDKV); DS_BL(sv##S##0, so_ + vdelta); DS_BL(sv##S##1, so_ + vdelta + 32 * LDKV); } while (0)
#define DS_VMW(n) asm volatile("s_waitcnt vmcnt(" #n ")" ::: "memory")
#define DS_SWRITE(S, slot) do { const int so_ = (slot) * 16384; *(bf16x8*)(V_lds + so_ + vst0) = sv##S##0; *(bf16x8*)(V_lds + so_ + vst1) = sv##S##1; *(bf16x8*)(K_lds + so_ + kst0) = sk##S##0; *(bf16x8*)(K_lds + so_ + kst1) = sk##S##1; } while (0)
#define DS_BAR() do { ATT_SBAR(); asm volatile("s_waitcnt lgkmcnt(0)\n\ts_barrier" ::: "memory"); ATT_SBAR(); } while (0)
#define DS_LGKM(n) asm volatile("s_waitcnt lgkmcnt(" #n ")" ::: "memory")
#define DS_KREADS(so) do { const int o_ = (so); kf0 = lds_rd128<0>(ka0 + o_); kf1 = lds_rd128<8192>(ka0 + o_); kf2 = lds_rd128<0>(ka1 + o_); kf3 = lds_rd128<8192>(ka1 + o_); \
    kf4 = lds_rd128<0>(ka2 + o_); kf5 = lds_rd128<8192>(ka2 + o_); kf6 = lds_rd128<0>(ka3 + o_); kf7 = lds_rd128<8192>(ka3 + o_); } while (0)
#define DS_QK() do { p0 = f32x16{}; p1 = f32x16{}; \
    p0 = __builtin_amdgcn_mfma_f32_32x32x16_bf16(kf0, qr[0], p0, 0, 0, 0); p1 = __builtin_amdgcn_mfma_f32_32x32x16_bf16(kf1, qr[0], p1, 0, 0, 0); \
    p0 = __builtin_amdgcn_mfma_f32_32x32x16_bf16(kf2, qr[1], p0, 0, 0, 0); p1 = __builtin_amdgcn_mfma_f32_32x32x16_bf16(kf3, qr[1], p1, 0, 0, 0); \
    p0 = __builtin_amdgcn_mfma_f32_32x32x16_bf16(kf4, qr[2], p0, 0, 0, 0); p1 = __builtin_amdgcn_mfma_f32_32x32x16_bf16(kf5, qr[2], p1, 0, 0, 0); \
    p0 = __builtin_amdgcn_mfma_f32_32x32x16_bf16(kf6, qr[3], p0, 0, 0, 0); p1 = __builtin_amdgcn_mfma_f32_32x32x16_bf16(kf7, qr[3], p1, 0, 0, 0); } while (0)
  DS_SLOAD(A, 0); DS_VMW(0); DS_SWRITE(A, 0); DS_SLOAD(A, 1); DS_VMW(0); DS_SWRITE(A, 1);
  if (g == 1 && 2 < NT) DS_SLOAD(A, 2);
  DS_BAR();
  f32x16 p0, p1; bf16x8 pa0, pa1, pa2, pa3; bf16x8 kf0, kf1, kf2, kf3, kf4, kf5, kf6, kf7;
  if (2 + g < NT) DS_SLOAD(B, 2 + g);
  ATT_SBAR(); DS_KREADS(0); DS_LGKM(0); ATT_SBAR(); DS_QK();
  if (g == 1) DS_BAR();
  int s0 = 0, s1 = 1;
#define DS_TILE(S, k_) do { \
    expSM(p0); expSM(p1); packSM(p0, p1, l_reg, pa0, pa1, pa2, pa3); \
    { const int jt = (k_) + 1 + g; if (jt >= 2 && jt < NT) { if (jt + 1 < NT) DS_VMW(4); else DS_VMW(0); int sl = s1 + g; sl = sl >= 3 ? sl - 3 : sl; DS_SWRITE(S, sl); } } \
    const int vb = vb0 + s0 * 16384; VFrag f; \
    ATT_SBAR(); ATT_TR8(0, f.a); ATT_TR8(1, f.b); ATT_SBAR(); \
    if (g == 0) DS_BAR(); \
    { const int jt = (k_) + 3 + g; if (jt < NT) DS_SLOAD(S, jt); } \
    if ((k_) + 1 == nswitch) { \
      _Pragma("unroll") for (int d0 = 0; d0 < 4; ++d0) qr[d0] = *(const bf16x8*)(Qsw + d0 * 1024); \
      asm volatile("s_waitcnt lgkmcnt(0)" ::: "memory"); } \
    ATT_SBAR(); \
    __builtin_amdgcn_s_setprio(1); DS_KREADS(s1 * 16384); \
    DS_LGKM(8); ATT_SBAR(); ATT_MM4(o[0], f.a); ATT_MM4(o[1], f.b); \
    ATT_SBAR(); DS_LGKM(0); ATT_SBAR(); \
    if ((k_) + 1 < NT) DS_QK(); \
    ATT_SBAR(); ATT_TR8(2, f.a); ATT_TR8(3, f.b); \
    DS_LGKM(8); ATT_SBAR(); ATT_MM4(o[2], f.a); \
    DS_LGKM(0); ATT_SBAR(); ATT_MM4(o[3], f.b); __builtin_amdgcn_s_setprio(0); \
    if (g == 1 && (k_) + 1 < NT) DS_BAR(); \
    s0 = s1; s1 = s1 == 2 ? 0 : s1 + 1; } while (0)
#pragma clang loop unroll(disable)
  for (int k = 0; k < NT; k += 2) { DS_TILE(A, k); DS_TILE(B, k + 1); }
#undef DS_TILE
  finish_l(l_reg, li_l, r32, hi, rli);
#undef DS_SLOAD
#undef DS_BL
#undef DS_VMW
#undef DS_SWRITE
#undef DS_BAR
#undef DS_LGKM
#undef DS_KREADS
#undef DS_QK
}
}

constexpr int DM = 2048, NBATCH = 2, SEQ = 8192, DEPTH = 4, CTXL = 256;
constexpr int ML = NBATCH * SEQ;
constexpr int MC = NBATCH * CTXL;
constexpr int MT = ML + MC;
constexpr int EV_IN = 5120;
constexpr int EVN = 4608 + 1024;
constexpr int ODN = 6144;
constexpr int FH = 5632;
constexpr int NPH = 1 + 8 * DEPTH;
#ifndef PHM
#define PHM 1023
#endif
#ifndef MXM
#define MXM 15
#endif
#ifndef MK_N_LAUNCHES
#define MK_N_LAUNCHES 1
#endif
constexpr float LAM_INIT0 = 0.2f, LAM_INIT1 = 0.47071301834370415f;

constexpr size_t MiB = 1u << 20;
constexpr size_t WS_CTL = 0, CTL_ZERO_BYTES = 1 * MiB;
constexpr size_t WS_MODV = 1 * MiB;
constexpr size_t WS_ROPE = 2 * MiB;
constexpr size_t WS_LAM = 2 * MiB + 64 * 1024;
constexpr size_t WS_FA1 = 2 * MiB + 128 * 1024;
constexpr size_t WS_FA2 = 2 * MiB + 192 * 1024;
constexpr size_t WS_FA3 = 2 * MiB + 256 * 1024;
constexpr size_t WS_WIN_E = 4 * MiB,  SZ_WIN_E = 22 * MiB;
constexpr size_t WS_WOUT_E = WS_WIN_E + 2 * SZ_WIN_E, SZ_WOUT = 8 * MiB;
constexpr size_t WS_WIN_O = WS_WOUT_E + 2 * SZ_WOUT, SZ_WIN_O = 24 * MiB;
constexpr size_t WS_WOUT_O = WS_WIN_O + 2 * SZ_WIN_O;
constexpr size_t WS_WFI = WS_WOUT_O + 2 * SZ_WOUT, SZ_WFI = 44 * MiB;
constexpr size_t WS_WFO = WS_WFI + 4 * SZ_WFI, SZ_WFO = 22 * MiB;
constexpr size_t WS_A = WS_WFO + 4 * SZ_WFO;
constexpr size_t WS_P = WS_A + 66 * MiB;
constexpr size_t WS_QR = WS_P + 198 * MiB;
constexpr size_t WS_MIX = WS_QR + 48 * MiB;
constexpr size_t WS_HID = WS_MIX + 66 * MiB;
constexpr size_t WS_HC = WS_HID + 182 * MiB;
constexpr size_t WS_STASH = WS_HC + 4 * MiB;
constexpr size_t WS_SLAB = WS_STASH + 128 * MiB;
constexpr size_t WS_END = WS_SLAB + 48 * MiB;
static_assert(WS_A == 392 * MiB && WS_END == 1132 * MiB, "d_ws map");
constexpr int CW_BAR = 4096;

constexpr int GEN_BYTES = 143360;
constexpr int MISC_OFF = GEN_BYTES;
constexpr int LDS_BYTES = 147456;

#define GAS __attribute__((address_space(1)))
#define LAS __attribute__((address_space(3)))
typedef unsigned short bf16;
typedef unsigned v4u __attribute__((ext_vector_type(4)));
typedef unsigned v2u __attribute__((ext_vector_type(2)));
typedef float f32x4 __attribute__((ext_vector_type(4)));
typedef short bf16x8 __attribute__((ext_vector_type(8)));
typedef GAS unsigned gu32;
#define RLX_AGENT __ATOMIC_RELAXED, __HIP_MEMORY_SCOPE_AGENT
#define LDS_WAIT() asm volatile("s_waitcnt lgkmcnt(0)" ::: "memory")
#define VM_WAIT() asm volatile("s_waitcnt vmcnt(0)" ::: "memory")
__device__ __forceinline__ unsigned f2bf(float f) { unsigned u = __builtin_bit_cast(unsigned, f); return (u + 0x7fffu + ((u >> 16) & 1u)) >> 16; }
__device__ __forceinline__ unsigned pk2(float lo, float hi) { return f2bf(lo) | (f2bf(hi) << 16); }
__device__ __forceinline__ float bflo(unsigned w) { return __uint_as_float(w << 16); }
__device__ __forceinline__ float bfhi(unsigned w) { return __uint_as_float(w & 0xffff0000u); }
__device__ __forceinline__ float hw_cos(float rev) { return __builtin_amdgcn_cosf(rev); }
__device__ __forceinline__ float hw_sin(float rev) { return __builtin_amdgcn_sinf(rev); }
#define XB_TMO      128
#define XB_XCNT(j)  (256  + 64 * (j))
#define XB_XSUB(j)  (1280 + 64 * (j))
#define XB_XGEN(j)  (2304 + 64 * (j))
#define XB_TOP      3328
#define XB_TOPGEN   3392
#define XCD_BAR_WORDS 3456
#define XB_SPIN_CAP (1u << 18)

__device__ __forceinline__ unsigned xb_ld(unsigned* p)              { return __hip_atomic_load(p, __ATOMIC_RELAXED, __HIP_MEMORY_SCOPE_AGENT); }
__device__ __forceinline__ unsigned xb_add(unsigned* p, unsigned v) { return __hip_atomic_fetch_add(p, v, __ATOMIC_RELAXED, __HIP_MEMORY_SCOPE_AGENT); }
__device__ __forceinline__ unsigned xb_xcc_id() { return (unsigned)__builtin_amdgcn_s_getreg((3 << 11) | 20) & 0xFu; }
#define XB_SPIN(cond, bar) do { unsigned _sp = 0; while (cond) { __builtin_amdgcn_s_sleep(1); \
    if ((++_sp & 255u) == 0u) { if (xb_ld(&(bar)[XB_TMO])) break; if (_sp > XB_SPIN_CAP) { atomicAdd(&(bar)[XB_TMO], 1u); break; } } } } while (0)

struct XcdBarrier {
    unsigned* bar; unsigned x;
    volatile LAS unsigned* st;
};

__device__ __forceinline__ XcdBarrier xcd_barrier_post(unsigned* bar, volatile LAS unsigned* st) {
    XcdBarrier b; b.bar = bar; b.x = xb_xcc_id(); b.st = st;
    if (threadIdx.x == 0) (void)xb_add(&bar[XB_XCNT(b.x)], 1u);
    return b;
}
__device__ __forceinline__ void xcd_barrier_complete(unsigned* bar, unsigned x, unsigned& nloc, unsigned& nx) {
    const unsigned G = gridDim.x * gridDim.y * gridDim.z;
    unsigned sum, cnt, mine, sp = 0u;
    for (;;) {
        sum = 0u; cnt = 0u; mine = 0u;
#pragma unroll
        for (unsigned j = 0; j < 16; ++j) { const unsigned c = xb_ld(&bar[XB_XCNT(j)]); sum += c; cnt += (c > 0u) ? 1u : 0u; mine = (j == x) ? c : mine; }
        if (sum == G) break;
        __builtin_amdgcn_s_sleep(1);
        if ((++sp & 255u) == 0u) { if (xb_ld(&bar[XB_TMO])) break; if (sp > XB_SPIN_CAP) { atomicAdd(&bar[XB_TMO], 1u); break; } }
    }
    nloc = mine > 0u ? mine : 1u; nx = cnt > 0u ? cnt : 1u;
}

__device__ __forceinline__ void xcd_barrier(const XcdBarrier& b) {
    asm volatile("s_waitcnt vmcnt(0)" ::: "memory");
    __syncthreads();
    if (threadIdx.x == 0) {
        unsigned* bar = b.bar;
        __builtin_amdgcn_s_waitcnt(0);
        unsigned nloc = b.st[0], nx = b.st[1];
        if (nloc == 0u) { xcd_barrier_complete(bar, b.x, nloc, nx); b.st[0] = nloc; b.st[1] = nx; }
        const unsigned old = xb_add(&bar[XB_XSUB(b.x)], 1u);
        const unsigned gen = old / nloc;
        if (old + 1u == (gen + 1u) * nloc) {
            __builtin_amdgcn_fence(__ATOMIC_RELEASE, "agent");
            asm volatile("s_waitcnt vmcnt(0)" ::: "memory");
            const unsigned og = xb_add(&bar[XB_TOP], 1u);
            const unsigned tg = og / nx;
            if (og + 1u == (tg + 1u) * nx) xb_add(&bar[XB_TOPGEN], 1u);
            else XB_SPIN(xb_ld(&bar[XB_TOPGEN]) == tg, bar);
            __builtin_amdgcn_fence(__ATOMIC_ACQUIRE, "agent");
            xb_add(&bar[XB_XGEN(b.x)], 1u);
            asm volatile("s_waitcnt vmcnt(0)" ::: "memory");
        } else {
            XB_SPIN(xb_ld(&bar[XB_XGEN(b.x)]) == gen, bar);
            __builtin_amdgcn_fence(__ATOMIC_ACQUIRE, "agent");
            asm volatile("s_waitcnt vmcnt(0)" ::: "memory");
        }
    }
    __syncthreads();
}

struct Args { const float* in[19]; float* out; unsigned char* ws; int ph_lo, ph_hi; };
typedef const __attribute__((address_space(4))) Args* ArgsP;
struct Frame {
    LAS unsigned char* lds; unsigned char* ldsg;
    volatile LAS unsigned* MISC;
    gu32* ctl;
    int tid, lane, wave, vcu, G;
    ArgsP ap; GAS float* out; GAS unsigned char* ws;
};
#define INP(F, k) ((const float*)(const GAS float*)(F).ap->in[k])
#define WSP(F) ((unsigned char*)(F).ws)
#define OUTP(F) ((float*)(F).out)
__device__ __forceinline__ Frame site(const Frame& F0) {
    Frame F = F0;
    int t = threadIdx.x; asm volatile("" : "+v"(t)); F.tid = t; F.lane = t & 63; F.wave = __builtin_amdgcn_readfirstlane(t >> 6);
    GAS unsigned char* w = F0.ws; asm volatile("" : "+s"(w)); F.ws = w;
    GAS float* o = F0.out; asm volatile("" : "+s"(o)); F.out = o;
    ArgsP a = F0.ap; asm volatile("" : "+s"(a)); F.ap = a;
    return F;
}
__device__ __forceinline__ float wave_sum(float v) {
#pragma unroll
    for (int o = 1; o < 64; o <<= 1) v += __shfl_xor(v, o);
    return v;
}

__device__ __forceinline__ void p0_modvec(Frame& F) {
    LAS float* sv = (LAS float*)F.lds;
    LAS float* red = (LAS float*)(F.lds + 24576);
    const float* c = INP(F, 1); const float* cctx = INP(F, 3); const float* wmod = INP(F, 4); const float* bmod = INP(F, 5);
    float* modv = (float*)(WSP(F) + WS_MODV);
    bool have = false;
    for (int it = blockIdx.x; it < 4 * 48; it += F.G) {
        if (!have) {
            for (int idx = F.tid; idx < 3 * DM; idx += 512) { const int g = idx >> 11, k = idx & 2047; const float v = g < 2 ? c[g * DM + k] : cctx[k]; sv[idx] = v / (1.0f + __expf(-v)); }
            __syncthreads(); have = true;
        }
        const int li = it / 48, ch = it % 48;
        const float* wp = wmod + ((size_t)li * DM + F.wave * 256) * 12288 + ch * 256 + F.lane * 4;
        f32x4 a0 = {0.f, 0.f, 0.f, 0.f}, a1 = a0, a2 = a0;
#pragma unroll 8
        for (int k = 0; k < 256; ++k) {
            const f32x4 w = *(const f32x4*)(wp + (size_t)k * 12288);
            const float s0 = sv[F.wave * 256 + k], s1 = sv[DM + F.wave * 256 + k], s2 = sv[2 * DM + F.wave * 256 + k];
            a0 += w * s0; a1 += w * s1; a2 += w * s2;
        }
        *(LAS f32x4*)(red + (F.wave * 3 + 0) * 256 + F.lane * 4) = a0;
        *(LAS f32x4*)(red + (F.wave * 3 + 1) * 256 + F.lane * 4) = a1;
        *(LAS f32x4*)(red + (F.wave * 3 + 2) * 256 + F.lane * 4) = a2;
        __syncthreads();
        for (int t = F.tid; t < 768; t += 512) { const int g = t >> 8, cc = t & 255; float s = bmod[li * 12288 + ch * 256 + cc];
#pragma unroll
            for (int w = 0; w < 8; ++w) s += red[(w * 3 + g) * 256 + cc];
            modv[(size_t)(li * 3 + g) * 12288 + ch * 256 + cc] = s; }
        __syncthreads();
    }
}
__device__ __forceinline__ void p0_tables(Frame& F) {
    const int gt = blockIdx.x * 512 + F.tid, NTH = F.G * 512;
    float* rope = (float*)(WSP(F) + WS_ROPE); float* lam = (float*)(WSP(F) + WS_LAM);
    bf16* fa1 = (bf16*)(WSP(F) + WS_FA1); bf16* fa2 = (bf16*)(WSP(F) + WS_FA2); bf16* fa3 = (bf16*)(WSP(F) + WS_FA3);
    for (int idx = gt; idx < 2048; idx += NTH) { const int pos = idx >> 4, f = idx & 15;
        const float inv = exp2f(-(float)f * (13.287712379549449f / 16.0f)); const float rev = (float)pos * inv * 0.15915494309189535f; const float fr = rev - floorf(rev);
        rope[idx * 2] = hw_cos(fr); rope[idx * 2 + 1] = hw_sin(fr); }
    for (int idx = gt; idx < 128 * 128; idx += NTH) { const int m = idx >> 7, k = idx & 127, rp = m >> 6, k1 = m & 63, ri = k >> 6, t1 = k & 63;
        const float ph = (float)((k1 * t1) & 63) * (1.0f / 64.0f); const float cs = hw_cos(ph), sn = hw_sin(ph);
        const float v = rp == 0 ? (ri == 0 ? cs : -sn) : (ri == 0 ? -sn : -cs); fa1[idx] = (bf16)f2bf(v); }
    for (int idx = gt; idx < 128 * 256; idx += NTH) { const int k2 = idx >> 8, k = idx & 255, ri = k >> 7, t2 = k & 127;
        const float ph = (float)((k2 * t2) & 127) * (1.0f / 128.0f); const float v = ri == 0 ? hw_cos(ph) : hw_sin(ph); fa2[idx] = (bf16)f2bf(v); }
    for (int idx = gt; idx < 256 * 512; idx += NTH) { const int kk = idx >> 9, k = idx & 511, ri = k >> 8, t = k & 255;
        const float ph = (float)((kk * t) & 255) * (1.0f / 256.0f); const float v = ri == 0 ? hw_cos(ph) : -hw_sin(ph); fa3[idx] = (bf16)f2bf(v); }
    if (gt < 2) { const float* lv = INP(F, 12) + gt * 256; float s01 = 0.f, s23 = 0.f;
        for (int d = 0; d < 64; ++d) { s01 += lv[d] * lv[64 + d]; s23 += lv[128 + d] * lv[192 + d]; }
        lam[gt] = __expf(s01) - __expf(s23) + (gt == 0 ? LAM_INIT0 : LAM_INIT1); }
}
__device__ __forceinline__ void p0_copy_ctx(Frame& F) {
    const f32x4* src = (const f32x4*)INP(F, 2); f32x4* dst = (f32x4*)(WSP(F) + WS_HC);
    for (int i = blockIdx.x * 512 + F.tid; i < MC * DM / 4; i += F.G * 512) dst[i] = src[i];
}
__device__ __forceinline__ void p0_fold(Frame& F) {
    LAS unsigned char* Wl = F.lds;
    LAS unsigned char* Tl = F.lds + 64 * 272;
    const int lane = F.lane, l15 = lane & 15, lq = lane >> 4;
    bool have_t = false;
    for (int it = blockIdx.x; it < 256; it += F.G) {
        const int j = it >> 7, g = (it >> 5) & 3, k0 = (it & 31) * 64;
        const float* W = INP(F, 9) + (size_t)j * DM * EV_IN;
        bf16* Bt = (bf16*)(WSP(F) + WS_WIN_E + (size_t)j * SZ_WIN_E);
        if (!have_t) { have_t = true;
            for (int idx = F.tid; idx < 256 * 128; idx += 512) { const int n = idx >> 7, cc = idx & 127, cp = n >> 1, ri = n & 1; const float ph = (float)((cc * cp) & 127) * (1.0f / 128.0f);
                *(LAS bf16*)(Tl + n * 272 + cc * 2) = (bf16)f2bf(ri ? hw_sin(ph) : hw_cos(ph)); } }
        for (int idx = F.tid; idx < 64 * 128; idx += 512) { const int r = idx >> 7, cc = idx & 127; *(LAS bf16*)(Wl + r * 272 + cc * 2) = (bf16)f2bf(W[(size_t)(k0 + r) * EV_IN + 4608 + g * 128 + cc]); }
        __syncthreads();
#pragma unroll 1
        for (int ni = 0; ni < 2; ++ni) { const int nt = F.wave * 2 + ni;
            bf16x8 bfr[4];
#pragma unroll
            for (int ks = 0; ks < 4; ++ks) bfr[ks] = *(const LAS bf16x8*)(Tl + (16 * nt + l15) * 272 + (32 * ks + 8 * lq) * 2);
#pragma unroll
            for (int mt = 0; mt < 4; ++mt) { f32x4 acc = {0.f, 0.f, 0.f, 0.f};
#pragma unroll
                for (int ks = 0; ks < 4; ++ks) { const bf16x8 af = *(const LAS bf16x8*)(Wl + (16 * mt + l15) * 272 + (32 * ks + 8 * lq) * 2); acc = __builtin_amdgcn_mfma_f32_16x16x32_bf16(af, bfr[ks], acc, 0, 0, 0); }
                v2u o; o.x = pk2(acc[0], acc[1]); o.y = pk2(acc[2], acc[3]);
                *(v2u*)(Bt + (size_t)(4608 + g * 256 + 16 * nt + l15) * DM + k0 + 16 * mt + 4 * lq) = o; } }
        __syncthreads();
    }
}
__device__ __forceinline__ void p0_transpose_item(const float* W, int K, int pitch, int ncols, bf16* WT, int mode, LAS float* scr, int item, int lane) {
    const int nblk = ncols / 32, kb = item / nblk, nb = item % nblk, k0 = 64 * kb, n0 = 32 * nb;
    float wv[32];
    const float* wp = W + (size_t)(k0 + (lane >> 5)) * pitch + n0 + (lane & 31);
#pragma unroll
    for (int i = 0; i < 32; ++i) wv[i] = __builtin_nontemporal_load(wp + (size_t)(2 * i) * pitch);
#pragma unroll
    for (int i = 0; i < 32; ++i) scr[(2 * i + (lane >> 5)) * 33 + (lane & 31)] = wv[i];
    LDS_WAIT(); asm volatile("" ::: "memory");
    int d0 = n0;
    if (mode == 1) { const int c = n0 < FH ? n0 : n0 - FH; d0 = (c >> 7) * 256 + (c & 127) + (n0 < FH ? 0 : 128); }
    const int c8 = lane & 7;
#pragma unroll
    for (int j = 0; j < 4; ++j) { const int n = (lane >> 3) + 8 * j; const LAS float* s = scr + (8 * c8) * 33 + n;
        v4u o; o.x = pk2(s[0 * 33], s[1 * 33]); o.y = pk2(s[2 * 33], s[3 * 33]); o.z = pk2(s[4 * 33], s[5 * 33]); o.w = pk2(s[6 * 33], s[7 * 33]);
        *(GAS v4u*)(WT + (size_t)(d0 + n) * K + k0 + 8 * c8) = o; }
    LDS_WAIT(); asm volatile("" ::: "memory");
}
constexpr int WQ_EVI = 32 * 144, WQ_ODI = 32 * 192, WQ_OUT = 32 * 64, WQ_FI = 32 * 352, WQ_FO = 88 * 64;
constexpr int WQ_LE = WQ_EVI + WQ_OUT + WQ_FI + WQ_FO, WQ_LO = WQ_ODI + WQ_OUT + WQ_FI + WQ_FO, WQ_N = 2 * (WQ_LE + WQ_LO);
static_assert(WQ_LE == 23552 && WQ_LO == 25088 && WQ_N == 97280, "weight queue sizes");
__device__ __forceinline__ void wq_item(Frame& F, int q, LAS float* scr) {
    int li = 0, r = q;
    if (r >= WQ_LE) { r -= WQ_LE; li = 1; if (r >= WQ_LO) { r -= WQ_LO; li = 2; if (r >= WQ_LE) { r -= WQ_LE; li = 3; } } }
    const int lj = li >> 1; const bool odd = li & 1; const int nin = odd ? WQ_ODI : WQ_EVI;
    if (r < nin) {
        if (odd) p0_transpose_item(INP(F, 14) + (size_t)lj * DM * ODN, DM, ODN, ODN, (bf16*)(WSP(F) + WS_WIN_O + (size_t)lj * SZ_WIN_O), 0, scr, r, F.lane);
        else     p0_transpose_item(INP(F, 9) + (size_t)lj * DM * EV_IN, DM, EV_IN, 4608, (bf16*)(WSP(F) + WS_WIN_E + (size_t)lj * SZ_WIN_E), 0, scr, r, F.lane);
        return; }
    r -= nin;
    if (r < WQ_OUT) { p0_transpose_item(INP(F, odd ? 15 : 10) + (size_t)lj * DM * DM, DM, DM, DM, (bf16*)(WSP(F) + (odd ? WS_WOUT_O : WS_WOUT_E) + (size_t)lj * SZ_WOUT), 0, scr, r, F.lane); return; }
    r -= WQ_OUT;
    if (r < WQ_FI) { p0_transpose_item(INP(F, 7) + (size_t)li * DM * 2 * FH, DM, 2 * FH, 2 * FH, (bf16*)(WSP(F) + WS_WFI + (size_t)li * SZ_WFI), 1, scr, r, F.lane); return; }
    r -= WQ_FI;
    p0_transpose_item(INP(F, 8) + (size_t)li * FH * DM, FH, DM, DM, (bf16*)(WSP(F) + WS_WFO + (size_t)li * SZ_WFO), 0, scr, r, F.lane);
}
__device__ const int WQ_TAIL[8] = {23552, 28928, 39680, 52992, 63744, 69120, 79872, 93184};
__device__ __forceinline__ void p0_weights(Frame& F) {
    LAS float* scr = (LAS float*)(F.lds + F.wave * 16384);
    const int gw = F.vcu * 8 + F.wave, NGW = F.G * 8;
    if (F.G != 256) { for (int q = gw; q < WQ_N; q += NGW) wq_item(F, q, scr); return; }
    constexpr int NP = WQ_LE + (WQ_N - 93184);
    for (int i = gw; i < NP; i += NGW) wq_item(F, i < WQ_LE ? i : 93184 + (i - WQ_LE), scr);
}
__device__ __forceinline__ void wq_tail(Frame& F, int t, int units) {
    const int rem = units % F.G; const int c = (int)blockIdx.x;
    if (F.G != 256 || rem == 0 || c < rem) return;
    LAS float* scr = (LAS float*)(F.lds + F.wave * 16384);
    const int nw = (F.G - rem) * 8, wr = (c - rem) * 8 + F.wave; const int qb = WQ_TAIL[t], qe = WQ_TAIL[t + 1];
    for (int i = 0; i < 8; ++i) { const int q = qb + wr + i * nw; if (q < qe) wq_item(F, q, scr); }
}

__device__ __forceinline__ void norm_phase(Frame& F, int li, int which, const float* hl, float* hcx, int red_ks, const float* red_gate) {
    const float* gain = INP(F, 6) + (size_t)(li * 2 + which) * DM;
    const float* modv = (const float*)(WSP(F) + WS_MODV) + (size_t)li * 3 * 12288;
    bf16* A = (bf16*)(WSP(F) + WS_A);
    LAS float* Gv = (LAS float*)F.lds; LAS float* Sv = Gv + 3 * DM;
    for (int i = F.tid; i < 3 * DM; i += 512) { const int grp = i >> 11, d = i & (DM - 1); const float* sh = modv + grp * 12288 + (which * 3) * DM;
        Gv[i] = gain[d] * (1.0f + sh[DM + d]); Sv[i] = sh[d]; }
    __syncthreads();
    const int gw = F.vcu * 8 + F.wave, NGW = F.G * 8; const int lane = F.lane;
    int r = gw;
    for (; r + 3 * NGW < ML; r += 4 * NGW) {
        f32x4 v[4][8]; float q[4] = {0.f, 0.f, 0.f, 0.f};
#pragma unroll
        for (int i = 0; i < 4; ++i) { const float* sp = hl + (size_t)(r + i * NGW) * DM + 4 * lane;
#pragma unroll
            for (int j = 0; j < 8; ++j) v[i][j] = *(const f32x4*)(sp + 256 * j); }
#pragma unroll
        for (int i = 0; i < 4; ++i)
#pragma unroll
            for (int j = 0; j < 8; ++j) q[i] += (v[i][j].x * v[i][j].x + v[i][j].y * v[i][j].y) + (v[i][j].z * v[i][j].z + v[i][j].w * v[i][j].w);
#pragma unroll
        for (int i = 0; i < 4; ++i) { const int ri = r + i * NGW; const float rs = rsqrtf(wave_sum(q[i]) * (1.0f / DM) + 1e-6f); const int go = (ri < SEQ ? 0 : 1) * DM;
#pragma unroll
            for (int j = 0; j < 8; ++j) { const int d = 4 * lane + 256 * j;
                const f32x4 a = v[i][j] * rs * *(const LAS f32x4*)(Gv + go + d) + *(const LAS f32x4*)(Sv + go + d);
                v2u o; o.x = pk2(a.x, a.y); o.y = pk2(a.z, a.w);
                *(v2u*)(A + (size_t)ri * DM + d) = o; } }
    }
    for (; r < MT; r += NGW) {
        const float* src = r < ML ? hl + (size_t)r * DM : hcx + (size_t)(r - ML) * DM;
        const int go = (r < SEQ ? 0 : (r < ML ? 1 : 2)) * DM;
        f32x4 v[8]; float ss = 0.f;
#pragma unroll
        for (int j = 0; j < 8; ++j) v[j] = *(const f32x4*)(src + 4 * lane + 256 * j);
        if (r >= ML && red_ks > 0) {
            const float* sl = (const float*)(WSP(F) + WS_SLAB) + (size_t)(r - ML) * DM + 4 * lane;
#pragma unroll
            for (int j = 0; j < 8; j += 2) { f32x4 t0[11], t1[11];
#pragma unroll
                for (int k = 0; k < 11; ++k) { const bool on = k < red_ks; const size_t ko = (size_t)(on ? k : 0) * (MC * DM);
                    t0[k] = *(const f32x4*)(sl + ko + 256 * j); t1[k] = *(const f32x4*)(sl + ko + 256 * (j + 1)); }
                f32x4 s0 = t0[0], s1 = t1[0];
#pragma unroll
                for (int k = 1; k < 11; ++k) if (k < red_ks) { s0 += t0[k]; s1 += t1[k]; }
                v[j] += *(const f32x4*)(red_gate + 4 * lane + 256 * j) * s0; v[j + 1] += *(const f32x4*)(red_gate + 4 * lane + 256 * (j + 1)) * s1;
                *(f32x4*)(hcx + (size_t)(r - ML) * DM + 4 * lane + 256 * j) = v[j]; *(f32x4*)(hcx + (size_t)(r - ML) * DM + 4 * lane + 256 * (j + 1)) = v[j + 1]; }
        }
#pragma unroll
        for (int j = 0; j < 8; ++j) ss += (v[j].x * v[j].x + v[j].y * v[j].y) + (v[j].z * v[j].z + v[j].w * v[j].w);
        const float rstd = rsqrtf(wave_sum(ss) * (1.0f / DM) + 1e-6f);
#pragma unroll
        for (int j = 0; j < 8; ++j) { const int d = 4 * lane + 256 * j;
            const f32x4 a = v[j] * rstd * *(const LAS f32x4*)(Gv + go + d) + *(const LAS f32x4*)(Sv + go + d);
            v2u o; o.x = pk2(a.x, a.y); o.y = pk2(a.z, a.w);
            *(v2u*)(A + (size_t)r * DM + d) = o; }
    }
    __syncthreads();
}

__device__ __forceinline__ void prep_even_row(bf16* P, bf16* QR, int r, bool lat, int lane, const v4u (&w6)[6], const f32x4 (&rw)[4], const float (&g0)[8], const float (&g1)[8]) {
    float cs[8], sn[8];
#pragma unroll
    for (int e = 0; e < 8; e += 2) { cs[e] = lat ? rw[e >> 1].x : 1.f; sn[e] = lat ? rw[e >> 1].y : 0.f; cs[e + 1] = lat ? rw[e >> 1].z : 1.f; sn[e + 1] = lat ? rw[e >> 1].w : 0.f; }
    bf16* prow = P + (size_t)r * EVN;
#pragma unroll
    for (int j = 0; j < 6; ++j) {
        const int ch = j * 64 + lane; const v4u w = w6[j];
        float x[8] = {bflo(w.x), bfhi(w.x), bflo(w.y), bfhi(w.y), bflo(w.z), bfhi(w.z), bflo(w.w), bfhi(w.w)};
        float ss = 0.f;
#pragma unroll
        for (int e = 0; e < 8; ++e) ss += x[e] * x[e];
        ss += __shfl_xor(ss, 1); ss += __shfl_xor(ss, 2); ss += __shfl_xor(ss, 4);
        const float rstd = rsqrtf(ss * (1.0f / 64.0f) + 1e-6f);
        float y[8], yr[8];
#pragma unroll
        for (int e = 0; e < 8; ++e) y[e] = x[e] * rstd * (j < 3 ? g0[e] * 0.18033688011112042f : g1[e]);
#pragma unroll
        for (int e = 0; e < 8; ++e) { const float yp = __shfl_xor(y[e], 2); yr[e] = (lane & 2) ? (y[e] * cs[e] + yp * sn[e]) : (y[e] * cs[e] - yp * sn[e]); }
        v4u on, orr;
        on.x = pk2(y[0], y[1]); on.y = pk2(y[2], y[3]); on.z = pk2(y[4], y[5]); on.w = pk2(y[6], y[7]);
        orr.x = pk2(yr[0], yr[1]); orr.y = pk2(yr[2], yr[3]); orr.z = pk2(yr[4], yr[5]); orr.w = pk2(yr[6], yr[7]);
        if (j < 3) { *(v4u*)(prow + ch * 8) = on; if (lat) *(v4u*)(QR + (size_t)r * 1536 + ch * 8) = orr; }
        else       { *(v4u*)(prow + ch * 8) = lat ? orr : on; }
    }
}
__device__ __forceinline__ void prep_even(Frame& F, int lj) {
    bf16* P = (bf16*)(WSP(F) + WS_P); bf16* QR = (bf16*)(WSP(F) + WS_QR);
    const float* gq = INP(F, 11) + (size_t)lj * 128; const float* rope = (const float*)(WSP(F) + WS_ROPE);
    const int gw = F.vcu * 8 + F.wave, NGW = F.G * 8; const int lane = F.lane;
    const int d0 = (lane & 7) * 8;
    float g0[8], g1[8];
#pragma unroll
    for (int e = 0; e < 8; ++e) { g0[e] = gq[d0 + e]; g1[e] = gq[64 + d0 + e]; }
    for (int r = gw; r < MT; r += 2 * NGW) {
        const int r1 = r + NGW; const bool has1 = r1 < MT; const int r1c = has1 ? r1 : r;
        v4u wa[6], wb[6]; f32x4 ra[4], rb[4];
        const int ta = r & (SEQ - 1), tb = r1c & (SEQ - 1);
        const int pa = ((lane >> 2) & 1) ? (ta & 63) : (ta >> 6), pb = ((lane >> 2) & 1) ? (tb & 63) : (tb >> 6);
#pragma unroll
        for (int j = 0; j < 6; ++j) { wa[j] = *(const v4u*)(P + (size_t)r * EVN + (j * 64 + lane) * 8); wb[j] = *(const v4u*)(P + (size_t)r1c * EVN + (j * 64 + lane) * 8); }
#pragma unroll
        for (int e = 0; e < 4; ++e) { ra[e] = *(const f32x4*)(rope + (size_t)((pa & 127) * 16 + (lane & 1) * 8) * 2 + e * 4); rb[e] = *(const f32x4*)(rope + (size_t)((pb & 127) * 16 + (lane & 1) * 8) * 2 + e * 4); }
        asm volatile("" ::: "memory");
        prep_even_row(P, QR, r, r < ML, lane, wa, ra, g0, g1);
        if (has1) prep_even_row(P, QR, r1, r1 < ML, lane, wb, rb, g0, g1);
    }
}

struct OddRow { v4u gb[2], gc[2][3], hh[2][3]; };
__device__ __forceinline__ void prep_odd_load(OddRow& R, const bf16* P, int r, int lane) {
    const bool lat = r < ML; const int t = lat ? (r & (SEQ - 1)) : ((r - ML) & (CTXL - 1)); const int n = lat ? SEQ : CTXL;
    const bf16* prow = P + (size_t)r * ODN;
#pragma unroll
    for (int j = 0; j < 2; ++j) { const int c0 = (j * 64 + lane) * 8; R.gb[j] = *(const v4u*)(prow + c0);
#pragma unroll
        for (int jj = 0; jj < 3; ++jj) { const int tt = t + jj - 1; const bool ok = tt >= 0 && tt < n; const bf16* pr = prow + (ok ? (ptrdiff_t)(jj - 1) * ODN : 0);
            R.gc[j][jj] = *(const v4u*)(pr + 1024 + c0); R.hh[j][jj] = *(const v4u*)(pr + 2048 + c0); } }
}
__device__ __forceinline__ void prep_odd_row(const OddRow& R, bf16* P, bf16* MIX, const float* cw, int r, int lane, const float (&g0)[8], const float (&g1)[8]) {
    const bool lat = r < ML; const int t = lat ? (r & (SEQ - 1)) : ((r - ML) & (CTXL - 1)); const int n = lat ? SEQ : CTXL;
    bf16* prow = P + (size_t)r * ODN;
#pragma unroll
    for (int j = 0; j < 2; ++j) {
        const int c0 = (j * 64 + lane) * 8;
        float accv[8];
#pragma unroll
        for (int e = 0; e < 8; ++e) accv[e] = 0.f;
#pragma unroll
        for (int jj = 0; jj < 3; ++jj) {
            const int tt = t + jj - 1; const float m = (tt >= 0 && tt < n) ? 1.f : 0.f;
            const v4u a = R.gc[j][jj], b = R.hh[j][jj];
            const f32x4 w0 = *(const f32x4*)(cw + jj * 1024 + c0) * m, w1 = *(const f32x4*)(cw + jj * 1024 + c0 + 4) * m;
            accv[0] += bflo(a.x) * bflo(b.x) * w0.x; accv[1] += bfhi(a.x) * bfhi(b.x) * w0.y; accv[2] += bflo(a.y) * bflo(b.y) * w0.z; accv[3] += bfhi(a.y) * bfhi(b.y) * w0.w;
            accv[4] += bflo(a.z) * bflo(b.z) * w1.x; accv[5] += bfhi(a.z) * bfhi(b.z) * w1.y; accv[6] += bflo(a.w) * bflo(b.w) * w1.z; accv[7] += bfhi(a.w) * bfhi(b.w) * w1.w;
        }
        const v4u gb = R.gb[j];
        v4u o; o.x = pk2(bflo(gb.x) * accv[0], bfhi(gb.x) * accv[1]); o.y = pk2(bflo(gb.y) * accv[2], bfhi(gb.y) * accv[3]);
        o.z = pk2(bflo(gb.z) * accv[4], bfhi(gb.z) * accv[5]); o.w = pk2(bflo(gb.w) * accv[6], bfhi(gb.w) * accv[7]);
        *(v4u*)(MIX + (size_t)r * DM + c0) = o;
    }
}
__device__ __forceinline__ void prep_odd(Frame& F, int lj) {
    bf16* P = (bf16*)(WSP(F) + WS_P); bf16* MIX = (bf16*)(WSP(F) + WS_MIX);
    const float* gq = INP(F, 16) + (size_t)lj * 256; const float* cw = INP(F, 17) + (size_t)lj * 3 * 1024;
    const int gw = F.vcu * 8 + F.wave, NGW = F.G * 8; const int lane = F.lane;
    const int d0 = (lane & 15) * 8;
    float g0[8], g1[8];
#pragma unroll
    for (int e = 0; e < 8; ++e) { g0[e] = gq[d0 + e]; g1[e] = gq[128 + d0 + e]; }
    for (int r = gw; r < MT; r += 2 * NGW) {
        const int r1 = r + NGW; const bool has1 = r1 < MT;
        OddRow Ra, Rb;
        prep_odd_load(Ra, P, r, lane); prep_odd_load(Rb, P, has1 ? r1 : r, lane);
        asm volatile("" ::: "memory");
        prep_odd_row(Ra, P, MIX, cw, r, lane, g0, g1);
        if (has1) prep_odd_row(Rb, P, MIX, cw, r1, lane, g0, g1);
    }
}

struct EvenTileRow { int ctx0, lat0; __device__ __forceinline__ int operator()(int j) const { return j < 4 ? ctx0 + 64 * j : lat0 + 64 * (j - 4); } };
__device__ __forceinline__ void even_attn_unit(Frame& F, int lj, int b, int h, int qrow0, bool is_ctx) {
    const bf16* P = (const bf16*)(WSP(F) + WS_P); const bf16* QR = (const bf16*)(WSP(F) + WS_QR); bf16* MIX = (bf16*)(WSP(F) + WS_MIX);
    const int lane = F.lane, r32 = lane & 31, hi = lane >> 5, wq = F.wave & 3, comp = F.wave >> 2;
    EvenTileRow trow{ML + b * CTXL, b * SEQ};
    att::f32x16 o[4]; float rli[16];
    att::attn_dual_stag<EVN, 1536, EVN>(P + (size_t)qrow0 * EVN + h * 128, QR + (size_t)(is_ctx ? 0 : qrow0) * 1536 + h * 128, is_ctx ? 1000 : 4,
                                        P + 1536 + h * 128, P + 3072 + h * 128, trow, is_ctx ? 4 : 132, (char*)F.ldsg, o, rli);
    __syncthreads();
    LAS float* xch = (LAS float*)F.lds + (size_t)wq * 4096 + lane;
    if (comp == 1) {
#pragma unroll
        for (int d = 0; d < 4; ++d)
#pragma unroll
            for (int r = 0; r < 16; ++r) xch[(d * 16 + r) * 64] = o[d][r] * rli[r];
    }
    __syncthreads();
    if (comp == 0) {
        const float lam = ((const float*)(WSP(F) + WS_LAM))[lj];
        const float cfac = 1.0f - (lj == 0 ? LAM_INIT0 : LAM_INIT1);
        const float* gsub = INP(F, 13) + (size_t)lj * 128;
        float ssq[16];
#pragma unroll
        for (int r = 0; r < 16; ++r) ssq[r] = 0.f;
#pragma unroll
        for (int d = 0; d < 4; ++d)
#pragma unroll
            for (int r = 0; r < 16; ++r) { const float v = o[d][r] * rli[r] - lam * xch[(d * 16 + r) * 64]; o[d][r] = v; ssq[r] += v * v; }
#pragma unroll
        for (int r = 0; r < 16; ++r) { float s = ssq[r]; s += __shfl_xor(s, 1); s += __shfl_xor(s, 2); s += __shfl_xor(s, 4); s += __shfl_xor(s, 8); s += __shfl_xor(s, 16);
            ssq[r] = rsqrtf(s * (1.0f / 128.0f) + 1e-6f) * cfac; }
#pragma unroll
        for (int d = 0; d < 4; ++d) { const float g = gsub[32 * d + r32];
#pragma unroll
            for (int r = 0; r < 16; ++r) MIX[(size_t)(qrow0 + wq * 32 + att::crow(r, hi)) * DM + h * 128 + 32 * d + r32] = (bf16)f2bf(o[d][r] * ssq[r] * g); }
    }
}

__device__ __forceinline__ void fft_unit(Frame& F, int b, int cp) {
    LAS unsigned char* Vl = F.lds;
    LAS unsigned char* Yl = F.lds + 69632;
    const bf16* P = (const bf16*)(WSP(F) + WS_P); bf16* MIX = (bf16*)(WSP(F) + WS_MIX);
    const bf16* FA1 = (const bf16*)(WSP(F) + WS_FA1); const bf16* FA2 = (const bf16*)(WSP(F) + WS_FA2);
    const int lane = F.lane, l15 = lane & 15, lq = lane >> 4;
    v2u wl[16];
#pragma unroll
    for (int jj = 0; jj < 16; ++jj) wl[jj] = *(const v2u*)(P + (size_t)(b * SEQ + F.tid + 512 * jj) * EVN + 4608 + 4 * cp);
#pragma unroll
    for (int jj = 0; jj < 16; ++jj) { const int t = F.tid + 512 * jj; const v2u w = wl[jj];
        const int t1 = t >> 7, t2 = t & 127;
        *(LAS bf16*)(Vl + (2 * t2 + 0) * 272 + (t1) * 2) = (bf16)(w.x & 0xffffu);       *(LAS bf16*)(Vl + (2 * t2 + 0) * 272 + (64 + t1) * 2) = (bf16)(w.x >> 16);
        *(LAS bf16*)(Vl + (2 * t2 + 1) * 272 + (t1) * 2) = (bf16)(w.y & 0xffffu);       *(LAS bf16*)(Vl + (2 * t2 + 1) * 272 + (64 + t1) * 2) = (bf16)(w.y >> 16); }
    __syncthreads();
    {
        const int mt = F.wave & 3, nt0 = (F.wave >> 2) * 8;
        bf16x8 aR[4], aI[4];
#pragma unroll
        for (int ks = 0; ks < 4; ++ks) { aR[ks] = *(const bf16x8*)(FA1 + (size_t)(16 * mt + l15) * 128 + 32 * ks + 8 * lq); aI[ks] = *(const bf16x8*)(FA1 + (size_t)(64 + 16 * mt + l15) * 128 + 32 * ks + 8 * lq); }
        for (int nt = nt0; nt < nt0 + 8; ++nt) {
            f32x4 accR = {0.f, 0.f, 0.f, 0.f}, accI = accR;
#pragma unroll
            for (int ks = 0; ks < 4; ++ks) { const bf16x8 bf = *(const LAS bf16x8*)(Vl + (16 * nt + l15) * 272 + (32 * ks + 8 * lq) * 2);
                accR = __builtin_amdgcn_mfma_f32_16x16x32_bf16(aR[ks], bf, accR, 0, 0, 0); accI = __builtin_amdgcn_mfma_f32_16x16x32_bf16(aI[ks], bf, accI, 0, 0, 0); }
            const int n1 = 16 * nt + l15, t2 = n1 >> 1, cc = n1 & 1;
#pragma unroll
            for (int r = 0; r < 4; ++r) { const int k1 = 16 * mt + lq * 4 + r; const float ph = (float)((t2 * k1) & 8191) * (1.0f / 8192.0f); const float cs = hw_cos(ph), sn = hw_sin(ph);
                const float yr = accR[r] * cs + accI[r] * sn, yi = accI[r] * cs - accR[r] * sn; const int n2 = k1 * 2 + cc;
                *(LAS bf16*)(Yl + n2 * 528 + t2 * 2) = (bf16)f2bf(yr); *(LAS bf16*)(Yl + n2 * 528 + (128 + t2) * 2) = (bf16)f2bf(yi); }
        }
    }
    __syncthreads();
    {
        const int mt = F.wave;
        bf16x8 a2[8];
#pragma unroll
        for (int ks = 0; ks < 8; ++ks) a2[ks] = *(const bf16x8*)(FA2 + (size_t)(16 * mt + l15) * 256 + 32 * ks + 8 * lq);
        for (int nt = 0; nt < 8; ++nt) {
            f32x4 acc = {0.f, 0.f, 0.f, 0.f};
#pragma unroll
            for (int ks = 0; ks < 8; ++ks) { const bf16x8 bf = *(const LAS bf16x8*)(Yl + (16 * nt + l15) * 528 + (32 * ks + 8 * lq) * 2); acc = __builtin_amdgcn_mfma_f32_16x16x32_bf16(a2[ks], bf, acc, 0, 0, 0); }
            const int n2 = 16 * nt + l15, k1 = n2 >> 1, cc = n2 & 1;
#pragma unroll
            for (int r = 0; r < 4; ++r) { const int k2 = 16 * mt + lq * 4 + r; const int tok = k1 + 64 * k2; const unsigned me = f2bf(acc[r] * (1.0f / 1024.0f)); const unsigned other = (unsigned)__shfl_xor((int)me, 1);
                if (cc == 0) *(unsigned*)(MIX + (size_t)(b * SEQ + tok) * DM + 1536 + 2 * cp) = me | (other << 16); }
        }
    }
    __syncthreads();
}
__device__ __forceinline__ void ctx_dft_unit(Frame& F, int b, int cb) {
    LAS unsigned char* Vc = F.lds;
    const bf16* P = (const bf16*)(WSP(F) + WS_P); bf16* MIX = (bf16*)(WSP(F) + WS_MIX); const bf16* FA3 = (const bf16*)(WSP(F) + WS_FA3);
    const int lane = F.lane, l15 = lane & 15, lq = lane >> 4;
    { const int t = F.tid >> 1, half = F.tid & 1; const bf16* src = P + (size_t)(ML + b * CTXL + t) * EVN + 4608 + 32 * cb + 16 * half;
      const v4u w0 = *(const v4u*)src, w1 = *(const v4u*)(src + 8);
      const unsigned ww[8] = {w0.x, w0.y, w0.z, w0.w, w1.x, w1.y, w1.z, w1.w};
#pragma unroll
      for (int i = 0; i < 8; ++i) { const int cl = half * 8 + i; *(LAS bf16*)(Vc + cl * 1040 + t * 2) = (bf16)(ww[i] & 0xffffu); *(LAS bf16*)(Vc + cl * 1040 + (256 + t) * 2) = (bf16)(ww[i] >> 16); } }
    __syncthreads();
#pragma unroll 1
    for (int mi = 0; mi < 2; ++mi) { const int mt = F.wave * 2 + mi; f32x4 acc = {0.f, 0.f, 0.f, 0.f};
#pragma unroll 4
        for (int ks = 0; ks < 16; ++ks) { const bf16x8 a = *(const bf16x8*)(FA3 + (size_t)(16 * mt + l15) * 512 + 32 * ks + 8 * lq); const bf16x8 bf = *(const LAS bf16x8*)(Vc + l15 * 1040 + (32 * ks + 8 * lq) * 2);
            acc = __builtin_amdgcn_mfma_f32_16x16x32_bf16(a, bf, acc, 0, 0, 0); }
#pragma unroll
        for (int r = 0; r < 4; ++r) { const int k = 16 * mt + lq * 4 + r; MIX[(size_t)(ML + b * CTXL + k) * DM + 1536 + 16 * cb + l15] = (bf16)f2bf(acc[r] * 0.005524271728019903f); } }
    __syncthreads();
}
__device__ __forceinline__ void mixer_even(Frame& F, int lj) {
    if (MXM & 1) {
        for (int uu = F.vcu; uu < ((DUP & 1) ? 2 : 1) * (1536 + 48); uu += F.G) { const int u = (DUP & 1) ? uu % (1536 + 48) : uu; const bool is_ctx = u >= 1536;
            const int pair = is_ctx ? (u - 1536) >> 1 : (u >> 6), qb = is_ctx ? (u & 1) : (u & 63); const int b = pair / 12, h = pair % 12;
            even_attn_unit(F, lj, b, h, is_ctx ? ML + b * CTXL + qb * 128 : b * SEQ + qb * 128, is_ctx); __syncthreads(); } }
    if (MXM & 4) for (int uu = F.vcu; uu < ((DUP & 16) ? 2 : 1) * 512; uu += F.G) { const int u = uu & 511; fft_unit(F, u >> 8, u & 255); }
    if (MXM & 8) for (int u = F.vcu - 64; u >= 0 && u < 64; u += F.G) ctx_dft_unit(F, u >> 5, u & 31);
}

struct OddTileRow { int ctx0, lat0; __device__ __forceinline__ int operator()(int j) const { return j < 4 ? ctx0 + 64 * j : lat0 + 64 * (j - 4); } };
struct NaMask {
    int R0, rw, cq, rs, cs, hi; const LAS float* bt; bool off;
    __device__ __forceinline__ void operator()(att::f32x16& p0, att::f32x16& p1, int j) const {
        if (off || j < 4) return;
        const int kr = R0 + j - 4;
        if (kr < rs || kr >= rs + 8) {
#pragma unroll
            for (int r = 0; r < 16; ++r) { p0[r] = -1e30f; p1[r] = -1e30f; }
            return; }
        int cq_ = cq, hi_ = hi; asm volatile("" : "+v"(cq_), "+v"(hi_));
        int cs_ = cq_ - 8; cs_ = cs_ < 0 ? 0 : (cs_ > 48 ? 48 : cs_);
        const int rowoff = (kr - rw + 7) * 31 + 15 - cq_;
#pragma unroll
        for (int r = 0; r < 16; ++r) { const int c0 = att::crow(r, hi_), c1 = 32 + c0; const int cs = cs_;
            const bool ok0 = c0 >= cs && c0 < cs + 16, ok1 = c1 >= cs && c1 < cs + 16;
            const float b0 = bt[ok0 ? rowoff + c0 : 0], b1 = bt[ok1 ? rowoff + c1 : 0];
            p0[r] = ok0 ? p0[r] + b0 : -1e30f; p1[r] = ok1 ? p1[r] + b1 : -1e30f;
            if ((r & 3) == 3) __builtin_amdgcn_sched_barrier(0); }
    }
};
__device__ __forceinline__ void odd_attn_unit(Frame& F, int lj, int b, int h, int rb, bool is_ctx) {
    const bf16* P = (const bf16*)(WSP(F) + WS_P); bf16* MIX = (bf16*)(WSP(F) + WS_MIX);
    const int lane = F.lane, r32 = lane & 31, hi = lane >> 5, wid = F.wave;
    const int qrow0 = is_ctx ? ML + b * CTXL : b * SEQ + rb * 256;
    int R0 = 4 * rb - 4; R0 = R0 < 0 ? 0 : (R0 > 116 ? 116 : R0);
    OddTileRow trow{ML + b * CTXL, b * SEQ + R0 * 64};
    LAS float* bt = (LAS float*)(F.lds + att::LDS_BT_OFF);
    if (!is_ctx) { const float* rpb = INP(F, 18) + (size_t)(lj * 8 + h) * 465; for (int t = F.tid; t < 465; t += 512) bt[t] = rpb[t] * 11.313708498984761f; }
    __syncthreads();
    NaMask mk; mk.R0 = R0; mk.rw = 4 * rb + (wid >> 1); mk.cq = 32 * (wid & 1) + r32; mk.hi = hi; mk.bt = bt; mk.off = is_ctx;
    { int rs = mk.rw - 4; rs = rs < 0 ? 0 : (rs > 120 ? 120 : rs); mk.rs = rs; int cs = mk.cq - 8; cs = cs < 0 ? 0 : (cs > 48 ? 48 : cs); mk.cs = cs; }
    att::f32x16 o[4]; float rli[16];
    att::attn_core<128, ODN, ODN, ODN, 1, false>(P + (size_t)qrow0 * ODN + 3072 + h * 128, (const bf16*)nullptr, 1000,
                        P + 4096 + h * 128, P + 5120 + h * 128, trow, is_ctx ? 4 : 16, mk, (char*)F.ldsg, o, rli);
#pragma unroll
    for (int d = 0; d < 4; ++d)
#pragma unroll
        for (int r = 0; r < 16; ++r) MIX[(size_t)(qrow0 + wid * 32 + att::crow(r, hi)) * DM + 1024 + h * 128 + 32 * d + r32] = (bf16)f2bf(o[d][r] * rli[r]);
}
__device__ __forceinline__ void mixer_odd(Frame& F, int lj) {
    if (MXM & 1) for (int uu = F.vcu; uu < ((DUP & 2) ? 2 : 1) * (512 + 16); uu += F.G) { const int u = (DUP & 2) ? uu % (512 + 16) : uu; const bool is_ctx = u >= 512; const int pair = is_ctx ? u - 512 : (u >> 5), rb = is_ctx ? 0 : (u & 31);
        odd_attn_unit(F, lj, pair >> 3, pair & 7, rb, is_ctx); __syncthreads(); }
}

__global__ void __launch_bounds__(512, 2) mk_fwd(Args args) {
    extern __shared__ __attribute__((aligned(16))) unsigned char lds[];
    Frame F;
    F.lds = (LAS unsigned char*)lds; F.ldsg = lds;
    F.MISC = (volatile LAS unsigned*)(F.lds + MISC_OFF);
    F.tid = threadIdx.x; F.lane = F.tid & 63; F.wave = __builtin_amdgcn_readfirstlane(F.tid >> 6);
    F.G = gridDim.x; { const int bx = blockIdx.x; F.vcu = (F.G % 8 == 0) ? (bx % 8) * (F.G / 8) + bx / 8 : bx; }
    F.ap = (ArgsP)__builtin_amdgcn_kernarg_segment_ptr();
    F.ws = (GAS unsigned char*)args.ws; F.out = (GAS float*)args.out; F.ctl = (gu32*)(F.ws + WS_CTL);
    for (int u = F.tid; u < (LDS_BYTES - MISC_OFF) / 4; u += 512) ((LAS unsigned*)(F.lds + MISC_OFF))[u] = 0u;
    __syncthreads();
    XcdBarrier bar = xcd_barrier_post((unsigned*)(F.ctl + CW_BAR), F.MISC + 8);
    const int lo = args.ph_lo, hi = args.ph_hi;
#define IN(k) (lo <= (k) && (k) < hi)
#define SEAM(k) do { if (IN(k) && IN((k) + 1)) xcd_barrier(bar); } while (0)
    if (IN(0) && (PHM & 1)) { Frame L = site(F); p0_modvec(L); __syncthreads(); p0_tables(L); p0_copy_ctx(L); p0_fold(L); __syncthreads(); p0_weights(L); __syncthreads(); }
    SEAM(0);
    for (int li = 0; li < DEPTH; ++li) {
        const int pb = 1 + 8 * li, lj = li >> 1; const bool even = (li & 1) == 0;
        if (IN(pb + 0) && (PHM & 2)) { Frame L = site(F); norm_phase(L, li, 0, li == 0 ? INP(L, 0) : OUTP(L), (float*)(WSP(L) + WS_HC), li == 0 ? 0 : 11, (const float*)(WSP(L) + WS_MODV) + (size_t)((li - 1) * 3 + 2) * 12288 + 5 * DM); if (DUP & 32) norm_phase(L, li, 0, li == 0 ? INP(L, 0) : OUTP(L), (float*)(WSP(L) + WS_HC), 0, nullptr); }
        SEAM(pb + 0);
        if (IN(pb + 1) && (PHM & 4)) { Frame L = site(F);
            const int N = even ? EVN : ODN;
            const bf16* Bt = even ? (const bf16*)(WSP(L) + WS_WIN_E + (size_t)lj * SZ_WIN_E) : (const bf16*)(WSP(L) + WS_WIN_O + (size_t)lj * SZ_WIN_O);
            pg8::Gemm g{(const bf16*)(WSP(L) + WS_A), Bt, MT, N, DM}; pg8::StaticOrder S; S.init(MT, N, L.G, (int)blockIdx.x);
            if (even) {
                pg8::EpiEvenIn E{(bf16*)(WSP(L) + WS_P), (bf16*)(WSP(L) + WS_QR), N, INP(L, 11) + (size_t)lj * 128, (const float*)(WSP(L) + WS_ROPE), (LAS float*)(L.lds + pg8::STAGE_BYTES)};
                pg8::gemm_phase<pg8::EpiEvenIn, pg8::StaticOrder, PG8_ALIGN, PG8_SP2>(L.lds, g, S, E);
            } else {
            pg8::EpiOddIn E{(bf16*)(WSP(L) + WS_P), N, INP(L, 16) + (size_t)lj * 256, (LAS float*)(L.lds + pg8::STAGE_BYTES)};
            pg8::gemm_phase<pg8::EpiOddIn, pg8::StaticOrder, PG8_ALIGN, PG8_SP2>(L.lds, g, S, E);
            }
            wq_tail(L, 2 * li, (MT / 256) * (N / 256));
        }
        SEAM(pb + 1);
        if (IN(pb + 3)) { Frame L = site(F); if (even) { if (PHM & 32) mixer_even(L, lj); } else { if (PHM & 16) prep_odd(L, lj); if (PHM & 64) mixer_odd(L, lj); } }
        SEAM(pb + 3);
        if (IN(pb + 4) && (PHM & 128)) { Frame L = site(F);
            const bf16* Bt = even ? (const bf16*)(WSP(L) + WS_WOUT_E + (size_t)lj * SZ_WOUT) : (const bf16*)(WSP(L) + WS_WOUT_O + (size_t)lj * SZ_WOUT);
            const float* modl = (const float*)(WSP(L) + WS_MODV) + (size_t)li * 3 * 12288;
            pg8::Gemm g{(const bf16*)(WSP(L) + WS_MIX), Bt, MT, DM, DM}; pg8::SplitOrder<8> S; S.init(ML, DM, DM, L.G, (int)blockIdx.x, li != 3);
            pg8::EpiGate E{li == 0 ? INP(L, 0) : OUTP(L), OUTP(L), (float*)(WSP(L) + WS_SLAB), modl + 2 * DM};
            if (DUP & 64) { pg8::EpiGate E2 = E; E2.out_l = (float*)(WSP(L) + WS_STASH); pg8::gemm_phase<pg8::EpiGate, pg8::SplitOrder<8>, PG8_ALIGN, PG8_SP2>(L.lds, g, S, E2); }
            pg8::gemm_phase<pg8::EpiGate, pg8::SplitOrder<8>, PG8_ALIGN, PG8_SP2>(L.lds, g, S, E);
        }
        SEAM(pb + 4);
        if (IN(pb + 5) && (PHM & 2)) { Frame L = site(F); norm_phase(L, li, 1, OUTP(L), (float*)(WSP(L) + WS_HC), li == 3 ? 0 : 8, (const float*)(WSP(L) + WS_MODV) + (size_t)(li * 3 + 2) * 12288 + 2 * DM); if (DUP & 32) norm_phase(L, li, 1, OUTP(L), (float*)(WSP(L) + WS_HC), 0, nullptr); }
        SEAM(pb + 5);
        if (IN(pb + 6) && (PHM & 256)) { Frame L = site(F);
            const int Mr = li == 3 ? ML : MT;
            pg8::Gemm g{(const bf16*)(WSP(L) + WS_A), (const bf16*)(WSP(L) + WS_WFI + (size_t)li * SZ_WFI), Mr, 2 * FH, DM}; pg8::StaticOrder S; S.init(Mr, 2 * FH, L.G, (int)blockIdx.x);
            pg8::EpiSwiglu E{(bf16*)(WSP(L) + WS_HID), FH};
            for (int rep = 0; rep < ((DUP & 4) ? 2 : 1); ++rep)
            pg8::gemm_phase<pg8::EpiSwiglu, pg8::StaticOrder, PG8_ALIGN, PG8_SP2>(L.lds, g, S, E);
            if (li < 3) wq_tail(L, 2 * li + 1, (Mr / 256) * (2 * FH / 256));
        }
        SEAM(pb + 6);
        if (IN(pb + 7) && (PHM & 512)) { Frame L = site(F);
            const float* modl = (const float*)(WSP(L) + WS_MODV) + (size_t)li * 3 * 12288;
            pg8::Gemm g{(const bf16*)(WSP(L) + WS_HID), (const bf16*)(WSP(L) + WS_WFO + (size_t)li * SZ_WFO), MT, DM, FH}; pg8::SplitOrder<11> S; S.init(ML, DM, FH, L.G, (int)blockIdx.x, li != 3);
            pg8::EpiGate E{OUTP(L), OUTP(L), (float*)(WSP(L) + WS_SLAB), modl + 5 * DM};
            if (DUP & 128) { pg8::EpiGate E2 = E; E2.out_l = (float*)(WSP(L) + WS_STASH); pg8::gemm_phase<pg8::EpiGate, pg8::SplitOrder<11>, PG8_ALIGN, PG8_SP2>(L.lds, g, S, E2); }
            pg8::gemm_phase<pg8::EpiGate, pg8::SplitOrder<11>, PG8_ALIGN, PG8_SP2>(L.lds, g, S, E);
        }
        SEAM(pb + 7);
    }
#undef IN
#undef SEAM
}

extern "C" void kernel_launch(void* const* d_in, const int* in_sizes, int n_in, void* d_out, int out_size, void* d_ws, size_t ws_size, hipStream_t stream) {
    static int grid = 0;
    if (grid == 0) {
        if (n_in != 19 || in_sizes[0] != ML * DM || out_size != ML * DM || ws_size < WS_END) { fprintf(stderr, "kernel_launch: shape mismatch (n_in %d, in0 %d, out %d, ws %zu < %zu); nothing launched\n", n_in, n_in > 0 ? in_sizes[0] : -1, out_size, ws_size, (size_t)WS_END); grid = -1; return; }
        int dev = 0, cus = 0, per_cu = 0;
        if (hipGetDevice(&dev) != hipSuccess || hipDeviceGetAttribute(&cus, hipDeviceAttributeMultiprocessorCount, dev) != hipSuccess) { fprintf(stderr, "kernel_launch: device query failed\n"); grid = -1; return; }
        if (hipFuncSetAttribute((const void*)mk_fwd, hipFuncAttributeMaxDynamicSharedMemorySize, LDS_BYTES) != hipSuccess) { fprintf(stderr, "kernel_launch: hipFuncSetAttribute failed\n"); grid = -1; return; }
        if (hipOccupancyMaxActiveBlocksPerMultiprocessor(&per_cu, (const void*)mk_fwd, 512, LDS_BYTES) != hipSuccess || per_cu < 1) fprintf(stderr, "kernel_launch: note: occupancy query reports %d workgroups per CU\n", per_cu);
        (void)hipGetLastError();
        grid = cus;
    }
    if (grid < 0) return;
    if (hipMemsetAsync((char*)d_ws + WS_CTL, 0, CTL_ZERO_BYTES, stream) != hipSuccess) { fprintf(stderr, "kernel_launch: memset failed\n"); return; }
    Args a{};
    for (int i = 0; i < 19; ++i) a.in[i] = (const float*)d_in[i];
    a.out = (float*)d_out; a.ws = (unsigned char*)d_ws;
    constexpr int NL = MK_N_LAUNCHES;
    for (int l = 0; l < NL; ++l) {
        a.ph_lo = (NL == 1) ? 0 : l; a.ph_hi = (NL == 1) ? NPH : l + 1;
        hipLaunchKernelGGL(mk_fwd, dim3(grid), dim3(512), LDS_BYTES, stream, a);
        const hipError_t le = hipPeekAtLastError();
        if (le != hipSuccess) { fprintf(stderr, "kernel_launch: launch %d failed: %s\n", l, hipGetErrorName(le)); break; }
    }
}
```

```cpp
#include <hip/hip_runtime.h>
#include <cstdio>
#include <cstdint>
#include <cstddef>
#ifndef DUP
#define DUP 0
#endif
namespace pg8 {
#define PG8_LAS __attribute__((address_space(3)))
typedef unsigned short bf16_t;
typedef short bf16x8 __attribute__((ext_vector_type(8)));
typedef float f32x4 __attribute__((ext_vector_type(4)));
typedef unsigned u32x4 __attribute__((ext_vector_type(4)));
constexpr int BM = 256, BK = 64, HALF = 128, HTB = HALF * BK * 2  , STAGE_BYTES = 8 * HTB, NXCD = 8, WGM = 8;

__host__ __device__ __forceinline__ int lds_byte(int r, int c) { const int st = (r >> 4) * 2 + (c >> 5), rr = r & 15, cc = c & 31, ob = rr * 64 + cc * 2; return st * 1024 + (ob ^ (((ob >> 9) & 1) << 5)); }
__host__ __device__ __forceinline__ void stage_rc(int b, int& R, int& C) { const int st = b / 1024, sb = b % 1024, swz = sb ^ (((sb >> 9) & 1) << 5); R = (st >> 1) * 16 + swz / 64; C = (st & 1) * 32 + (swz % 64) / 2; }
__host__ __device__ __forceinline__ int perm32(int rho) { const int n = rho >> 4, i = rho & 15; return 8 * (i >> 2) + 4 * n + (i & 3); }

struct Unit { int pm, pn; int kb, nt; };
struct Gemm { const bf16_t* A; const bf16_t* Bt; int M, N, K; };

struct StaticOrder {
    int nM, nN, nwg, G, c;
    __host__ __device__ void init(int M, int N, int G_, int c_) { nM = M / BM; nN = N / BM; nwg = nM * nN; G = G_; c = c_; }
    __host__ __device__ bool next(int i, Unit& u) const {
        const long L = (long)i * G + c; if (L >= nwg) return false;
        int wgid = (int)L; { const int q = nwg / NXCD, r = nwg % NXCD, xcd = wgid % NXCD, off = wgid / NXCD; wgid = (xcd < r ? xcd * (q + 1) : r * (q + 1) + (xcd - r) * q) + off; }
        const int nig = WGM * nN, gid = wgid / nig, fm = gid * WGM, gsz = (nM - fm) < WGM ? (nM - fm) : WGM;
        u.pm = fm + ((wgid % nig) % gsz); u.pn = (wgid % nig) / gsz; return true;
    }
    static constexpr bool SPLITK = false;
    __device__ __forceinline__ void a_ready(const Unit&) const {}
    __device__ __forceinline__ void done(const Unit&) const {}
};

__device__ __forceinline__ unsigned cvt_pk_bf16(float lo, float hi) { unsigned r; asm volatile("v_cvt_pk_bf16_f32 %0, %1, %2" : "=v"(r) : "v"(lo), "v"(hi)); return r; }
typedef float f32x2 __attribute__((ext_vector_type(2)));
__device__ __forceinline__ f32x2 gelu_pk(f32x2 v) {
    const f32x2 av = __builtin_elementwise_abs(v), d = av * 0.2316418882f + 1.0f;
    f32x2 t; t.x = __builtin_amdgcn_rcpf(d.x); t.y = __builtin_amdgcn_rcpf(d.y);
    f32x2 q = t * 0.5307027145f + (-0.7265760135f); q = q * t + 0.7107068705f; q = q * t + (-0.142248368f); q = q * t + 0.127414796f; q = q * t;
    const f32x2 s = (v * v) * (-0.72134752044f);
    f32x2 e; e.x = __builtin_amdgcn_exp2f(s.x); e.y = __builtin_amdgcn_exp2f(s.y);
    const f32x2 m = v * (q * e), r = v - m;
    f32x2 o; o.x = v.x < 0.f ? m.x : r.x; o.y = v.y < 0.f ? m.y : r.y; return o;
}

template <int ACT  > struct EpiBf16 {
    static constexpr bool PERM = true, AFTER_DRAIN = false; static_assert(ACT == 0 || ACT == 1, "EpiBf16: ACT is 0 (none) or 1 (gelu_pk)");
    bf16_t* O; int ldc; const float* bias; int split_cols; size_t split_stride; float scale0;
    __device__ __forceinline__ void operator()(const f32x4 (&acc)[2][2][4][2], const Unit& u, int wr, int wc, int fr, int fq) const {
        const int row0 = u.pm * BM + wr * 64 + fr; int colt = u.pn * BM; bf16_t* base = O;
        float sc = 1.f; if (split_cols) { const int t = colt / split_cols; base += (size_t)t * split_stride; colt -= t * split_cols; if (t == 0) sc = scale0; }
        const int col0 = colt + wc * 32 + 8 * fq, bcol0 = u.pn * BM + wc * 32 + 8 * fq;
        f32x4 bv[2][2];
#pragma unroll
        for (int bj = 0; bj < 2; ++bj)
#pragma unroll
            for (int n = 0; n < 2; ++n) bv[bj][n] = bias ? *(const f32x4*)(bias + bcol0 + bj * HALF + 4 * n) : (f32x4){0.f, 0.f, 0.f, 0.f};
#pragma unroll
        for (int ai = 0; ai < 2; ++ai)
#pragma unroll
            for (int m = 0; m < 4; ++m) { bf16_t* rowp = base + (size_t)(row0 + ai * HALF + m * 16) * ldc + col0;
#pragma unroll
                for (int bj = 0; bj < 2; ++bj) { f32x4 v0 = acc[ai][bj][m][0] + bv[bj][0], v1 = acc[ai][bj][m][1] + bv[bj][1];
                    if (ACT == 1) { f32x2 a = gelu_pk((f32x2){v0[0], v0[1]}), b = gelu_pk((f32x2){v0[2], v0[3]}), c = gelu_pk((f32x2){v1[0], v1[1]}), d = gelu_pk((f32x2){v1[2], v1[3]});
                        v0 = (f32x4){a.x, a.y, b.x, b.y}; v1 = (f32x4){c.x, c.y, d.x, d.y}; }
                    v0 = v0 * sc; v1 = v1 * sc; u32x4 w; w.x = cvt_pk_bf16(v0[0], v0[1]); w.y = cvt_pk_bf16(v0[2], v0[3]); w.z = cvt_pk_bf16(v1[0], v1[1]); w.w = cvt_pk_bf16(v1[2], v1[3]);
                    *(u32x4*)(rowp + bj * HALF) = w; } }
    }
};

struct EpiGate {
    static constexpr bool PERM = false, AFTER_DRAIN = false;
    const float* base_l; float* out_l; float* slab; const float* gate;
    __device__ __forceinline__ void operator()(const f32x4 (&acc)[2][2][4][2], const Unit& u, int wr, int wc, int fr, int fq) const {
        const bool isc = u.pm >= 64; const int grp = u.pm < 32 ? 0 : (u.pm < 64 ? 1 : 2);
        const float* bp = base_l; float* op = out_l;
        const int rowt = (isc ? (u.pm - 64) : u.pm) * BM + wr * 64 + fr;
        const int col0 = u.pn * BM + wc * 32 + 4 * fq;
        if (isc) {
            const int kc = u.kb / (u.nt * BK * 2); float* sp = slab + (size_t)kc * (512 * 2048);
#pragma unroll
            for (int ai = 0; ai < 2; ++ai)
#pragma unroll
                for (int m = 0; m < 4; ++m) { const size_t off = (size_t)(rowt + ai * HALF + m * 16) * 2048 + col0;
#pragma unroll
                    for (int bj = 0; bj < 2; ++bj)
#pragma unroll
                        for (int n = 0; n < 2; ++n) *(f32x4*)(sp + off + bj * HALF + n * 16) = acc[ai][bj][m][n]; }
            return; }
        f32x4 gv[2][2];
#pragma unroll
        for (int bj = 0; bj < 2; ++bj)
#pragma unroll
            for (int n = 0; n < 2; ++n) gv[bj][n] = *(const f32x4*)(gate + grp * 12288 + col0 + bj * HALF + n * 16);
#pragma unroll
        for (int ai = 0; ai < 2; ++ai) {
            f32x4 pre[4][2][2];
#pragma unroll
            for (int m = 0; m < 4; ++m) { const size_t off = (size_t)(rowt + ai * HALF + m * 16) * 2048 + col0;
#pragma unroll
                for (int bj = 0; bj < 2; ++bj)
#pragma unroll
                    for (int n = 0; n < 2; ++n) pre[m][bj][n] = *(const f32x4*)(bp + off + bj * HALF + n * 16); }
            asm volatile("" ::: "memory");
#pragma unroll
            for (int m = 0; m < 4; ++m) { const size_t off = (size_t)(rowt + ai * HALF + m * 16) * 2048 + col0;
#pragma unroll
                for (int bj = 0; bj < 2; ++bj)
#pragma unroll
                    for (int n = 0; n < 2; ++n) *(f32x4*)(op + off + bj * HALF + n * 16) = pre[m][bj][n] + gv[bj][n] * acc[ai][bj][m][n]; }
            asm volatile("" ::: "memory");
        }
    }
};
template <int KS> struct SplitOrder {
    static constexpr bool SPLITK = true;
    StaticOrder so; int G, c, ntc, ntf, nctx;
    __device__ void init(int Mlat, int N, int K, int G_, int c_, bool with_ctx) { so.init(Mlat, N, G_, c_); G = G_; c = c_; ntf = K / BK; ntc = ntf / KS; nctx = with_ctx ? 16 * KS : 0; }
    __device__ bool next(int i, Unit& u) const {
        const long L = (long)i * G + c;
        if (L < so.nwg) { so.next(i, u); u.kb = 0; u.nt = ntf; return true; }
        const int x = (int)(L - so.nwg); if (x >= nctx) return false;
        const int kc = x % KS, tile = x / KS; u.pn = tile & 7; u.pm = so.nM + (tile >> 3); u.kb = kc * ntc * BK * 2; u.nt = ntc; return true;
    }
    __device__ __forceinline__ void a_ready(const Unit&) const {}
    __device__ __forceinline__ void done(const Unit&) const {}
};
struct EpiEvenIn {
    static constexpr bool PERM = true, AFTER_DRAIN = false;
    bf16_t* P; bf16_t* QR; int ldc; const float* gains; const float* rope; PG8_LAS float* part;
    __device__ __forceinline__ void operator()(const f32x4 (&acc)[2][2][4][2], const Unit& u, int wr, int wc, int fr, int fq) const {
        const int row0 = u.pm * BM + wr * 64 + fr; const int col0 = u.pn * BM + wc * 32 + 8 * fq;
        if (u.pn >= 12) {
#pragma unroll
            for (int ai = 0; ai < 2; ++ai)
#pragma unroll
                for (int m = 0; m < 4; ++m) { bf16_t* rowp = P + (size_t)(row0 + ai * HALF + m * 16) * ldc + col0;
#pragma unroll
                    for (int bj = 0; bj < 2; ++bj) { const f32x4 v0 = acc[ai][bj][m][0], v1 = acc[ai][bj][m][1];
                        u32x4 w; w.x = cvt_pk_bf16(v0[0], v0[1]); w.y = cvt_pk_bf16(v0[2], v0[3]); w.z = cvt_pk_bf16(v1[0], v1[1]); w.w = cvt_pk_bf16(v1[2], v1[3]);
                        *(u32x4*)(rowp + bj * HALF) = w; } }
            return; }
        const bool isq = u.pn < 6, lat = u.pm < 64;
        int rb_ = wr * 64 + fr; asm volatile("" : "+v"(rb_));
#pragma unroll
        for (int ai = 0; ai < 2; ++ai)
#pragma unroll
            for (int m = 0; m < 4; ++m)
#pragma unroll
                for (int bj = 0; bj < 2; ++bj) { const f32x4 a = acc[ai][bj][m][0], b = acc[ai][bj][m][1];
                    float s = (a[0] * a[0] + a[1] * a[1]) + (a[2] * a[2] + a[3] * a[3]) + (b[0] * b[0] + b[1] * b[1]) + (b[2] * b[2] + b[3] * b[3]);
                    s += __shfl_xor(s, 16); s += __shfl_xor(s, 32);
                    if (fq == 0) part[((ai * HALF + m * 16 + rb_) * 2 + bj) * 4 + wc] = s; }
        asm volatile("s_waitcnt lgkmcnt(0)" ::: "memory"); __builtin_amdgcn_s_barrier(); asm volatile("" ::: "memory");
        const float* gp = gains + (isq ? 0 : 64) + 32 * (wc & 1) + 8 * fq; const float qs = isq ? 0.18033688011112042f : 1.0f;
        float gn[8];
#pragma unroll
        for (int e = 0; e < 8; ++e) gn[e] = gp[e] * qs;
#pragma unroll
        for (int ai = 0; ai < 2; ++ai)
#pragma unroll
            for (int m = 0; m < 4; ++m) { const int rl = ai * HALF + m * 16 + rb_; const int row = u.pm * BM + rl;
                f32x4 cs0 = {1.f, 0.f, 1.f, 0.f}, cs1 = cs0, cs2 = cs0, cs3 = cs0;
                if (lat) { const int t = row & 8191; const int pos = (wc & 1) ? (t & 63) : (t >> 6); const float* rp = rope + (size_t)(pos * 16 + 8 * (fq & 1)) * 2;
                    cs0 = *(const f32x4*)rp; cs1 = *(const f32x4*)(rp + 4); cs2 = *(const f32x4*)(rp + 8); cs3 = *(const f32x4*)(rp + 12); }
                const float c8[8] = {cs0[0], cs0[2], cs1[0], cs1[2], cs2[0], cs2[2], cs3[0], cs3[2]}, s8[8] = {cs0[1], cs0[3], cs1[1], cs1[3], cs2[1], cs2[3], cs3[1], cs3[3]};
#pragma unroll
                for (int bj = 0; bj < 2; ++bj) {
                    const float ss = part[(rl * 2 + bj) * 4 + wc] + part[(rl * 2 + bj) * 4 + (wc ^ 1)];
                    const float rstd = rsqrtf(ss * (1.0f / 64.0f) + 1e-6f);
                    float y[8], yr[8];
#pragma unroll
                    for (int e = 0; e < 8; ++e) y[e] = acc[ai][bj][m][e >> 2][e & 3] * rstd * gn[e];
#pragma unroll
                    for (int e = 0; e < 8; ++e) { const float yp = __shfl_xor(y[e], 32); yr[e] = (fq & 2) ? (y[e] * c8[e] + yp * s8[e]) : (y[e] * c8[e] - yp * s8[e]); }
                    u32x4 wn, wrot;
                    wn.x = cvt_pk_bf16(y[0], y[1]); wn.y = cvt_pk_bf16(y[2], y[3]); wn.z = cvt_pk_bf16(y[4], y[5]); wn.w = cvt_pk_bf16(y[6], y[7]);
                    wrot.x = cvt_pk_bf16(yr[0], yr[1]); wrot.y = cvt_pk_bf16(yr[2], yr[3]); wrot.z = cvt_pk_bf16(yr[4], yr[5]); wrot.w = cvt_pk_bf16(yr[6], yr[7]);
                    bf16_t* pp = P + (size_t)row * ldc + col0 + bj * HALF;
                    if (isq) { *(u32x4*)pp = wn; if (lat) *(u32x4*)(QR + (size_t)row * 1536 + col0 + bj * HALF) = wrot; }
                    else     { *(u32x4*)pp = lat ? wrot : wn; }
                }
                asm volatile("" ::: "memory"); }
    }
};
struct EpiOddIn {
    static constexpr bool PERM = true, AFTER_DRAIN = false;
    bf16_t* P; int ldc; const float* gains; PG8_LAS float* part;
    __device__ __forceinline__ void operator()(const f32x4 (&acc)[2][2][4][2], const Unit& u, int wr, int wc, int fr, int fq) const {
        const int row0 = u.pm * BM + wr * 64 + fr; const int col0 = u.pn * BM + wc * 32 + 8 * fq;
        const bool isqk = u.pn >= 12 && u.pn < 20;
        float rs[2][4][2];
        if (isqk) {
            int rb_ = wr * 64 + fr; asm volatile("" : "+v"(rb_));
#pragma unroll
            for (int ai = 0; ai < 2; ++ai)
#pragma unroll
                for (int m = 0; m < 4; ++m)
#pragma unroll
                    for (int bj = 0; bj < 2; ++bj) { const f32x4 a = acc[ai][bj][m][0], b = acc[ai][bj][m][1];
                        float s = (a[0] * a[0] + a[1] * a[1]) + (a[2] * a[2] + a[3] * a[3]) + (b[0] * b[0] + b[1] * b[1]) + (b[2] * b[2] + b[3] * b[3]);
                        s += __shfl_xor(s, 16); s += __shfl_xor(s, 32);
                        if (fq == 0) part[((ai * HALF + m * 16 + rb_) * 2 + bj) * 4 + wc] = s; }
            asm volatile("s_waitcnt lgkmcnt(0)" ::: "memory"); __builtin_amdgcn_s_barrier(); asm volatile("" ::: "memory");
#pragma unroll
            for (int ai = 0; ai < 2; ++ai)
#pragma unroll
                for (int m = 0; m < 4; ++m)
#pragma unroll
                    for (int bj = 0; bj < 2; ++bj) { const f32x4 t = *(const PG8_LAS f32x4*)(part + ((ai * HALF + m * 16 + rb_) * 2 + bj) * 4);
                        rs[ai][m][bj] = rsqrtf(((t[0] + t[1]) + (t[2] + t[3])) * (1.0f / 128.0f) + 1e-6f); }
        }
        float gn[8];
        { const float* gp = gains + (u.pn >= 16 ? 128 : 0) + 32 * wc + 8 * fq;
#pragma unroll
          for (int e = 0; e < 8; ++e) gn[e] = isqk ? gp[e] : 1.0f; }
#pragma unroll
        for (int ai = 0; ai < 2; ++ai)
#pragma unroll
            for (int m = 0; m < 4; ++m) { bf16_t* rowp = P + (size_t)(row0 + ai * HALF + m * 16) * ldc + col0;
#pragma unroll
                for (int bj = 0; bj < 2; ++bj) { const float r = isqk ? rs[ai][m][bj] : 1.0f; const f32x4 v0 = acc[ai][bj][m][0], v1 = acc[ai][bj][m][1];
                    u32x4 w; w.x = cvt_pk_bf16(v0[0] * r * gn[0], v0[1] * r * gn[1]); w.y = cvt_pk_bf16(v0[2] * r * gn[2], v0[3] * r * gn[3]);
                    w.z = cvt_pk_bf16(v1[0] * r * gn[4], v1[1] * r * gn[5]); w.w = cvt_pk_bf16(v1[2] * r * gn[6], v1[3] * r * gn[7]);
                    *(u32x4*)(rowp + bj * HALF) = w; } }
    }
};
struct EpiSwiglu {
    static constexpr bool PERM = true, AFTER_DRAIN = false;
    bf16_t* O; int ldc;
    __device__ __forceinline__ void operator()(const f32x4 (&acc)[2][2][4][2], const Unit& u, int wr, int wc, int fr, int fq) const {
        const int row0 = u.pm * BM + wr * 64 + fr; const int col0 = u.pn * HALF + wc * 32 + 8 * fq;
#pragma unroll
        for (int ai = 0; ai < 2; ++ai)
#pragma unroll
            for (int m = 0; m < 4; ++m) { bf16_t* rowp = O + (size_t)(row0 + ai * HALF + m * 16) * ldc + col0;
                float hv[8];
#pragma unroll
                for (int n = 0; n < 2; ++n)
#pragma unroll
                    for (int e = 0; e < 4; ++e) { const float g = acc[ai][0][m][n][e], up = acc[ai][1][m][n][e];
                        hv[n * 4 + e] = g * __builtin_amdgcn_rcpf(1.0f + __expf(-g)) * up; }
                u32x4 w; w.x = cvt_pk_bf16(hv[0], hv[1]); w.y = cvt_pk_bf16(hv[2], hv[3]); w.z = cvt_pk_bf16(hv[4], hv[5]); w.w = cvt_pk_bf16(hv[6], hv[7]);
                *(u32x4*)rowp = w; }
    }
};

template <class Epi, class Sched, bool ALIGN_EPI = false, bool SP2 = false>
__device__ __forceinline__ void gemm_phase(PG8_LAS unsigned char* lds, const Gemm g, const Sched& S, const Epi& E) {
    int tid_ = threadIdx.x; asm volatile("" : "+v"(tid_));
    const int tid = tid_, wid = __builtin_amdgcn_readfirstlane(tid >> 6), lane = tid & 63, wr = wid >> 2, wc = wid & 3, fr = lane & 15, fq = lane >> 4;
    const int K = g.K, ntf = K / BK;
    unsigned voffA[2], voffB[2];
#pragma unroll
    for (int i = 0; i < 2; ++i) { int R, C; stage_rc(tid * 16 + i * 8192, R, C); const int Rb = Epi::PERM ? ((R & ~31) + perm32(R & 31)) : R;
        voffA[i] = (unsigned)(R * K + C) * 2u; voffB[i] = (unsigned)(Rb * K + C) * 2u; }
    const size_t kstep = (size_t)(BK * 2);
    const size_t hstep = (size_t)HALF * K * 2;
    const size_t tstep = 2 * hstep;
    const unsigned ldsw = (unsigned)wid * 1024u;
    const int aoff = lds_byte(wr * 64 + fr, fq * 8), boff = lds_byte(wc * 32 + fr, fq * 8);
#define PG8_SA(b, h) (((b) * 2 + (h)) * HTB)
#define PG8_SB(b, h) ((4 + (b) * 2 + (h)) * HTB)
#define PG8_STAGE(bufoff, gbase, voff) do { _Pragma("unroll") for (int _i = 0; _i < 2; ++_i) \
        __builtin_amdgcn_global_load_lds((const unsigned*)((const char*)(gbase) + (voff)[_i]), (PG8_LAS unsigned*)(lds + (bufoff) + ldsw + _i * 8192), 16, 0, 0); } while (0)
#define PG8_LDA(dst, b, h) do { _Pragma("unroll") for (int m = 0; m < 4; ++m) _Pragma("unroll") for (int k = 0; k < 2; ++k) dst[m][k] = *(const PG8_LAS bf16x8*)(lds + PG8_SA(b, h) + aoff + m * 2048 + k * 1024); } while (0)
#define PG8_LDB(dst, b, h) do { _Pragma("unroll") for (int n = 0; n < 2; ++n) _Pragma("unroll") for (int k = 0; k < 2; ++k) dst[n][k] = *(const PG8_LAS bf16x8*)(lds + PG8_SB(b, h) + boff + n * 2048 + k * 1024); } while (0)
#define PG8_MMA(ai, bj, At, Bt) do { __builtin_amdgcn_s_setprio(1); _Pragma("unroll") for (int m = 0; m < 4; ++m) _Pragma("unroll") for (int n = 0; n < 2; ++n) _Pragma("unroll") for (int k = 0; k < 2; ++k) \
        acc[ai][bj][m][n] = __builtin_amdgcn_mfma_f32_16x16x32_bf16(Bt[n][k], At[m][k], acc[ai][bj][m][n], 0, 0, 0); __builtin_amdgcn_s_setprio(0); } while (0)
#define PG8_WAIT_V(n) asm volatile("s_waitcnt vmcnt(" #n ")" ::: "memory")
#define PG8_WAIT_L(n) asm volatile("s_waitcnt lgkmcnt(" #n ")" ::: "memory")
#define PG8_BAR __builtin_amdgcn_s_barrier()
#define PG8_SCHED __builtin_amdgcn_sched_barrier(0)
    Unit cur, nxt; int ui = 0;
    if (!S.next(0, cur)) return;
    f32x4 acc[2][2][4][2];
#pragma unroll
    for (int a = 0; a < 2; ++a)
#pragma unroll
        for (int b = 0; b < 2; ++b)
#pragma unroll
            for (int m = 0; m < 4; ++m)
#pragma unroll
                for (int n = 0; n < 2; ++n) acc[a][b][m][n] = (f32x4){0.f, 0.f, 0.f, 0.f};
    bf16x8 At[4][2], B0[2][2], B1[2][2];
    const char* cA = (const char*)g.A + (size_t)cur.pm * tstep + (Sched::SPLITK ? cur.kb : 0); const char* cB = (const char*)g.Bt + (size_t)cur.pn * tstep + (Sched::SPLITK ? cur.kb : 0);
    S.a_ready(cur);
    if constexpr (SP2) {
        PG8_STAGE(PG8_SB(0, 0), cB, voffB); PG8_STAGE(PG8_SB(0, 1), cB + hstep, voffB); PG8_STAGE(PG8_SA(0, 0), cA, voffA); PG8_STAGE(PG8_SA(0, 1), cA + hstep, voffA);
        if (wr == 1) PG8_BAR;
        PG8_WAIT_V(2); PG8_BAR;
        PG8_STAGE(PG8_SB(1, 0), cB + kstep, voffB); PG8_STAGE(PG8_SA(1, 0), cA + kstep, voffA); PG8_STAGE(PG8_SB(1, 1), cB + hstep + kstep, voffB);
        PG8_WAIT_V(6); PG8_BAR;
    } else {
        PG8_STAGE(PG8_SB(0, 0), cB, voffB); PG8_STAGE(PG8_SA(0, 0), cA, voffA); PG8_STAGE(PG8_SB(0, 1), cB + hstep, voffB); PG8_STAGE(PG8_SA(0, 1), cA + hstep, voffA);
        if (wr == 1) PG8_BAR;
        PG8_WAIT_V(4); PG8_BAR;
        PG8_STAGE(PG8_SB(1, 0), cB + kstep, voffB); PG8_STAGE(PG8_SA(1, 0), cA + kstep, voffA); PG8_STAGE(PG8_SB(1, 1), cB + hstep + kstep, voffB);
        PG8_WAIT_V(6); PG8_BAR;
    }
    for (;;) {
        const bool has_next = S.next(ui + 1, nxt);
        const char* nA = has_next ? (const char*)g.A + (size_t)nxt.pm * tstep + (Sched::SPLITK ? nxt.kb : 0) : cA; const char* nB = has_next ? (const char*)g.Bt + (size_t)nxt.pn * tstep + (Sched::SPLITK ? nxt.kb : 0) : cB;
        const int nt = Sched::SPLITK ? cur.nt : ntf;
        for (int t = 0; t < nt; t += 2) {
            const bool last = (t == nt - 2);
            const char* a1 = cA + (size_t)(t + 1) * kstep;
            const char* a2 = last ? nA : cA + (size_t)(t + 2) * kstep; const char* b2 = last ? nB : cB + (size_t)(t + 2) * kstep;
            const char* a3 = a2 + kstep; const char* b3 = b2 + kstep;
            if (last && has_next) S.a_ready(nxt);
            if constexpr (SP2) {
            PG8_LDB(B0, 0, 0); PG8_LDB(B1, 0, 1); PG8_SCHED; PG8_LDA(At, 0, 0); PG8_STAGE(PG8_SA(1, 1), a1 + hstep, voffA);
            PG8_WAIT_V(8); PG8_WAIT_L(0); PG8_BAR; PG8_MMA(0, 0, At, B0); PG8_MMA(0, 1, At, B1); PG8_BAR; PG8_SCHED;
            PG8_LDA(At, 0, 1); PG8_STAGE(PG8_SB(0, 0), b2, voffB); PG8_STAGE(PG8_SB(0, 1), b2 + hstep, voffB); PG8_STAGE(PG8_SA(0, 0), a2, voffA);
            PG8_WAIT_V(8); PG8_WAIT_L(0); PG8_BAR; PG8_MMA(1, 0, At, B0); PG8_MMA(1, 1, At, B1); PG8_BAR; PG8_SCHED;
            PG8_LDB(B0, 1, 0); PG8_LDB(B1, 1, 1); PG8_SCHED; PG8_LDA(At, 1, 0); PG8_STAGE(PG8_SA(0, 1), a2 + hstep, voffA);
            PG8_WAIT_V(8); PG8_WAIT_L(0); PG8_BAR; PG8_MMA(0, 0, At, B0); PG8_MMA(0, 1, At, B1); PG8_BAR; PG8_SCHED;
            PG8_LDA(At, 1, 1); PG8_STAGE(PG8_SB(1, 0), b3, voffB); PG8_STAGE(PG8_SB(1, 1), b3 + hstep, voffB); PG8_STAGE(PG8_SA(1, 0), a3, voffA);
            PG8_WAIT_V(8); PG8_WAIT_L(0); PG8_BAR; PG8_MMA(1, 0, At, B0); PG8_MMA(1, 1, At, B1); PG8_BAR; PG8_SCHED;
            } else {
            PG8_LDB(B0, 0, 0); PG8_SCHED; PG8_LDA(At, 0, 0); PG8_STAGE(PG8_SA(1, 1), a1 + hstep, voffA);
            PG8_WAIT_L(8); PG8_BAR; PG8_WAIT_L(0); PG8_MMA(0, 0, At, B0); PG8_BAR; PG8_SCHED;
            PG8_LDB(B1, 0, 1); PG8_STAGE(PG8_SB(0, 0), b2, voffB);
            PG8_BAR; PG8_WAIT_L(0); PG8_MMA(0, 1, At, B1); PG8_BAR;
            PG8_LDA(At, 0, 1); PG8_STAGE(PG8_SA(0, 0), a2, voffA);
            PG8_BAR; PG8_WAIT_L(0); PG8_MMA(1, 0, At, B0); PG8_BAR; PG8_SCHED;
            PG8_STAGE(PG8_SB(0, 1), b2 + hstep, voffB);
            PG8_WAIT_V(6); PG8_BAR; PG8_MMA(1, 1, At, B1); PG8_BAR;
            PG8_LDB(B0, 1, 0); PG8_SCHED; PG8_LDA(At, 1, 0); PG8_STAGE(PG8_SA(0, 1), a2 + hstep, voffA);
            PG8_WAIT_L(8); PG8_BAR; PG8_WAIT_L(0); PG8_MMA(0, 0, At, B0); PG8_BAR; PG8_SCHED;
            PG8_LDB(B1, 1, 1); PG8_STAGE(PG8_SB(1, 0), b3, voffB);
            PG8_BAR; PG8_WAIT_L(0); PG8_MMA(0, 1, At, B1); PG8_BAR;
            PG8_LDA(At, 1, 1); PG8_STAGE(PG8_SA(1, 0), a3, voffA);
            PG8_BAR; PG8_WAIT_L(0); PG8_MMA(1, 0, At, B0); PG8_BAR; PG8_SCHED;
            PG8_STAGE(PG8_SB(1, 1), b3 + hstep, voffB);
            PG8_WAIT_V(6); PG8_BAR; PG8_MMA(1, 1, At, B1); PG8_BAR;
            }
        }
        if constexpr (ALIGN_EPI) { if (wr == 0) PG8_BAR; }
        if constexpr (!Epi::AFTER_DRAIN) { E(acc, cur, wr, wc, fr, fq); S.done(cur); }
        if (!has_next) break;
#pragma unroll
        for (int a = 0; a < 2; ++a)
#pragma unroll
            for (int b = 0; b < 2; ++b)
#pragma unroll
                for (int m = 0; m < 4; ++m)
#pragma unroll
                    for (int n = 0; n < 2; ++n) acc[a][b][m][n] = (f32x4){0.f, 0.f, 0.f, 0.f};
        cur = nxt; cA = nA; cB = nB; ++ui;
        if constexpr (ALIGN_EPI) { if (wr == 1) PG8_BAR; }
    }
    PG8_WAIT_V(0);
    if constexpr (!ALIGN_EPI) { if (wr == 0) PG8_BAR; }
    PG8_BAR;
    if constexpr (Epi::AFTER_DRAIN) { E.fused(acc, cur, wr, wc, fr, fq, lds, wid, lane); S.done(cur); }
#undef PG8_SA
#undef PG8_SB
#undef PG8_STAGE
#undef PG8_LDA
#undef PG8_LDB
#undef PG8_MMA
#undef PG8_WAIT_V
#undef PG8_WAIT_L
#undef PG8_BAR
#undef PG8_SCHED
}
}

#ifndef PG8_SP2
#define PG8_SP2 true
#endif
#ifndef PG8_ALIGN
#define PG8_ALIGN true
#endif

namespace att {
using bf16 = unsigned short;
using bf16x8 = __attribute__((ext_vector_type(8))) short;
using s16x4  = __attribute__((ext_vector_type(4))) short;
using f32x16 = __attribute__((ext_vector_type(16))) float;
using u32x4  = __attribute__((ext_vector_type(4))) unsigned;
constexpr int NW = 8, QBLK = 32, KVBLK = 64, DV = 128;
constexpr float THR = 8.f;
constexpr int SHM_V = KVBLK * DV * 2;
constexpr int LDS_WS_OFF = 2 * SHM_V + 2 * (KVBLK * 128 * 2);
constexpr int LDS_BT_OFF = LDS_WS_OFF + NW * 64 * 4;
constexpr int LDS_Q_OFF = LDS_BT_OFF + 2048;
constexpr int LDS_END = LDS_Q_OFF + NW * 8192;
#define ATT_KSWZ128(row, colB) ((row) * 256 + ((colB) ^ (((row) & 7) << 4)))
#define ATT_KSWZ64(row, colB)  ((row) * 128 + ((colB) ^ ((((row) >> 1) & 7) << 4)))
#define ATT_SBAR() __builtin_amdgcn_sched_barrier(0)
__device__ __forceinline__ int crow(int r, int hi) { return (r & 3) + 8 * (r >> 2) + 4 * hi; }
__device__ __forceinline__ unsigned cvtpk(float lo, float hi) { unsigned r; asm volatile("v_cvt_pk_bf16_f32 %0, %1, %2" : "=v"(r) : "v"(lo), "v"(hi)); return r; }
__device__ __forceinline__ bf16x8 ld8(const bf16* p) { return *reinterpret_cast<const bf16x8*>(p); }

template <int DQK> __device__ __forceinline__ void partialSM(f32x16& p0, f32x16& p1, float& m_reg, float& mn, float& alpha) {
  constexpr float SCALE = (DQK == 64) ? 0.125f : 0.088388347648318440f;
  constexpr float C = SCALE * 1.4426950408889634f;
  float pmax = p0[0];
#pragma unroll
  for (int r = 1; r < 16; ++r) pmax = fmaxf(pmax, p0[r]);
#pragma unroll
  for (int r = 0; r < 16; ++r) pmax = fmaxf(pmax, p1[r]);
  { auto rr = __builtin_amdgcn_permlane32_swap(__float_as_uint(pmax), __float_as_uint(pmax), false, false);
    pmax = fmaxf(__uint_as_float(rr[0]), __uint_as_float(rr[1])); }
  if (__builtin_expect(__all(pmax - m_reg <= THR / SCALE), 1)) { mn = m_reg; alpha = 1.f; }
  else { mn = fmaxf(m_reg, pmax); alpha = __builtin_amdgcn_exp2f((m_reg - mn) * C); m_reg = mn; }
  float mnC = -mn * C;
#pragma unroll
  for (int r = 0; r < 16; ++r) p0[r] = fmaf(p0[r], C, mnC);
#pragma unroll
  for (int r = 0; r < 16; ++r) p1[r] = fmaf(p1[r], C, mnC);
#pragma unroll
  for (int r = 0; r < 16; ++r) p0[r] = __builtin_amdgcn_exp2f(p0[r]);
}
__device__ __forceinline__ void finishSM(f32x16& p0, f32x16& p1, float alpha, float& l_reg, bf16x8& pa0, bf16x8& pa1, bf16x8& pa2, bf16x8& pa3) {
#pragma unroll
  for (int r = 0; r < 16; ++r) p1[r] = __builtin_amdgcn_exp2f(p1[r]);
  float ps = 0;
#pragma unroll
  for (int r = 0; r < 16; ++r) ps += p0[r];
#pragma unroll
  for (int r = 0; r < 16; ++r) ps += p1[r];
  { auto rr = __builtin_amdgcn_permlane32_swap(__float_as_uint(ps), __float_as_uint(ps), false, false);
    ps = __uint_as_float(rr[0]) + __uint_as_float(rr[1]); }
  l_reg = l_reg * alpha + ps;
#define ATT_PK4(P, BASE, OUT) do { unsigned a0 = cvtpk(P[BASE + 0], P[BASE + 1]), a1 = cvtpk(P[BASE + 2], P[BASE + 3]);   \
    unsigned b0 = cvtpk(P[BASE + 4], P[BASE + 5]), b1 = cvtpk(P[BASE + 6], P[BASE + 7]);                              \
    auto r0 = __builtin_amdgcn_permlane32_swap(a0, b0, false, false); auto r1 = __builtin_amdgcn_permlane32_swap(a1, b1, false, false); \
    u32x4 w = {r0[0], r1[0], r0[1], r1[1]}; OUT = *reinterpret_cast<bf16x8*>(&w); } while (0)
  ATT_PK4(p0, 0, pa0); ATT_PK4(p0, 8, pa1); ATT_PK4(p1, 0, pa2); ATT_PK4(p1, 8, pa3);
#undef ATT_PK4
}
__device__ __forceinline__ void expSM(f32x16& p) {
#pragma unroll
  for (int r = 0; r < 16; ++r) p[r] = __builtin_amdgcn_exp2f(p[r]);
}
__device__ __forceinline__ void packSM(f32x16& p0, f32x16& p1, float& l_reg, bf16x8& pa0, bf16x8& pa1, bf16x8& pa2, bf16x8& pa3) {
  float ps = 0;
#pragma unroll
  for (int r = 0; r < 16; ++r) ps += p0[r];
#pragma unroll
  for (int r = 0; r < 16; ++r) ps += p1[r];
  l_reg += ps; asm volatile("" : "+v"(l_reg));
#define ATT_PK4(P, BASE, OUT) do { unsigned a0 = cvtpk(P[BASE + 0], P[BASE + 1]), a1 = cvtpk(P[BASE + 2], P[BASE + 3]);   \
    unsigned b0 = cvtpk(P[BASE + 4], P[BASE + 5]), b1 = cvtpk(P[BASE + 6], P[BASE + 7]);                              \
    auto r0 = __builtin_amdgcn_permlane32_swap(a0, b0, false, false); auto r1 = __builtin_amdgcn_permlane32_swap(a1, b1, false, false); \
    u32x4 w = {r0[0], r1[0], r0[1], r1[1]}; OUT = *reinterpret_cast<bf16x8*>(&w); } while (0)
  ATT_PK4(p0, 0, pa0); ATT_PK4(p0, 8, pa1); ATT_PK4(p1, 0, pa2); ATT_PK4(p1, 8, pa3);
#undef ATT_PK4
}
__device__ __forceinline__ void finish_l(float l_reg, float* li_l, int r32, int hi, float (&rli)[16]) {
  { auto rr = __builtin_amdgcn_permlane32_swap(__float_as_uint(l_reg), __float_as_uint(l_reg), false, false); l_reg = __uint_as_float(rr[0]) + __uint_as_float(rr[1]); }
  if (hi == 0) li_l[r32] = l_reg; asm volatile("s_waitcnt lgkmcnt(0)" ::: "memory");
#pragma unroll
  for (int r = 0; r < 16; ++r) rli[r] = __builtin_amdgcn_rcpf(li_l[crow(r, hi)]);
}
template <int DQK, bool QLDS, int KW> __device__ __forceinline__ void qkt(f32x16& p0, f32x16& p1, const char* Ks, const bf16x8* qr, const char* Qs, int r32, int hi, int kcb) {
  p0 = f32x16{}; p1 = f32x16{};
#pragma unroll
  for (int d0 = 0; d0 < DQK / 16; ++d0) { const int cb = (d0 * 16 + hi * 8) * 2;
    bf16x8 b0, b1, qv;
    if constexpr (QLDS) qv = *reinterpret_cast<const bf16x8*>(Qs + ATT_KSWZ128(r32, cb)); else qv = qr[d0];
    if constexpr (KW == 128) { b0 = *reinterpret_cast<const bf16x8*>(Ks + ATT_KSWZ128(r32, kcb + cb)); b1 = *reinterpret_cast<const bf16x8*>(Ks + ATT_KSWZ128(32 + r32, kcb + cb)); }
    else                      { b0 = *reinterpret_cast<const bf16x8*>(Ks + ATT_KSWZ64(r32, cb));  b1 = *reinterpret_cast<const bf16x8*>(Ks + ATT_KSWZ64(32 + r32, cb)); }
    p0 = __builtin_amdgcn_mfma_f32_32x32x16_bf16(b0, qv, p0, 0, 0, 0);
    p1 = __builtin_amdgcn_mfma_f32_32x32x16_bf16(b1, qv, p1, 0, 0, 0); }
}
__device__ __forceinline__ int v_st(int k, int c) { const int kk = (k & ~0xC) | ((k & 4) << 1) | ((k & 8) >> 1); return ((kk >> 3) * 4 + (c >> 5)) * 512 + ((kk & 7) * 32 + (c & 31)) * 2; }
__device__ __forceinline__ int v_rd_base(int lane) { return ((lane & 3) << 3) | (((lane >> 2) & 3) << 6) | (((lane >> 4) & 1) << 5) | (((lane >> 5) & 1) << 8); }
constexpr int v_rd_off(int d0, int ks, int half) { return d0 * 512 + ks * 4096 + half * 2048; }
template <int OFF> __device__ __forceinline__ s16x4 tr_read(int vb) {
  s16x4 r; asm volatile("ds_read_b64_tr_b16 %0, %1 offset:%2" : "=&v"(r) : "v"(vb), "i"(OFF) : "memory"); return r;
}
template <int D0> __device__ __forceinline__ void pv_one(f32x16& od, int vb, bf16x8 pa0, bf16x8 pa1, bf16x8 pa2, bf16x8 pa3) {
  const s16x4 l0 = tr_read<v_rd_off(D0, 0, 0)>(vb), h0 = tr_read<v_rd_off(D0, 0, 1)>(vb), l1 = tr_read<v_rd_off(D0, 1, 0)>(vb), h1 = tr_read<v_rd_off(D0, 1, 1)>(vb);
  const s16x4 l2 = tr_read<v_rd_off(D0, 2, 0)>(vb), h2 = tr_read<v_rd_off(D0, 2, 1)>(vb), l3 = tr_read<v_rd_off(D0, 3, 0)>(vb), h3 = tr_read<v_rd_off(D0, 3, 1)>(vb);
  asm volatile("s_waitcnt lgkmcnt(0)" ::: "memory"); ATT_SBAR();
#define ATT_PK(L, H) (bf16x8){L[0], L[1], L[2], L[3], H[0], H[1], H[2], H[3]}
  od = __builtin_amdgcn_mfma_f32_32x32x16_bf16(pa0, ATT_PK(l0, h0), od, 0, 0, 0);
  od = __builtin_amdgcn_mfma_f32_32x32x16_bf16(pa1, ATT_PK(l1, h1), od, 0, 0, 0);
  od = __builtin_amdgcn_mfma_f32_32x32x16_bf16(pa2, ATT_PK(l2, h2), od, 0, 0, 0);
  od = __builtin_amdgcn_mfma_f32_32x32x16_bf16(pa3, ATT_PK(l3, h3), od, 0, 0, 0);
#undef ATT_PK
}
__device__ __forceinline__ void pv_d0(f32x16* o, int vb, bf16x8 pa0, bf16x8 pa1, bf16x8 pa2, bf16x8 pa3) {
  pv_one<0>(o[0], vb, pa0, pa1, pa2, pa3); pv_one<1>(o[1], vb, pa0, pa1, pa2, pa3); pv_one<2>(o[2], vb, pa0, pa1, pa2, pa3); pv_one<3>(o[3], vb, pa0, pa1, pa2, pa3);
}

#define ATT_TR8(D0, A) do { A##0 = tr_read<v_rd_off(D0, 0, 0)>(vb); A##1 = tr_read<v_rd_off(D0, 0, 1)>(vb); A##2 = tr_read<v_rd_off(D0, 1, 0)>(vb); A##3 = tr_read<v_rd_off(D0, 1, 1)>(vb); \
    A##4 = tr_read<v_rd_off(D0, 2, 0)>(vb); A##5 = tr_read<v_rd_off(D0, 2, 1)>(vb); A##6 = tr_read<v_rd_off(D0, 3, 0)>(vb); A##7 = tr_read<v_rd_off(D0, 3, 1)>(vb); } while (0)
#define ATT_PK2(L, H) (bf16x8){L[0], L[1], L[2], L[3], H[0], H[1], H[2], H[3]}
#define ATT_MM4(OD, A) do { OD = __builtin_amdgcn_mfma_f32_32x32x16_bf16(pa0, ATT_PK2(A##0, A##1), OD, 0, 0, 0); OD = __builtin_amdgcn_mfma_f32_32x32x16_bf16(pa1, ATT_PK2(A##2, A##3), OD, 0, 0, 0); \
    OD = __builtin_amdgcn_mfma_f32_32x32x16_bf16(pa2, ATT_PK2(A##4, A##5), OD, 0, 0, 0); OD = __builtin_amdgcn_mfma_f32_32x32x16_bf16(pa3, ATT_PK2(A##6, A##7), OD, 0, 0, 0); } while (0)
struct VFrag { s16x4 a0, a1, a2, a3, a4, a5, a6, a7, b0, b1, b2, b3, b4, b5, b6, b7; };
__device__ __forceinline__ void pv_issue(VFrag& f, int vb) { ATT_TR8(0, f.a); ATT_TR8(1, f.b); }
__device__ __forceinline__ void pv_pipe(VFrag& f, f32x16* o, int vb, bf16x8 pa0, bf16x8 pa1, bf16x8 pa2, bf16x8 pa3) {
  asm volatile("s_waitcnt lgkmcnt(0)" ::: "memory"); ATT_SBAR(); ATT_MM4(o[0], f.a);
  ATT_SBAR(); ATT_TR8(2, f.a); ATT_SBAR(); ATT_MM4(o[1], f.b);
  ATT_SBAR(); ATT_TR8(3, f.b);
  asm volatile("s_waitcnt lgkmcnt(8)" ::: "memory"); ATT_SBAR(); ATT_MM4(o[2], f.a);
  asm volatile("s_waitcnt lgkmcnt(0)" ::: "memory"); ATT_SBAR(); ATT_MM4(o[3], f.b);
}

struct NoMask { __device__ __forceinline__ void operator()(f32x16&, f32x16&, int) const {} };

template <int DQK, int LDQ, int LDQ2, int LDKV, int SDEPTH, bool DUAL, class TileRow, class Mask>
__device__ __forceinline__ void attn_core(const bf16* __restrict__ Qa, const bf16* __restrict__ Qalt, int nswitch,
                                          const bf16* __restrict__ Kb, const bf16* __restrict__ Vb,
                                          const TileRow& trow, const int NT, const Mask& mask, char* lds, f32x16 (&o)[4], float (&rli)[16]) {
  static_assert(!DUAL || DQK == 64, "DUAL is the differential-attention form");
  constexpr int KW = DUAL ? 128 : DQK;
  constexpr int SHM_K = KVBLK * KW * 2;
  constexpr int NQ = DQK / 16;
  int tid_ = threadIdx.x; asm volatile("" : "+v"(tid_));
  const int tid = tid_, wid = tid >> 6, lane = tid & 63, r32 = lane & 31, hi = lane >> 5;
  const int wq = DUAL ? (wid & 3) : wid, comp = DUAL ? (wid >> 2) : 0, kcb = comp * 128;
  char* V_lds = lds; char* K_lds = lds + 2 * SHM_V;
  float* wsf = (float*)(lds + LDS_WS_OFF) + wid * 64; float* li_l = wsf; float* al_l = wsf + 32;
  float m_reg = -1e30f, l_reg = 0;
#pragma unroll
  for (int d = 0; d < 4; ++d) o[d] = f32x16{};
  constexpr bool QLDS = (DQK == 128);
  char* Qs = lds + LDS_Q_OFF + wid * 8192;
  bf16x8 qr[NQ];
  { const bf16* Qw = Qa + (long)(wq * QBLK + r32) * LDQ + comp * 64 + hi * 8;
#pragma unroll
    for (int d0 = 0; d0 < NQ; ++d0) qr[d0] = ld8(Qw + d0 * 16);
    if constexpr (QLDS) {
#pragma unroll
      for (int d0 = 0; d0 < NQ; ++d0) *reinterpret_cast<bf16x8*>(Qs + ATT_KSWZ128(r32, (d0 * 16 + hi * 8) * 2)) = qr[d0];
      asm volatile("s_waitcnt lgkmcnt(0)" ::: "memory"); } }
  const int sr = tid >> 4, sc = (tid & 15) * 8, vst0 = v_st(sr, sc), vst1 = v_st(32 + sr, sc);
  const int k64r = tid >> 3, k64c = (tid & 7) * 8;
  const unsigned voffV = (unsigned)(sr * LDKV + sc) * 2u, voffK = (KW == 128) ? voffV : (unsigned)(k64r * LDKV + k64c) * 2u;
  const int vb0 = (int)(unsigned)(uintptr_t)V_lds + v_rd_base(lane);
  struct { bf16x8 vs0, vs1, ks0, ks1; } sr_[SDEPTH];
#define ATT_SLOAD(i, jt) do { const long row0_ = (long)__builtin_amdgcn_readfirstlane(trow(jt)); const char* vt_ = (const char*)(Vb + row0_ * LDKV); const char* kt_ = (const char*)(Kb + row0_ * LDKV); \
    sr_[i].vs0 = *(const bf16x8*)(vt_ + voffV); sr_[i].vs1 = *(const bf16x8*)(vt_ + 64 * LDKV + voffV); \
    if constexpr (KW == 128) { sr_[i].ks0 = *(const bf16x8*)(kt_ + voffK); sr_[i].ks1 = *(const bf16x8*)(kt_ + 64 * LDKV + voffK); } \
    else { sr_[i].ks0 = *(const bf16x8*)(kt_ + voffK); } } while (0)
#define ATT_SWRITE(b, i) do { *(bf16x8*)(V_lds + (b) * SHM_V + vst0) = sr_[i].vs0; *(bf16x8*)(V_lds + (b) * SHM_V + vst1) = sr_[i].vs1; \
    if constexpr (KW == 128) { const int kc_ = sc * 2; *(bf16x8*)(K_lds + (b) * SHM_K + ATT_KSWZ128(sr, kc_)) = sr_[i].ks0; *(bf16x8*)(K_lds + (b) * SHM_K + ATT_KSWZ128(32 + sr, kc_)) = sr_[i].ks1; } \
    else { *(bf16x8*)(K_lds + (b) * SHM_K + ATT_KSWZ64(k64r, k64c * 2)) = sr_[i].ks0; } } while (0)
#define ATT_SWAIT() do { if constexpr (SDEPTH == 1) asm volatile("s_waitcnt vmcnt(0)" ::: "memory"); else if constexpr (KW == 128) asm volatile("s_waitcnt vmcnt(4)" ::: "memory"); else asm volatile("s_waitcnt vmcnt(3)" ::: "memory"); } while (0)
#define ATT_RESC(a) do { if (__any((a) < 1.f)) { if (hi == 0) al_l[r32] = (a); asm volatile("s_waitcnt lgkmcnt(0)" ::: "memory"); \
    _Pragma("unroll") for (int d = 0; d < 4; ++d) _Pragma("unroll") for (int r = 0; r < 16; ++r) o[d][r] *= al_l[crow(r, hi)]; } } while (0)
  f32x16 pA0, pA1, pB0, pB1; float mnA, mnB, alA, alB; bf16x8 pa0, pa1, pa2, pa3;
  constexpr int SE = 0, SO = SDEPTH - 1;
  ATT_SLOAD(SE, 0); asm volatile("s_waitcnt vmcnt(0)" ::: "memory"); ATT_SWRITE(0, SE); __syncthreads();
  qkt<DQK, QLDS, KW>(pA0, pA1, K_lds, qr, Qs, r32, hi, kcb); mask(pA0, pA1, 0); partialSM<DQK>(pA0, pA1, m_reg, mnA, alA);
  ATT_SLOAD(SO, 1); if constexpr (SDEPTH == 2) { if (2 < NT) ATT_SLOAD(SE, 2); }
  ATT_SWAIT(); ATT_SWRITE(1, SO); __syncthreads();
  for (int j = 1; j + 1 < NT; j += 2) {
    ATT_SBAR(); qkt<DQK, QLDS, KW>(pB0, pB1, K_lds + SHM_K, qr, Qs, r32, hi, kcb);
    finishSM(pA0, pA1, alA, l_reg, pa0, pa1, pa2, pa3); ATT_SBAR();
    ATT_SLOAD(SO, j + SDEPTH); ATT_SBAR();
    pv_d0(o, vb0, pa0, pa1, pa2, pa3); mask(pB0, pB1, j); partialSM<DQK>(pB0, pB1, m_reg, mnB, alB);
    __syncthreads(); ATT_SWAIT(); ATT_SWRITE(0, SE);
    ATT_RESC(alB); __syncthreads();
    if constexpr (DQK == 64) { if (j + 1 == nswitch) { const bf16* Qw = Qalt + (long)(wq * QBLK + r32) * LDQ2 + comp * 64 + hi * 8;
#pragma unroll
        for (int d0 = 0; d0 < NQ; ++d0) qr[d0] = ld8(Qw + d0 * 16); } }
    ATT_SBAR(); qkt<DQK, QLDS, KW>(pA0, pA1, K_lds, qr, Qs, r32, hi, kcb);
    finishSM(pB0, pB1, alB, l_reg, pa0, pa1, pa2, pa3); ATT_SBAR();
    if (SDEPTH == 1 || j + 3 < NT) ATT_SLOAD(SE, j + 1 + SDEPTH); ATT_SBAR();
    pv_d0(o, vb0 + SHM_V, pa0, pa1, pa2, pa3); mask(pA0, pA1, j + 1); partialSM<DQK>(pA0, pA1, m_reg, mnA, alA);
    __syncthreads(); ATT_SWAIT(); ATT_SWRITE(1, SO);
    ATT_RESC(alA); __syncthreads();
  }
  ATT_SBAR(); qkt<DQK, QLDS, KW>(pB0, pB1, K_lds + SHM_K, qr, Qs, r32, hi, kcb);
  finishSM(pA0, pA1, alA, l_reg, pa0, pa1, pa2, pa3); ATT_SBAR();
  pv_d0(o, vb0, pa0, pa1, pa2, pa3); mask(pB0, pB1, NT - 1); partialSM<DQK>(pB0, pB1, m_reg, mnB, alB);
  __syncthreads(); ATT_RESC(alB);
  finishSM(pB0, pB1, alB, l_reg, pa0, pa1, pa2, pa3); ATT_SBAR();
  pv_d0(o, vb0 + SHM_V, pa0, pa1, pa2, pa3);
  if (hi == 0) li_l[r32] = l_reg; asm volatile("s_waitcnt lgkmcnt(0)" ::: "memory");
#pragma unroll
  for (int r = 0; r < 16; ++r) rli[r] = __builtin_amdgcn_rcpf(li_l[crow(r, hi)]);
#undef ATT_SLOAD
#undef ATT_SWRITE
#undef ATT_SWAIT
#undef ATT_RESC
}

constexpr int DS_V = 0, DS_K = 3 * 16384, DS_WS = 6 * 16384, DS_Q = DS_WS + NW * 64 * 4, DS_END = DS_Q + NW * 4096;
template <int OFF> __device__ __forceinline__ bf16x8 lds_rd128(int addr) { bf16x8 r; asm volatile("ds_read_b128 %0, %1 offset:%2" : "=&v"(r) : "v"(addr), "i"(OFF) : "memory"); return r; }
template <int LDQ, int LDQ2, int LDKV, class TileRow>
__device__ __forceinline__ void attn_dual_stag(const bf16* __restrict__ Qa, const bf16* __restrict__ Qalt, int nswitch,
                                               const bf16* __restrict__ Kb, const bf16* __restrict__ Vb,
                                               const TileRow& trow, const int NT, char* lds, f32x16 (&o)[4], float (&rli)[16]) {
  int tid_ = threadIdx.x; asm volatile("" : "+v"(tid_));
  const int tid = tid_, wid = tid >> 6, lane = tid & 63, r32 = lane & 31, hi = lane >> 5;
  const int wq = wid & 3, g = __builtin_amdgcn_readfirstlane(wid >> 2), kcb = g * 128;
  char* V_lds = lds + DS_V; char* K_lds = lds + DS_K;
  float* wsf = (float*)(lds + DS_WS) + wid * 64; float* li_l = wsf;
  float l_reg = 0;
#pragma unroll
  for (int d = 0; d < 4; ++d) o[d] = f32x16{};
  bf16x8 qr[4];
  char* Qsw = lds + DS_Q + wid * 4096 + lane * 16;
  { const bf16* Qw = Qa + (long)(wq * QBLK + r32) * LDQ + g * 64 + hi * 8;
    const bf16* Qw2 = Qalt + (long)(wq * QBLK + r32) * LDQ2 + g * 64 + hi * 8;
#pragma unroll
    for (int d0 = 0; d0 < 4; ++d0) { qr[d0] = ld8(Qw + d0 * 16); *(bf16x8*)(Qsw + d0 * 1024) = ld8(Qw2 + d0 * 16); } }
  const int tg = tid & 255, sr = 32 * g + (tg >> 4), sc = (tg & 15) * 8;
  const int vst0 = v_st(sr, sc), vst1 = v_st(sr + 16, sc), kst0 = ATT_KSWZ128(sr, sc * 2), kst1 = ATT_KSWZ128(sr + 16, sc * 2);
  const unsigned voff = (unsigned)(sr * LDKV + sc) * 2u;
  const bf16* kbu = (const bf16*)(((unsigned long long)(unsigned)__builtin_amdgcn_readfirstlane((int)((unsigned long long)Kb >> 32)) << 32) | (unsigned)__builtin_amdgcn_readfirstlane((int)(unsigned long long)Kb));
  const int vdelta = __builtin_amdgcn_readfirstlane((int)((const char*)Vb - (const char*)Kb));
  const __amdgpu_buffer_rsrc_t kvrs = __builtin_amdgcn_make_buffer_rsrc((void*)kbu, 0, 0x7fffffff, 0x00020000);
  const int vb0 = (int)(unsigned)(uintptr_t)V_lds + v_rd_base(lane);
  const int kb0 = (int)(unsigned)(uintptr_t)K_lds;
  const int ka0 = kb0 + ATT_KSWZ128(r32, kcb + (0 * 16 + hi * 8) * 2), ka1 = kb0 + ATT_KSWZ128(r32, kcb + (1 * 16 + hi * 8) * 2);
  const int ka2 = kb0 + ATT_KSWZ128(r32, kcb + (2 * 16 + hi * 8) * 2), ka3 = kb0 + ATT_KSWZ128(r32, kcb + (3 * 16 + hi * 8) * 2);
  bf16x8 svA0, svA1, skA0, skA1, svB0, svB1, skB0, skB1;
#define DS_SLOAD(S, jt) do { const int so_ = __builtin_amdgcn_readfirstlane(trow(jt)) * (LDKV * 2);   \
    sk##S##0 = __builtin_bit_cast(bf16x8, __builtin_amdgcn_raw_buffer_load_b128(kvrs, (int)voff, so_, 0)); sk##S##1 = __builtin_bit_cast(bf16x8, __builtin_amdgcn_raw_buffer_load_b128(kvrs, (int)voff, so_ + 32 * LDKV, 0)); \
    sv##S##0 = __builtin_bit_cast(bf16x8, __builtin_amdgcn_raw_buffer_load_b128(kvrs, (int)voff, so_ + vdelta, 0)); sv##S##1 = __builtin_bit_cast(bf16x8, __builtin_amdgcn_raw_buffer_load_b128(kvrs, (int)voff, so_ + vdelta + 32 * LDKV, 0)); } while (0)
#define DS_SWRITE(S, slot) do { const int so_ = (slot) * 16384; *(bf16x8*)(V_lds + so_ + vst0) = sv##S##0; *(bf16x8*)(V_lds + so_ + vst1) = sv##S##1; *(bf16x8*)(K_lds + so_ + kst0) = sk##S##0; *(bf16x8*)(K_lds + so_ + kst1) = sk##S##1; } while (0)
#define DS_BAR() do { ATT_SBAR(); asm volatile("s_waitcnt lgkmcnt(0)\n\ts_barrier" ::: "memory"); ATT_SBAR(); } while (0)
#define DS_LGKM(n) asm volatile("s_waitcnt lgkmcnt(" #n ")" ::: "memory")
#define DS_KREADS(so) do { const int o_ = (so); kf0 = lds_rd128<0>(ka0 + o_); kf1 = lds_rd128<8192>(ka0 + o_); kf2 = lds_rd128<0>(ka1 + o_); kf3 = lds_rd128<8192>(ka1 + o_); \
    kf4 = lds_rd128<0>(ka2 + o_); kf5 = lds_rd128<8192>(ka2 + o_); kf6 = lds_rd128<0>(ka3 + o_); kf7 = lds_rd128<8192>(ka3 + o_); } while (0)
#define DS_QK() do { p0 = f32x16{}; p1 = f32x16{}; \
    p0 = __builtin_amdgcn_mfma_f32_32x32x16_bf16(kf0, qr[0], p0, 0, 0, 0); p1 = __builtin_amdgcn_mfma_f32_32x32x16_bf16(kf1, qr[0], p1, 0, 0, 0); \
    p0 = __builtin_amdgcn_mfma_f32_32x32x16_bf16(kf2, qr[1], p0, 0, 0, 0); p1 = __builtin_amdgcn_mfma_f32_32x32x16_bf16(kf3, qr[1], p1, 0, 0, 0); \
    p0 = __builtin_amdgcn_mfma_f32_32x32x16_bf16(kf4, qr[2], p0, 0, 0, 0); p1 = __builtin_amdgcn_mfma_f32_32x32x16_bf16(kf5, qr[2], p1, 0, 0, 0); \
    p0 = __builtin_amdgcn_mfma_f32_32x32x16_bf16(kf6, qr[3], p0, 0, 0, 0); p1 = __builtin_amdgcn_mfma_f32_32x32x16_bf16(kf7, qr[3], p1, 0, 0, 0); } while (0)
#define DS_QKA() do { p0 = f32x16{}; p1 = f32x16{}; \
    p0 = __builtin_amdgcn_mfma_f32_32x32x16_bf16(kf0, qr[0], p0, 0, 0, 0); p1 = __builtin_amdgcn_mfma_f32_32x32x16_bf16(kf1, qr[0], p1, 0, 0, 0); \
    p0 = __builtin_amdgcn_mfma_f32_32x32x16_bf16(kf2, qr[1], p0, 0, 0, 0); p1 = __builtin_amdgcn_mfma_f32_32x32x16_bf16(kf3, qr[1], p1, 0, 0, 0); } while (0)
#define DS_QKB() do { \
    p0 = __builtin_amdgcn_mfma_f32_32x32x16_bf16(kf4, qr[2], p0, 0, 0, 0); p1 = __builtin_amdgcn_mfma_f32_32x32x16_bf16(kf5, qr[2], p1, 0, 0, 0); \
    p0 = __builtin_amdgcn_mfma_f32_32x32x16_bf16(kf6, qr[3], p0, 0, 0, 0); p1 = __builtin_amdgcn_mfma_f32_32x32x16_bf16(kf7, qr[3], p1, 0, 0, 0); } while (0)
  DS_SLOAD(A, 0); DS_SWRITE(A, 0); DS_SLOAD(A, 1); DS_SWRITE(A, 1);
  if (g == 1 && 2 < NT) DS_SLOAD(A, 2);
  DS_BAR();
  f32x16 p0, p1; bf16x8 pa0, pa1, pa2, pa3; bf16x8 kf0, kf1, kf2, kf3, kf4, kf5, kf6, kf7;
  if (2 + g < NT) DS_SLOAD(B, 2 + g);
  ATT_SBAR(); DS_KREADS(0); DS_LGKM(0); ATT_SBAR(); DS_QK();
  if (g == 1) DS_BAR();
  int s0 = 0, s1 = 1;
#define DS_TILE(S, k_) do { \
    expSM(p0); expSM(p1); packSM(p0, p1, l_reg, pa0, pa1, pa2, pa3); \
    { const int jt = (k_) + 1 + g; if (jt >= 2 && jt < NT) { int sl = s1 + g; sl = sl >= 3 ? sl - 3 : sl; DS_SWRITE(S, sl); } } \
    const int vb = vb0 + s0 * 16384; VFrag f; \
    ATT_SBAR(); ATT_TR8(0, f.a); ATT_TR8(1, f.b); ATT_SBAR(); \
    if (g == 0) DS_BAR(); \
    { const int jt = (k_) + 3 + g; if (jt < NT) DS_SLOAD(S, jt); } \
    if ((k_) + 1 == nswitch) { \
      const int qa_ = (int)(unsigned)(uintptr_t)Qsw; qr[0] = lds_rd128<0>(qa_); qr[1] = lds_rd128<1024>(qa_); qr[2] = lds_rd128<2048>(qa_); qr[3] = lds_rd128<3072>(qa_);   \
      asm volatile("s_waitcnt lgkmcnt(0)" ::: "memory"); } \
    ATT_SBAR(); \
    __builtin_amdgcn_s_setprio(1); DS_KREADS(s1 * 16384); \
    DS_LGKM(8); ATT_SBAR(); ATT_MM4(o[0], f.a); ATT_SBAR(); ATT_TR8(2, f.a); ATT_SBAR(); ATT_MM4(o[1], f.b); \
    ATT_SBAR(); DS_LGKM(8); ATT_SBAR();                  \
    if ((k_) + 1 < NT) { DS_QKA(); DS_QKB(); } \
    ATT_SBAR(); ATT_TR8(3, f.b); \
    ATT_SBAR(); DS_LGKM(8); ATT_SBAR(); ATT_MM4(o[2], f.a); \
    ATT_SBAR(); DS_LGKM(0); ATT_SBAR(); ATT_MM4(o[3], f.b); __builtin_amdgcn_s_setprio(0); \
    if (g == 1 && (k_) + 1 < NT) DS_BAR(); \
    s0 = s1; s1 = s1 == 2 ? 0 : s1 + 1; } while (0)
#pragma clang loop unroll(disable)
  for (int k = 0; k < NT; k += 2) { DS_TILE(A, k); DS_TILE(B, k + 1); }
#undef DS_TILE
  finish_l(l_reg, li_l, r32, hi, rli);
#undef DS_SLOAD
#undef DS_SWRITE
#undef DS_BAR
#undef DS_LGKM
#undef DS_KREADS
#undef DS_QK
#undef DS_QKA
#undef DS_QKB
}
}

constexpr int DM = 2048, NBATCH = 2, SEQ = 8192, DEPTH = 4, CTXL = 256;
constexpr int ML = NBATCH * SEQ;
constexpr int MC = NBATCH * CTXL;
constexpr int MT = ML + MC;
constexpr int EV_IN = 5120;
constexpr int EVN = 4608 + 1024;
constexpr int ODN = 6144;
constexpr int FH = 5632;
constexpr int NPH = 1 + 8 * DEPTH;
#ifndef PHM
#define PHM 1023
#endif
#ifndef MXM
#define MXM 15
#endif
#ifndef MK_N_LAUNCHES
#define MK_N_LAUNCHES 1
#endif
constexpr float LAM_INIT0 = 0.2f, LAM_INIT1 = 0.47071301834370415f;

constexpr size_t MiB = 1u << 20;
constexpr size_t WS_CTL = 0, CTL_ZERO_BYTES = 1 * MiB;
constexpr size_t WS_MODV = 1 * MiB;
constexpr size_t WS_ROPE = 2 * MiB;
constexpr size_t WS_LAM = 2 * MiB + 64 * 1024;
constexpr size_t WS_FA1 = 2 * MiB + 128 * 1024;
constexpr size_t WS_FA2 = 2 * MiB + 192 * 1024;
constexpr size_t WS_FA3 = 2 * MiB + 256 * 1024;
constexpr size_t WS_WIN_E = 4 * MiB,  SZ_WIN_E = 22 * MiB;
constexpr size_t WS_WOUT_E = WS_WIN_E + 2 * SZ_WIN_E, SZ_WOUT = 8 * MiB;
constexpr size_t WS_WIN_O = WS_WOUT_E + 2 * SZ_WOUT, SZ_WIN_O = 24 * MiB;
constexpr size_t WS_WOUT_O = WS_WIN_O + 2 * SZ_WIN_O;
constexpr size_t WS_WFI = WS_WOUT_O + 2 * SZ_WOUT, SZ_WFI = 44 * MiB;
constexpr size_t WS_WFO = WS_WFI + 4 * SZ_WFI, SZ_WFO = 22 * MiB;
constexpr size_t WS_A = WS_WFO + 4 * SZ_WFO;
constexpr size_t WS_P = WS_A + 66 * MiB;
constexpr size_t WS_QR = WS_P + 198 * MiB;
constexpr size_t WS_MIX = WS_QR + 48 * MiB;
constexpr size_t WS_HID = WS_MIX + 66 * MiB;
constexpr size_t WS_HC = WS_HID + 182 * MiB;
constexpr size_t WS_STASH = WS_HC + 4 * MiB;
constexpr size_t WS_SLAB = WS_STASH + 128 * MiB;
constexpr size_t WS_END = WS_SLAB + 48 * MiB;
static_assert(WS_A == 392 * MiB && WS_END == 1132 * MiB, "d_ws map");
constexpr int CW_BAR = 4096;

constexpr int GEN_BYTES = 143360;
constexpr int MISC_OFF = GEN_BYTES;
constexpr int LDS_BYTES = 147456;

#define GAS __attribute__((address_space(1)))
#define LAS __attribute__((address_space(3)))
typedef unsigned short bf16;
typedef unsigned v4u __attribute__((ext_vector_type(4)));
typedef unsigned v2u __attribute__((ext_vector_type(2)));
typedef float f32x4 __attribute__((ext_vector_type(4)));
typedef short bf16x8 __attribute__((ext_vector_type(8)));
typedef GAS unsigned gu32;
#define RLX_AGENT __ATOMIC_RELAXED, __HIP_MEMORY_SCOPE_AGENT
#define LDS_WAIT() asm volatile("s_waitcnt lgkmcnt(0)" ::: "memory")
#define VM_WAIT() asm volatile("s_waitcnt vmcnt(0)" ::: "memory")
__device__ __forceinline__ unsigned f2bf(float f) { unsigned u = __builtin_bit_cast(unsigned, f); return (u + 0x7fffu + ((u >> 16) & 1u)) >> 16; }
__device__ __forceinline__ unsigned pk2(float lo, float hi) { return f2bf(lo) | (f2bf(hi) << 16); }
__device__ __forceinline__ float bflo(unsigned w) { return __uint_as_float(w << 16); }
__device__ __forceinline__ float bfhi(unsigned w) { return __uint_as_float(w & 0xffff0000u); }
__device__ __forceinline__ float hw_cos(float rev) { return __builtin_amdgcn_cosf(rev); }
__device__ __forceinline__ float hw_sin(float rev) { return __builtin_amdgcn_sinf(rev); }
#define XB_TMO      128
#define XB_XCNT(j)  (256  + 64 * (j))
#define XB_XSUB(j)  (1280 + 64 * (j))
#define XB_XGEN(j)  (2304 + 64 * (j))
#define XB_TOP      3328
#define XB_TOPGEN   3392
#define XCD_BAR_WORDS 3456
#define XB_SPIN_CAP (1u << 18)

__device__ __forceinline__ unsigned xb_ld(unsigned* p)              { return __hip_atomic_load(p, __ATOMIC_RELAXED, __HIP_MEMORY_SCOPE_AGENT); }
__device__ __forceinline__ unsigned xb_add(unsigned* p, unsigned v) { return __hip_atomic_fetch_add(p, v, __ATOMIC_RELAXED, __HIP_MEMORY_SCOPE_AGENT); }
__device__ __forceinline__ unsigned xb_xcc_id() { return (unsigned)__builtin_amdgcn_s_getreg((3 << 11) | 20) & 0xFu; }
#define XB_SPIN(cond, bar) do { unsigned _sp = 0; while (cond) { __builtin_amdgcn_s_sleep(1); \
    if ((++_sp & 255u) == 0u) { if (xb_ld(&(bar)[XB_TMO])) break; if (_sp > XB_SPIN_CAP) { atomicAdd(&(bar)[XB_TMO], 1u); break; } } } } while (0)

struct XcdBarrier {
    unsigned* bar; unsigned x;
    volatile LAS unsigned* st;
};

__device__ __forceinline__ XcdBarrier xcd_barrier_post(unsigned* bar, volatile LAS unsigned* st) {
    XcdBarrier b; b.bar = bar; b.x = xb_xcc_id(); b.st = st;
    if (threadIdx.x == 0) (void)xb_add(&bar[XB_XCNT(b.x)], 1u);
    return b;
}
__device__ __forceinline__ void xcd_barrier_complete(unsigned* bar, unsigned x, unsigned& nloc, unsigned& nx) {
    const unsigned G = gridDim.x * gridDim.y * gridDim.z;
    unsigned sum, cnt, mine, sp = 0u;
    for (;;) {
        sum = 0u; cnt = 0u; mine = 0u;
#pragma unroll
        for (unsigned j = 0; j < 16; ++j) { const unsigned c = xb_ld(&bar[XB_XCNT(j)]); sum += c; cnt += (c > 0u) ? 1u : 0u; mine = (j == x) ? c : mine; }
        if (sum == G) break;
        __builtin_amdgcn_s_sleep(1);
        if ((++sp & 255u) == 0u) { if (xb_ld(&bar[XB_TMO])) break; if (sp > XB_SPIN_CAP) { atomicAdd(&bar[XB_TMO], 1u); break; } }
    }
    nloc = mine > 0u ? mine : 1u; nx = cnt > 0u ? cnt : 1u;
}

__device__ __forceinline__ void xcd_barrier(const XcdBarrier& b) {
    asm volatile("s_waitcnt vmcnt(0)" ::: "memory");
    __syncthreads();
    if (threadIdx.x == 0) {
        unsigned* bar = b.bar;
        __builtin_amdgcn_s_waitcnt(0);
        unsigned nloc = b.st[0], nx = b.st[1];
        if (nloc == 0u) { xcd_barrier_complete(bar, b.x, nloc, nx); b.st[0] = nloc; b.st[1] = nx; }
        const unsigned old = xb_add(&bar[XB_XSUB(b.x)], 1u);
        const unsigned gen = old / nloc;
        if (old + 1u == (gen + 1u) * nloc) {
            __builtin_amdgcn_fence(__ATOMIC_RELEASE, "agent");
            asm volatile("s_waitcnt vmcnt(0)" ::: "memory");
            const unsigned og = xb_add(&bar[XB_TOP], 1u);
            const unsigned tg = og / nx;
            if (og + 1u == (tg + 1u) * nx) xb_add(&bar[XB_TOPGEN], 1u);
            else XB_SPIN(xb_ld(&bar[XB_TOPGEN]) == tg, bar);
            __builtin_amdgcn_fence(__ATOMIC_ACQUIRE, "agent");
            xb_add(&bar[XB_XGEN(b.x)], 1u);
            asm volatile("s_waitcnt vmcnt(0)" ::: "memory");
        } else {
            XB_SPIN(xb_ld(&bar[XB_XGEN(b.x)]) == gen, bar);
            __builtin_amdgcn_fence(__ATOMIC_ACQUIRE, "agent");
            asm volatile("s_waitcnt vmcnt(0)" ::: "memory");
        }
    }
    __syncthreads();
}

struct Args { const float* in[19]; float* out; unsigned char* ws; int ph_lo, ph_hi; };
typedef const __attribute__((address_space(4))) Args* ArgsP;
struct Frame {
    LAS unsigned char* lds; unsigned char* ldsg;
    volatile LAS unsigned* MISC;
    gu32* ctl;
    int tid, lane, wave, vcu, G;
    ArgsP ap; GAS float* out; GAS unsigned char* ws;
};
#define INP(F, k) ((const float*)(const GAS float*)(F).ap->in[k])
#define WSP(F) ((unsigned char*)(F).ws)
#define OUTP(F) ((float*)(F).out)
__device__ __forceinline__ Frame site(const Frame& F0) {
    Frame F = F0;
    int t = threadIdx.x; asm volatile("" : "+v"(t)); F.tid = t; F.lane = t & 63; F.wave = __builtin_amdgcn_readfirstlane(t >> 6);
    GAS unsigned char* w = F0.ws; asm volatile("" : "+s"(w)); F.ws = w;
    GAS float* o = F0.out; asm volatile("" : "+s"(o)); F.out = o;
    ArgsP a = F0.ap; asm volatile("" : "+s"(a)); F.ap = a;
    return F;
}
__device__ __forceinline__ float wave_sum(float v) {
#pragma unroll
    for (int o = 1; o < 64; o <<= 1) v += __shfl_xor(v, o);
    return v;
}

__device__ __forceinline__ void p0_modvec(Frame& F) {
    LAS float* sv = (LAS float*)F.lds;
    LAS float* red = (LAS float*)(F.lds + 24576);
    const float* c = INP(F, 1); const float* cctx = INP(F, 3); const float* wmod = INP(F, 4); const float* bmod = INP(F, 5);
    float* modv = (float*)(WSP(F) + WS_MODV);
    bool have = false;
    for (int it = blockIdx.x; it < 4 * 48; it += F.G) {
        if (!have) {
            for (int idx = F.tid; idx < 3 * DM; idx += 512) { const int g = idx >> 11, k = idx & 2047; const float v = g < 2 ? c[g * DM + k] : cctx[k]; sv[idx] = v / (1.0f + __expf(-v)); }
            __syncthreads(); have = true;
        }
        const int li = it / 48, ch = it % 48;
        const float* wp = wmod + ((size_t)li * DM + F.wave * 256) * 12288 + ch * 256 + F.lane * 4;
        f32x4 a0 = {0.f, 0.f, 0.f, 0.f}, a1 = a0, a2 = a0;
#pragma unroll 8
        for (int k = 0; k < 256; ++k) {
            const f32x4 w = *(const f32x4*)(wp + (size_t)k * 12288);
            const float s0 = sv[F.wave * 256 + k], s1 = sv[DM + F.wave * 256 + k], s2 = sv[2 * DM + F.wave * 256 + k];
            a0 += w * s0; a1 += w * s1; a2 += w * s2;
        }
        *(LAS f32x4*)(red + (F.wave * 3 + 0) * 256 + F.lane * 4) = a0;
        *(LAS f32x4*)(red + (F.wave * 3 + 1) * 256 + F.lane * 4) = a1;
        *(LAS f32x4*)(red + (F.wave * 3 + 2) * 256 + F.lane * 4) = a2;
        __syncthreads();
        for (int t = F.tid; t < 768; t += 512) { const int g = t >> 8, cc = t & 255; float s = bmod[li * 12288 + ch * 256 + cc];
#pragma unroll
            for (int w = 0; w < 8; ++w) s += red[(w * 3 + g) * 256 + cc];
            modv[(size_t)(li * 3 + g) * 12288 + ch * 256 + cc] = s; }
        __syncthreads();
    }
}
__device__ __forceinline__ void p0_tables(Frame& F) {
    const int gt = blockIdx.x * 512 + F.tid, NTH = F.G * 512;
    float* rope = (float*)(WSP(F) + WS_ROPE); float* lam = (float*)(WSP(F) + WS_LAM);
    bf16* fa1 = (bf16*)(WSP(F) + WS_FA1); bf16* fa2 = (bf16*)(WSP(F) + WS_FA2); bf16* fa3 = (bf16*)(WSP(F) + WS_FA3);
    for (int idx = gt; idx < 2048; idx += NTH) { const int pos = idx >> 4, f = idx & 15;
        const float inv = exp2f(-(float)f * (13.287712379549449f / 16.0f)); const float rev = (float)pos * inv * 0.15915494309189535f; const float fr = rev - floorf(rev);
        rope[idx * 2] = hw_cos(fr); rope[idx * 2 + 1] = hw_sin(fr); }
    for (int idx = gt; idx < 128 * 128; idx += NTH) { const int m = idx >> 7, k = idx & 127, rp = m >> 6, k1 = m & 63, ri = k >> 6, t1 = k & 63;
        const float ph = (float)((k1 * t1) & 63) * (1.0f / 64.0f); const float cs = hw_cos(ph), sn = hw_sin(ph);
        const float v = rp == 0 ? (ri == 0 ? cs : -sn) : (ri == 0 ? -sn : -cs); fa1[idx] = (bf16)f2bf(v); }
    for (int idx = gt; idx < 128 * 256; idx += NTH) { const int k2 = idx >> 8, k = idx & 255, ri = k >> 7, t2 = k & 127;
        const float ph = (float)((k2 * t2) & 127) * (1.0f / 128.0f); const float v = ri == 0 ? hw_cos(ph) : hw_sin(ph); fa2[idx] = (bf16)f2bf(v); }
    for (int idx = gt; idx < 256 * 512; idx += NTH) { const int kk = idx >> 9, k = idx & 511, ri = k >> 8, t = k & 255;
        const float ph = (float)((kk * t) & 255) * (1.0f / 256.0f); const float v = ri == 0 ? hw_cos(ph) : -hw_sin(ph); fa3[idx] = (bf16)f2bf(v); }
    if (gt < 2) { const float* lv = INP(F, 12) + gt * 256; float s01 = 0.f, s23 = 0.f;
        for (int d = 0; d < 64; ++d) { s01 += lv[d] * lv[64 + d]; s23 += lv[128 + d] * lv[192 + d]; }
        lam[gt] = __expf(s01) - __expf(s23) + (gt == 0 ? LAM_INIT0 : LAM_INIT1); }
}
__device__ __forceinline__ void p0_copy_ctx(Frame& F) {
    const f32x4* src = (const f32x4*)INP(F, 2); f32x4* dst = (f32x4*)(WSP(F) + WS_HC);
    for (int i = blockIdx.x * 512 + F.tid; i < MC * DM / 4; i += F.G * 512) dst[i] = src[i];
}
__device__ __forceinline__ void p0_fold(Frame& F) {
    LAS unsigned char* Wl = F.lds;
    LAS unsigned char* Tl = F.lds + 64 * 272;
    const int lane = F.lane, l15 = lane & 15, lq = lane >> 4;
    bool have_t = false;
    for (int it = blockIdx.x; it < 256; it += F.G) {
        const int j = it >> 7, g = (it >> 5) & 3, k0 = (it & 31) * 64;
        const float* W = INP(F, 9) + (size_t)j * DM * EV_IN;
        bf16* Bt = (bf16*)(WSP(F) + WS_WIN_E + (size_t)j * SZ_WIN_E);
        if (!have_t) { have_t = true;
            for (int idx = F.tid; idx < 256 * 128; idx += 512) { const int n = idx >> 7, cc = idx & 127, cp = n >> 1, ri = n & 1; const float ph = (float)((cc * cp) & 127) * (1.0f / 128.0f);
                *(LAS bf16*)(Tl + n * 272 + cc * 2) = (bf16)f2bf(ri ? hw_sin(ph) : hw_cos(ph)); } }
        for (int idx = F.tid; idx < 64 * 128; idx += 512) { const int r = idx >> 7, cc = idx & 127; *(LAS bf16*)(Wl + r * 272 + cc * 2) = (bf16)f2bf(W[(size_t)(k0 + r) * EV_IN + 4608 + g * 128 + cc]); }
        __syncthreads();
#pragma unroll 1
        for (int ni = 0; ni < 2; ++ni) { const int nt = F.wave * 2 + ni;
            bf16x8 bfr[4];
#pragma unroll
            for (int ks = 0; ks < 4; ++ks) bfr[ks] = *(const LAS bf16x8*)(Tl + (16 * nt + l15) * 272 + (32 * ks + 8 * lq) * 2);
#pragma unroll
            for (int mt = 0; mt < 4; ++mt) { f32x4 acc = {0.f, 0.f, 0.f, 0.f};
#pragma unroll
                for (int ks = 0; ks < 4; ++ks) { const bf16x8 af = *(const LAS bf16x8*)(Wl + (16 * mt + l15) * 272 + (32 * ks + 8 * lq) * 2); acc = __builtin_amdgcn_mfma_f32_16x16x32_bf16(af, bfr[ks], acc, 0, 0, 0); }
                v2u o; o.x = pk2(acc[0], acc[1]); o.y = pk2(acc[2], acc[3]);
                *(v2u*)(Bt + (size_t)(4608 + g * 256 + 16 * nt + l15) * DM + k0 + 16 * mt + 4 * lq) = o; } }
        __syncthreads();
    }
}
__device__ __forceinline__ void p0_transpose_item(const float* W, int K, int pitch, int ncols, bf16* WT, int mode, LAS float* scr, int item, int lane) {
    const int nblk = ncols / 32, kb = item / nblk, nb = item % nblk, k0 = 64 * kb, n0 = 32 * nb;
    float wv[32];
    const float* wp = W + (size_t)(k0 + (lane >> 5)) * pitch + n0 + (lane & 31);
#pragma unroll
    for (int i = 0; i < 32; ++i) wv[i] = __builtin_nontemporal_load(wp + (size_t)(2 * i) * pitch);
#pragma unroll
    for (int i = 0; i < 32; ++i) scr[(2 * i + (lane >> 5)) * 33 + (lane & 31)] = wv[i];
    LDS_WAIT(); asm volatile("" ::: "memory");
    int d0 = n0;
    if (mode == 1) { const int c = n0 < FH ? n0 : n0 - FH; d0 = (c >> 7) * 256 + (c & 127) + (n0 < FH ? 0 : 128); }
    const int c8 = lane & 7;
#pragma unroll
    for (int j = 0; j < 4; ++j) { const int n = (lane >> 3) + 8 * j; const LAS float* s = scr + (8 * c8) * 33 + n;
        v4u o; o.x = pk2(s[0 * 33], s[1 * 33]); o.y = pk2(s[2 * 33], s[3 * 33]); o.z = pk2(s[4 * 33], s[5 * 33]); o.w = pk2(s[6 * 33], s[7 * 33]);
        *(GAS v4u*)(WT + (size_t)(d0 + n) * K + k0 + 8 * c8) = o; }
    LDS_WAIT(); asm volatile("" ::: "memory");
}
constexpr int WQ_EVI = 32 * 144, WQ_ODI = 32 * 192, WQ_OUT = 32 * 64, WQ_FI = 32 * 352, WQ_FO = 88 * 64;
constexpr int WQ_LE = WQ_EVI + WQ_OUT + WQ_FI + WQ_FO, WQ_LO = WQ_ODI + WQ_OUT + WQ_FI + WQ_FO, WQ_N = 2 * (WQ_LE + WQ_LO);
static_assert(WQ_LE == 23552 && WQ_LO == 25088 && WQ_N == 97280, "weight queue sizes");
__device__ __forceinline__ void wq_item(Frame& F, int q, LAS float* scr) {
    int li = 0, r = q;
    if (r >= WQ_LE) { r -= WQ_LE; li = 1; if (r >= WQ_LO) { r -= WQ_LO; li = 2; if (r >= WQ_LE) { r -= WQ_LE; li = 3; } } }
    const int lj = li >> 1; const bool odd = li & 1; const int nin = odd ? WQ_ODI : WQ_EVI;
    if (r < nin) {
        if (odd) p0_transpose_item(INP(F, 14) + (size_t)lj * DM * ODN, DM, ODN, ODN, (bf16*)(WSP(F) + WS_WIN_O + (size_t)lj * SZ_WIN_O), 0, scr, r, F.lane);
        else     p0_transpose_item(INP(F, 9) + (size_t)lj * DM * EV_IN, DM, EV_IN, 4608, (bf16*)(WSP(F) + WS_WIN_E + (size_t)lj * SZ_WIN_E), 0, scr, r, F.lane);
        return; }
    r -= nin;
    if (r < WQ_OUT) { p0_transpose_item(INP(F, odd ? 15 : 10) + (size_t)lj * DM * DM, DM, DM, DM, (bf16*)(WSP(F) + (odd ? WS_WOUT_O : WS_WOUT_E) + (size_t)lj * SZ_WOUT), 0, scr, r, F.lane); return; }
    r -= WQ_OUT;
    if (r < WQ_FI) { p0_transpose_item(INP(F, 7) + (size_t)li * DM * 2 * FH, DM, 2 * FH, 2 * FH, (bf16*)(WSP(F) + WS_WFI + (size_t)li * SZ_WFI), 1, scr, r, F.lane); return; }
    r -= WQ_FI;
    p0_transpose_item(INP(F, 8) + (size_t)li * FH * DM, FH, DM, DM, (bf16*)(WSP(F) + WS_WFO + (size_t)li * SZ_WFO), 0, scr, r, F.lane);
}
__device__ const int WQ_TAIL[8] = {23552, 28928, 39680, 52992, 63744, 69120, 79872, 93184};
__device__ __forceinline__ void p0_weights(Frame& F) {
    LAS float* scr = (LAS float*)(F.lds + F.wave * 16384);
    const int gw = F.vcu * 8 + F.wave, NGW = F.G * 8;
    if (F.G != 256) { for (int q = gw; q < WQ_N; q += NGW) wq_item(F, q, scr); return; }
    constexpr int NP = WQ_LE + (WQ_N - 93184);
    for (int i = gw; i < NP; i += NGW) wq_item(F, i < WQ_LE ? i : 93184 + (i - WQ_LE), scr);
}
__device__ __forceinline__ void wq_tail(Frame& F, int t, int units) {
    const int rem = units % F.G; const int c = (int)blockIdx.x;
    if (F.G != 256 || rem == 0 || c < rem) return;
    LAS float* scr = (LAS float*)(F.lds + F.wave * 16384);
    const int nw = (F.G - rem) * 8, wr = (c - rem) * 8 + F.wave; const int qb = WQ_TAIL[t], qe = WQ_TAIL[t + 1];
    for (int i = 0; i < 8; ++i) { const int q = qb + wr + i * nw; if (q < qe) wq_item(F, q, scr); }
}

__device__ __forceinline__ void norm_phase(Frame& F, int li, int which, const float* hl, float* hcx, int red_ks, const float* red_gate) {
    const float* gain = INP(F, 6) + (size_t)(li * 2 + which) * DM;
    const float* modv = (const float*)(WSP(F) + WS_MODV) + (size_t)li * 3 * 12288;
    bf16* A = (bf16*)(WSP(F) + WS_A);
    LAS float* Gv = (LAS float*)F.lds; LAS float* Sv = Gv + 3 * DM;
    for (int i = F.tid; i < 3 * DM; i += 512) { const int grp = i >> 11, d = i & (DM - 1); const float* sh = modv + grp * 12288 + (which * 3) * DM;
        Gv[i] = gain[d] * (1.0f + sh[DM + d]); Sv[i] = sh[d]; }
    __syncthreads();
    const int gw = F.vcu * 8 + F.wave, NGW = F.G * 8; const int lane = F.lane;
    int r = gw;
    for (; r + 3 * NGW < ML; r += 4 * NGW) {
        f32x4 v[4][8]; float q[4] = {0.f, 0.f, 0.f, 0.f};
#pragma unroll
        for (int i = 0; i < 4; ++i) { const float* sp = hl + (size_t)(r + i * NGW) * DM + 4 * lane;
#pragma unroll
            for (int j = 0; j < 8; ++j) v[i][j] = *(const f32x4*)(sp + 256 * j); }
#pragma unroll
        for (int i = 0; i < 4; ++i)
#pragma unroll
            for (int j = 0; j < 8; ++j) q[i] += (v[i][j].x * v[i][j].x + v[i][j].y * v[i][j].y) + (v[i][j].z * v[i][j].z + v[i][j].w * v[i][j].w);
#pragma unroll
        for (int i = 0; i < 4; ++i) { const int ri = r + i * NGW; const float rs = rsqrtf(wave_sum(q[i]) * (1.0f / DM) + 1e-6f); const int go = (ri < SEQ ? 0 : 1) * DM;
#pragma unroll
            for (int j = 0; j < 8; ++j) { const int d = 4 * lane + 256 * j;
                const f32x4 a = v[i][j] * rs * *(const LAS f32x4*)(Gv + go + d) + *(const LAS f32x4*)(Sv + go + d);
                v2u o; o.x = pk2(a.x, a.y); o.y = pk2(a.z, a.w);
                *(v2u*)(A + (size_t)ri * DM + d) = o; } }
    }
    for (; r < MT; r += NGW) {
        const float* src = r < ML ? hl + (size_t)r * DM : hcx + (size_t)(r - ML) * DM;
        const int go = (r < SEQ ? 0 : (r < ML ? 1 : 2)) * DM;
        f32x4 v[8]; float ss = 0.f;
#pragma unroll
        for (int j = 0; j < 8; ++j) v[j] = *(const f32x4*)(src + 4 * lane + 256 * j);
        if (r >= ML && red_ks > 0) {
            const float* sl = (const float*)(WSP(F) + WS_SLAB) + (size_t)(r - ML) * DM + 4 * lane;
#pragma unroll
            for (int j = 0; j < 8; j += 2) { f32x4 t0[11], t1[11];
#pragma unroll
                for (int k = 0; k < 11; ++k) { const bool on = k < red_ks; const size_t ko = (size_t)(on ? k : 0) * (MC * DM);
                    t0[k] = *(const f32x4*)(sl + ko + 256 * j); t1[k] = *(const f32x4*)(sl + ko + 256 * (j + 1)); }
                f32x4 s0 = t0[0], s1 = t1[0];
#pragma unroll
                for (int k = 1; k < 11; ++k) if (k < red_ks) { s0 += t0[k]; s1 += t1[k]; }
                v[j] += *(const f32x4*)(red_gate + 4 * lane + 256 * j) * s0; v[j + 1] += *(const f32x4*)(red_gate + 4 * lane + 256 * (j + 1)) * s1;
                *(f32x4*)(hcx + (size_t)(r - ML) * DM + 4 * lane + 256 * j) = v[j]; *(f32x4*)(hcx + (size_t)(r - ML) * DM + 4 * lane + 256 * (j + 1)) = v[j + 1]; }
        }
#pragma unroll
        for (int j = 0; j < 8; ++j) ss += (v[j].x * v[j].x + v[j].y * v[j].y) + (v[j].z * v[j].z + v[j].w * v[j].w);
        const float rstd = rsqrtf(wave_sum(ss) * (1.0f / DM) + 1e-6f);
#pragma unroll
        for (int j = 0; j < 8; ++j) { const int d = 4 * lane + 256 * j;
            const f32x4 a = v[j] * rstd * *(const LAS f32x4*)(Gv + go + d) + *(const LAS f32x4*)(Sv + go + d);
            v2u o; o.x = pk2(a.x, a.y); o.y = pk2(a.z, a.w);
            *(v2u*)(A + (size_t)r * DM + d) = o; }
    }
    __syncthreads();
}

__device__ __forceinline__ void prep_even_row(bf16* P, bf16* QR, int r, bool lat, int lane, const v4u (&w6)[6], const f32x4 (&rw)[4], const float (&g0)[8], const float (&g1)[8]) {
    float cs[8], sn[8];
#pragma unroll
    for (int e = 0; e < 8; e += 2) { cs[e] = lat ? rw[e >> 1].x : 1.f; sn[e] = lat ? rw[e >> 1].y : 0.f; cs[e + 1] = lat ? rw[e >> 1].z : 1.f; sn[e + 1] = lat ? rw[e >> 1].w : 0.f; }
    bf16* prow = P + (size_t)r * EVN;
#pragma unroll
    for (int j = 0; j < 6; ++j) {
        const int ch = j * 64 + lane; const v4u w = w6[j];
        float x[8] = {bflo(w.x), bfhi(w.x), bflo(w.y), bfhi(w.y), bflo(w.z), bfhi(w.z), bflo(w.w), bfhi(w.w)};
        float ss = 0.f;
#pragma unroll
        for (int e = 0; e < 8; ++e) ss += x[e] * x[e];
        ss += __shfl_xor(ss, 1); ss += __shfl_xor(ss, 2); ss += __shfl_xor(ss, 4);
        const float rstd = rsqrtf(ss * (1.0f / 64.0f) + 1e-6f);
        float y[8], yr[8];
#pragma unroll
        for (int e = 0; e < 8; ++e) y[e] = x[e] * rstd * (j < 3 ? g0[e] * 0.18033688011112042f : g1[e]);
#pragma unroll
        for (int e = 0; e < 8; ++e) { const float yp = __shfl_xor(y[e], 2); yr[e] = (lane & 2) ? (y[e] * cs[e] + yp * sn[e]) : (y[e] * cs[e] - yp * sn[e]); }
        v4u on, orr;
        on.x = pk2(y[0], y[1]); on.y = pk2(y[2], y[3]); on.z = pk2(y[4], y[5]); on.w = pk2(y[6], y[7]);
        orr.x = pk2(yr[0], yr[1]); orr.y = pk2(yr[2], yr[3]); orr.z = pk2(yr[4], yr[5]); orr.w = pk2(yr[6], yr[7]);
        if (j < 3) { *(v4u*)(prow + ch * 8) = on; if (lat) *(v4u*)(QR + (size_t)r * 1536 + ch * 8) = orr; }
        else       { *(v4u*)(prow + ch * 8) = lat ? orr : on; }
    }
}
__device__ __forceinline__ void prep_even(Frame& F, int lj) {
    bf16* P = (bf16*)(WSP(F) + WS_P); bf16* QR = (bf16*)(WSP(F) + WS_QR);
    const float* gq = INP(F, 11) + (size_t)lj * 128; const float* rope = (const float*)(WSP(F) + WS_ROPE);
    const int gw = F.vcu * 8 + F.wave, NGW = F.G * 8; const int lane = F.lane;
    const int d0 = (lane & 7) * 8;
    float g0[8], g1[8];
#pragma unroll
    for (int e = 0; e < 8; ++e) { g0[e] = gq[d0 + e]; g1[e] = gq[64 + d0 + e]; }
    for (int r = gw; r < MT; r += 2 * NGW) {
        const int r1 = r + NGW; const bool has1 = r1 < MT; const int r1c = has1 ? r1 : r;
        v4u wa[6], wb[6]; f32x4 ra[4], rb[4];
        const int ta = r & (SEQ - 1), tb = r1c & (SEQ - 1);
        const int pa = ((lane >> 2) & 1) ? (ta & 63) : (ta >> 6), pb = ((lane >> 2) & 1) ? (tb & 63) : (tb >> 6);
#pragma unroll
        for (int j = 0; j < 6; ++j) { wa[j] = *(const v4u*)(P + (size_t)r * EVN + (j * 64 + lane) * 8); wb[j] = *(const v4u*)(P + (size_t)r1c * EVN + (j * 64 + lane) * 8); }
#pragma unroll
        for (int e = 0; e < 4; ++e) { ra[e] = *(const f32x4*)(rope + (size_t)((pa & 127) * 16 + (lane & 1) * 8) * 2 + e * 4); rb[e] = *(const f32x4*)(rope + (size_t)((pb & 127) * 16 + (lane & 1) * 8) * 2 + e * 4); }
        asm volatile("" ::: "memory");
        prep_even_row(P, QR, r, r < ML, lane, wa, ra, g0, g1);
        if (has1) prep_even_row(P, QR, r1, r1 < ML, lane, wb, rb, g0, g1);
    }
}

struct OddRow { v4u gb[2], gc[2][3], hh[2][3]; };
__device__ __forceinline__ void prep_odd_load(OddRow& R, const bf16* P, int r, int lane) {
    const bool lat = r < ML; const int t = lat ? (r & (SEQ - 1)) : ((r - ML) & (CTXL - 1)); const int n = lat ? SEQ : CTXL;
    const bf16* prow = P + (size_t)r * ODN;
#pragma unroll
    for (int j = 0; j < 2; ++j) { const int c0 = (j * 64 + lane) * 8; R.gb[j] = *(const v4u*)(prow + c0);
#pragma unroll
        for (int jj = 0; jj < 3; ++jj) { const int tt = t + jj - 1; const bool ok = tt >= 0 && tt < n; const bf16* pr = prow + (ok ? (ptrdiff_t)(jj - 1) * ODN : 0);
            R.gc[j][jj] = *(const v4u*)(pr + 1024 + c0); R.hh[j][jj] = *(const v4u*)(pr + 2048 + c0); } }
}
__device__ __forceinline__ void prep_odd_row(const OddRow& R, bf16* P, bf16* MIX, const float* cw, int r, int lane, const float (&g0)[8], const float (&g1)[8]) {
    const bool lat = r < ML; const int t = lat ? (r & (SEQ - 1)) : ((r - ML) & (CTXL - 1)); const int n = lat ? SEQ : CTXL;
    bf16* prow = P + (size_t)r * ODN;
#pragma unroll
    for (int j = 0; j < 2; ++j) {
        const int c0 = (j * 64 + lane) * 8;
        float accv[8];
#pragma unroll
        for (int e = 0; e < 8; ++e) accv[e] = 0.f;
#pragma unroll
        for (int jj = 0; jj < 3; ++jj) {
            const int tt = t + jj - 1; const float m = (tt >= 0 && tt < n) ? 1.f : 0.f;
            const v4u a = R.gc[j][jj], b = R.hh[j][jj];
            const f32x4 w0 = *(const f32x4*)(cw + jj * 1024 + c0) * m, w1 = *(const f32x4*)(cw + jj * 1024 + c0 + 4) * m;
            accv[0] += bflo(a.x) * bflo(b.x) * w0.x; accv[1] += bfhi(a.x) * bfhi(b.x) * w0.y; accv[2] += bflo(a.y) * bflo(b.y) * w0.z; accv[3] += bfhi(a.y) * bfhi(b.y) * w0.w;
            accv[4] += bflo(a.z) * bflo(b.z) * w1.x; accv[5] += bfhi(a.z) * bfhi(b.z) * w1.y; accv[6] += bflo(a.w) * bflo(b.w) * w1.z; accv[7] += bfhi(a.w) * bfhi(b.w) * w1.w;
        }
        const v4u gb = R.gb[j];
        v4u o; o.x = pk2(bflo(gb.x) * accv[0], bfhi(gb.x) * accv[1]); o.y = pk2(bflo(gb.y) * accv[2], bfhi(gb.y) * accv[3]);
        o.z = pk2(bflo(gb.z) * accv[4], bfhi(gb.z) * accv[5]); o.w = pk2(bflo(gb.w) * accv[6], bfhi(gb.w) * accv[7]);
        *(v4u*)(MIX + (size_t)r * DM + c0) = o;
    }
}
__device__ __forceinline__ void prep_odd(Frame& F, int lj) {
    bf16* P = (bf16*)(WSP(F) + WS_P); bf16* MIX = (bf16*)(WSP(F) + WS_MIX);
    const float* gq = INP(F, 16) + (size_t)lj * 256; const float* cw = INP(F, 17) + (size_t)lj * 3 * 1024;
    const int gw = F.vcu * 8 + F.wave, NGW = F.G * 8; const int lane = F.lane;
    const int d0 = (lane & 15) * 8;
    float g0[8], g1[8];
#pragma unroll
    for (int e = 0; e < 8; ++e) { g0[e] = gq[d0 + e]; g1[e] = gq[128 + d0 + e]; }
    for (int r = gw; r < MT; r += 2 * NGW) {
        const int r1 = r + NGW; const bool has1 = r1 < MT;
        OddRow Ra, Rb;
        prep_odd_load(Ra, P, r, lane); prep_odd_load(Rb, P, has1 ? r1 : r, lane);
        asm volatile("" ::: "memory");
        prep_odd_row(Ra, P, MIX, cw, r, lane, g0, g1);
        if (has1) prep_odd_row(Rb, P, MIX, cw, r1, lane, g0, g1);
    }
}

struct EvenTileRow { int ctx0, lat0; __device__ __forceinline__ int operator()(int j) const { return j < 4 ? ctx0 + 64 * j : lat0 + 64 * (j - 4); } };
__device__ __forceinline__ void even_attn_unit(Frame& F, int lj, int b, int h, int qrow0, bool is_ctx) {
    const bf16* P = (const bf16*)(WSP(F) + WS_P); const bf16* QR = (const bf16*)(WSP(F) + WS_QR); bf16* MIX = (bf16*)(WSP(F) + WS_MIX);
    const int lane = F.lane, r32 = lane & 31, hi = lane >> 5, wq = F.wave & 3, comp = F.wave >> 2;
    EvenTileRow trow{ML + b * CTXL, b * SEQ};
    att::f32x16 o[4]; float rli[16];
    att::attn_dual_stag<EVN, 1536, EVN>(P + (size_t)qrow0 * EVN + h * 128, QR + (size_t)(is_ctx ? 0 : qrow0) * 1536 + h * 128, is_ctx ? 1000 : 4,
                                        P + 1536 + h * 128, P + 3072 + h * 128, trow, is_ctx ? 4 : 132, (char*)F.ldsg, o, rli);
    __syncthreads();
    LAS float* xch = (LAS float*)F.lds + (size_t)wq * 4096 + lane;
    if (comp == 1) {
#pragma unroll
        for (int d = 0; d < 4; ++d)
#pragma unroll
            for (int r = 0; r < 16; ++r) xch[(d * 16 + r) * 64] = o[d][r] * rli[r];
    }
    __syncthreads();
    if (comp == 0) {
        const float lam = ((const float*)(WSP(F) + WS_LAM))[lj];
        const float cfac = 1.0f - (lj == 0 ? LAM_INIT0 : LAM_INIT1);
        const float* gsub = INP(F, 13) + (size_t)lj * 128;
        float ssq[16];
#pragma unroll
        for (int r = 0; r < 16; ++r) ssq[r] = 0.f;
#pragma unroll
        for (int d = 0; d < 4; ++d)
#pragma unroll
            for (int r = 0; r < 16; ++r) { const float v = o[d][r] * rli[r] - lam * xch[(d * 16 + r) * 64]; o[d][r] = v; ssq[r] += v * v; }
#pragma unroll
        for (int r = 0; r < 16; ++r) { float s = ssq[r]; s += __shfl_xor(s, 1); s += __shfl_xor(s, 2); s += __shfl_xor(s, 4); s += __shfl_xor(s, 8); s += __shfl_xor(s, 16);
            ssq[r] = rsqrtf(s * (1.0f / 128.0f) + 1e-6f) * cfac; }
#pragma unroll
        for (int d = 0; d < 4; ++d) { const float g = gsub[32 * d + r32];
#pragma unroll
            for (int r = 0; r < 16; ++r) MIX[(size_t)(qrow0 + wq * 32 + att::crow(r, hi)) * DM + h * 128 + 32 * d + r32] = (bf16)f2bf(o[d][r] * ssq[r] * g); }
    }
}

__device__ __forceinline__ void fft_unit(Frame& F, int b, int cp) {
    LAS unsigned char* Vl = F.lds;
    LAS unsigned char* Yl = F.lds + 69632;
    const bf16* P = (const bf16*)(WSP(F) + WS_P); bf16* MIX = (bf16*)(WSP(F) + WS_MIX);
    const bf16* FA1 = (const bf16*)(WSP(F) + WS_FA1); const bf16* FA2 = (const bf16*)(WSP(F) + WS_FA2);
    const int lane = F.lane, l15 = lane & 15, lq = lane >> 4;
    v2u wl[16];
#pragma unroll
    for (int jj = 0; jj < 16; ++jj) wl[jj] = *(const v2u*)(P + (size_t)(b * SEQ + F.tid + 512 * jj) * EVN + 4608 + 4 * cp);
#pragma unroll
    for (int jj = 0; jj < 16; ++jj) { const int t = F.tid + 512 * jj; const v2u w = wl[jj];
        const int t1 = t >> 7, t2 = t & 127;
        *(LAS bf16*)(Vl + (2 * t2 + 0) * 272 + (t1) * 2) = (bf16)(w.x & 0xffffu);       *(LAS bf16*)(Vl + (2 * t2 + 0) * 272 + (64 + t1) * 2) = (bf16)(w.x >> 16);
        *(LAS bf16*)(Vl + (2 * t2 + 1) * 272 + (t1) * 2) = (bf16)(w.y & 0xffffu);       *(LAS bf16*)(Vl + (2 * t2 + 1) * 272 + (64 + t1) * 2) = (bf16)(w.y >> 16); }
    __syncthreads();
    {
        const int mt = F.wave & 3, nt0 = (F.wave >> 2) * 8;
        bf16x8 aR[4], aI[4];
#pragma unroll
        for (int ks = 0; ks < 4; ++ks) { aR[ks] = *(const bf16x8*)(FA1 + (size_t)(16 * mt + l15) * 128 + 32 * ks + 8 * lq); aI[ks] = *(const bf16x8*)(FA1 + (size_t)(64 + 16 * mt + l15) * 128 + 32 * ks + 8 * lq); }
        for (int nt = nt0; nt < nt0 + 8; ++nt) {
            f32x4 accR = {0.f, 0.f, 0.f, 0.f}, accI = accR;
#pragma unroll
            for (int ks = 0; ks < 4; ++ks) { const bf16x8 bf = *(const LAS bf16x8*)(Vl + (16 * nt + l15) * 272 + (32 * ks + 8 * lq) * 2);
                accR = __builtin_amdgcn_mfma_f32_16x16x32_bf16(aR[ks], bf, accR, 0, 0, 0); accI = __builtin_amdgcn_mfma_f32_16x16x32_bf16(aI[ks], bf, accI, 0, 0, 0); }
            const int n1 = 16 * nt + l15, t2 = n1 >> 1, cc = n1 & 1;
#pragma unroll
            for (int r = 0; r < 4; ++r) { const int k1 = 16 * mt + lq * 4 + r; const float ph = (float)((t2 * k1) & 8191) * (1.0f / 8192.0f); const float cs = hw_cos(ph), sn = hw_sin(ph);
                const float yr = accR[r] * cs + accI[r] * sn, yi = accI[r] * cs - accR[r] * sn; const int n2 = k1 * 2 + cc;
                *(LAS bf16*)(Yl + n2 * 528 + t2 * 2) = (bf16)f2bf(yr); *(LAS bf16*)(Yl + n2 * 528 + (128 + t2) * 2) = (bf16)f2bf(yi); }
        }
    }
    __syncthreads();
    {
        const int mt = F.wave;
        bf16x8 a2[8];
#pragma unroll
        for (int ks = 0; ks < 8; ++ks) a2[ks] = *(const bf16x8*)(FA2 + (size_t)(16 * mt + l15) * 256 + 32 * ks + 8 * lq);
        for (int nt = 0; nt < 8; ++nt) {
            f32x4 acc = {0.f, 0.f, 0.f, 0.f};
#pragma unroll
            for (int ks = 0; ks < 8; ++ks) { const bf16x8 bf = *(const LAS bf16x8*)(Yl + (16 * nt + l15) * 528 + (32 * ks + 8 * lq) * 2); acc = __builtin_amdgcn_mfma_f32_16x16x32_bf16(a2[ks], bf, acc, 0, 0, 0); }
            const int n2 = 16 * nt + l15, k1 = n2 >> 1, cc = n2 & 1;
#pragma unroll
            for (int r = 0; r < 4; ++r) { const int k2 = 16 * mt + lq * 4 + r; const int tok = k1 + 64 * k2; const unsigned me = f2bf(acc[r] * (1.0f / 1024.0f)); const unsigned other = (unsigned)__shfl_xor((int)me, 1);
                if (cc == 0) *(unsigned*)(MIX + (size_t)(b * SEQ + tok) * DM + 1536 + 2 * cp) = me | (other << 16); }
        }
    }
    __syncthreads();
}
__device__ __forceinline__ void ctx_dft_unit(Frame& F, int b, int cb) {
    LAS unsigned char* Vc = F.lds;
    const bf16* P = (const bf16*)(WSP(F) + WS_P); bf16* MIX = (bf16*)(WSP(F) + WS_MIX); const bf16* FA3 = (const bf16*)(WSP(F) + WS_FA3);
    const int lane = F.lane, l15 = lane & 15, lq = lane >> 4;
    { const int t = F.tid >> 1, half = F.tid & 1; const bf16* src = P + (size_t)(ML + b * CTXL + t) * EVN + 4608 + 32 * cb + 16 * half;
      const v4u w0 = *(const v4u*)src, w1 = *(const v4u*)(src + 8);
      const unsigned ww[8] = {w0.x, w0.y, w0.z, w0.w, w1.x, w1.y, w1.z, w1.w};
#pragma unroll
      for (int i = 0; i < 8; ++i) { const int cl = half * 8 + i; *(LAS bf16*)(Vc + cl * 1040 + t * 2) = (bf16)(ww[i] & 0xffffu); *(LAS bf16*)(Vc + cl * 1040 + (256 + t) * 2) = (bf16)(ww[i] >> 16); } }
    __syncthreads();
#pragma unroll 1
    for (int mi = 0; mi < 2; ++mi) { const int mt = F.wave * 2 + mi; f32x4 acc = {0.f, 0.f, 0.f, 0.f};
#pragma unroll 4
        for (int ks = 0; ks < 16; ++ks) { const bf16x8 a = *(const bf16x8*)(FA3 + (size_t)(16 * mt + l15) * 512 + 32 * ks + 8 * lq); const bf16x8 bf = *(const LAS bf16x8*)(Vc + l15 * 1040 + (32 * ks + 8 * lq) * 2);
            acc = __builtin_amdgcn_mfma_f32_16x16x32_bf16(a, bf, acc, 0, 0, 0); }
#pragma unroll
        for (int r = 0; r < 4; ++r) { const int k = 16 * mt + lq * 4 + r; MIX[(size_t)(ML + b * CTXL + k) * DM + 1536 + 16 * cb + l15] = (bf16)f2bf(acc[r] * 0.005524271728019903f); } }
    __syncthreads();
}
__device__ __forceinline__ void mixer_even(Frame& F, int lj) {
    if (MXM & 1) {
        for (int uu = F.vcu; uu < ((DUP & 1) ? 2 : 1) * (1536 + 48); uu += F.G) { const int u = (DUP & 1) ? uu % (1536 + 48) : uu; const bool is_ctx = u >= 1536;
            const int pair = is_ctx ? (u - 1536) >> 1 : (u >> 6), qb = is_ctx ? (u & 1) : (u & 63); const int b = pair / 12, h = pair % 12;
            even_attn_unit(F, lj, b, h, is_ctx ? ML + b * CTXL + qb * 128 : b * SEQ + qb * 128, is_ctx); __syncthreads(); } }
    if (MXM & 4) for (int uu = F.vcu; uu < ((DUP & 16) ? 2 : 1) * 512; uu += F.G) { const int u = uu & 511; fft_unit(F, u >> 8, u & 255); }
    if (MXM & 8) for (int u = F.vcu - 64; u >= 0 && u < 64; u += F.G) ctx_dft_unit(F, u >> 5, u & 31);
}

struct OddTileRow { int ctx0, lat0; __device__ __forceinline__ int operator()(int j) const { return j < 4 ? ctx0 + 64 * j : lat0 + 64 * (j - 4); } };
struct NaMask {
    int R0, rw, cq, rs, cs, hi; const LAS float* bt; bool off;
    __device__ __forceinline__ void operator()(att::f32x16& p0, att::f32x16& p1, int j) const {
        if (off || j < 4) return;
        const int kr = R0 + j - 4;
        if (kr < rs || kr >= rs + 8) {
#pragma unroll
            for (int r = 0; r < 16; ++r) { p0[r] = -1e30f; p1[r] = -1e30f; }
            return; }
        int cq_ = cq, hi_ = hi; asm volatile("" : "+v"(cq_), "+v"(hi_));
        int cs_ = cq_ - 8; cs_ = cs_ < 0 ? 0 : (cs_ > 48 ? 48 : cs_);
        const int rowoff = (kr - rw + 7) * 31 + 15 - cq_;
#pragma unroll
        for (int r = 0; r < 16; ++r) { const int c0 = att::crow(r, hi_), c1 = 32 + c0; const int cs = cs_;
            const bool ok0 = c0 >= cs && c0 < cs + 16, ok1 = c1 >= cs && c1 < cs + 16;
            const float b0 = bt[ok0 ? rowoff + c0 : 0], b1 = bt[ok1 ? rowoff + c1 : 0];
            p0[r] = ok0 ? p0[r] + b0 : -1e30f; p1[r] = ok1 ? p1[r] + b1 : -1e30f;
            if ((r & 3) == 3) __builtin_amdgcn_sched_barrier(0); }
    }
};
__device__ __forceinline__ void odd_attn_unit(Frame& F, int lj, int b, int h, int rb, bool is_ctx) {
    const bf16* P = (const bf16*)(WSP(F) + WS_P); bf16* MIX = (bf16*)(WSP(F) + WS_MIX);
    const int lane = F.lane, r32 = lane & 31, hi = lane >> 5, wid = F.wave;
    const int qrow0 = is_ctx ? ML + b * CTXL : b * SEQ + rb * 256;
    int R0 = 4 * rb - 4; R0 = R0 < 0 ? 0 : (R0 > 116 ? 116 : R0);
    OddTileRow trow{ML + b * CTXL, b * SEQ + R0 * 64};
    LAS float* bt = (LAS float*)(F.lds + att::LDS_BT_OFF);
    if (!is_ctx) { const float* rpb = INP(F, 18) + (size_t)(lj * 8 + h) * 465; for (int t = F.tid; t < 465; t += 512) bt[t] = rpb[t] * 11.313708498984761f; }
    __syncthreads();
    NaMask mk; mk.R0 = R0; mk.rw = 4 * rb + (wid >> 1); mk.cq = 32 * (wid & 1) + r32; mk.hi = hi; mk.bt = bt; mk.off = is_ctx;
    { int rs = mk.rw - 4; rs = rs < 0 ? 0 : (rs > 120 ? 120 : rs); mk.rs = rs; int cs = mk.cq - 8; cs = cs < 0 ? 0 : (cs > 48 ? 48 : cs); mk.cs = cs; }
    att::f32x16 o[4]; float rli[16];
    att::attn_core<128, ODN, ODN, ODN, 1, false>(P + (size_t)qrow0 * ODN + 3072 + h * 128, (const bf16*)nullptr, 1000,
                        P + 4096 + h * 128, P + 5120 + h * 128, trow, is_ctx ? 4 : 16, mk, (char*)F.ldsg, o, rli);
#pragma unroll
    for (int d = 0; d < 4; ++d)
#pragma unroll
        for (int r = 0; r < 16; ++r) MIX[(size_t)(qrow0 + wid * 32 + att::crow(r, hi)) * DM + 1024 + h * 128 + 32 * d + r32] = (bf16)f2bf(o[d][r] * rli[r]);
}
__device__ __forceinline__ void mixer_odd(Frame& F, int lj) {
    if (MXM & 1) for (int uu = F.vcu; uu < ((DUP & 2) ? 2 : 1) * (512 + 16); uu += F.G) { const int u = (DUP & 2) ? uu % (512 + 16) : uu; const bool is_ctx = u >= 512; const int pair = is_ctx ? u - 512 : (u >> 5), rb = is_ctx ? 0 : (u & 31);
        odd_attn_unit(F, lj, pair >> 3, pair & 7, rb, is_ctx); __syncthreads(); }
}

__global__ void __launch_bounds__(512, 2) mk_fwd(Args args) {
    extern __shared__ __attribute__((aligned(16))) unsigned char lds[];
    Frame F;
    F.lds = (LAS unsigned char*)lds; F.ldsg = lds;
    F.MISC = (volatile LAS unsigned*)(F.lds + MISC_OFF);
    F.tid = threadIdx.x; F.lane = F.tid & 63; F.wave = __builtin_amdgcn_readfirstlane(F.tid >> 6);
    F.G = gridDim.x; { const int bx = blockIdx.x; F.vcu = (F.G % 8 == 0) ? (bx % 8) * (F.G / 8) + bx / 8 : bx; }
    F.ap = (ArgsP)__builtin_amdgcn_kernarg_segment_ptr();
    F.ws = (GAS unsigned char*)args.ws; F.out = (GAS float*)args.out; F.ctl = (gu32*)(F.ws + WS_CTL);
    for (int u = F.tid; u < (LDS_BYTES - MISC_OFF) / 4; u += 512) ((LAS unsigned*)(F.lds + MISC_OFF))[u] = 0u;
    __syncthreads();
    XcdBarrier bar = xcd_barrier_post((unsigned*)(F.ctl + CW_BAR), F.MISC + 8);
    const int lo = args.ph_lo, hi = args.ph_hi;
#define IN(k) (lo <= (k) && (k) < hi)
#define SEAM(k) do { if (IN(k) && IN((k) + 1)) xcd_barrier(bar); } while (0)
    if (IN(0) && (PHM & 1)) { Frame L = site(F); p0_modvec(L); __syncthreads(); p0_tables(L); p0_copy_ctx(L); p0_fold(L); __syncthreads(); p0_weights(L); __syncthreads(); }
    SEAM(0);
    for (int li = 0; li < DEPTH; ++li) {
        const int pb = 1 + 8 * li, lj = li >> 1; const bool even = (li & 1) == 0;
        if (IN(pb + 0) && (PHM & 2)) { Frame L = site(F); norm_phase(L, li, 0, li == 0 ? INP(L, 0) : OUTP(L), (float*)(WSP(L) + WS_HC), li == 0 ? 0 : 11, (const float*)(WSP(L) + WS_MODV) + (size_t)((li - 1) * 3 + 2) * 12288 + 5 * DM); if (DUP & 32) norm_phase(L, li, 0, li == 0 ? INP(L, 0) : OUTP(L), (float*)(WSP(L) + WS_HC), 0, nullptr); }
        SEAM(pb + 0);
        if (IN(pb + 1) && (PHM & 4)) { Frame L = site(F);
            const int N = even ? EVN : ODN;
            const bf16* Bt = even ? (const bf16*)(WSP(L) + WS_WIN_E + (size_t)lj * SZ_WIN_E) : (const bf16*)(WSP(L) + WS_WIN_O + (size_t)lj * SZ_WIN_O);
            pg8::Gemm g{(const bf16*)(WSP(L) + WS_A), Bt, MT, N, DM}; pg8::StaticOrder S; S.init(MT, N, L.G, (int)blockIdx.x);
            if (even) {
                pg8::EpiEvenIn E{(bf16*)(WSP(L) + WS_P), (bf16*)(WSP(L) + WS_QR), N, INP(L, 11) + (size_t)lj * 128, (const float*)(WSP(L) + WS_ROPE), (LAS float*)(L.lds + pg8::STAGE_BYTES)};
                pg8::gemm_phase<pg8::EpiEvenIn, pg8::StaticOrder, PG8_ALIGN, PG8_SP2>(L.lds, g, S, E);
            } else {
            pg8::EpiOddIn E{(bf16*)(WSP(L) + WS_P), N, INP(L, 16) + (size_t)lj * 256, (LAS float*)(L.lds + pg8::STAGE_BYTES)};
            pg8::gemm_phase<pg8::EpiOddIn, pg8::StaticOrder, PG8_ALIGN, PG8_SP2>(L.lds, g, S, E);
            }
            wq_tail(L, 2 * li, (MT / 256) * (N / 256));
        }
        SEAM(pb + 1);
        if (IN(pb + 3)) { Frame L = site(F); if (even) { if (PHM & 32) mixer_even(L, lj); } else { if (PHM & 16) prep_odd(L, lj); if (PHM & 64) mixer_odd(L, lj); } }
        SEAM(pb + 3);
        if (IN(pb + 4) && (PHM & 128)) { Frame L = site(F);
            const bf16* Bt = even ? (const bf16*)(WSP(L) + WS_WOUT_E + (size_t)lj * SZ_WOUT) : (const bf16*)(WSP(L) + WS_WOUT_O + (size_t)lj * SZ_WOUT);
            const float* modl = (const float*)(WSP(L) + WS_MODV) + (size_t)li * 3 * 12288;
            pg8::Gemm g{(const bf16*)(WSP(L) + WS_MIX), Bt, MT, DM, DM}; pg8::SplitOrder<8> S; S.init(ML, DM, DM, L.G, (int)blockIdx.x, li != 3);
            pg8::EpiGate E{li == 0 ? INP(L, 0) : OUTP(L), OUTP(L), (float*)(WSP(L) + WS_SLAB), modl + 2 * DM};
            if (DUP & 64) { pg8::EpiGate E2 = E; E2.out_l = (float*)(WSP(L) + WS_STASH); pg8::gemm_phase<pg8::EpiGate, pg8::SplitOrder<8>, PG8_ALIGN, PG8_SP2>(L.lds, g, S, E2); }
            pg8::gemm_phase<pg8::EpiGate, pg8::SplitOrder<8>, PG8_ALIGN, PG8_SP2>(L.lds, g, S, E);
        }
        SEAM(pb + 4);
        if (IN(pb + 5) && (PHM & 2)) { Frame L = site(F); norm_phase(L, li, 1, OUTP(L), (float*)(WSP(L) + WS_HC), li == 3 ? 0 : 8, (const float*)(WSP(L) + WS_MODV) + (size_t)(li * 3 + 2) * 12288 + 2 * DM); if (DUP & 32) norm_phase(L, li, 1, OUTP(L), (float*)(WSP(L) + WS_HC), 0, nullptr); }
        SEAM(pb + 5);
        if (IN(pb + 6) && (PHM & 256)) { Frame L = site(F);
            const int Mr = li == 3 ? ML : MT;
            pg8::Gemm g{(const bf16*)(WSP(L) + WS_A), (const bf16*)(WSP(L) + WS_WFI + (size_t)li * SZ_WFI), Mr, 2 * FH, DM}; pg8::StaticOrder S; S.init(Mr, 2 * FH, L.G, (int)blockIdx.x);
            pg8::EpiSwiglu E{(bf16*)(WSP(L) + WS_HID), FH};
            for (int rep = 0; rep < ((DUP & 4) ? 2 : 1); ++rep)
            pg8::gemm_phase<pg8::EpiSwiglu, pg8::StaticOrder, PG8_ALIGN, PG8_SP2>(L.lds, g, S, E);
            if (li < 3) wq_tail(L, 2 * li + 1, (Mr / 256) * (2 * FH / 256));
        }
        SEAM(pb + 6);
        if (IN(pb + 7) && (PHM & 512)) { Frame L = site(F);
            const float* modl = (const float*)(WSP(L) + WS_MODV) + (size_t)li * 3 * 12288;
            pg8::Gemm g{(const bf16*)(WSP(L) + WS_HID), (const bf16*)(WSP(L) + WS_WFO + (size_t)li * SZ_WFO), MT, DM, FH}; pg8::SplitOrder<11> S; S.init(ML, DM, FH, L.G, (int)blockIdx.x, li != 3);
            pg8::EpiGate E{OUTP(L), OUTP(L), (float*)(WSP(L) + WS_SLAB), modl + 5 * DM};
            if (DUP & 128) { pg8::EpiGate E2 = E; E2.out_l = (float*)(WSP(L) + WS_STASH); pg8::gemm_phase<pg8::EpiGate, pg8::SplitOrder<11>, PG8_ALIGN, PG8_SP2>(L.lds, g, S, E2); }
            pg8::gemm_phase<pg8::EpiGate, pg8::SplitOrder<11>, PG8_ALIGN, PG8_SP2>(L.lds, g, S, E);
        }
        SEAM(pb + 7);
    }
#undef IN
#undef SEAM
}

extern "C" void kernel_launch(void* const* d_in, const int* in_sizes, int n_in, void* d_out, int out_size, void* d_ws, size_t ws_size, hipStream_t stream) {
    static int grid = 0;
    if (grid == 0) {
        if (n_in != 19 || in_sizes[0] != ML * DM || out_size != ML * DM || ws_size < WS_END) { fprintf(stderr, "kernel_launch: shape mismatch (n_in %d, in0 %d, out %d, ws %zu < %zu); nothing launched\n", n_in, n_in > 0 ? in_sizes[0] : -1, out_size, ws_size, (size_t)WS_END); grid = -1; return; }
        int dev = 0, cus = 0, per_cu = 0;
        if (hipGetDevice(&dev) != hipSuccess || hipDeviceGetAttribute(&cus, hipDeviceAttributeMultiprocessorCount, dev) != hipSuccess) { fprintf(stderr, "kernel_launch: device query failed\n"); grid = -1; return; }
        if (hipFuncSetAttribute((const void*)mk_fwd, hipFuncAttributeMaxDynamicSharedMemorySize, LDS_BYTES) != hipSuccess) { fprintf(stderr, "kernel_launch: hipFuncSetAttribute failed\n"); grid = -1; return; }
        if (hipOccupancyMaxActiveBlocksPerMultiprocessor(&per_cu, (const void*)mk_fwd, 512, LDS_BYTES) != hipSuccess || per_cu < 1) fprintf(stderr, "kernel_launch: note: occupancy query reports %d workgroups per CU\n", per_cu);
        (void)hipGetLastError();
        grid = cus;
    }
    if (grid < 0) return;
    if (hipMemsetAsync((char*)d_ws + WS_CTL, 0, CTL_ZERO_BYTES, stream) != hipSuccess) { fprintf(stderr, "kernel_launch: memset failed\n"); return; }
    Args a{};
    for (int i = 0; i < 19; ++i) a.in[i] = (const float*)d_in[i];
    a.out = (float*)d_out; a.ws = (unsigned char*)d_ws;
    constexpr int NL = MK_N_LAUNCHES;
    for (int l = 0; l < NL; ++l) {
        a.ph_lo = (NL == 1) ? 0 : l; a.ph_hi = (NL == 1) ? NPH : l + 1;
        hipLaunchKernelGGL(mk_fwd, dim3(grid), dim3(512), LDS_BYTES, stream, a);
        const hipError_t le = hipPeekAtLastError();
        if (le != hipSuccess) { fprintf(stderr, "kernel_launch: launch %d failed: %s\n", l, hipGetErrorName(le)); break; }
    }
}
```

```cpp
#include <hip/hip_runtime.h>
#include <cstdio>
#include <cstdint>
#include <cstddef>
#ifndef DUP
#define DUP 0
#endif

#ifndef STAMP
#define STAMP 0
#endif
#ifndef STAMP_LJ
#define STAMP_LJ 0
#endif
namespace pg8 {
#define PG8_LAS __attribute__((address_space(3)))
typedef unsigned short bf16_t;
typedef short bf16x8 __attribute__((ext_vector_type(8)));
typedef float f32x4 __attribute__((ext_vector_type(4)));
typedef unsigned u32x4 __attribute__((ext_vector_type(4)));
constexpr int BM = 256, BK = 64, HALF = 128, HTB = HALF * BK * 2  , STAGE_BYTES = 8 * HTB, NXCD = 8, WGM = 8;

__host__ __device__ __forceinline__ int lds_byte(int r, int c) { const int st = (r >> 4) * 2 + (c >> 5), rr = r & 15, cc = c & 31, ob = rr * 64 + cc * 2; return st * 1024 + (ob ^ (((ob >> 9) & 1) << 5)); }
__host__ __device__ __forceinline__ void stage_rc(int b, int& R, int& C) { const int st = b / 1024, sb = b % 1024, swz = sb ^ (((sb >> 9) & 1) << 5); R = (st >> 1) * 16 + swz / 64; C = (st & 1) * 32 + (swz % 64) / 2; }
__host__ __device__ __forceinline__ int perm32(int rho) { const int n = rho >> 4, i = rho & 15; return 8 * (i >> 2) + 4 * n + (i & 3); }

struct Unit { int pm, pn; int kb, nt; };
struct Gemm { const bf16_t* A; const bf16_t* Bt; int M, N, K; };

struct StaticOrder {
    int nM, nN, nwg, G, c;
    __host__ __device__ void init(int M, int N, int G_, int c_) { nM = M / BM; nN = N / BM; nwg = nM * nN; G = G_; c = c_; }
    __host__ __device__ bool next(int i, Unit& u) const {
        const long L = (long)i * G + c; if (L >= nwg) return false;
        int wgid = (int)L; { const int q = nwg / NXCD, r = nwg % NXCD, xcd = wgid % NXCD, off = wgid / NXCD; wgid = (xcd < r ? xcd * (q + 1) : r * (q + 1) + (xcd - r) * q) + off; }
        const int nig = WGM * nN, gid = wgid / nig, fm = gid * WGM, gsz = (nM - fm) < WGM ? (nM - fm) : WGM;
        u.pm = fm + ((wgid % nig) % gsz); u.pn = (wgid % nig) / gsz; return true;
    }
    static constexpr bool SPLITK = false;
    __device__ __forceinline__ void a_ready(const Unit&) const {}
    __device__ __forceinline__ void done(const Unit&) const {}
};

__device__ __forceinline__ unsigned cvt_pk_bf16(float lo, float hi) { unsigned r; asm volatile("v_cvt_pk_bf16_f32 %0, %1, %2" : "=v"(r) : "v"(lo), "v"(hi)); return r; }
typedef float f32x2 __attribute__((ext_vector_type(2)));
__device__ __forceinline__ f32x2 gelu_pk(f32x2 v) {
    const f32x2 av = __builtin_elementwise_abs(v), d = av * 0.2316418882f + 1.0f;
    f32x2 t; t.x = __builtin_amdgcn_rcpf(d.x); t.y = __builtin_amdgcn_rcpf(d.y);
    f32x2 q = t * 0.5307027145f + (-0.7265760135f); q = q * t + 0.7107068705f; q = q * t + (-0.142248368f); q = q * t + 0.127414796f; q = q * t;
    const f32x2 s = (v * v) * (-0.72134752044f);
    f32x2 e; e.x = __builtin_amdgcn_exp2f(s.x); e.y = __builtin_amdgcn_exp2f(s.y);
    const f32x2 m = v * (q * e), r = v - m;
    f32x2 o; o.x = v.x < 0.f ? m.x : r.x; o.y = v.y < 0.f ? m.y : r.y; return o;
}

template <int ACT  > struct EpiBf16 {
    static constexpr bool PERM = true, AFTER_DRAIN = false; static_assert(ACT == 0 || ACT == 1, "EpiBf16: ACT is 0 (none) or 1 (gelu_pk)");
    bf16_t* O; int ldc; const float* bias; int split_cols; size_t split_stride; float scale0;
    __device__ __forceinline__ void operator()(const f32x4 (&acc)[2][2][4][2], const Unit& u, int wr, int wc, int fr, int fq) const {
        const int row0 = u.pm * BM + wr * 64 + fr; int colt = u.pn * BM; bf16_t* base = O;
        float sc = 1.f; if (split_cols) { const int t = colt / split_cols; base += (size_t)t * split_stride; colt -= t * split_cols; if (t == 0) sc = scale0; }
        const int col0 = colt + wc * 32 + 8 * fq, bcol0 = u.pn * BM + wc * 32 + 8 * fq;
        f32x4 bv[2][2];
#pragma unroll
        for (int bj = 0; bj < 2; ++bj)
#pragma unroll
            for (int n = 0; n < 2; ++n) bv[bj][n] = bias ? *(const f32x4*)(bias + bcol0 + bj * HALF + 4 * n) : (f32x4){0.f, 0.f, 0.f, 0.f};
#pragma unroll
        for (int ai = 0; ai < 2; ++ai)
#pragma unroll
            for (int m = 0; m < 4; ++m) { bf16_t* rowp = base + (size_t)(row0 + ai * HALF + m * 16) * ldc + col0;
#pragma unroll
                for (int bj = 0; bj < 2; ++bj) { f32x4 v0 = acc[ai][bj][m][0] + bv[bj][0], v1 = acc[ai][bj][m][1] + bv[bj][1];
                    if (ACT == 1) { f32x2 a = gelu_pk((f32x2){v0[0], v0[1]}), b = gelu_pk((f32x2){v0[2], v0[3]}), c = gelu_pk((f32x2){v1[0], v1[1]}), d = gelu_pk((f32x2){v1[2], v1[3]});
                        v0 = (f32x4){a.x, a.y, b.x, b.y}; v1 = (f32x4){c.x, c.y, d.x, d.y}; }
                    v0 = v0 * sc; v1 = v1 * sc; u32x4 w; w.x = cvt_pk_bf16(v0[0], v0[1]); w.y = cvt_pk_bf16(v0[2], v0[3]); w.z = cvt_pk_bf16(v1[0], v1[1]); w.w = cvt_pk_bf16(v1[2], v1[3]);
                    *(u32x4*)(rowp + bj * HALF) = w; } }
    }
};

template <bool BASE_F32> struct EpiGate {
    static constexpr bool PERM = true, AFTER_DRAIN = false;
    const void* base_l; void* out_l; float* slab; const float* gate; int out_f32;
    __device__ __forceinline__ void operator()(const f32x4 (&acc)[2][2][4][2], const Unit& u, int wr, int wc, int fr, int fq) const {
        const bool isc = u.pm >= 64; const int grp = u.pm < 32 ? 0 : (u.pm < 64 ? 1 : 2);
        const int rowt = (isc ? (u.pm - 64) : u.pm) * BM + wr * 64 + fr;
        const int col0 = u.pn * BM + wc * 32 + 8 * fq;
        if (isc) {
            const int kc = u.kb / (u.nt * BK * 2); float* sp = slab + (size_t)kc * (512 * 2048);
#pragma unroll
            for (int ai = 0; ai < 2; ++ai)
#pragma unroll
                for (int m = 0; m < 4; ++m) { const size_t off = (size_t)(rowt + ai * HALF + m * 16) * 2048 + col0;
#pragma unroll
                    for (int bj = 0; bj < 2; ++bj)
#pragma unroll
                        for (int n = 0; n < 2; ++n) *(f32x4*)(sp + off + bj * HALF + n * 4) = acc[ai][bj][m][n]; }
            return; }
        f32x4 gv[2][2];
#pragma unroll
        for (int bj = 0; bj < 2; ++bj)
#pragma unroll
            for (int n = 0; n < 2; ++n) gv[bj][n] = *(const f32x4*)(gate + grp * 12288 + col0 + bj * HALF + n * 4);
        u32x4 pball[2][4][2];
        if constexpr (!BASE_F32) {
            const unsigned long long bpu = (unsigned long long)base_l;
            const void* bps = (const void*)(((unsigned long long)(unsigned)__builtin_amdgcn_readfirstlane((int)(bpu >> 32)) << 32) | (unsigned)__builtin_amdgcn_readfirstlane((int)bpu));
            const __amdgpu_buffer_rsrc_t rs = __builtin_amdgcn_make_buffer_rsrc((void*)bps, 0, 0x7fffffff, 0x00020000);
            const int voff = ((wr * 64 + fr) * 2048 + wc * 32 + 8 * fq) * 2;
            const int sb = __builtin_amdgcn_readfirstlane((u.pm * BM * 2048 + u.pn * BM) * 2);
#pragma unroll
            for (int ai = 0; ai < 2; ++ai)
#pragma unroll
                for (int m = 0; m < 4; ++m)
#pragma unroll
                    for (int bj = 0; bj < 2; ++bj) pball[ai][m][bj] = __builtin_bit_cast(u32x4, __builtin_amdgcn_raw_buffer_load_b128(rs, voff, sb + ((ai * HALF + m * 16) * 2048 + bj * HALF) * 2, 0));
            asm volatile("" ::: "memory");
        }
#pragma unroll
        for (int ai = 0; ai < 2; ++ai) {
            f32x4 pre[4][2][2]; u32x4 pb[4][2];
            if constexpr (BASE_F32) { const float* bp = (const float*)base_l;
#pragma unroll
                for (int m = 0; m < 4; ++m) { const size_t off = (size_t)(rowt + ai * HALF + m * 16) * 2048 + col0;
#pragma unroll
                    for (int bj = 0; bj < 2; ++bj)
#pragma unroll
                        for (int n = 0; n < 2; ++n) pre[m][bj][n] = *(const f32x4*)(bp + off + bj * HALF + n * 4); }
            } else {
#pragma unroll
                for (int m = 0; m < 4; ++m)
#pragma unroll
                    for (int bj = 0; bj < 2; ++bj) pb[m][bj] = pball[ai][m][bj];
            }
            asm volatile("" ::: "memory");
#pragma unroll
            for (int m = 0; m < 4; ++m) { const size_t off = (size_t)(rowt + ai * HALF + m * 16) * 2048 + col0;
#pragma unroll
                for (int bj = 0; bj < 2; ++bj) { f32x4 x0, x1;
                    if constexpr (BASE_F32) { x0 = pre[m][bj][0]; x1 = pre[m][bj][1]; }
                    else { const u32x4 w = pb[m][bj];
                        x0 = f32x4{__uint_as_float(w.x << 16), __uint_as_float(w.x & 0xffff0000u), __uint_as_float(w.y << 16), __uint_as_float(w.y & 0xffff0000u)};
                        x1 = f32x4{__uint_as_float(w.z << 16), __uint_as_float(w.z & 0xffff0000u), __uint_as_float(w.w << 16), __uint_as_float(w.w & 0xffff0000u)}; }
                    const f32x4 a = x0 + gv[bj][0] * acc[ai][bj][m][0], b = x1 + gv[bj][1] * acc[ai][bj][m][1];
                    if (out_f32) { float* op = (float*)out_l + off + bj * HALF; *(f32x4*)op = a; *(f32x4*)(op + 4) = b; }
                    else { u32x4 w; w.x = cvt_pk_bf16(a.x, a.y); w.y = cvt_pk_bf16(a.z, a.w); w.z = cvt_pk_bf16(b.x, b.y); w.w = cvt_pk_bf16(b.z, b.w);
                        *(u32x4*)((bf16_t*)out_l + off + bj * HALF) = w; } } }
            asm volatile("" ::: "memory");
        }
    }
};
template <int KS> struct SplitOrder {
    static constexpr bool SPLITK = true;
    StaticOrder so; int G, c, ntc, ntf, nctx;
    __device__ void init(int Mlat, int N, int K, int G_, int c_, bool with_ctx) { so.init(Mlat, N, G_, c_); G = G_; c = c_; ntf = K / BK; ntc = ntf / KS; nctx = with_ctx ? 16 * KS : 0; }
    __device__ bool next(int i, Unit& u) const {
        const long L = (long)i * G + c;
        if (L < so.nwg) { so.next(i, u); u.kb = 0; u.nt = ntf; return true; }
        const int x = (int)(L - so.nwg); if (x >= nctx) return false;
        const int kc = x % KS, tile = x / KS; u.pn = tile & 7; u.pm = so.nM + (tile >> 3); u.kb = kc * ntc * BK * 2; u.nt = ntc; return true;
    }
    __device__ __forceinline__ void a_ready(const Unit&) const {}
    __device__ __forceinline__ void done(const Unit&) const {}
};
struct EpiEvenIn {
    static constexpr bool PERM = true, AFTER_DRAIN = false;
    bf16_t* P; bf16_t* QR; int ldc; const float* gains; const float* rope; PG8_LAS float* part; bf16_t* FT;
    __device__ __forceinline__ void operator()(const f32x4 (&acc)[2][2][4][2], const Unit& u, int wr, int wc, int fr, int fq) const {
        const int row0 = u.pm * BM + wr * 64 + fr; const int col0 = u.pn * BM + wc * 32 + 8 * fq;
        if (u.pn >= 18 && u.pm < 64) {
            const int cp0 = (col0 - 4608) >> 2;
#pragma unroll
            for (int ai = 0; ai < 2; ++ai)
#pragma unroll
                for (int m = 0; m < 4; ++m) { const int row = row0 + ai * HALF + m * 16; const int b = row >> 13, t = row & 8191;
#pragma unroll
                    for (int bj = 0; bj < 2; ++bj) { const f32x4 v0 = acc[ai][bj][m][0], v1 = acc[ai][bj][m][1];
                        bf16_t* fp = FT + ((size_t)(b * 256 + cp0 + 32 * bj) * 8192 + t) * 4;
                        typedef unsigned u32x2_ __attribute__((ext_vector_type(2)));
                        u32x2_ wa, wb; wa.x = cvt_pk_bf16(v0[0], v0[1]); wa.y = cvt_pk_bf16(v0[2], v0[3]); wb.x = cvt_pk_bf16(v1[0], v1[1]); wb.y = cvt_pk_bf16(v1[2], v1[3]);
                        *(u32x2_*)fp = wa; *(u32x2_*)(fp + 8192 * 4) = wb; } }
            return; }
        if (u.pn >= 12) {
#pragma unroll
            for (int ai = 0; ai < 2; ++ai)
#pragma unroll
                for (int m = 0; m < 4; ++m) { bf16_t* rowp = P + (size_t)(row0 + ai * HALF + m * 16) * ldc + col0;
#pragma unroll
                    for (int bj = 0; bj < 2; ++bj) { const f32x4 v0 = acc[ai][bj][m][0], v1 = acc[ai][bj][m][1];
                        u32x4 w; w.x = cvt_pk_bf16(v0[0], v0[1]); w.y = cvt_pk_bf16(v0[2], v0[3]); w.z = cvt_pk_bf16(v1[0], v1[1]); w.w = cvt_pk_bf16(v1[2], v1[3]);
                        *(u32x4*)(rowp + bj * HALF) = w; } }
            return; }
        const bool isq = u.pn < 6, lat = u.pm < 64;
        int rb_ = wr * 64 + fr; asm volatile("" : "+v"(rb_));
#pragma unroll
        for (int ai = 0; ai < 2; ++ai)
#pragma unroll
            for (int m = 0; m < 4; ++m)
#pragma unroll
                for (int bj = 0; bj < 2; ++bj) { const f32x4 a = acc[ai][bj][m][0], b = acc[ai][bj][m][1];
                    float s = (a[0] * a[0] + a[1] * a[1]) + (a[2] * a[2] + a[3] * a[3]) + (b[0] * b[0] + b[1] * b[1]) + (b[2] * b[2] + b[3] * b[3]);
                    s += __shfl_xor(s, 16); s += __shfl_xor(s, 32);
                    if (fq == 0) part[((ai * HALF + m * 16 + rb_) * 2 + bj) * 4 + wc] = s; }
        asm volatile("s_waitcnt lgkmcnt(0)" ::: "memory"); __builtin_amdgcn_s_barrier(); asm volatile("" ::: "memory");
        const float* gp = gains + (isq ? 0 : 64) + 32 * (wc & 1) + 8 * fq; const float qs = isq ? 0.18033688011112042f : 1.0f;
        float gn[8];
#pragma unroll
        for (int e = 0; e < 8; ++e) gn[e] = gp[e] * qs;
#pragma unroll
        for (int ai = 0; ai < 2; ++ai)
#pragma unroll
            for (int m = 0; m < 4; ++m) { const int rl = ai * HALF + m * 16 + rb_; const int row = u.pm * BM + rl;
                f32x4 cs0 = {1.f, 0.f, 1.f, 0.f}, cs1 = cs0, cs2 = cs0, cs3 = cs0;
                if (lat) { const int t = row & 8191; const int pos = (wc & 1) ? (t & 63) : (t >> 6); const float* rp = rope + (size_t)(pos * 16 + 8 * (fq & 1)) * 2;
                    cs0 = *(const f32x4*)rp; cs1 = *(const f32x4*)(rp + 4); cs2 = *(const f32x4*)(rp + 8); cs3 = *(const f32x4*)(rp + 12); }
                const float c8[8] = {cs0[0], cs0[2], cs1[0], cs1[2], cs2[0], cs2[2], cs3[0], cs3[2]}, s8[8] = {cs0[1], cs0[3], cs1[1], cs1[3], cs2[1], cs2[3], cs3[1], cs3[3]};
#pragma unroll
                for (int bj = 0; bj < 2; ++bj) {
                    const float ss = part[(rl * 2 + bj) * 4 + wc] + part[(rl * 2 + bj) * 4 + (wc ^ 1)];
                    const float rstd = rsqrtf(ss * (1.0f / 64.0f) + 1e-6f);
                    float y[8], yr[8];
#pragma unroll
                    for (int e = 0; e < 8; ++e) y[e] = acc[ai][bj][m][e >> 2][e & 3] * rstd * gn[e];
#pragma unroll
                    for (int e = 0; e < 8; ++e) { const float yp = __shfl_xor(y[e], 32); yr[e] = (fq & 2) ? (y[e] * c8[e] + yp * s8[e]) : (y[e] * c8[e] - yp * s8[e]); }
                    u32x4 wn, wrot;
                    wn.x = cvt_pk_bf16(y[0], y[1]); wn.y = cvt_pk_bf16(y[2], y[3]); wn.z = cvt_pk_bf16(y[4], y[5]); wn.w = cvt_pk_bf16(y[6], y[7]);
                    wrot.x = cvt_pk_bf16(yr[0], yr[1]); wrot.y = cvt_pk_bf16(yr[2], yr[3]); wrot.z = cvt_pk_bf16(yr[4], yr[5]); wrot.w = cvt_pk_bf16(yr[6], yr[7]);
                    bf16_t* pp = P + (size_t)row * ldc + col0 + bj * HALF;
                    if (isq) { *(u32x4*)pp = wn; if (lat) *(u32x4*)(QR + (size_t)row * 1536 + col0 + bj * HALF) = wrot; }
                    else     { *(u32x4*)pp = lat ? wrot : wn; }
                }
                asm volatile("" ::: "memory"); }
    }
};
struct EpiOddIn {
    static constexpr bool PERM = true, AFTER_DRAIN = false;
    bf16_t* P; int ldc; const float* gains; PG8_LAS float* part;
    __device__ __forceinline__ void operator()(const f32x4 (&acc)[2][2][4][2], const Unit& u, int wr, int wc, int fr, int fq) const {
        const int row0 = u.pm * BM + wr * 64 + fr; const int col0 = u.pn * BM + wc * 32 + 8 * fq;
        const bool isqk = u.pn >= 12 && u.pn < 20;
        float rs[2][4][2];
        if (isqk) {
            int rb_ = wr * 64 + fr; asm volatile("" : "+v"(rb_));
#pragma unroll
            for (int ai = 0; ai < 2; ++ai)
#pragma unroll
                for (int m = 0; m < 4; ++m)
#pragma unroll
                    for (int bj = 0; bj < 2; ++bj) { const f32x4 a = acc[ai][bj][m][0], b = acc[ai][bj][m][1];
                        float s = (a[0] * a[0] + a[1] * a[1]) + (a[2] * a[2] + a[3] * a[3]) + (b[0] * b[0] + b[1] * b[1]) + (b[2] * b[2] + b[3] * b[3]);
                        s += __shfl_xor(s, 16); s += __shfl_xor(s, 32);
                        if (fq == 0) part[((ai * HALF + m * 16 + rb_) * 2 + bj) * 4 + wc] = s; }
            asm volatile("s_waitcnt lgkmcnt(0)" ::: "memory"); __builtin_amdgcn_s_barrier(); asm volatile("" ::: "memory");
#pragma unroll
            for (int ai = 0; ai < 2; ++ai)
#pragma unroll
                for (int m = 0; m < 4; ++m)
#pragma unroll
                    for (int bj = 0; bj < 2; ++bj) { const f32x4 t = *(const PG8_LAS f32x4*)(part + ((ai * HALF + m * 16 + rb_) * 2 + bj) * 4);
                        rs[ai][m][bj] = rsqrtf(((t[0] + t[1]) + (t[2] + t[3])) * (1.0f / 128.0f) + 1e-6f); }
        }
        float gn[8];
        { const float* gp = gains + (u.pn >= 16 ? 128 : 0) + 32 * wc + 8 * fq;
          const float qs = u.pn < 16 ? 0.12751743f : 1.0f;
#pragma unroll
          for (int e = 0; e < 8; ++e) gn[e] = isqk ? gp[e] * qs : 1.0f; }
#pragma unroll
        for (int ai = 0; ai < 2; ++ai)
#pragma unroll
            for (int m = 0; m < 4; ++m) { bf16_t* rowp = P + (size_t)(row0 + ai * HALF + m * 16) * ldc + col0;
#pragma unroll
                for (int bj = 0; bj < 2; ++bj) { const float r = isqk ? rs[ai][m][bj] : 1.0f; const f32x4 v0 = acc[ai][bj][m][0], v1 = acc[ai][bj][m][1];
                    u32x4 w; w.x = cvt_pk_bf16(v0[0] * r * gn[0], v0[1] * r * gn[1]); w.y = cvt_pk_bf16(v0[2] * r * gn[2], v0[3] * r * gn[3]);
                    w.z = cvt_pk_bf16(v1[0] * r * gn[4], v1[1] * r * gn[5]); w.w = cvt_pk_bf16(v1[2] * r * gn[6], v1[3] * r * gn[7]);
                    *(u32x4*)(rowp + bj * HALF) = w; } }
    }
};
struct EpiSwiglu {
    static constexpr bool PERM = true, AFTER_DRAIN = false;
    bf16_t* O; int ldc;
    __device__ __forceinline__ void operator()(const f32x4 (&acc)[2][2][4][2], const Unit& u, int wr, int wc, int fr, int fq) const {
        const int row0 = u.pm * BM + wr * 64 + fr; const int col0 = u.pn * HALF + wc * 32 + 8 * fq;
#pragma unroll
        for (int ai = 0; ai < 2; ++ai)
#pragma unroll
            for (int m = 0; m < 4; ++m) { bf16_t* rowp = O + (size_t)(row0 + ai * HALF + m * 16) * ldc + col0;
                float hv[8];
#pragma unroll
                for (int n = 0; n < 2; ++n)
#pragma unroll
                    for (int e = 0; e < 4; ++e) { const float g = acc[ai][0][m][n][e], up = acc[ai][1][m][n][e];
                        hv[n * 4 + e] = g * __builtin_amdgcn_rcpf(1.0f + __expf(-g)) * up; }
                u32x4 w; w.x = cvt_pk_bf16(hv[0], hv[1]); w.y = cvt_pk_bf16(hv[2], hv[3]); w.z = cvt_pk_bf16(hv[4], hv[5]); w.w = cvt_pk_bf16(hv[6], hv[7]);
                *(u32x4*)rowp = w; }
    }
};

template <class Epi, class Sched, bool ALIGN_EPI = false, bool SP2 = false>
__device__ __forceinline__ void gemm_phase(PG8_LAS unsigned char* lds, const Gemm g, const Sched& S, const Epi& E) {
    int tid_ = threadIdx.x; asm volatile("" : "+v"(tid_));
    const int tid = tid_, wid = __builtin_amdgcn_readfirstlane(tid >> 6), lane = tid & 63, wr = wid >> 2, wc = wid & 3, fr = lane & 15, fq = lane >> 4;
    const int K = g.K, ntf = K / BK;
    unsigned voffA[2], voffB[2];
#pragma unroll
    for (int i = 0; i < 2; ++i) { int R, C; stage_rc(tid * 16 + i * 8192, R, C); const int Rb = Epi::PERM ? ((R & ~31) + perm32(R & 31)) : R;
        voffA[i] = (unsigned)(R * K + C) * 2u; voffB[i] = (unsigned)(Rb * K + C) * 2u; }
    const size_t kstep = (size_t)(BK * 2);
    const size_t hstep = (size_t)HALF * K * 2;
    const size_t tstep = 2 * hstep;
    const unsigned ldsw = (unsigned)wid * 1024u;
    const int aoff = lds_byte(wr * 64 + fr, fq * 8), boff = lds_byte(wc * 32 + fr, fq * 8);
#define PG8_SA(b, h) (((b) * 2 + (h)) * HTB)
#define PG8_SB(b, h) ((4 + (b) * 2 + (h)) * HTB)
#define PG8_STAGE(bufoff, gbase, voff) do { _Pragma("unroll") for (int _i = 0; _i < 2; ++_i) \
        __builtin_amdgcn_global_load_lds((const unsigned*)((const char*)(gbase) + (voff)[_i]), (PG8_LAS unsigned*)(lds + (bufoff) + ldsw + _i * 8192), 16, 0, 0); } while (0)
#define PG8_LDA(dst, b, h) do { _Pragma("unroll") for (int m = 0; m < 4; ++m) _Pragma("unroll") for (int k = 0; k < 2; ++k) dst[m][k] = *(const PG8_LAS bf16x8*)(lds + PG8_SA(b, h) + aoff + m * 2048 + k * 1024); } while (0)
#define PG8_LDB(dst, b, h) do { _Pragma("unroll") for (int n = 0; n < 2; ++n) _Pragma("unroll") for (int k = 0; k < 2; ++k) dst[n][k] = *(const PG8_LAS bf16x8*)(lds + PG8_SB(b, h) + boff + n * 2048 + k * 1024); } while (0)
#define PG8_MMA(ai, bj, At, Bt) do { __builtin_amdgcn_s_setprio(1); _Pragma("unroll") for (int m = 0; m < 4; ++m) _Pragma("unroll") for (int n = 0; n < 2; ++n) _Pragma("unroll") for (int k = 0; k < 2; ++k) \
        acc[ai][bj][m][n] = __builtin_amdgcn_mfma_f32_16x16x32_bf16(Bt[n][k], At[m][k], acc[ai][bj][m][n], 0, 0, 0); __builtin_amdgcn_s_setprio(0); } while (0)
#define PG8_WAIT_V(n) asm volatile("s_waitcnt vmcnt(" #n ")" ::: "memory")
#define PG8_WAIT_L(n) asm volatile("s_waitcnt lgkmcnt(" #n ")" ::: "memory")
#define PG8_BAR __builtin_amdgcn_s_barrier()
#define PG8_SCHED __builtin_amdgcn_sched_barrier(0)
    Unit cur, nxt; int ui = 0;
    if (!S.next(0, cur)) return;
    f32x4 acc[2][2][4][2];
#pragma unroll
    for (int a = 0; a < 2; ++a)
#pragma unroll
        for (int b = 0; b < 2; ++b)
#pragma unroll
            for (int m = 0; m < 4; ++m)
#pragma unroll
                for (int n = 0; n < 2; ++n) acc[a][b][m][n] = (f32x4){0.f, 0.f, 0.f, 0.f};
    bf16x8 At[4][2], B0[2][2], B1[2][2];
    const char* cA = (const char*)g.A + (size_t)cur.pm * tstep + (Sched::SPLITK ? cur.kb : 0); const char* cB = (const char*)g.Bt + (size_t)cur.pn * tstep + (Sched::SPLITK ? cur.kb : 0);
    S.a_ready(cur);
    if constexpr (SP2) {
        PG8_STAGE(PG8_SB(0, 0), cB, voffB); PG8_STAGE(PG8_SB(0, 1), cB + hstep, voffB); PG8_STAGE(PG8_SA(0, 0), cA, voffA); PG8_STAGE(PG8_SA(0, 1), cA + hstep, voffA);
        if (wr == 1) PG8_BAR;
        PG8_WAIT_V(2); PG8_BAR;
        PG8_STAGE(PG8_SB(1, 0), cB + kstep, voffB); PG8_STAGE(PG8_SA(1, 0), cA + kstep, voffA); PG8_STAGE(PG8_SB(1, 1), cB + hstep + kstep, voffB);
        PG8_WAIT_V(6); PG8_BAR;
    } else {
        PG8_STAGE(PG8_SB(0, 0), cB, voffB); PG8_STAGE(PG8_SA(0, 0), cA, voffA); PG8_STAGE(PG8_SB(0, 1), cB + hstep, voffB); PG8_STAGE(PG8_SA(0, 1), cA + hstep, voffA);
        if (wr == 1) PG8_BAR;
        PG8_WAIT_V(4); PG8_BAR;
        PG8_STAGE(PG8_SB(1, 0), cB + kstep, voffB); PG8_STAGE(PG8_SA(1, 0), cA + kstep, voffA); PG8_STAGE(PG8_SB(1, 1), cB + hstep + kstep, voffB);
        PG8_WAIT_V(6); PG8_BAR;
    }
    for (;;) {
        const bool has_next = S.next(ui + 1, nxt);
        const char* nA = has_next ? (const char*)g.A + (size_t)nxt.pm * tstep + (Sched::SPLITK ? nxt.kb : 0) : cA; const char* nB = has_next ? (const char*)g.Bt + (size_t)nxt.pn * tstep + (Sched::SPLITK ? nxt.kb : 0) : cB;
        const int nt = Sched::SPLITK ? cur.nt : ntf;
        for (int t = 0; t < nt; t += 2) {
            const bool last = (t == nt - 2);
            const char* a1 = cA + (size_t)(t + 1) * kstep;
            const char* a2 = last ? nA : cA + (size_t)(t + 2) * kstep; const char* b2 = last ? nB : cB + (size_t)(t + 2) * kstep;
            const char* a3 = a2 + kstep; const char* b3 = b2 + kstep;
            if (last && has_next) S.a_ready(nxt);
            if constexpr (SP2) {
            PG8_LDB(B0, 0, 0); PG8_LDB(B1, 0, 1); PG8_SCHED; PG8_LDA(At, 0, 0); PG8_STAGE(PG8_SA(1, 1), a1 + hstep, voffA);
            PG8_WAIT_V(8); PG8_WAIT_L(0); PG8_BAR; PG8_MMA(0, 0, At, B0); PG8_MMA(0, 1, At, B1); PG8_BAR; PG8_SCHED;
            PG8_LDA(At, 0, 1); PG8_STAGE(PG8_SB(0, 0), b2, voffB); PG8_STAGE(PG8_SB(0, 1), b2 + hstep, voffB); PG8_STAGE(PG8_SA(0, 0), a2, voffA);
            PG8_WAIT_V(8); PG8_WAIT_L(0); PG8_BAR; PG8_MMA(1, 0, At, B0); PG8_MMA(1, 1, At, B1); PG8_BAR; PG8_SCHED;
            PG8_LDB(B0, 1, 0); PG8_LDB(B1, 1, 1); PG8_SCHED; PG8_LDA(At, 1, 0); PG8_STAGE(PG8_SA(0, 1), a2 + hstep, voffA);
            PG8_WAIT_V(8); PG8_WAIT_L(0); PG8_BAR; PG8_MMA(0, 0, At, B0); PG8_MMA(0, 1, At, B1); PG8_BAR; PG8_SCHED;
            PG8_LDA(At, 1, 1); PG8_STAGE(PG8_SB(1, 0), b3, voffB); PG8_STAGE(PG8_SB(1, 1), b3 + hstep, voffB); PG8_STAGE(PG8_SA(1, 0), a3, voffA);
            PG8_WAIT_V(8); PG8_WAIT_L(0); PG8_BAR; PG8_MMA(1, 0, At, B0); PG8_MMA(1, 1, At, B1); PG8_BAR; PG8_SCHED;
            } else {
            PG8_LDB(B0, 0, 0); PG8_SCHED; PG8_LDA(At, 0, 0); PG8_STAGE(PG8_SA(1, 1), a1 + hstep, voffA);
            PG8_WAIT_L(8); PG8_BAR; PG8_WAIT_L(0); PG8_MMA(0, 0, At, B0); PG8_BAR; PG8_SCHED;
            PG8_LDB(B1, 0, 1); PG8_STAGE(PG8_SB(0, 0), b2, voffB);
            PG8_BAR; PG8_WAIT_L(0); PG8_MMA(0, 1, At, B1); PG8_BAR;
            PG8_LDA(At, 0, 1); PG8_STAGE(PG8_SA(0, 0), a2, voffA);
            PG8_BAR; PG8_WAIT_L(0); PG8_MMA(1, 0, At, B0); PG8_BAR; PG8_SCHED;
            PG8_STAGE(PG8_SB(0, 1), b2 + hstep, voffB);
            PG8_WAIT_V(6); PG8_BAR; PG8_MMA(1, 1, At, B1); PG8_BAR;
            PG8_LDB(B0, 1, 0); PG8_SCHED; PG8_LDA(At, 1, 0); PG8_STAGE(PG8_SA(0, 1), a2 + hstep, voffA);
            PG8_WAIT_L(8); PG8_BAR; PG8_WAIT_L(0); PG8_MMA(0, 0, At, B0); PG8_BAR; PG8_SCHED;
            PG8_LDB(B1, 1, 1); PG8_STAGE(PG8_SB(1, 0), b3, voffB);
            PG8_BAR; PG8_WAIT_L(0); PG8_MMA(0, 1, At, B1); PG8_BAR;
            PG8_LDA(At, 1, 1); PG8_STAGE(PG8_SA(1, 0), a3, voffA);
            PG8_BAR; PG8_WAIT_L(0); PG8_MMA(1, 0, At, B0); PG8_BAR; PG8_SCHED;
            PG8_STAGE(PG8_SB(1, 1), b3 + hstep, voffB);
            PG8_WAIT_V(6); PG8_BAR; PG8_MMA(1, 1, At, B1); PG8_BAR;
            }
        }
        if constexpr (ALIGN_EPI) { if (wr == 0) PG8_BAR; }
        if constexpr (!Epi::AFTER_DRAIN) { E(acc, cur, wr, wc, fr, fq); S.done(cur); }
        if (!has_next) break;
#pragma unroll
        for (int a = 0; a < 2; ++a)
#pragma unroll
            for (int b = 0; b < 2; ++b)
#pragma unroll
                for (int m = 0; m < 4; ++m)
#pragma unroll
                    for (int n = 0; n < 2; ++n) acc[a][b][m][n] = (f32x4){0.f, 0.f, 0.f, 0.f};
        cur = nxt; cA = nA; cB = nB; ++ui;
        if constexpr (ALIGN_EPI) { if (wr == 1) PG8_BAR; }
    }
    PG8_WAIT_V(0);
    if constexpr (!ALIGN_EPI) { if (wr == 0) PG8_BAR; }
    PG8_BAR;
    if constexpr (Epi::AFTER_DRAIN) { E.fused(acc, cur, wr, wc, fr, fq, lds, wid, lane); S.done(cur); }
#undef PG8_SA
#undef PG8_SB
#undef PG8_STAGE
#undef PG8_LDA
#undef PG8_LDB
#undef PG8_MMA
#undef PG8_WAIT_V
#undef PG8_WAIT_L
#undef PG8_BAR
#undef PG8_SCHED
}
}

#ifndef PG8_SP2
#define PG8_SP2 true
#endif
#ifndef PG8_ALIGN
#define PG8_ALIGN true
#endif

namespace att {
using bf16 = unsigned short;
using bf16x8 = __attribute__((ext_vector_type(8))) short;
using s16x4  = __attribute__((ext_vector_type(4))) short;
using f32x16 = __attribute__((ext_vector_type(16))) float;
using u32x4  = __attribute__((ext_vector_type(4))) unsigned;
constexpr int NW = 8, QBLK = 32, KVBLK = 64, DV = 128;
constexpr float THR = 8.f;
constexpr int SHM_V = KVBLK * DV * 2;
constexpr int LDS_WS_OFF = 2 * SHM_V + 2 * (KVBLK * 128 * 2);
constexpr int LDS_BT_OFF = LDS_WS_OFF + NW * 64 * 4;
constexpr int LDS_Q_OFF = LDS_BT_OFF + 2048;
constexpr int LDS_END = LDS_Q_OFF + NW * 8192;
#define ATT_KSWZ128(row, colB) ((row) * 256 + ((colB) ^ (((row) & 7) << 4)))
#define ATT_KSWZ64(row, colB)  ((row) * 128 + ((colB) ^ ((((row) >> 1) & 7) << 4)))
#define ATT_SBAR() __builtin_amdgcn_sched_barrier(0)
__device__ __forceinline__ int crow(int r, int hi) { return (r & 3) + 8 * (r >> 2) + 4 * hi; }
__device__ __forceinline__ unsigned cvtpk(float lo, float hi) { unsigned r; asm volatile("v_cvt_pk_bf16_f32 %0, %1, %2" : "=v"(r) : "v"(lo), "v"(hi)); return r; }
__device__ __forceinline__ bf16x8 ld8(const bf16* p) { return *reinterpret_cast<const bf16x8*>(p); }

template <int DQK> __device__ __forceinline__ void partialSM(f32x16& p0, f32x16& p1, float& m_reg, float& mn, float& alpha) {
  constexpr float SCALE = (DQK == 64) ? 0.125f : 0.088388347648318440f;
  constexpr float C = SCALE * 1.4426950408889634f;
  float pmax = p0[0];
#pragma unroll
  for (int r = 1; r < 16; ++r) pmax = fmaxf(pmax, p0[r]);
#pragma unroll
  for (int r = 0; r < 16; ++r) pmax = fmaxf(pmax, p1[r]);
  { auto rr = __builtin_amdgcn_permlane32_swap(__float_as_uint(pmax), __float_as_uint(pmax), false, false);
    pmax = fmaxf(__uint_as_float(rr[0]), __uint_as_float(rr[1])); }
  if (__builtin_expect(__all(pmax - m_reg <= THR / SCALE), 1)) { mn = m_reg; alpha = 1.f; }
  else { mn = fmaxf(m_reg, pmax); alpha = __builtin_amdgcn_exp2f((m_reg - mn) * C); m_reg = mn; }
  float mnC = -mn * C;
#pragma unroll
  for (int r = 0; r < 16; ++r) p0[r] = fmaf(p0[r], C, mnC);
#pragma unroll
  for (int r = 0; r < 16; ++r) p1[r] = fmaf(p1[r], C, mnC);
#pragma unroll
  for (int r = 0; r < 16; ++r) p0[r] = __builtin_amdgcn_exp2f(p0[r]);
}
__device__ __forceinline__ void finishSM(f32x16& p0, f32x16& p1, float alpha, float& l_reg, bf16x8& pa0, bf16x8& pa1, bf16x8& pa2, bf16x8& pa3) {
#pragma unroll
  for (int r = 0; r < 16; ++r) p1[r] = __builtin_amdgcn_exp2f(p1[r]);
  float ps = 0;
#pragma unroll
  for (int r = 0; r < 16; ++r) ps += p0[r];
#pragma unroll
  for (int r = 0; r < 16; ++r) ps += p1[r];
  { auto rr = __builtin_amdgcn_permlane32_swap(__float_as_uint(ps), __float_as_uint(ps), false, false);
    ps = __uint_as_float(rr[0]) + __uint_as_float(rr[1]); }
  l_reg = l_reg * alpha + ps;
#define ATT_PK4(P, BASE, OUT) do { unsigned a0 = cvtpk(P[BASE + 0], P[BASE + 1]), a1 = cvtpk(P[BASE + 2], P[BASE + 3]);   \
    unsigned b0 = cvtpk(P[BASE + 4], P[BASE + 5]), b1 = cvtpk(P[BASE + 6], P[BASE + 7]);                              \
    auto r0 = __builtin_amdgcn_permlane32_swap(a0, b0, false, false); auto r1 = __builtin_amdgcn_permlane32_swap(a1, b1, false, false); \
    u32x4 w = {r0[0], r1[0], r0[1], r1[1]}; OUT = *reinterpret_cast<bf16x8*>(&w); } while (0)
  ATT_PK4(p0, 0, pa0); ATT_PK4(p0, 8, pa1); ATT_PK4(p1, 0, pa2); ATT_PK4(p1, 8, pa3);
#undef ATT_PK4
}
__device__ __forceinline__ void expSM(f32x16& p) {
#pragma unroll
  for (int r = 0; r < 16; ++r) p[r] = __builtin_amdgcn_exp2f(p[r]);
}
__device__ __forceinline__ void packSM(f32x16& p0, f32x16& p1, float& l_reg, bf16x8& pa0, bf16x8& pa1, bf16x8& pa2, bf16x8& pa3) {
  float ps = 0;
#pragma unroll
  for (int r = 0; r < 16; ++r) ps += p0[r];
#pragma unroll
  for (int r = 0; r < 16; ++r) ps += p1[r];
  l_reg += ps; asm volatile("" : "+v"(l_reg));
#define ATT_PK4(P, BASE, OUT) do { unsigned a0 = cvtpk(P[BASE + 0], P[BASE + 1]), a1 = cvtpk(P[BASE + 2], P[BASE + 3]);   \
    unsigned b0 = cvtpk(P[BASE + 4], P[BASE + 5]), b1 = cvtpk(P[BASE + 6], P[BASE + 7]);                              \
    auto r0 = __builtin_amdgcn_permlane32_swap(a0, b0, false, false); auto r1 = __builtin_amdgcn_permlane32_swap(a1, b1, false, false); \
    u32x4 w = {r0[0], r1[0], r0[1], r1[1]}; OUT = *reinterpret_cast<bf16x8*>(&w); } while (0)
  ATT_PK4(p0, 0, pa0); ATT_PK4(p0, 8, pa1); ATT_PK4(p1, 0, pa2); ATT_PK4(p1, 8, pa3);
#undef ATT_PK4
}
__device__ __forceinline__ void finishSM_nm(f32x16& p0, f32x16& p1, float& l_reg, bf16x8& pa0, bf16x8& pa1, bf16x8& pa2, bf16x8& pa3) {
#pragma unroll
  for (int r = 0; r < 16; ++r) p1[r] = __builtin_amdgcn_exp2f(p1[r]);
  float ps = 0;
#pragma unroll
  for (int r = 0; r < 16; ++r) ps += p0[r];
#pragma unroll
  for (int r = 0; r < 16; ++r) ps += p1[r];
  { auto rr = __builtin_amdgcn_permlane32_swap(__float_as_uint(ps), __float_as_uint(ps), false, false);
    ps = __uint_as_float(rr[0]) + __uint_as_float(rr[1]); }
  l_reg += ps;
#define ATT_PK4(P, BASE, OUT) do { unsigned a0 = cvtpk(P[BASE + 0], P[BASE + 1]), a1 = cvtpk(P[BASE + 2], P[BASE + 3]);   \
    unsigned b0 = cvtpk(P[BASE + 4], P[BASE + 5]), b1 = cvtpk(P[BASE + 6], P[BASE + 7]);                              \
    auto r0 = __builtin_amdgcn_permlane32_swap(a0, b0, false, false); auto r1 = __builtin_amdgcn_permlane32_swap(a1, b1, false, false); \
    u32x4 w = {r0[0], r1[0], r0[1], r1[1]}; OUT = *reinterpret_cast<bf16x8*>(&w); } while (0)
  ATT_PK4(p0, 0, pa0); ATT_PK4(p0, 8, pa1); ATT_PK4(p1, 0, pa2); ATT_PK4(p1, 8, pa3);
#undef ATT_PK4
}
__device__ __forceinline__ void finish_l(float l_reg, float* li_l, int r32, int hi, float (&rli)[16]) {
  { auto rr = __builtin_amdgcn_permlane32_swap(__float_as_uint(l_reg), __float_as_uint(l_reg), false, false); l_reg = __uint_as_float(rr[0]) + __uint_as_float(rr[1]); }
  if (hi == 0) li_l[r32] = l_reg; asm volatile("s_waitcnt lgkmcnt(0)" ::: "memory");
#pragma unroll
  for (int r = 0; r < 16; ++r) rli[r] = __builtin_amdgcn_rcpf(li_l[crow(r, hi)]);
}
template <int DQK, bool QLDS, int KW> __device__ __forceinline__ void qkt(f32x16& p0, f32x16& p1, const char* Ks, const bf16x8* qr, const char* Qs, int r32, int hi, int kcb) {
  p0 = f32x16{}; p1 = f32x16{};
#pragma unroll
  for (int d0 = 0; d0 < DQK / 16; ++d0) { const int cb = (d0 * 16 + hi * 8) * 2;
    bf16x8 b0, b1, qv;
    if constexpr (QLDS) qv = *reinterpret_cast<const bf16x8*>(Qs + ATT_KSWZ128(r32, cb)); else qv = qr[d0];
    if constexpr (KW == 128) { b0 = *reinterpret_cast<const bf16x8*>(Ks + ATT_KSWZ128(r32, kcb + cb)); b1 = *reinterpret_cast<const bf16x8*>(Ks + ATT_KSWZ128(32 + r32, kcb + cb)); }
    else                      { b0 = *reinterpret_cast<const bf16x8*>(Ks + ATT_KSWZ64(r32, cb));  b1 = *reinterpret_cast<const bf16x8*>(Ks + ATT_KSWZ64(32 + r32, cb)); }
    p0 = __builtin_amdgcn_mfma_f32_32x32x16_bf16(b0, qv, p0, 0, 0, 0);
    p1 = __builtin_amdgcn_mfma_f32_32x32x16_bf16(b1, qv, p1, 0, 0, 0); }
}
__device__ __forceinline__ int v_st(int k, int c) { const int kk = (k & ~0xC) | ((k & 4) << 1) | ((k & 8) >> 1); return ((kk >> 3) * 4 + (c >> 5)) * 512 + ((kk & 7) * 32 + (c & 31)) * 2; }
__device__ __forceinline__ int v_rd_base(int lane) { return ((lane & 3) << 3) | (((lane >> 2) & 3) << 6) | (((lane >> 4) & 1) << 5) | (((lane >> 5) & 1) << 8); }
constexpr int v_rd_off(int d0, int ks, int half) { return d0 * 512 + ks * 4096 + half * 2048; }
template <int OFF> __device__ __forceinline__ s16x4 tr_read(int vb) {
  s16x4 r; asm volatile("ds_read_b64_tr_b16 %0, %1 offset:%2" : "=&v"(r) : "v"(vb), "i"(OFF) : "memory"); return r;
}
template <int D0> __device__ __forceinline__ void pv_one(f32x16& od, int vb, bf16x8 pa0, bf16x8 pa1, bf16x8 pa2, bf16x8 pa3) {
  const s16x4 l0 = tr_read<v_rd_off(D0, 0, 0)>(vb), h0 = tr_read<v_rd_off(D0, 0, 1)>(vb), l1 = tr_read<v_rd_off(D0, 1, 0)>(vb), h1 = tr_read<v_rd_off(D0, 1, 1)>(vb);
  const s16x4 l2 = tr_read<v_rd_off(D0, 2, 0)>(vb), h2 = tr_read<v_rd_off(D0, 2, 1)>(vb), l3 = tr_read<v_rd_off(D0, 3, 0)>(vb), h3 = tr_read<v_rd_off(D0, 3, 1)>(vb);
  asm volatile("s_waitcnt lgkmcnt(0)" ::: "memory"); ATT_SBAR();
#define ATT_PK(L, H) (bf16x8){L[0], L[1], L[2], L[3], H[0], H[1], H[2], H[3]}
  od = __builtin_amdgcn_mfma_f32_32x32x16_bf16(pa0, ATT_PK(l0, h0), od, 0, 0, 0);
  od = __builtin_amdgcn_mfma_f32_32x32x16_bf16(pa1, ATT_PK(l1, h1), od, 0, 0, 0);
  od = __builtin_amdgcn_mfma_f32_32x32x16_bf16(pa2, ATT_PK(l2, h2), od, 0, 0, 0);
  od = __builtin_amdgcn_mfma_f32_32x32x16_bf16(pa3, ATT_PK(l3, h3), od, 0, 0, 0);
#undef ATT_PK
}
__device__ __forceinline__ void pv_d0(f32x16* o, int vb, bf16x8 pa0, bf16x8 pa1, bf16x8 pa2, bf16x8 pa3) {
  pv_one<0>(o[0], vb, pa0, pa1, pa2, pa3); pv_one<1>(o[1], vb, pa0, pa1, pa2, pa3); pv_one<2>(o[2], vb, pa0, pa1, pa2, pa3); pv_one<3>(o[3], vb, pa0, pa1, pa2, pa3);
}

#define ATT_TR8(D0, A) do { A##0 = tr_read<v_rd_off(D0, 0, 0)>(vb); A##1 = tr_read<v_rd_off(D0, 0, 1)>(vb); A##2 = tr_read<v_rd_off(D0, 1, 0)>(vb); A##3 = tr_read<v_rd_off(D0, 1, 1)>(vb); \
    A##4 = tr_read<v_rd_off(D0, 2, 0)>(vb); A##5 = tr_read<v_rd_off(D0, 2, 1)>(vb); A##6 = tr_read<v_rd_off(D0, 3, 0)>(vb); A##7 = tr_read<v_rd_off(D0, 3, 1)>(vb); } while (0)
#define ATT_PK2(L, H) (bf16x8){L[0], L[1], L[2], L[3], H[0], H[1], H[2], H[3]}
#define ATT_MM4(OD, A) do { OD = __builtin_amdgcn_mfma_f32_32x32x16_bf16(pa0, ATT_PK2(A##0, A##1), OD, 0, 0, 0); OD = __builtin_amdgcn_mfma_f32_32x32x16_bf16(pa1, ATT_PK2(A##2, A##3), OD, 0, 0, 0); \
    OD = __builtin_amdgcn_mfma_f32_32x32x16_bf16(pa2, ATT_PK2(A##4, A##5), OD, 0, 0, 0); OD = __builtin_amdgcn_mfma_f32_32x32x16_bf16(pa3, ATT_PK2(A##6, A##7), OD, 0, 0, 0); } while (0)
struct VFrag { s16x4 a0, a1, a2, a3, a4, a5, a6, a7, b0, b1, b2, b3, b4, b5, b6, b7; };
__device__ __forceinline__ void pv_issue(VFrag& f, int vb) { ATT_TR8(0, f.a); ATT_TR8(1, f.b); }
__device__ __forceinline__ void pv_pipe(VFrag& f, f32x16* o, int vb, bf16x8 pa0, bf16x8 pa1, bf16x8 pa2, bf16x8 pa3) {
  asm volatile("s_waitcnt lgkmcnt(0)" ::: "memory"); ATT_SBAR(); ATT_MM4(o[0], f.a);
  ATT_SBAR(); ATT_TR8(2, f.a); ATT_SBAR(); ATT_MM4(o[1], f.b);
  ATT_SBAR(); ATT_TR8(3, f.b);
  asm volatile("s_waitcnt lgkmcnt(8)" ::: "memory"); ATT_SBAR(); ATT_MM4(o[2], f.a);
  asm volatile("s_waitcnt lgkmcnt(0)" ::: "memory"); ATT_SBAR(); ATT_MM4(o[3], f.b);
}

struct NoMask { __device__ __forceinline__ void operator()(f32x16&, f32x16&, int) const {} __device__ __forceinline__ bool skip(int) const { return false; } };

template <int DQK, int LDQ, int LDQ2, int LDKV, int SDEPTH, bool DUAL, bool NOMAX, class TileRow, class Mask>
__device__ __forceinline__ void attn_core(const bf16* __restrict__ Qa, const bf16* __restrict__ Qalt, int nswitch,
                                          const bf16* __restrict__ Kb, const bf16* __restrict__ Vb,
                                          const TileRow& trow, const int NT, const Mask& mask, char* lds, f32x16 (&o)[4], float (&rli)[16]) {
  static_assert(!DUAL || DQK == 64, "DUAL is the differential-attention form");
  constexpr int KW = DUAL ? 128 : DQK;
  constexpr int SHM_K = KVBLK * KW * 2;
  constexpr int NQ = DQK / 16;
  int tid_ = threadIdx.x; asm volatile("" : "+v"(tid_));
  const int tid = tid_, wid = tid >> 6, lane = tid & 63, r32 = lane & 31, hi = lane >> 5;
  const int wq = DUAL ? (wid & 3) : wid, comp = DUAL ? (wid >> 2) : 0, kcb = comp * 128;
  char* V_lds = lds; char* K_lds = lds + 2 * SHM_V;
  float* wsf = (float*)(lds + LDS_WS_OFF) + wid * 64; float* li_l = wsf; float* al_l = wsf + 32;
  float m_reg = -1e30f, l_reg = 0;
#pragma unroll
  for (int d = 0; d < 4; ++d) o[d] = f32x16{};
  constexpr bool QLDS = (DQK == 128);
  char* Qs = lds + LDS_Q_OFF + wid * 8192;
  bf16x8 qr[NQ];
  { const bf16* Qw = Qa + (long)(wq * QBLK + r32) * LDQ + comp * 64 + hi * 8;
#pragma unroll
    for (int d0 = 0; d0 < NQ; ++d0) qr[d0] = ld8(Qw + d0 * 16);
    if constexpr (QLDS) {
#pragma unroll
      for (int d0 = 0; d0 < NQ; ++d0) *reinterpret_cast<bf16x8*>(Qs + ATT_KSWZ128(r32, (d0 * 16 + hi * 8) * 2)) = qr[d0];
      asm volatile("s_waitcnt lgkmcnt(0)" ::: "memory"); } }
  const int sr = tid >> 4, sc = (tid & 15) * 8, vst0 = v_st(sr, sc), vst1 = v_st(32 + sr, sc);
  const int k64r = tid >> 3, k64c = (tid & 7) * 8;
  const unsigned voffV = (unsigned)(sr * LDKV + sc) * 2u, voffK = (KW == 128) ? voffV : (unsigned)(k64r * LDKV + k64c) * 2u;
  const int vb0 = (int)(unsigned)(uintptr_t)V_lds + v_rd_base(lane);
  struct { bf16x8 vs0, vs1, ks0, ks1; } sr_[SDEPTH];
#define ATT_SLOAD(i, jt) do { const long row0_ = (long)__builtin_amdgcn_readfirstlane(trow(jt)); const char* vt_ = (const char*)(Vb + row0_ * LDKV); const char* kt_ = (const char*)(Kb + row0_ * LDKV); \
    sr_[i].vs0 = *(const bf16x8*)(vt_ + voffV); sr_[i].vs1 = *(const bf16x8*)(vt_ + 64 * LDKV + voffV); \
    if constexpr (KW == 128) { sr_[i].ks0 = *(const bf16x8*)(kt_ + voffK); sr_[i].ks1 = *(const bf16x8*)(kt_ + 64 * LDKV + voffK); } \
    else { sr_[i].ks0 = *(const bf16x8*)(kt_ + voffK); } } while (0)
#define ATT_SWRITE(b, i) do { *(bf16x8*)(V_lds + (b) * SHM_V + vst0) = sr_[i].vs0; *(bf16x8*)(V_lds + (b) * SHM_V + vst1) = sr_[i].vs1; \
    if constexpr (KW == 128) { const int kc_ = sc * 2; *(bf16x8*)(K_lds + (b) * SHM_K + ATT_KSWZ128(sr, kc_)) = sr_[i].ks0; *(bf16x8*)(K_lds + (b) * SHM_K + ATT_KSWZ128(32 + sr, kc_)) = sr_[i].ks1; } \
    else { *(bf16x8*)(K_lds + (b) * SHM_K + ATT_KSWZ64(k64r, k64c * 2)) = sr_[i].ks0; } } while (0)
#define ATT_SWAIT() do { if constexpr (SDEPTH == 1) asm volatile("s_waitcnt vmcnt(0)" ::: "memory"); else if constexpr (KW == 128) asm volatile("s_waitcnt vmcnt(4)" ::: "memory"); else asm volatile("s_waitcnt vmcnt(3)" ::: "memory"); } while (0)
#define ATT_RESC(a) do { if (__any((a) < 1.f)) { if (hi == 0) al_l[r32] = (a); asm volatile("s_waitcnt lgkmcnt(0)" ::: "memory"); \
    _Pragma("unroll") for (int d = 0; d < 4; ++d) _Pragma("unroll") for (int r = 0; r < 16; ++r) o[d][r] *= al_l[crow(r, hi)]; } } while (0)
  f32x16 pA0, pA1, pB0, pB1; float mnA, mnB, alA, alB; bf16x8 pa0, pa1, pa2, pa3;
  constexpr int SE = 0, SO = SDEPTH - 1;
  ATT_SLOAD(SE, 0); asm volatile("s_waitcnt vmcnt(0)" ::: "memory"); ATT_SWRITE(0, SE); __syncthreads();
  bool sA = mask.skip(0), sB = false;
  if (!sA) { qkt<DQK, QLDS, KW>(pA0, pA1, K_lds, qr, Qs, r32, hi, kcb); mask(pA0, pA1, 0); if constexpr (NOMAX) { expSM(pA0); alA = 1.f; } else partialSM<DQK>(pA0, pA1, m_reg, mnA, alA); } else alA = 1.f;
  ATT_SLOAD(SO, 1); if constexpr (SDEPTH == 2) { if (2 < NT) ATT_SLOAD(SE, 2); }
  ATT_SWAIT(); ATT_SWRITE(1, SO); __syncthreads();
  for (int j = 1; j + 1 < NT; j += 2) {
    sB = mask.skip(j);
    ATT_SBAR(); if (!sB) qkt<DQK, QLDS, KW>(pB0, pB1, K_lds + SHM_K, qr, Qs, r32, hi, kcb);
    if (!sA) if constexpr (NOMAX) finishSM_nm(pA0, pA1, l_reg, pa0, pa1, pa2, pa3); else finishSM(pA0, pA1, alA, l_reg, pa0, pa1, pa2, pa3); ATT_SBAR();
    ATT_SLOAD(SO, j + SDEPTH); ATT_SBAR();
    if (!sA) pv_d0(o, vb0, pa0, pa1, pa2, pa3);
    if (!sB) { mask(pB0, pB1, j); if constexpr (NOMAX) { expSM(pB0); alB = 1.f; } else partialSM<DQK>(pB0, pB1, m_reg, mnB, alB); } else alB = 1.f;
    __syncthreads(); ATT_SWAIT(); ATT_SWRITE(0, SE);
    ATT_RESC(alB); __syncthreads();
    if constexpr (DQK == 64) { if (j + 1 == nswitch) { const bf16* Qw = Qalt + (long)(wq * QBLK + r32) * LDQ2 + comp * 64 + hi * 8;
#pragma unroll
        for (int d0 = 0; d0 < NQ; ++d0) qr[d0] = ld8(Qw + d0 * 16); } }
    sA = mask.skip(j + 1);
    ATT_SBAR(); if (!sA) qkt<DQK, QLDS, KW>(pA0, pA1, K_lds, qr, Qs, r32, hi, kcb);
    if (!sB) if constexpr (NOMAX) finishSM_nm(pB0, pB1, l_reg, pa0, pa1, pa2, pa3); else finishSM(pB0, pB1, alB, l_reg, pa0, pa1, pa2, pa3); ATT_SBAR();
    if (SDEPTH == 1 || j + 3 < NT) ATT_SLOAD(SE, j + 1 + SDEPTH); ATT_SBAR();
    if (!sB) pv_d0(o, vb0 + SHM_V, pa0, pa1, pa2, pa3);
    if (!sA) { mask(pA0, pA1, j + 1); if constexpr (NOMAX) { expSM(pA0); alA = 1.f; } else partialSM<DQK>(pA0, pA1, m_reg, mnA, alA); } else alA = 1.f;
    __syncthreads(); ATT_SWAIT(); ATT_SWRITE(1, SO);
    ATT_RESC(alA); __syncthreads();
  }
  sB = mask.skip(NT - 1);
  ATT_SBAR(); if (!sB) qkt<DQK, QLDS, KW>(pB0, pB1, K_lds + SHM_K, qr, Qs, r32, hi, kcb);
  if (!sA) if constexpr (NOMAX) finishSM_nm(pA0, pA1, l_reg, pa0, pa1, pa2, pa3); else finishSM(pA0, pA1, alA, l_reg, pa0, pa1, pa2, pa3); ATT_SBAR();
  if (!sA) pv_d0(o, vb0, pa0, pa1, pa2, pa3);
  if (!sB) { mask(pB0, pB1, NT - 1); if constexpr (NOMAX) { expSM(pB0); alB = 1.f; } else partialSM<DQK>(pB0, pB1, m_reg, mnB, alB); } else alB = 1.f;
  __syncthreads(); ATT_RESC(alB);
  if (!sB) { if constexpr (NOMAX) finishSM_nm(pB0, pB1, l_reg, pa0, pa1, pa2, pa3); else finishSM(pB0, pB1, alB, l_reg, pa0, pa1, pa2, pa3); ATT_SBAR();
  pv_d0(o, vb0 + SHM_V, pa0, pa1, pa2, pa3); }
  if (hi == 0) li_l[r32] = l_reg; asm volatile("s_waitcnt lgkmcnt(0)" ::: "memory");
#pragma unroll
  for (int r = 0; r < 16; ++r) rli[r] = __builtin_amdgcn_rcpf(li_l[crow(r, hi)]);
#undef ATT_SLOAD
#undef ATT_SWRITE
#undef ATT_SWAIT
#undef ATT_RESC
}

#if STAMP && STAMP < 6
__device__ __forceinline__ unsigned stamp_lo() { unsigned long long t; __builtin_amdgcn_sched_barrier(0); asm volatile("s_memtime %0\n\ts_waitcnt lgkmcnt(0)" : "=s"(t) :: "memory"); __builtin_amdgcn_sched_barrier(0); return (unsigned)t; }
#endif
constexpr int DS_V = 0, DS_K = 3 * 16384, DS_WS = 6 * 16384, DS_Q = DS_WS + NW * 64 * 4, DS_END = DS_Q + NW * 4096;
template <int OFF> __device__ __forceinline__ bf16x8 lds_rd128(int addr) { bf16x8 r; asm volatile("ds_read_b128 %0, %1 offset:%2" : "=&v"(r) : "v"(addr), "i"(OFF) : "memory"); return r; }
template <int LDQ, int LDQ2, int LDKV, class TileRow>
__device__ __forceinline__ void attn_dual_stag(const bf16* __restrict__ Qa, const bf16* __restrict__ Qalt, int nswitch,
                                               const bf16* __restrict__ Kb, const bf16* __restrict__ Vb,
                                               const TileRow& trow, const int NT, char* lds, f32x16 (&o)[4], float (&rli)[16], unsigned& sacc) {
  int tid_ = threadIdx.x; asm volatile("" : "+v"(tid_));
  const int tid = tid_, wid = tid >> 6, lane = tid & 63, r32 = lane & 31, hi = lane >> 5;
  const int wq = wid & 3, g = __builtin_amdgcn_readfirstlane(wid >> 2), kcb = g * 128;
  char* V_lds = lds + DS_V; char* K_lds = lds + DS_K;
  float* wsf = (float*)(lds + DS_WS) + wid * 64; float* li_l = wsf;
  float l_reg = 0;
#pragma unroll
  for (int d = 0; d < 4; ++d) o[d] = f32x16{};
  bf16x8 qr[4];
  char* Qsw = lds + DS_Q + wid * 4096 + lane * 16;
  { const bf16* Qw = Qa + (long)(wq * QBLK + r32) * LDQ + g * 64 + hi * 8;
    const bf16* Qw2 = Qalt + (long)(wq * QBLK + r32) * LDQ2 + g * 64 + hi * 8;
#pragma unroll
    for (int d0 = 0; d0 < 4; ++d0) { qr[d0] = ld8(Qw + d0 * 16); *(bf16x8*)(Qsw + d0 * 1024) = ld8(Qw2 + d0 * 16); } }
  const int tg = tid & 255, sr = 32 * g + (tg >> 4), sc = (tg & 15) * 8;
  const int vst0 = v_st(sr, sc), vst1 = v_st(sr + 16, sc), kst0 = ATT_KSWZ128(sr, sc * 2), kst1 = ATT_KSWZ128(sr + 16, sc * 2);
  const unsigned voff = (unsigned)(sr * LDKV + sc) * 2u;
  const bf16* kbu = (const bf16*)(((unsigned long long)(unsigned)__builtin_amdgcn_readfirstlane((int)((unsigned long long)Kb >> 32)) << 32) | (unsigned)__builtin_amdgcn_readfirstlane((int)(unsigned long long)Kb));
  const int vdelta = __builtin_amdgcn_readfirstlane((int)((const char*)Vb - (const char*)Kb));
  const __amdgpu_buffer_rsrc_t kvrs = __builtin_amdgcn_make_buffer_rsrc((void*)kbu, 0, 0x7fffffff, 0x00020000);
  const int vb0 = (int)(unsigned)(uintptr_t)V_lds + v_rd_base(lane);
  const int kb0 = (int)(unsigned)(uintptr_t)K_lds;
  const int ka0 = kb0 + ATT_KSWZ128(r32, kcb + (0 * 16 + hi * 8) * 2), ka1 = kb0 + ATT_KSWZ128(r32, kcb + (1 * 16 + hi * 8) * 2);
  const int ka2 = kb0 + ATT_KSWZ128(r32, kcb + (2 * 16 + hi * 8) * 2), ka3 = kb0 + ATT_KSWZ128(r32, kcb + (3 * 16 + hi * 8) * 2);
  bf16x8 svA0, svA1, skA0, skA1, svB0, svB1, skB0, skB1;
#define DS_BL(dst, so) asm volatile("buffer_load_dwordx4 %0, %1, %2, %3 offen" : "=v"(dst) : "v"(voff), "s"(kvrs), "s"(so))
#define DS_SLOAD(S, jt) do { const int so_ = __builtin_amdgcn_readfirstlane(trow(jt)) * (LDKV * 2);   \
      \
    DS_BL(sk##S##0, so_); DS_BL(sk##S##1, so_ + 32 * LDKV); DS_BL(sv##S##0, so_ + vdelta); DS_BL(sv##S##1, so_ + vdelta + 32 * LDKV); } while (0)
#define DS_VMW(n) asm volatile("s_waitcnt vmcnt(" #n ")" ::: "memory")
#define DS_SWRITE(S, slot) do { const int so_ = (slot) * 16384; *(bf16x8*)(V_lds + so_ + vst0) = sv##S##0; *(bf16x8*)(V_lds + so_ + vst1) = sv##S##1; *(bf16x8*)(K_lds + so_ + kst0) = sk##S##0; *(bf16x8*)(K_lds + so_ + kst1) = sk##S##1; } while (0)
#define DS_BAR() do { ATT_SBAR(); asm volatile("s_waitcnt lgkmcnt(0)\n\ts_barrier" ::: "memory"); ATT_SBAR(); } while (0)
#if STAMP == 2 || STAMP == 3
#define DS_BARL() do { const unsigned t0_ = stamp_lo(); DS_BAR(); const unsigned t1_ = stamp_lo(); sacc += t1_ - t0_; } while (0)
#else
#define DS_BARL() DS_BAR()
#endif
#if STAMP == 4 || STAMP == 5
#define DS_STAMP(v) do { if (g == 0) v = stamp_lo(); } while (0)
#else
#define DS_STAMP(v) (void)0
#endif
#define DS_LGKM(n) asm volatile("s_waitcnt lgkmcnt(" #n ")" ::: "memory")
#define DS_KREADS(so) do { const int o_ = (so); kf0 = lds_rd128<0>(ka0 + o_); kf1 = lds_rd128<8192>(ka0 + o_); kf2 = lds_rd128<0>(ka1 + o_); kf3 = lds_rd128<8192>(ka1 + o_); \
    kf4 = lds_rd128<0>(ka2 + o_); kf5 = lds_rd128<8192>(ka2 + o_); kf6 = lds_rd128<0>(ka3 + o_); kf7 = lds_rd128<8192>(ka3 + o_); } while (0)
#define DS_QK() do { p0 = f32x16{}; p1 = f32x16{}; \
    p0 = __builtin_amdgcn_mfma_f32_32x32x16_bf16(kf0, qr[0], p0, 0, 0, 0); p1 = __builtin_amdgcn_mfma_f32_32x32x16_bf16(kf1, qr[0], p1, 0, 0, 0); \
    p0 = __builtin_amdgcn_mfma_f32_32x32x16_bf16(kf2, qr[1], p0, 0, 0, 0); p1 = __builtin_amdgcn_mfma_f32_32x32x16_bf16(kf3, qr[1], p1, 0, 0, 0); \
    p0 = __builtin_amdgcn_mfma_f32_32x32x16_bf16(kf4, qr[2], p0, 0, 0, 0); p1 = __builtin_amdgcn_mfma_f32_32x32x16_bf16(kf5, qr[2], p1, 0, 0, 0); \
    p0 = __builtin_amdgcn_mfma_f32_32x32x16_bf16(kf6, qr[3], p0, 0, 0, 0); p1 = __builtin_amdgcn_mfma_f32_32x32x16_bf16(kf7, qr[3], p1, 0, 0, 0); } while (0)
#define DS_QKA() do { p0 = f32x16{}; p1 = f32x16{}; \
    p0 = __builtin_amdgcn_mfma_f32_32x32x16_bf16(kf0, qr[0], p0, 0, 0, 0); p1 = __builtin_amdgcn_mfma_f32_32x32x16_bf16(kf1, qr[0], p1, 0, 0, 0); \
    p0 = __builtin_amdgcn_mfma_f32_32x32x16_bf16(kf2, qr[1], p0, 0, 0, 0); p1 = __builtin_amdgcn_mfma_f32_32x32x16_bf16(kf3, qr[1], p1, 0, 0, 0); } while (0)
#define DS_QKB() do { \
    p0 = __builtin_amdgcn_mfma_f32_32x32x16_bf16(kf4, qr[2], p0, 0, 0, 0); p1 = __builtin_amdgcn_mfma_f32_32x32x16_bf16(kf5, qr[2], p1, 0, 0, 0); \
    p0 = __builtin_amdgcn_mfma_f32_32x32x16_bf16(kf6, qr[3], p0, 0, 0, 0); p1 = __builtin_amdgcn_mfma_f32_32x32x16_bf16(kf7, qr[3], p1, 0, 0, 0); } while (0)
  DS_SLOAD(A, 0); DS_SLOAD(B, 1); DS_VMW(0); DS_SWRITE(A, 0); DS_SWRITE(B, 1);
  if (g == 1 && 2 < NT) DS_SLOAD(A, 2);
  DS_BAR();
  f32x16 p0, p1; bf16x8 pa0, pa1, pa2, pa3; bf16x8 kf0, kf1, kf2, kf3, kf4, kf5, kf6, kf7;
  if (2 + g < NT) DS_SLOAD(B, 2 + g);
  ATT_SBAR(); DS_KREADS(0); DS_LGKM(0); ATT_SBAR(); DS_QK();
  if (g == 1) DS_BAR();
  int s0 = 0, s1 = 1;
#define DS_TILE(S, k_) do { unsigned ts0_ = 0, ts1_ = 0, ts2_ = 0; DS_STAMP(ts0_); \
    expSM(p0); expSM(p1); packSM(p0, p1, l_reg, pa0, pa1, pa2, pa3); \
    { const int jt = (k_) + 1 + g; if (jt >= 2 && jt < NT) { if (jt + 1 < NT) DS_VMW(4); else DS_VMW(0); int sl = s1 + g; sl = sl >= 3 ? sl - 3 : sl; DS_SWRITE(S, sl); } } \
    const int vb = vb0 + s0 * 16384; VFrag f; \
    ATT_SBAR(); ATT_TR8(0, f.a); ATT_TR8(1, f.b); ATT_SBAR(); \
    DS_STAMP(ts1_); if (g == 0) DS_BARL(); DS_STAMP(ts2_); \
    { const int jt = (k_) + 3 + g; if (jt < NT) DS_SLOAD(S, jt); } \
    if ((k_) + 1 == nswitch) { \
      const int qa_ = (int)(unsigned)(uintptr_t)Qsw; qr[0] = lds_rd128<0>(qa_); qr[1] = lds_rd128<1024>(qa_); qr[2] = lds_rd128<2048>(qa_); qr[3] = lds_rd128<3072>(qa_);   \
      asm volatile("s_waitcnt lgkmcnt(0)" ::: "memory"); } \
    ATT_SBAR(); \
    __builtin_amdgcn_s_setprio(1); DS_KREADS(s1 * 16384); \
    DS_LGKM(8); ATT_SBAR(); ATT_MM4(o[0], f.a); ATT_SBAR(); ATT_TR8(2, f.a); ATT_SBAR(); ATT_MM4(o[1], f.b); \
    ATT_SBAR(); DS_LGKM(8); ATT_SBAR();                  \
    if ((k_) + 1 < NT) { DS_QKA(); DS_QKB(); } \
    ATT_SBAR(); ATT_TR8(3, f.b); \
    ATT_SBAR(); DS_LGKM(8); ATT_SBAR(); ATT_MM4(o[2], f.a); \
    ATT_SBAR(); DS_LGKM(0); ATT_SBAR(); ATT_MM4(o[3], f.b); __builtin_amdgcn_s_setprio(0); \
    { unsigned ts3_ = 0; DS_STAMP(ts3_); if (STAMP == 4 && g == 0) sacc += ts3_ - ts2_; if (STAMP == 5 && g == 0) sacc += ts1_ - ts0_; } \
    if (g == 1 && (k_) + 1 < NT) DS_BARL(); \
    s0 = s1; s1 = s1 == 2 ? 0 : s1 + 1; } while (0)
#if STAMP == 42
  const unsigned tl0_ = (unsigned)__builtin_amdgcn_s_memrealtime();
#endif
#pragma clang loop unroll(disable)
  for (int k = 0; k < NT; k += 2) { DS_TILE(A, k); DS_TILE(B, k + 1); }
#if STAMP == 42
  { const unsigned tl1_ = (unsigned)__builtin_amdgcn_s_memrealtime(); if (tid == 0) *(volatile unsigned*)(lds + 143360 + 64) += tl1_ - tl0_; }
#endif
#undef DS_TILE
  finish_l(l_reg, li_l, r32, hi, rli);
#undef DS_SLOAD
#undef DS_BL
#undef DS_VMW
#undef DS_SWRITE
#undef DS_BAR
#undef DS_LGKM
#undef DS_BARL
#undef DS_STAMP
#undef DS_KREADS
#undef DS_QK
#undef DS_QKA
#undef DS_QKB
}
}

constexpr int DM = 2048, NBATCH = 2, SEQ = 8192, DEPTH = 4, CTXL = 256;
constexpr int ML = NBATCH * SEQ;
constexpr int MC = NBATCH * CTXL;
constexpr int MT = ML + MC;
constexpr int EV_IN = 5120;
constexpr int EVN = 4608 + 1024;
constexpr int ODN = 6144;
constexpr int FH = 5632;
constexpr int NPH = 1 + 8 * DEPTH;
#ifndef PHM
#define PHM 1023
#endif
#ifndef MXM
#define MXM 15
#endif
#ifndef MK_N_LAUNCHES
#define MK_N_LAUNCHES 1
#endif
constexpr float LAM_INIT0 = 0.2f, LAM_INIT1 = 0.47071301834370415f;

constexpr size_t MiB = 1u << 20;
constexpr size_t WS_CTL = 0, CTL_ZERO_BYTES = 1 * MiB;
constexpr size_t WS_MODV = 1 * MiB;
constexpr size_t WS_ROPE = 2 * MiB;
constexpr size_t WS_LAM = 2 * MiB + 64 * 1024;
constexpr size_t WS_FA1 = 2 * MiB + 128 * 1024;
constexpr size_t WS_FA2 = 2 * MiB + 192 * 1024;
constexpr size_t WS_FA3 = 2 * MiB + 256 * 1024;
constexpr size_t WS_WIN_E = 4 * MiB,  SZ_WIN_E = 22 * MiB;
constexpr size_t WS_WOUT_E = WS_WIN_E + 2 * SZ_WIN_E, SZ_WOUT = 8 * MiB;
constexpr size_t WS_WIN_O = WS_WOUT_E + 2 * SZ_WOUT, SZ_WIN_O = 24 * MiB;
constexpr size_t WS_WOUT_O = WS_WIN_O + 2 * SZ_WIN_O;
constexpr size_t WS_WFI = WS_WOUT_O + 2 * SZ_WOUT, SZ_WFI = 44 * MiB;
constexpr size_t WS_WFO = WS_WFI + 4 * SZ_WFI, SZ_WFO = 22 * MiB;
constexpr size_t WS_A = WS_WFO + 4 * SZ_WFO;
constexpr size_t WS_P = WS_A + 66 * MiB;
constexpr size_t WS_QR = WS_P + 198 * MiB;
constexpr size_t WS_MIX = WS_QR + 48 * MiB;
constexpr size_t WS_HID = WS_MIX + 66 * MiB;
constexpr size_t WS_HC = WS_HID + 182 * MiB;
constexpr size_t WS_STASH = WS_HC + 4 * MiB;
constexpr size_t WS_HB = WS_STASH;
constexpr size_t WS_FT = WS_STASH + 64 * MiB;
constexpr size_t WS_SLAB = WS_STASH + 128 * MiB;
constexpr size_t WS_END = WS_SLAB + 48 * MiB;
static_assert(WS_A == 392 * MiB && WS_END == 1132 * MiB, "d_ws map");
constexpr int CW_FFT = 3072;
constexpr int CW_BAR = 4096;

constexpr int GEN_BYTES = 143360;
constexpr int MISC_OFF = GEN_BYTES;
constexpr int LDS_BYTES = 147456;

#define GAS __attribute__((address_space(1)))
#define LAS __attribute__((address_space(3)))
typedef unsigned short bf16;
typedef unsigned v4u __attribute__((ext_vector_type(4)));
typedef unsigned v2u __attribute__((ext_vector_type(2)));
typedef float f32x4 __attribute__((ext_vector_type(4)));
typedef short bf16x8 __attribute__((ext_vector_type(8)));
typedef GAS unsigned gu32;
#define RLX_AGENT __ATOMIC_RELAXED, __HIP_MEMORY_SCOPE_AGENT
#define LDS_WAIT() asm volatile("s_waitcnt lgkmcnt(0)" ::: "memory")
#define VM_WAIT() asm volatile("s_waitcnt vmcnt(0)" ::: "memory")
__device__ __forceinline__ unsigned f2bf(float f) { unsigned u = __builtin_bit_cast(unsigned, f); return (u + 0x7fffu + ((u >> 16) & 1u)) >> 16; }
__device__ __forceinline__ unsigned pk2(float lo, float hi) { return f2bf(lo) | (f2bf(hi) << 16); }
__device__ __forceinline__ float bflo(unsigned w) { return __uint_as_float(w << 16); }
__device__ __forceinline__ float bfhi(unsigned w) { return __uint_as_float(w & 0xffff0000u); }
__device__ __forceinline__ float hw_cos(float rev) { return __builtin_amdgcn_cosf(rev); }
__device__ __forceinline__ float hw_sin(float rev) { return __builtin_amdgcn_sinf(rev); }
#define XB_TMO      128
#define XB_XCNT(j)  (256  + 64 * (j))
#define XB_XSUB(j)  (1280 + 64 * (j))
#define XB_XGEN(j)  (2304 + 64 * (j))
#define XB_TOP      3328
#define XB_TOPGEN   3392
#define XCD_BAR_WORDS 3456
#define XB_SPIN_CAP (1u << 18)

__device__ __forceinline__ unsigned xb_ld(unsigned* p)              { return __hip_atomic_load(p, __ATOMIC_RELAXED, __HIP_MEMORY_SCOPE_AGENT); }
__device__ __forceinline__ unsigned xb_add(unsigned* p, unsigned v) { return __hip_atomic_fetch_add(p, v, __ATOMIC_RELAXED, __HIP_MEMORY_SCOPE_AGENT); }
__device__ __forceinline__ unsigned xb_xcc_id() { return (unsigned)__builtin_amdgcn_s_getreg((3 << 11) | 20) & 0xFu; }
#define XB_SPIN(cond, bar) do { unsigned _sp = 0; while (cond) { __builtin_amdgcn_s_sleep(1); \
    if ((++_sp & 255u) == 0u) { if (xb_ld(&(bar)[XB_TMO])) break; if (_sp > XB_SPIN_CAP) { atomicAdd(&(bar)[XB_TMO], 1u); break; } } } } while (0)

struct XcdBarrier {
    unsigned* bar; unsigned x;
    volatile LAS unsigned* st;
};

__device__ __forceinline__ XcdBarrier xcd_barrier_post(unsigned* bar, volatile LAS unsigned* st) {
    XcdBarrier b; b.bar = bar; b.x = xb_xcc_id(); b.st = st;
    if (threadIdx.x == 0) (void)xb_add(&bar[XB_XCNT(b.x)], 1u);
    return b;
}
__device__ __forceinline__ void xcd_barrier_complete(unsigned* bar, unsigned x, unsigned& nloc, unsigned& nx) {
    const unsigned G = gridDim.x * gridDim.y * gridDim.z;
    unsigned sum, cnt, mine, sp = 0u;
    for (;;) {
        sum = 0u; cnt = 0u; mine = 0u;
#pragma unroll
        for (unsigned j = 0; j < 16; ++j) { const unsigned c = xb_ld(&bar[XB_XCNT(j)]); sum += c; cnt += (c > 0u) ? 1u : 0u; mine = (j == x) ? c : mine; }
        if (sum == G) break;
        __builtin_amdgcn_s_sleep(1);
        if ((++sp & 255u) == 0u) { if (xb_ld(&bar[XB_TMO])) break; if (sp > XB_SPIN_CAP) { atomicAdd(&bar[XB_TMO], 1u); break; } }
    }
    nloc = mine > 0u ? mine : 1u; nx = cnt > 0u ? cnt : 1u;
}

__device__ __forceinline__ void xcd_barrier(const XcdBarrier& b) {
    asm volatile("s_waitcnt vmcnt(0)" ::: "memory");
    __syncthreads();
    if (threadIdx.x == 0) {
        unsigned* bar = b.bar;
        __builtin_amdgcn_s_waitcnt(0);
        unsigned nloc = b.st[0], nx = b.st[1];
        if (nloc == 0u) { xcd_barrier_complete(bar, b.x, nloc, nx); b.st[0] = nloc; b.st[1] = nx; }
        const unsigned old = xb_add(&bar[XB_XSUB(b.x)], 1u);
        const unsigned gen = old / nloc;
        if (old + 1u == (gen + 1u) * nloc) {
            __builtin_amdgcn_fence(__ATOMIC_RELEASE, "agent");
            asm volatile("s_waitcnt vmcnt(0)" ::: "memory");
            const unsigned og = xb_add(&bar[XB_TOP], 1u);
            const unsigned tg = og / nx;
            if (og + 1u == (tg + 1u) * nx) xb_add(&bar[XB_TOPGEN], 1u);
            else XB_SPIN(xb_ld(&bar[XB_TOPGEN]) == tg, bar);
            __builtin_amdgcn_fence(__ATOMIC_ACQUIRE, "agent");
            xb_add(&bar[XB_XGEN(b.x)], 1u);
            asm volatile("s_waitcnt vmcnt(0)" ::: "memory");
        } else {
            XB_SPIN(xb_ld(&bar[XB_XGEN(b.x)]) == gen, bar);
            __builtin_amdgcn_fence(__ATOMIC_ACQUIRE, "agent");
            asm volatile("s_waitcnt vmcnt(0)" ::: "memory");
        }
    }
    __syncthreads();
}

struct Args { const float* in[19]; float* out; unsigned char* ws; int ph_lo, ph_hi; };
typedef const __attribute__((address_space(4))) Args* ArgsP;
struct Frame {
    LAS unsigned char* lds; unsigned char* ldsg;
    volatile LAS unsigned* MISC;
    gu32* ctl;
    int tid, lane, wave, vcu, G;
    ArgsP ap; GAS float* out; GAS unsigned char* ws;
};
#define INP(F, k) ((const float*)(const GAS float*)(F).ap->in[k])
#define WSP(F) ((unsigned char*)(F).ws)
#define OUTP(F) ((float*)(F).out)
__device__ __forceinline__ Frame site(const Frame& F0) {
    Frame F = F0;
    int t = threadIdx.x; asm volatile("" : "+v"(t)); F.tid = t; F.lane = t & 63; F.wave = __builtin_amdgcn_readfirstlane(t >> 6);
    GAS unsigned char* w = F0.ws; asm volatile("" : "+s"(w)); F.ws = w;
    GAS float* o = F0.out; asm volatile("" : "+s"(o)); F.out = o;
    ArgsP a = F0.ap; asm volatile("" : "+s"(a)); F.ap = a;
    return F;
}
__device__ __forceinline__ float wave_sum(float v) {
#pragma unroll
    for (int o = 1; o < 64; o <<= 1) v += __shfl_xor(v, o);
    return v;
}

__device__ __forceinline__ void p0_modvec(Frame& F) {
    LAS float* sv = (LAS float*)F.lds;
    LAS float* red = (LAS float*)(F.lds + 24576);
    const float* c = INP(F, 1); const float* cctx = INP(F, 3); const float* wmod = INP(F, 4); const float* bmod = INP(F, 5);
    float* modv = (float*)(WSP(F) + WS_MODV);
    bool have = false;
    for (int it = blockIdx.x; it < 4 * 48; it += F.G) {
        if (!have) {
            for (int idx = F.tid; idx < 3 * DM; idx += 512) { const int g = idx >> 11, k = idx & 2047; const float v = g < 2 ? c[g * DM + k] : cctx[k]; sv[idx] = v / (1.0f + __expf(-v)); }
            __syncthreads(); have = true;
        }
        const int li = it / 48, ch = it % 48;
        const float* wp = wmod + ((size_t)li * DM + F.wave * 256) * 12288 + ch * 256 + F.lane * 4;
        f32x4 a0 = {0.f, 0.f, 0.f, 0.f}, a1 = a0, a2 = a0;
#pragma unroll 8
        for (int k = 0; k < 256; ++k) {
            const f32x4 w = *(const f32x4*)(wp + (size_t)k * 12288);
            const float s0 = sv[F.wave * 256 + k], s1 = sv[DM + F.wave * 256 + k], s2 = sv[2 * DM + F.wave * 256 + k];
            a0 += w * s0; a1 += w * s1; a2 += w * s2;
        }
        *(LAS f32x4*)(red + (F.wave * 3 + 0) * 256 + F.lane * 4) = a0;
        *(LAS f32x4*)(red + (F.wave * 3 + 1) * 256 + F.lane * 4) = a1;
        *(LAS f32x4*)(red + (F.wave * 3 + 2) * 256 + F.lane * 4) = a2;
        __syncthreads();
        for (int t = F.tid; t < 768; t += 512) { const int g = t >> 8, cc = t & 255; float s = bmod[li * 12288 + ch * 256 + cc];
#pragma unroll
            for (int w = 0; w < 8; ++w) s += red[(w * 3 + g) * 256 + cc];
            modv[(size_t)(li * 3 + g) * 12288 + ch * 256 + cc] = s; }
        __syncthreads();
    }
}
__device__ __forceinline__ void p0_tables(Frame& F) {
    const int gt = blockIdx.x * 512 + F.tid, NTH = F.G * 512;
    float* rope = (float*)(WSP(F) + WS_ROPE); float* lam = (float*)(WSP(F) + WS_LAM);
    bf16* fa1 = (bf16*)(WSP(F) + WS_FA1); bf16* fa2 = (bf16*)(WSP(F) + WS_FA2); bf16* fa3 = (bf16*)(WSP(F) + WS_FA3);
    for (int idx = gt; idx < 2048; idx += NTH) { const int pos = idx >> 4, f = idx & 15;
        const float inv = exp2f(-(float)f * (13.287712379549449f / 16.0f)); const float rev = (float)pos * inv * 0.15915494309189535f; const float fr = rev - floorf(rev);
        rope[idx * 2] = hw_cos(fr); rope[idx * 2 + 1] = hw_sin(fr); }
    for (int idx = gt; idx < 128 * 128; idx += NTH) { const int m = idx >> 7, k = idx & 127, rp = m >> 6, k1 = m & 63, ri = k >> 6, t1 = k & 63;
        const float ph = (float)((k1 * t1) & 63) * (1.0f / 64.0f); const float cs = hw_cos(ph), sn = hw_sin(ph);
        const float v = rp == 0 ? (ri == 0 ? cs : -sn) : (ri == 0 ? -sn : -cs); fa1[idx] = (bf16)f2bf(v); }
    for (int idx = gt; idx < 128 * 256; idx += NTH) { const int k2 = idx >> 8, k = idx & 255, ri = k >> 7, t2 = k & 127;
        const float ph = (float)((k2 * t2) & 127) * (1.0f / 128.0f); const float v = ri == 0 ? hw_cos(ph) : hw_sin(ph); fa2[idx] = (bf16)f2bf(v); }
    for (int idx = gt; idx < 256 * 512; idx += NTH) { const int kk = idx >> 9, k = idx & 511, ri = k >> 8, t = k & 255;
        const float ph = (float)((kk * t) & 255) * (1.0f / 256.0f); const float v = ri == 0 ? hw_cos(ph) : -hw_sin(ph); fa3[idx] = (bf16)f2bf(v); }
    if (gt < 2) { const float* lv = INP(F, 12) + gt * 256; float s01 = 0.f, s23 = 0.f;
        for (int d = 0; d < 64; ++d) { s01 += lv[d] * lv[64 + d]; s23 += lv[128 + d] * lv[192 + d]; }
        lam[gt] = __expf(s01) - __expf(s23) + (gt == 0 ? LAM_INIT0 : LAM_INIT1); }
}
__device__ __forceinline__ void p0_copy_ctx(Frame& F) {
    const f32x4* src = (const f32x4*)INP(F, 2); f32x4* dst = (f32x4*)(WSP(F) + WS_HC);
    for (int i = blockIdx.x * 512 + F.tid; i < MC * DM / 4; i += F.G * 512) dst[i] = src[i];
}
__device__ __forceinline__ void p0_fold(Frame& F) {
    LAS unsigned char* Wl = F.lds;
    LAS unsigned char* Tl = F.lds + 64 * 272;
    const int lane = F.lane, l15 = lane & 15, lq = lane >> 4;
    bool have_t = false;
    for (int it = blockIdx.x; it < 256; it += F.G) {
        const int j = it >> 7, g = (it >> 5) & 3, k0 = (it & 31) * 64;
        const float* W = INP(F, 9) + (size_t)j * DM * EV_IN;
        bf16* Bt = (bf16*)(WSP(F) + WS_WIN_E + (size_t)j * SZ_WIN_E);
        if (!have_t) { have_t = true;
            for (int idx = F.tid; idx < 256 * 128; idx += 512) { const int n = idx >> 7, cc = idx & 127, cp = n >> 1, ri = n & 1; const float ph = (float)((cc * cp) & 127) * (1.0f / 128.0f);
                *(LAS bf16*)(Tl + n * 272 + cc * 2) = (bf16)f2bf(ri ? hw_sin(ph) : hw_cos(ph)); } }
        for (int idx = F.tid; idx < 64 * 128; idx += 512) { const int r = idx >> 7, cc = idx & 127; *(LAS bf16*)(Wl + r * 272 + cc * 2) = (bf16)f2bf(W[(size_t)(k0 + r) * EV_IN + 4608 + g * 128 + cc]); }
        __syncthreads();
#pragma unroll 1
        for (int ni = 0; ni < 2; ++ni) { const int nt = F.wave * 2 + ni;
            bf16x8 bfr[4];
#pragma unroll
            for (int ks = 0; ks < 4; ++ks) bfr[ks] = *(const LAS bf16x8*)(Tl + (16 * nt + l15) * 272 + (32 * ks + 8 * lq) * 2);
#pragma unroll
            for (int mt = 0; mt < 4; ++mt) { f32x4 acc = {0.f, 0.f, 0.f, 0.f};
#pragma unroll
                for (int ks = 0; ks < 4; ++ks) { const bf16x8 af = *(const LAS bf16x8*)(Wl + (16 * mt + l15) * 272 + (32 * ks + 8 * lq) * 2); acc = __builtin_amdgcn_mfma_f32_16x16x32_bf16(af, bfr[ks], acc, 0, 0, 0); }
                v2u o; o.x = pk2(acc[0], acc[1]); o.y = pk2(acc[2], acc[3]);
                *(v2u*)(Bt + (size_t)(4608 + g * 256 + 16 * nt + l15) * DM + k0 + 16 * mt + 4 * lq) = o; } }
        __syncthreads();
    }
}
__device__ __forceinline__ void p0_transpose_item(const float* W, int K, int pitch, int ncols, bf16* WT, int mode, LAS float* scr, int item, int lane) {
    const int nblk = ncols / 32, kb = item / nblk, nb = item % nblk, k0 = 64 * kb, n0 = 32 * nb;
    float wv[32];
    const float* wp = W + (size_t)(k0 + (lane >> 5)) * pitch + n0 + (lane & 31);
#pragma unroll
    for (int i = 0; i < 32; ++i) wv[i] = __builtin_nontemporal_load(wp + (size_t)(2 * i) * pitch);
#pragma unroll
    for (int i = 0; i < 32; ++i) scr[(2 * i + (lane >> 5)) * 33 + (lane & 31)] = wv[i];
    LDS_WAIT(); asm volatile("" ::: "memory");
    int d0 = n0;
    if (mode == 1) { const int c = n0 < FH ? n0 : n0 - FH; d0 = (c >> 7) * 256 + (c & 127) + (n0 < FH ? 0 : 128); }
    const int c8 = lane & 7;
#pragma unroll
    for (int j = 0; j < 4; ++j) { const int n = (lane >> 3) + 8 * j; const LAS float* s = scr + (8 * c8) * 33 + n;
        v4u o; o.x = pk2(s[0 * 33], s[1 * 33]); o.y = pk2(s[2 * 33], s[3 * 33]); o.z = pk2(s[4 * 33], s[5 * 33]); o.w = pk2(s[6 * 33], s[7 * 33]);
        *(GAS v4u*)(WT + (size_t)(d0 + n) * K + k0 + 8 * c8) = o; }
    LDS_WAIT(); asm volatile("" ::: "memory");
}
constexpr int WQ_EVI = 32 * 144, WQ_ODI = 32 * 192, WQ_OUT = 32 * 64, WQ_FI = 32 * 352, WQ_FO = 88 * 64;
constexpr int WQ_LE = WQ_EVI + WQ_OUT + WQ_FI + WQ_FO, WQ_LO = WQ_ODI + WQ_OUT + WQ_FI + WQ_FO, WQ_N = 2 * (WQ_LE + WQ_LO);
static_assert(WQ_LE == 23552 && WQ_LO == 25088 && WQ_N == 97280, "weight queue sizes");
__device__ __forceinline__ void wq_item(Frame& F, int q, LAS float* scr) {
    int li = 0, r = q;
    if (r >= WQ_LE) { r -= WQ_LE; li = 1; if (r >= WQ_LO) { r -= WQ_LO; li = 2; if (r >= WQ_LE) { r -= WQ_LE; li = 3; } } }
    const int lj = li >> 1; const bool odd = li & 1; const int nin = odd ? WQ_ODI : WQ_EVI;
    if (r < nin) {
        if (odd) p0_transpose_item(INP(F, 14) + (size_t)lj * DM * ODN, DM, ODN, ODN, (bf16*)(WSP(F) + WS_WIN_O + (size_t)lj * SZ_WIN_O), 0, scr, r, F.lane);
        else     p0_transpose_item(INP(F, 9) + (size_t)lj * DM * EV_IN, DM, EV_IN, 4608, (bf16*)(WSP(F) + WS_WIN_E + (size_t)lj * SZ_WIN_E), 0, scr, r, F.lane);
        return; }
    r -= nin;
    if (r < WQ_OUT) { p0_transpose_item(INP(F, odd ? 15 : 10) + (size_t)lj * DM * DM, DM, DM, DM, (bf16*)(WSP(F) + (odd ? WS_WOUT_O : WS_WOUT_E) + (size_t)lj * SZ_WOUT), 0, scr, r, F.lane); return; }
    r -= WQ_OUT;
    if (r < WQ_FI) { p0_transpose_item(INP(F, 7) + (size_t)li * DM * 2 * FH, DM, 2 * FH, 2 * FH, (bf16*)(WSP(F) + WS_WFI + (size_t)li * SZ_WFI), 1, scr, r, F.lane); return; }
    r -= WQ_FI;
    p0_transpose_item(INP(F, 8) + (size_t)li * FH * DM, FH, DM, DM, (bf16*)(WSP(F) + WS_WFO + (size_t)li * SZ_WFO), 0, scr, r, F.lane);
}
constexpr int WQ_IPW = 10, WQ_P0 = 11200;
__device__ const int WQ_TAIL[8] = {11200, 17920, 31360, 48000, 61440, 68160, 81600, 97280};
static_assert(17920 - 11200 <= 84 * 8 * WQ_IPW && 31360 - 17920 <= 168 * 8 * WQ_IPW && 48000 - 31360 <= 208 * 8 * WQ_IPW && 61440 - 48000 <= 168 * 8 * WQ_IPW && 68160 - 61440 <= 84 * 8 * WQ_IPW && 81600 - 68160 <= 168 * 8 * WQ_IPW && 97280 - 81600 <= 208 * 8 * WQ_IPW, "tail capacities");
__device__ __forceinline__ void p0_weights(Frame& F) {
    LAS float* scr = (LAS float*)(F.lds + F.wave * 16384);
    const int gw = F.vcu * 8 + F.wave, NGW = F.G * 8;
    if (F.G != 256) { for (int q = gw; q < WQ_N; q += NGW) wq_item(F, q, scr); return; }
    for (int i = gw; i < WQ_P0; i += NGW) wq_item(F, i, scr);
}
__device__ __forceinline__ void wq_tail(Frame& F, int t, int units) {
    const int rem = units % F.G; const int c = (int)blockIdx.x;
    if (F.G != 256 || rem == 0 || c < rem) return;
    LAS float* scr = (LAS float*)(F.lds + F.wave * 16384);
    const int nw = (F.G - rem) * 8, wr = (c - rem) * 8 + F.wave; const int qb = WQ_TAIL[t], qe = WQ_TAIL[t + 1];
    for (int i = 0; i < WQ_IPW; ++i) { const int q = qb + wr + i * nw; if (q < qe) wq_item(F, q, scr); }
}

template <bool F32SRC>
__device__ __forceinline__ void norm_phase(Frame& F, int li, int which, const void* hlv, float* hcx, int red_ks, const float* red_gate) {
    const float* hl = (const float*)hlv; const bf16* hb = (const bf16*)hlv;
    const float* gain = INP(F, 6) + (size_t)(li * 2 + which) * DM;
    const float* modv = (const float*)(WSP(F) + WS_MODV) + (size_t)li * 3 * 12288;
    bf16* A = (bf16*)(WSP(F) + WS_A);
    LAS float* Gv = (LAS float*)F.lds; LAS float* Sv = Gv + 3 * DM;
    for (int i = F.tid; i < 3 * DM; i += 512) { const int grp = i >> 11, d = i & (DM - 1); const float* sh = modv + grp * 12288 + (which * 3) * DM;
        Gv[i] = gain[d] * (1.0f + sh[DM + d]); Sv[i] = sh[d]; }
    __syncthreads();
    const int gw = F.vcu * 8 + F.wave, NGW = F.G * 8; const int lane = F.lane;
    int r = gw;
    if constexpr (F32SRC) {
    for (; r + 3 * NGW < ML; r += 4 * NGW) {
        f32x4 v[4][8]; float q[4] = {0.f, 0.f, 0.f, 0.f};
#pragma unroll
        for (int i = 0; i < 4; ++i) { const float* sp = hl + (size_t)(r + i * NGW) * DM + 4 * lane;
#pragma unroll
            for (int j = 0; j < 8; ++j) v[i][j] = *(const f32x4*)(sp + 256 * j); }
#pragma unroll
        for (int i = 0; i < 4; ++i)
#pragma unroll
            for (int j = 0; j < 8; ++j) q[i] += (v[i][j].x * v[i][j].x + v[i][j].y * v[i][j].y) + (v[i][j].z * v[i][j].z + v[i][j].w * v[i][j].w);
#pragma unroll
        for (int i = 0; i < 4; ++i) { const int ri = r + i * NGW; const float rs = rsqrtf(wave_sum(q[i]) * (1.0f / DM) + 1e-6f); const int go = (ri < SEQ ? 0 : 1) * DM;
#pragma unroll
            for (int j = 0; j < 8; ++j) { const int d = 4 * lane + 256 * j;
                const f32x4 a = v[i][j] * rs * *(const LAS f32x4*)(Gv + go + d) + *(const LAS f32x4*)(Sv + go + d);
                v2u o; o.x = pk2(a.x, a.y); o.y = pk2(a.z, a.w);
                *(v2u*)(A + (size_t)ri * DM + d) = o; } }
    }
    } else {
    for (; r + 3 * NGW < ML; r += 4 * NGW) {
        v4u w[4][4]; float q[4];
#pragma unroll
        for (int i = 0; i < 4; ++i) { const bf16* sp = hb + (size_t)(r + i * NGW) * DM + 8 * lane;
#pragma unroll
            for (int j = 0; j < 4; ++j) w[i][j] = *(const v4u*)(sp + 512 * j); }
        asm volatile("" ::: "memory");
#pragma unroll
        for (int i = 0; i < 4; ++i) { float a = 0.f;
#pragma unroll
            for (int j = 0; j < 4; ++j) { const v4u t = w[i][j];
                a += (bflo(t.x) * bflo(t.x) + bfhi(t.x) * bfhi(t.x)) + (bflo(t.y) * bflo(t.y) + bfhi(t.y) * bfhi(t.y)) + (bflo(t.z) * bflo(t.z) + bfhi(t.z) * bfhi(t.z)) + (bflo(t.w) * bflo(t.w) + bfhi(t.w) * bfhi(t.w)); }
            q[i] = a; }
#pragma unroll
        for (int i = 0; i < 4; ++i) { const int ri = r + i * NGW; const float rs = rsqrtf(wave_sum(q[i]) * (1.0f / DM) + 1e-6f); const int go = (ri < SEQ ? 0 : 1) * DM;
#pragma unroll
            for (int j = 0; j < 4; ++j) { const int d = 8 * lane + 512 * j; const v4u t = w[i][j];
                const f32x4 x0 = f32x4{bflo(t.x), bfhi(t.x), bflo(t.y), bfhi(t.y)}, x1 = f32x4{bflo(t.z), bfhi(t.z), bflo(t.w), bfhi(t.w)};
                const f32x4 a0 = x0 * rs * *(const LAS f32x4*)(Gv + go + d) + *(const LAS f32x4*)(Sv + go + d);
                const f32x4 a1 = x1 * rs * *(const LAS f32x4*)(Gv + go + d + 4) + *(const LAS f32x4*)(Sv + go + d + 4);
                v4u o; o.x = pk2(a0.x, a0.y); o.y = pk2(a0.z, a0.w); o.z = pk2(a1.x, a1.y); o.w = pk2(a1.z, a1.w);
                *(v4u*)(A + (size_t)ri * DM + d) = o; } }
    }
    }
    if (F.G == 256 && r >= ML) {
        const int cr = F.vcu * 2 + (F.wave >> 2), qo = 4 * lane + 512 * (F.wave & 3);
        float* hrow = hcx + (size_t)cr * DM + qo;
        f32x4 v0 = *(const f32x4*)hrow, v1 = *(const f32x4*)(hrow + 256);
        if (red_ks > 0) {
            const float* sl = (const float*)(WSP(F) + WS_SLAB) + (size_t)cr * DM + qo;
            f32x4 t0[11], t1[11];
#pragma unroll
            for (int k = 0; k < 11; ++k) { const bool on = k < red_ks; const size_t ko = (size_t)(on ? k : 0) * (MC * DM); t0[k] = *(const f32x4*)(sl + ko); t1[k] = *(const f32x4*)(sl + ko + 256); }
            f32x4 s0 = t0[0], s1 = t1[0];
#pragma unroll
            for (int k = 1; k < 11; ++k) if (k < red_ks) { s0 += t0[k]; s1 += t1[k]; }
            v0 += *(const f32x4*)(red_gate + qo) * s0; v1 += *(const f32x4*)(red_gate + qo + 256) * s1;
            *(f32x4*)hrow = v0; *(f32x4*)(hrow + 256) = v1;
        }
        const float ssq = wave_sum((v0.x * v0.x + v0.y * v0.y) + (v0.z * v0.z + v0.w * v0.w) + (v1.x * v1.x + v1.y * v1.y) + (v1.z * v1.z + v1.w * v1.w));
        LAS float* red = (LAS float*)(F.lds + 49152);
        if (lane == 0) red[F.wave] = ssq;
        __syncthreads();
        const int w0 = F.wave & 4; const float rstd = rsqrtf(((red[w0] + red[w0 + 1]) + (red[w0 + 2] + red[w0 + 3])) * (1.0f / DM) + 1e-6f);
        const f32x4 a0 = v0 * rstd * *(const LAS f32x4*)(Gv + 2 * DM + qo) + *(const LAS f32x4*)(Sv + 2 * DM + qo);
        const f32x4 a1 = v1 * rstd * *(const LAS f32x4*)(Gv + 2 * DM + qo + 256) + *(const LAS f32x4*)(Sv + 2 * DM + qo + 256);
        v2u o0, o1; o0.x = pk2(a0.x, a0.y); o0.y = pk2(a0.z, a0.w); o1.x = pk2(a1.x, a1.y); o1.y = pk2(a1.z, a1.w);
        *(v2u*)(A + (size_t)(ML + cr) * DM + qo) = o0; *(v2u*)(A + (size_t)(ML + cr) * DM + qo + 256) = o1;
    } else
    for (; r < MT; r += NGW) {
        const int go = (r < SEQ ? 0 : (r < ML ? 1 : 2)) * DM;
        f32x4 v[8]; float ss = 0.f;
        if (!F32SRC && r < ML) {
#pragma unroll
            for (int j = 0; j < 8; ++j) { const v2u t = *(const v2u*)(hb + (size_t)r * DM + 4 * lane + 256 * j); v[j] = f32x4{bflo(t.x), bfhi(t.x), bflo(t.y), bfhi(t.y)}; }
        } else { const float* src = r < ML ? hl + (size_t)r * DM : hcx + (size_t)(r - ML) * DM;
#pragma unroll
            for (int j = 0; j < 8; ++j) v[j] = *(const f32x4*)(src + 4 * lane + 256 * j); }
        if (r >= ML && red_ks > 0) {
            const float* sl = (const float*)(WSP(F) + WS_SLAB) + (size_t)(r - ML) * DM + 4 * lane;
#pragma unroll
            for (int j = 0; j < 8; j += 2) { f32x4 t0[11], t1[11];
#pragma unroll
                for (int k = 0; k < 11; ++k) { const bool on = k < red_ks; const size_t ko = (size_t)(on ? k : 0) * (MC * DM);
                    t0[k] = *(const f32x4*)(sl + ko + 256 * j); t1[k] = *(const f32x4*)(sl + ko + 256 * (j + 1)); }
                f32x4 s0 = t0[0], s1 = t1[0];
#pragma unroll
                for (int k = 1; k < 11; ++k) if (k < red_ks) { s0 += t0[k]; s1 += t1[k]; }
                v[j] += *(const f32x4*)(red_gate + 4 * lane + 256 * j) * s0; v[j + 1] += *(const f32x4*)(red_gate + 4 * lane + 256 * (j + 1)) * s1;
                *(f32x4*)(hcx + (size_t)(r - ML) * DM + 4 * lane + 256 * j) = v[j]; *(f32x4*)(hcx + (size_t)(r - ML) * DM + 4 * lane + 256 * (j + 1)) = v[j + 1]; }
        }
#pragma unroll
        for (int j = 0; j < 8; ++j) ss += (v[j].x * v[j].x + v[j].y * v[j].y) + (v[j].z * v[j].z + v[j].w * v[j].w);
        const float rstd = rsqrtf(wave_sum(ss) * (1.0f / DM) + 1e-6f);
#pragma unroll
        for (int j = 0; j < 8; ++j) { const int d = 4 * lane + 256 * j;
            const f32x4 a = v[j] * rstd * *(const LAS f32x4*)(Gv + go + d) + *(const LAS f32x4*)(Sv + go + d);
            v2u o; o.x = pk2(a.x, a.y); o.y = pk2(a.z, a.w);
            *(v2u*)(A + (size_t)r * DM + d) = o; }
    }
    __syncthreads();
}

__device__ __forceinline__ void prep_even_row(bf16* P, bf16* QR, int r, bool lat, int lane, const v4u (&w6)[6], const f32x4 (&rw)[4], const float (&g0)[8], const float (&g1)[8]) {
    float cs[8], sn[8];
#pragma unroll
    for (int e = 0; e < 8; e += 2) { cs[e] = lat ? rw[e >> 1].x : 1.f; sn[e] = lat ? rw[e >> 1].y : 0.f; cs[e + 1] = lat ? rw[e >> 1].z : 1.f; sn[e + 1] = lat ? rw[e >> 1].w : 0.f; }
    bf16* prow = P + (size_t)r * EVN;
#pragma unroll
    for (int j = 0; j < 6; ++j) {
        const int ch = j * 64 + lane; const v4u w = w6[j];
        float x[8] = {bflo(w.x), bfhi(w.x), bflo(w.y), bfhi(w.y), bflo(w.z), bfhi(w.z), bflo(w.w), bfhi(w.w)};
        float ss = 0.f;
#pragma unroll
        for (int e = 0; e < 8; ++e) ss += x[e] * x[e];
        ss += __shfl_xor(ss, 1); ss += __shfl_xor(ss, 2); ss += __shfl_xor(ss, 4);
        const float rstd = rsqrtf(ss * (1.0f / 64.0f) + 1e-6f);
        float y[8], yr[8];
#pragma unroll
        for (int e = 0; e < 8; ++e) y[e] = x[e] * rstd * (j < 3 ? g0[e] * 0.18033688011112042f : g1[e]);
#pragma unroll
        for (int e = 0; e < 8; ++e) { const float yp = __shfl_xor(y[e], 2); yr[e] = (lane & 2) ? (y[e] * cs[e] + yp * sn[e]) : (y[e] * cs[e] - yp * sn[e]); }
        v4u on, orr;
        on.x = pk2(y[0], y[1]); on.y = pk2(y[2], y[3]); on.z = pk2(y[4], y[5]); on.w = pk2(y[6], y[7]);
        orr.x = pk2(yr[0], yr[1]); orr.y = pk2(yr[2], yr[3]); orr.z = pk2(yr[4], yr[5]); orr.w = pk2(yr[6], yr[7]);
        if (j < 3) { *(v4u*)(prow + ch * 8) = on; if (lat) *(v4u*)(QR + (size_t)r * 1536 + ch * 8) = orr; }
        else       { *(v4u*)(prow + ch * 8) = lat ? orr : on; }
    }
}
__device__ __forceinline__ void prep_even(Frame& F, int lj) {
    bf16* P = (bf16*)(WSP(F) + WS_P); bf16* QR = (bf16*)(WSP(F) + WS_QR);
    const float* gq = INP(F, 11) + (size_t)lj * 128; const float* rope = (const float*)(WSP(F) + WS_ROPE);
    const int gw = F.vcu * 8 + F.wave, NGW = F.G * 8; const int lane = F.lane;
    const int d0 = (lane & 7) * 8;
    float g0[8], g1[8];
#pragma unroll
    for (int e = 0; e < 8; ++e) { g0[e] = gq[d0 + e]; g1[e] = gq[64 + d0 + e]; }
    for (int r = gw; r < MT; r += 2 * NGW) {
        const int r1 = r + NGW; const bool has1 = r1 < MT; const int r1c = has1 ? r1 : r;
        v4u wa[6], wb[6]; f32x4 ra[4], rb[4];
        const int ta = r & (SEQ - 1), tb = r1c & (SEQ - 1);
        const int pa = ((lane >> 2) & 1) ? (ta & 63) : (ta >> 6), pb = ((lane >> 2) & 1) ? (tb & 63) : (tb >> 6);
#pragma unroll
        for (int j = 0; j < 6; ++j) { wa[j] = *(const v4u*)(P + (size_t)r * EVN + (j * 64 + lane) * 8); wb[j] = *(const v4u*)(P + (size_t)r1c * EVN + (j * 64 + lane) * 8); }
#pragma unroll
        for (int e = 0; e < 4; ++e) { ra[e] = *(const f32x4*)(rope + (size_t)((pa & 127) * 16 + (lane & 1) * 8) * 2 + e * 4); rb[e] = *(const f32x4*)(rope + (size_t)((pb & 127) * 16 + (lane & 1) * 8) * 2 + e * 4); }
        asm volatile("" ::: "memory");
        prep_even_row(P, QR, r, r < ML, lane, wa, ra, g0, g1);
        if (has1) prep_even_row(P, QR, r1, r1 < ML, lane, wb, rb, g0, g1);
    }
}

struct OddRow { v4u gb[2], gc[2][3], hh[2][3]; };
__device__ __forceinline__ void prep_odd_load(OddRow& R, const bf16* P, int r, int lane) {
    const bool lat = r < ML; const int t = lat ? (r & (SEQ - 1)) : ((r - ML) & (CTXL - 1)); const int n = lat ? SEQ : CTXL;
    const bf16* prow = P + (size_t)r * ODN;
#pragma unroll
    for (int j = 0; j < 2; ++j) { const int c0 = (j * 64 + lane) * 8; R.gb[j] = *(const v4u*)(prow + c0);
#pragma unroll
        for (int jj = 0; jj < 3; ++jj) { const int tt = t + jj - 1; const bool ok = tt >= 0 && tt < n; const bf16* pr = prow + (ok ? (ptrdiff_t)(jj - 1) * ODN : 0);
            R.gc[j][jj] = *(const v4u*)(pr + 1024 + c0); R.hh[j][jj] = *(const v4u*)(pr + 2048 + c0); } }
}
__device__ __forceinline__ void prep_odd_row(const OddRow& R, bf16* P, bf16* MIX, const float* cw, int r, int lane, const float (&g0)[8], const float (&g1)[8]) {
    const bool lat = r < ML; const int t = lat ? (r & (SEQ - 1)) : ((r - ML) & (CTXL - 1)); const int n = lat ? SEQ : CTXL;
    bf16* prow = P + (size_t)r * ODN;
#pragma unroll
    for (int j = 0; j < 2; ++j) {
        const int c0 = (j * 64 + lane) * 8;
        float accv[8];
#pragma unroll
        for (int e = 0; e < 8; ++e) accv[e] = 0.f;
#pragma unroll
        for (int jj = 0; jj < 3; ++jj) {
            const int tt = t + jj - 1; const float m = (tt >= 0 && tt < n) ? 1.f : 0.f;
            const v4u a = R.gc[j][jj], b = R.hh[j][jj];
            const f32x4 w0 = *(const f32x4*)(cw + jj * 1024 + c0) * m, w1 = *(const f32x4*)(cw + jj * 1024 + c0 + 4) * m;
            accv[0] += bflo(a.x) * bflo(b.x) * w0.x; accv[1] += bfhi(a.x) * bfhi(b.x) * w0.y; accv[2] += bflo(a.y) * bflo(b.y) * w0.z; accv[3] += bfhi(a.y) * bfhi(b.y) * w0.w;
            accv[4] += bflo(a.z) * bflo(b.z) * w1.x; accv[5] += bfhi(a.z) * bfhi(b.z) * w1.y; accv[6] += bflo(a.w) * bflo(b.w) * w1.z; accv[7] += bfhi(a.w) * bfhi(b.w) * w1.w;
        }
        const v4u gb = R.gb[j];
        v4u o; o.x = pk2(bflo(gb.x) * accv[0], bfhi(gb.x) * accv[1]); o.y = pk2(bflo(gb.y) * accv[2], bfhi(gb.y) * accv[3]);
        o.z = pk2(bflo(gb.z) * accv[4], bfhi(gb.z) * accv[5]); o.w = pk2(bflo(gb.w) * accv[6], bfhi(gb.w) * accv[7]);
        *(v4u*)(MIX + (size_t)r * DM + c0) = o;
    }
}
__device__ __forceinline__ void prep_odd(Frame& F, int lj) {
    const bf16* P = (const bf16*)(WSP(F) + WS_P); bf16* MIX = (bf16*)(WSP(F) + WS_MIX);
    const float* cw = INP(F, 17) + (size_t)lj * 3 * 1024;
    const int gw = F.vcu * 8 + F.wave, NGW = F.G * 8; const int lane = F.lane;
    f32x4 wt[2][3][2];
#pragma unroll
    for (int j = 0; j < 2; ++j)
#pragma unroll
        for (int jj = 0; jj < 3; ++jj) { const int c0 = (j * 64 + lane) * 8; wt[j][jj][0] = *(const f32x4*)(cw + jj * 1024 + c0); wt[j][jj][1] = *(const f32x4*)(cw + jj * 1024 + c0 + 4); }
    for (int g = gw; g < MT / 4; g += NGW) {
        const int r0 = 4 * g; const bool lat = r0 < ML; const int t0 = lat ? (r0 & (SEQ - 1)) : ((r0 - ML) & (CTXL - 1)); const int n = lat ? SEQ : CTXL;
        const bf16* pb = P + (size_t)r0 * ODN;
        v4u gb[4][2], gc[6][2], hh[6][2];
#pragma unroll
        for (int i = 0; i < 6; ++i) { const int tt = t0 + i - 1; const bool ok = tt >= 0 && tt < n; const bf16* pr = pb + (ok ? (ptrdiff_t)(i - 1) * ODN : 0);
#pragma unroll
            for (int j = 0; j < 2; ++j) { const int c0 = (j * 64 + lane) * 8; gc[i][j] = *(const v4u*)(pr + 1024 + c0); hh[i][j] = *(const v4u*)(pr + 2048 + c0); } }
#pragma unroll
        for (int i = 0; i < 4; ++i)
#pragma unroll
            for (int j = 0; j < 2; ++j) gb[i][j] = *(const v4u*)(pb + (size_t)i * ODN + (j * 64 + lane) * 8);
        asm volatile("" ::: "memory");
#pragma unroll
        for (int i = 0; i < 4; ++i)
#pragma unroll
            for (int j = 0; j < 2; ++j) { const int c0 = (j * 64 + lane) * 8;
                float accv[8];
#pragma unroll
                for (int e = 0; e < 8; ++e) accv[e] = 0.f;
#pragma unroll
                for (int jj = 0; jj < 3; ++jj) { const int tt = t0 + i + jj - 1; const float m = (tt >= 0 && tt < n) ? 1.f : 0.f;
                    const v4u a = gc[i + jj][j], b = hh[i + jj][j]; const f32x4 w0 = wt[j][jj][0] * m, w1 = wt[j][jj][1] * m;
                    accv[0] += bflo(a.x) * bflo(b.x) * w0.x; accv[1] += bfhi(a.x) * bfhi(b.x) * w0.y; accv[2] += bflo(a.y) * bflo(b.y) * w0.z; accv[3] += bfhi(a.y) * bfhi(b.y) * w0.w;
                    accv[4] += bflo(a.z) * bflo(b.z) * w1.x; accv[5] += bfhi(a.z) * bfhi(b.z) * w1.y; accv[6] += bflo(a.w) * bflo(b.w) * w1.z; accv[7] += bfhi(a.w) * bfhi(b.w) * w1.w; }
                const v4u q = gb[i][j];
                v4u o; o.x = pk2(bflo(q.x) * accv[0], bfhi(q.x) * accv[1]); o.y = pk2(bflo(q.y) * accv[2], bfhi(q.y) * accv[3]);
                o.z = pk2(bflo(q.z) * accv[4], bfhi(q.z) * accv[5]); o.w = pk2(bflo(q.w) * accv[6], bfhi(q.w) * accv[7]);
                *(v4u*)(MIX + (size_t)(r0 + i) * DM + c0) = o; }
    }
}

struct EvenTileRow { int ctx0, lat0; __device__ __forceinline__ int operator()(int j) const { return j < 4 ? ctx0 + 64 * j : lat0 + 64 * (j - 4); } };
__device__ __forceinline__ void even_attn_unit(Frame& F, int lj, int b, int h, int qrow0, bool is_ctx, unsigned& sacc) {
    const bf16* P = (const bf16*)(WSP(F) + WS_P); const bf16* QR = (const bf16*)(WSP(F) + WS_QR); bf16* MIX = (bf16*)(WSP(F) + WS_MIX);
    const int lane = F.lane, r32 = lane & 31, hi = lane >> 5, wq = F.wave & 3, comp = F.wave >> 2;
    EvenTileRow trow{ML + b * CTXL, b * SEQ};
    att::f32x16 o[4]; float rli[16];
    att::attn_dual_stag<EVN, 1536, EVN>(P + (size_t)qrow0 * EVN + h * 128, QR + (size_t)(is_ctx ? 0 : qrow0) * 1536 + h * 128, is_ctx ? 1000 : 4,
                                        P + 1536 + h * 128, P + 3072 + h * 128, trow, is_ctx ? 4 : 132, (char*)F.ldsg, o, rli, sacc);
    __syncthreads();
    LAS float* xch = (LAS float*)F.lds + (size_t)wq * 4096 + lane;
    if (comp == 1) {
#pragma unroll
        for (int d = 0; d < 4; ++d)
#pragma unroll
            for (int r = 0; r < 16; ++r) xch[(d * 16 + r) * 64] = o[d][r] * rli[r];
    }
    __syncthreads();
    if (comp == 0) {
        const float lam = ((const float*)(WSP(F) + WS_LAM))[lj];
        const float cfac = 1.0f - (lj == 0 ? LAM_INIT0 : LAM_INIT1);
        const float* gsub = INP(F, 13) + (size_t)lj * 128;
        float ssq[16];
#pragma unroll
        for (int r = 0; r < 16; ++r) ssq[r] = 0.f;
#pragma unroll
        for (int d = 0; d < 4; ++d)
#pragma unroll
            for (int r = 0; r < 16; ++r) { const float v = o[d][r] * rli[r] - lam * xch[(d * 16 + r) * 64]; o[d][r] = v; ssq[r] += v * v; }
#pragma unroll
        for (int r = 0; r < 16; ++r) { float s = ssq[r]; s += __shfl_xor(s, 1); s += __shfl_xor(s, 2); s += __shfl_xor(s, 4); s += __shfl_xor(s, 8); s += __shfl_xor(s, 16);
            ssq[r] = rsqrtf(s * (1.0f / 128.0f) + 1e-6f) * cfac; }
        int r32s = r32; asm volatile("" : "+v"(r32s));
#pragma unroll
        for (int d = 0; d < 4; ++d) { const float g = gsub[32 * d + r32s];
#pragma unroll
            for (int r = 0; r < 16; ++r) MIX[(size_t)(qrow0 + wq * 32 + att::crow(r, hi)) * DM + h * 128 + 32 * d + r32s] = (bf16)f2bf(o[d][r] * ssq[r] * g); }
    }
}

__device__ __forceinline__ void fft_unit(Frame& F, int b, int cp) {
    LAS unsigned char* Vl = F.lds;
    LAS unsigned char* Yl = F.lds + 69632;
    const bf16* P = (const bf16*)(WSP(F) + WS_P); bf16* MIX = (bf16*)(WSP(F) + WS_MIX);
    const bf16* FA1 = (const bf16*)(WSP(F) + WS_FA1); const bf16* FA2 = (const bf16*)(WSP(F) + WS_FA2);
    const int lane = F.lane, l15 = lane & 15, lq = lane >> 4;
    v2u wl[16];
    const bf16* FT = (const bf16*)(WSP(F) + WS_FT) + (size_t)(b * 256 + cp) * 8192 * 4;
#pragma unroll
    for (int jj = 0; jj < 16; ++jj) wl[jj] = *(const v2u*)(FT + (size_t)(F.tid + 512 * jj) * 4);
#pragma unroll
    for (int jj = 0; jj < 16; ++jj) { const int t = F.tid + 512 * jj; const v2u w = wl[jj];
        const int t1 = t >> 7, t2 = t & 127;
        *(LAS bf16*)(Vl + (2 * t2 + 0) * 272 + (t1) * 2) = (bf16)(w.x & 0xffffu);       *(LAS bf16*)(Vl + (2 * t2 + 0) * 272 + (64 + t1) * 2) = (bf16)(w.x >> 16);
        *(LAS bf16*)(Vl + (2 * t2 + 1) * 272 + (t1) * 2) = (bf16)(w.y & 0xffffu);       *(LAS bf16*)(Vl + (2 * t2 + 1) * 272 + (64 + t1) * 2) = (bf16)(w.y >> 16); }
    __syncthreads();
    {
        const int mt = F.wave & 3, nt0 = (F.wave >> 2) * 8;
        bf16x8 aR[4], aI[4];
#pragma unroll
        for (int ks = 0; ks < 4; ++ks) { aR[ks] = *(const bf16x8*)(FA1 + (size_t)(16 * mt + l15) * 128 + 32 * ks + 8 * lq); aI[ks] = *(const bf16x8*)(FA1 + (size_t)(64 + 16 * mt + l15) * 128 + 32 * ks + 8 * lq); }
        for (int nt = nt0; nt < nt0 + 8; ++nt) {
            f32x4 accR = {0.f, 0.f, 0.f, 0.f}, accI = accR;
#pragma unroll
            for (int ks = 0; ks < 4; ++ks) { const bf16x8 bf = *(const LAS bf16x8*)(Vl + (16 * nt + l15) * 272 + (32 * ks + 8 * lq) * 2);
                accR = __builtin_amdgcn_mfma_f32_16x16x32_bf16(aR[ks], bf, accR, 0, 0, 0); accI = __builtin_amdgcn_mfma_f32_16x16x32_bf16(aI[ks], bf, accI, 0, 0, 0); }
            const int n1 = 16 * nt + l15, t2 = n1 >> 1, cc = n1 & 1;
#pragma unroll
            for (int r = 0; r < 4; ++r) { const int k1 = 16 * mt + lq * 4 + r; const float ph = (float)((t2 * k1) & 8191) * (1.0f / 8192.0f); const float cs = hw_cos(ph), sn = hw_sin(ph);
                const float yr = accR[r] * cs + accI[r] * sn, yi = accI[r] * cs - accR[r] * sn; const int n2 = k1 * 2 + cc;
                *(LAS bf16*)(Yl + n2 * 528 + t2 * 2) = (bf16)f2bf(yr); *(LAS bf16*)(Yl + n2 * 528 + (128 + t2) * 2) = (bf16)f2bf(yi); }
        }
    }
    __syncthreads();
    {
        const int mt = F.wave;
        bf16x8 a2[8];
#pragma unroll
        for (int ks = 0; ks < 8; ++ks) a2[ks] = *(const bf16x8*)(FA2 + (size_t)(16 * mt + l15) * 256 + 32 * ks + 8 * lq);
        for (int nt = 0; nt < 8; ++nt) {
            f32x4 acc = {0.f, 0.f, 0.f, 0.f};
#pragma unroll
            for (int ks = 0; ks < 8; ++ks) { const bf16x8 bf = *(const LAS bf16x8*)(Yl + (16 * nt + l15) * 528 + (32 * ks + 8 * lq) * 2); acc = __builtin_amdgcn_mfma_f32_16x16x32_bf16(a2[ks], bf, acc, 0, 0, 0); }
            const int n2 = 16 * nt + l15, k1 = n2 >> 1, cc = n2 & 1;
#pragma unroll
            for (int r = 0; r < 4; ++r) { const int k2 = 16 * mt + lq * 4 + r; const int tok = k1 + 64 * k2; const unsigned me = f2bf(acc[r] * (1.0f / 1024.0f)); const unsigned other = (unsigned)__shfl_xor((int)me, 1);
                if (cc == 0) *(unsigned*)(MIX + (size_t)(b * SEQ + tok) * DM + 1536 + 2 * cp) = me | (other << 16); }
        }
    }
    __syncthreads();
}
__device__ __forceinline__ void ctx_dft_unit(Frame& F, int b, int cb) {
    LAS unsigned char* Vc = F.lds;
    const bf16* P = (const bf16*)(WSP(F) + WS_P); bf16* MIX = (bf16*)(WSP(F) + WS_MIX); const bf16* FA3 = (const bf16*)(WSP(F) + WS_FA3);
    const int lane = F.lane, l15 = lane & 15, lq = lane >> 4;
    { const int t = F.tid >> 1, half = F.tid & 1; const bf16* src = P + (size_t)(ML + b * CTXL + t) * EVN + 4608 + 32 * cb + 16 * half;
      const v4u w0 = *(const v4u*)src, w1 = *(const v4u*)(src + 8);
      const unsigned ww[8] = {w0.x, w0.y, w0.z, w0.w, w1.x, w1.y, w1.z, w1.w};
#pragma unroll
      for (int i = 0; i < 8; ++i) { const int cl = half * 8 + i; *(LAS bf16*)(Vc + cl * 1040 + t * 2) = (bf16)(ww[i] & 0xffffu); *(LAS bf16*)(Vc + cl * 1040 + (256 + t) * 2) = (bf16)(ww[i] >> 16); } }
    __syncthreads();
#pragma unroll 1
    for (int mi = 0; mi < 2; ++mi) { const int mt = F.wave * 2 + mi; f32x4 acc = {0.f, 0.f, 0.f, 0.f};
#pragma unroll 4
        for (int ks = 0; ks < 16; ++ks) { const bf16x8 a = *(const bf16x8*)(FA3 + (size_t)(16 * mt + l15) * 512 + 32 * ks + 8 * lq); const bf16x8 bf = *(const LAS bf16x8*)(Vc + l15 * 1040 + (32 * ks + 8 * lq) * 2);
            acc = __builtin_amdgcn_mfma_f32_16x16x32_bf16(a, bf, acc, 0, 0, 0); }
#pragma unroll
        for (int r = 0; r < 4; ++r) { const int k = 16 * mt + lq * 4 + r; MIX[(size_t)(ML + b * CTXL + k) * DM + 1536 + 16 * cb + l15] = (bf16)f2bf(acc[r] * 0.005524271728019903f); } }
    __syncthreads();
}
__device__ __forceinline__ void mixer_even(Frame& F, int lj) {
    unsigned sacc = 0;
#if STAMP == 1
    const unsigned long long sm0_ = __builtin_amdgcn_s_memtime(), sr0_ = __builtin_amdgcn_s_memrealtime(); __builtin_amdgcn_s_waitcnt(0xC07F);
#endif
#if STAMP == 40 || STAMP == 41
    const unsigned tA_ = (unsigned)__builtin_amdgcn_s_memrealtime();
#endif
    if (MXM & 1) {
        for (int uu = F.vcu; uu < ((DUP & 1) ? 2 : 1) * (1536 + 48); uu += F.G) { const int u = (DUP & 1) ? uu % (1536 + 48) : uu; const bool is_ctx = u >= 1536;
            const int pair = is_ctx ? (u - 1536) >> 1 : (u >> 6), qb = is_ctx ? (u & 1) : (u & 63); const int b = pair / 12, h = pair % 12;
            even_attn_unit(F, lj, b, h, is_ctx ? ML + b * CTXL + qb * 128 : b * SEQ + qb * 128, is_ctx, sacc); __syncthreads(); } }
#if STAMP && STAMP < 6
    if (lj == (STAMP_LJ) && blockIdx.x == 0) {
#if STAMP == 1
        const unsigned long long sm1_ = __builtin_amdgcn_s_memtime(), sr1_ = __builtin_amdgcn_s_memrealtime(); __builtin_amdgcn_s_waitcnt(0xC07F);
        sacc = (unsigned)(((sm1_ - sm0_) * 100ull) / (sr1_ - sr0_));
#endif
        if (F.wave == ((STAMP == 3) ? 4 : 0) && F.lane == 0) __hip_atomic_store((GAS unsigned*)(WSP(F) + WS_LAM + 1024), sacc, RLX_AGENT);
    }
#endif
#if STAMP == 40 || STAMP == 41
    const unsigned tB_ = (unsigned)__builtin_amdgcn_s_memrealtime();
#endif
    if ((MXM & 12) == 12) {
        gu32* cnt = (gu32*)(WSP(F) + WS_CTL) + CW_FFT + lj;
        for (;;) {
            if (F.tid == 0) F.MISC[20] = __hip_atomic_fetch_add(cnt, 1u, RLX_AGENT);
            __syncthreads();
            const int u = (int)F.MISC[20];
            if (u >= 512 + 64) break;
            if (u < 512) fft_unit(F, u >> 8, u & 255); else { ctx_dft_unit(F, (u - 512) >> 5, (u - 512) & 31); __syncthreads(); }
        }
    }
#if STAMP == 40 || STAMP == 41
    { const unsigned tC_ = (unsigned)__builtin_amdgcn_s_memrealtime(); if (F.tid == 0) F.MISC[16] += (STAMP == 40) ? tB_ - tA_ : tC_ - tB_; }
#endif
}

struct OddTileRow { int ctx0, lat0; __device__ __forceinline__ int operator()(int j) const { return j < 4 ? ctx0 + 64 * j : lat0 + 64 * (j - 4); } };
struct NaMask {
    int R0, rw, cq, rs, cs, hi; const LAS float* bt; bool off;
    __device__ __forceinline__ bool skip(int j) const { if (off || j < 4) return false; const int kr = R0 + j - 4; return __builtin_amdgcn_readfirstlane((int)(kr < rs || kr >= rs + 8)) != 0; }
    __device__ __forceinline__ void operator()(att::f32x16& p0, att::f32x16& p1, int j) const {
        if (off || j < 4) return;
        const int kr = R0 + j - 4;
        if (kr < rs || kr >= rs + 8) {
#pragma unroll
            for (int r = 0; r < 16; ++r) { p0[r] = -1e30f; p1[r] = -1e30f; }
            return; }
        int cq_ = cq, hi_ = hi; asm volatile("" : "+v"(cq_), "+v"(hi_));
        int cs_ = cq_ - 8; cs_ = cs_ < 0 ? 0 : (cs_ > 48 ? 48 : cs_);
        const int rowoff = (kr - rw + 7) * 31 + 15 - cq_;
#pragma unroll
        for (int r = 0; r < 16; ++r) { const int c0 = att::crow(r, hi_), c1 = 32 + c0; const int cs = cs_;
            const bool ok0 = c0 >= cs && c0 < cs + 16, ok1 = c1 >= cs && c1 < cs + 16;
            const float b0 = bt[ok0 ? rowoff + c0 : 0], b1 = bt[ok1 ? rowoff + c1 : 0];
            p0[r] = ok0 ? p0[r] + b0 : -1e30f; p1[r] = ok1 ? p1[r] + b1 : -1e30f;
            if ((r & 7) == 7) __builtin_amdgcn_sched_barrier(0); }
    }
};
__device__ __forceinline__ void odd_attn_unit(Frame& F, int lj, int b, int h, int rb, bool is_ctx) {
    const bf16* P = (const bf16*)(WSP(F) + WS_P); bf16* MIX = (bf16*)(WSP(F) + WS_MIX);
    const int lane = F.lane, r32 = lane & 31, hi = lane >> 5, wid = F.wave;
    const int qrow0 = is_ctx ? ML + b * CTXL : b * SEQ + rb * 256;
    int R0 = 4 * rb - 4; R0 = R0 < 0 ? 0 : (R0 > 116 ? 116 : R0);
    OddTileRow trow{ML + b * CTXL, b * SEQ + R0 * 64};
    LAS float* bt = (LAS float*)(F.lds + att::LDS_BT_OFF);
    if (!is_ctx) { const float* rpb = INP(F, 18) + (size_t)(lj * 8 + h) * 465; for (int t = F.tid; t < 465; t += 512) bt[t] = rpb[t] * 1.4426950408889634f; }
    __syncthreads();
    NaMask mk; mk.R0 = R0; mk.rw = 4 * rb + (wid >> 1); mk.cq = 32 * (wid & 1) + r32; mk.hi = hi; mk.bt = bt; mk.off = is_ctx;
    { int rs = mk.rw - 4; rs = rs < 0 ? 0 : (rs > 120 ? 120 : rs); mk.rs = rs; int cs = mk.cq - 8; cs = cs < 0 ? 0 : (cs > 48 ? 48 : cs); mk.cs = cs; }
    att::f32x16 o[4]; float rli[16];
    att::attn_core<128, ODN, ODN, ODN, 2, false, true>(P + (size_t)qrow0 * ODN + 3072 + h * 128, (const bf16*)nullptr, 1000,
                        P + 4096 + h * 128, P + 5120 + h * 128, trow, is_ctx ? 4 : 16, mk, (char*)F.ldsg, o, rli);
#pragma unroll
    for (int d = 0; d < 4; ++d)
#pragma unroll
        for (int r = 0; r < 16; ++r) MIX[(size_t)(qrow0 + wid * 32 + att::crow(r, hi)) * DM + 1024 + h * 128 + 32 * d + r32] = (bf16)f2bf(o[d][r] * rli[r]);
}
__device__ __forceinline__ void mixer_odd(Frame& F, int lj, bool with_ctx) {
    const int nun = 512 + (with_ctx ? 16 : 0);
    if (MXM & 1) for (int uu = F.vcu; uu < ((DUP & 2) ? 2 : 1) * nun; uu += F.G) { const int u = (DUP & 2) ? uu % nun : uu; const bool is_ctx = u >= 512; const int pair = is_ctx ? u - 512 : (u >> 5), rb = is_ctx ? 0 : (u & 31);
        odd_attn_unit(F, lj, pair >> 3, pair & 7, rb, is_ctx); __syncthreads(); }
}

#if STAMP >= 6
constexpr bool seam_sel(int ph) {
    if (STAMP == 50) return ph == 3;
    if (STAMP >= 20) return ph == STAMP - 20;
    if (STAMP == 13 || STAMP == 14) return false;
    return STAMP == 6 ? true : STAMP == 7 ? (ph == 1) : STAMP == 8 ? (ph == 3) : STAMP == 9 ? (ph == 6) : STAMP == 10 ? (ph == 4 || ph == 7) : STAMP == 11 ? (ph == 0 || ph == 5) : (ph == 8);
}
#endif
__global__ void __launch_bounds__(512, 2) mk_fwd(Args args) {
    extern __shared__ __attribute__((aligned(16))) unsigned char lds[];
    Frame F;
    F.lds = (LAS unsigned char*)lds; F.ldsg = lds;
    F.MISC = (volatile LAS unsigned*)(F.lds + MISC_OFF);
    F.tid = threadIdx.x; F.lane = F.tid & 63; F.wave = __builtin_amdgcn_readfirstlane(F.tid >> 6);
    F.G = gridDim.x; { const int bx = blockIdx.x; F.vcu = (F.G % 8 == 0) ? (bx % 8) * (F.G / 8) + bx / 8 : bx; }
    F.ap = (ArgsP)__builtin_amdgcn_kernarg_segment_ptr();
    F.ws = (GAS unsigned char*)args.ws; F.out = (GAS float*)args.out; F.ctl = (gu32*)(F.ws + WS_CTL);
    for (int u = F.tid; u < (LDS_BYTES - MISC_OFF) / 4; u += 512) ((LAS unsigned*)(F.lds + MISC_OFF))[u] = 0u;
    __syncthreads();
    XcdBarrier bar = xcd_barrier_post((unsigned*)(F.ctl + CW_BAR), F.MISC + 8);
#if STAMP >= 20
    if (F.tid == 0) F.MISC[17] = (unsigned)__builtin_amdgcn_s_memrealtime();
#endif
    const int lo = args.ph_lo, hi = args.ph_hi;
#define IN(k) (lo <= (k) && (k) < hi)
#if STAMP >= 6
#define SEAMC(k, cat) do { if (IN(k) && IN((k) + 1)) { const unsigned long long tb0_ = __builtin_amdgcn_s_memrealtime(); xcd_barrier(bar); const unsigned long long tb1_ = __builtin_amdgcn_s_memrealtime(); \
        if (F.tid == 0) { if (STAMP >= 20) { F.MISC[16] += (seam_sel(cat) && (STAMP != 50 || (((k) & 8) != 0))) ? (unsigned)tb1_ - F.MISC[17] : 0u; F.MISC[17] = (unsigned)tb1_; } else F.MISC[16] += seam_sel(cat) ? (unsigned)(tb1_ - tb0_) : 0u; } } } while (0)
#else
#define SEAMC(k, cat) do { if (IN(k) && IN((k) + 1)) xcd_barrier(bar); } while (0)
#endif
    if (IN(0) && (PHM & 1)) { Frame L = site(F); p0_modvec(L); __syncthreads(); p0_tables(L); p0_copy_ctx(L); p0_fold(L); __syncthreads(); p0_weights(L); __syncthreads(); }
    SEAMC(0, 8);
    for (int li = 0; li < DEPTH; ++li) {
        const int pb = 1 + 8 * li, lj = li >> 1; const bool even = (li & 1) == 0;
        if (IN(pb + 0) && (PHM & 2)) { Frame L = site(F); const float* rg = (const float*)(WSP(L) + WS_MODV) + (size_t)((li - 1) * 3 + 2) * 12288 + 5 * DM;
            if (li == 0) norm_phase<true>(L, li, 0, INP(L, 0), (float*)(WSP(L) + WS_HC), 0, rg); else norm_phase<false>(L, li, 0, WSP(L) + WS_HB, (float*)(WSP(L) + WS_HC), 11, rg);
            if (DUP & 32) { if (li == 0) norm_phase<true>(L, li, 0, INP(L, 0), (float*)(WSP(L) + WS_HC), 0, nullptr); else norm_phase<false>(L, li, 0, WSP(L) + WS_HB, (float*)(WSP(L) + WS_HC), 0, nullptr); } }
        SEAMC(pb + 0, 0);
        if (IN(pb + 1) && (PHM & 4)) { Frame L = site(F);
            const int N = even ? EVN : ODN;
            const bf16* Bt = even ? (const bf16*)(WSP(L) + WS_WIN_E + (size_t)lj * SZ_WIN_E) : (const bf16*)(WSP(L) + WS_WIN_O + (size_t)lj * SZ_WIN_O);
            pg8::Gemm g{(const bf16*)(WSP(L) + WS_A), Bt, MT, N, DM}; pg8::StaticOrder S; S.init(MT, N, L.G, (int)blockIdx.x);
            if (even) {
                pg8::EpiEvenIn E{(bf16*)(WSP(L) + WS_P), (bf16*)(WSP(L) + WS_QR), N, INP(L, 11) + (size_t)lj * 128, (const float*)(WSP(L) + WS_ROPE), (LAS float*)(L.lds + pg8::STAGE_BYTES), (bf16*)(WSP(L) + WS_FT)};
                pg8::gemm_phase<pg8::EpiEvenIn, pg8::StaticOrder, PG8_ALIGN, PG8_SP2>(L.lds, g, S, E);
            } else {
            pg8::EpiOddIn E{(bf16*)(WSP(L) + WS_P), N, INP(L, 16) + (size_t)lj * 256, (LAS float*)(L.lds + pg8::STAGE_BYTES)};
            pg8::gemm_phase<pg8::EpiOddIn, pg8::StaticOrder, PG8_ALIGN, PG8_SP2>(L.lds, g, S, E);
            }
            wq_tail(L, 2 * li, (MT / 256) * (N / 256));
        }
        SEAMC(pb + 1, 1);
        if (IN(pb + 3)) { Frame L = site(F); if (even) { if (PHM & 32) mixer_even(L, lj); } else {
#if STAMP == 13 || STAMP == 14
            if (F.tid == 0) F.MISC[18] = (unsigned)__builtin_amdgcn_s_memrealtime();
#endif
            if (PHM & 16) prep_odd(L, lj);
#if STAMP == 14
            if (F.tid == 0) F.MISC[16] += (unsigned)__builtin_amdgcn_s_memrealtime() - F.MISC[18];
#endif
#if STAMP == 13
            if (F.tid == 0) F.MISC[18] = (unsigned)__builtin_amdgcn_s_memrealtime();
#endif
            if (PHM & 64) mixer_odd(L, lj, li != DEPTH - 1);
#if STAMP == 13
            if (F.tid == 0) F.MISC[16] += (unsigned)__builtin_amdgcn_s_memrealtime() - F.MISC[18];
#endif
            } }
        SEAMC(pb + 3, 3);
        if (IN(pb + 4) && (PHM & 128)) { Frame L = site(F);
            const bf16* Bt = even ? (const bf16*)(WSP(L) + WS_WOUT_E + (size_t)lj * SZ_WOUT) : (const bf16*)(WSP(L) + WS_WOUT_O + (size_t)lj * SZ_WOUT);
            const float* modl = (const float*)(WSP(L) + WS_MODV) + (size_t)li * 3 * 12288;
            pg8::Gemm g{(const bf16*)(WSP(L) + WS_MIX), Bt, MT, DM, DM}; pg8::SplitOrder<8> S; S.init(ML, DM, DM, L.G, (int)blockIdx.x, li != 3);
            if (li == 0) {
                pg8::EpiGate<true> E{(const void*)INP(L, 0), (void*)(WSP(L) + WS_HB), (float*)(WSP(L) + WS_SLAB), modl + 2 * DM, 0};
                pg8::gemm_phase<pg8::EpiGate<true>, pg8::SplitOrder<8>, PG8_ALIGN, PG8_SP2>(L.lds, g, S, E);
            } else {
                pg8::EpiGate<false> E{(const void*)(WSP(L) + WS_HB), (void*)(WSP(L) + WS_HB), (float*)(WSP(L) + WS_SLAB), modl + 2 * DM, 0};
                pg8::gemm_phase<pg8::EpiGate<false>, pg8::SplitOrder<8>, PG8_ALIGN, PG8_SP2>(L.lds, g, S, E);
            }
        }
        SEAMC(pb + 4, 4);
        if (IN(pb + 5) && (PHM & 2)) { Frame L = site(F); norm_phase<false>(L, li, 1, WSP(L) + WS_HB, (float*)(WSP(L) + WS_HC), li == 3 ? 0 : 8, (const float*)(WSP(L) + WS_MODV) + (size_t)(li * 3 + 2) * 12288 + 2 * DM); if (DUP & 32) norm_phase<false>(L, li, 1, WSP(L) + WS_HB, (float*)(WSP(L) + WS_HC), 0, nullptr); }
        SEAMC(pb + 5, 5);
        if (IN(pb + 6) && (PHM & 256)) { Frame L = site(F);
            const int Mr = li == 3 ? ML : MT;
            pg8::Gemm g{(const bf16*)(WSP(L) + WS_A), (const bf16*)(WSP(L) + WS_WFI + (size_t)li * SZ_WFI), Mr, 2 * FH, DM}; pg8::StaticOrder S; S.init(Mr, 2 * FH, L.G, (int)blockIdx.x);
            pg8::EpiSwiglu E{(bf16*)(WSP(L) + WS_HID), FH};
            for (int rep = 0; rep < ((DUP & 4) ? 2 : 1); ++rep)
            pg8::gemm_phase<pg8::EpiSwiglu, pg8::StaticOrder, PG8_ALIGN, PG8_SP2>(L.lds, g, S, E);
            if (li < 3) wq_tail(L, 2 * li + 1, (Mr / 256) * (2 * FH / 256));
        }
        SEAMC(pb + 6, 6);
        if (IN(pb + 7) && (PHM & 512)) { Frame L = site(F);
            const float* modl = (const float*)(WSP(L) + WS_MODV) + (size_t)li * 3 * 12288;
            pg8::Gemm g{(const bf16*)(WSP(L) + WS_HID), (const bf16*)(WSP(L) + WS_WFO + (size_t)li * SZ_WFO), MT, DM, FH}; pg8::SplitOrder<11> S; S.init(ML, DM, FH, L.G, (int)blockIdx.x, li != 3);
            pg8::EpiGate<false> E{(const void*)(WSP(L) + WS_HB), li == 3 ? (void*)OUTP(L) : (void*)(WSP(L) + WS_HB), (float*)(WSP(L) + WS_SLAB), modl + 5 * DM, li == 3 ? 1 : 0};
            pg8::gemm_phase<pg8::EpiGate<false>, pg8::SplitOrder<11>, PG8_ALIGN, PG8_SP2>(L.lds, g, S, E);
        }
        SEAMC(pb + 7, 7);
    }
#if STAMP >= 6
    if (STAMP >= 20 && F.tid == 0) { if (seam_sel(7)) F.MISC[16] += (unsigned)__builtin_amdgcn_s_memrealtime() - F.MISC[17]; if (blockIdx.x != 0) F.MISC[16] = 0u; else F.MISC[16] *= F.G; }
    if (F.tid == 0) __hip_atomic_fetch_add((GAS unsigned*)(F.ctl + 2048), (unsigned)F.MISC[16], RLX_AGENT);
    __syncthreads(); xcd_barrier(bar);
    if (blockIdx.x == 0 && F.wave == 0) {
        const unsigned v = __hip_atomic_load((GAS unsigned*)(F.ctl + 2048), RLX_AGENT);
        const unsigned long long ticks = (unsigned long long)v / F.G;
        const unsigned long long t0 = __builtin_amdgcn_s_memrealtime();
        while (__builtin_amdgcn_s_memrealtime() - t0 < ticks) __builtin_amdgcn_s_sleep(64);
    }
#elif STAMP
    if (blockIdx.x == 0 && F.wave == 0) {
        const unsigned v = __hip_atomic_load((GAS unsigned*)(F.ws + WS_LAM + 1024), RLX_AGENT);
        const unsigned long long ticks = (STAMP == 1) ? (unsigned long long)v * 100ull : ((unsigned long long)v * 100ull) >> 10;
        const unsigned long long t0 = __builtin_amdgcn_s_memrealtime();
        while (__builtin_amdgcn_s_memrealtime() - t0 < ticks) __builtin_amdgcn_s_sleep(64);
    }
#endif
#undef IN
#undef SEAMC
}

extern "C" void kernel_launch(void* const* d_in, const int* in_sizes, int n_in, void* d_out, int out_size, void* d_ws, size_t ws_size, hipStream_t stream) {
    static int grid = 0;
    if (grid == 0) {
        if (n_in != 19 || in_sizes[0] != ML * DM || out_size != ML * DM || ws_size < WS_END) { fprintf(stderr, "kernel_launch: shape mismatch (n_in %d, in0 %d, out %d, ws %zu < %zu); nothing launched\n", n_in, n_in > 0 ? in_sizes[0] : -1, out_size, ws_size, (size_t)WS_END); grid = -1; return; }
        int dev = 0, cus = 0, per_cu = 0;
        if (hipGetDevice(&dev) != hipSuccess || hipDeviceGetAttribute(&cus, hipDeviceAttributeMultiprocessorCount, dev) != hipSuccess) { fprintf(stderr, "kernel_launch: device query failed\n"); grid = -1; return; }
        if (hipFuncSetAttribute((const void*)mk_fwd, hipFuncAttributeMaxDynamicSharedMemorySize, LDS_BYTES) != hipSuccess) { fprintf(stderr, "kernel_launch: hipFuncSetAttribute failed\n"); grid = -1; return; }
        if (hipOccupancyMaxActiveBlocksPerMultiprocessor(&per_cu, (const void*)mk_fwd, 512, LDS_BYTES) != hipSuccess || per_cu < 1) fprintf(stderr, "kernel_launch: note: occupancy query reports %d workgroups per CU\n", per_cu);
        (void)hipGetLastError();
        grid = cus;
    }
    if (grid < 0) return;
    if (hipMemsetAsync((char*)d_ws + WS_CTL, 0, CTL_ZERO_BYTES, stream) != hipSuccess) { fprintf(stderr, "kernel_launch: memset failed\n"); return; }
    Args a{};
    for (int i = 0; i < 19; ++i) a.in[i] = (const float*)d_in[i];
    a.out = (float*)d_out; a.ws = (unsigned char*)d_ws;
    constexpr int NL = MK_N_LAUNCHES;
    for (int l = 0; l < NL; ++l) {
        a.ph_lo = (NL == 1) ? 0 : l; a.ph_hi = (NL == 1) ? NPH : l + 1;
        hipLaunchKernelGGL(mk_fwd, dim3(grid), dim3(512), LDS_BYTES, stream, a);
        const hipError_t le = hipPeekAtLastError();
        if (le != hipSuccess) { fprintf(stderr, "kernel_launch: launch %d failed: %s\n", l, hipGetErrorName(le)); break; }
    }
}
```

```cpp
#include <hip/hip_runtime.h>
#include <cstdio>
#include <cstdint>
#include <cstddef>
#ifndef DUP
#define DUP 0
#endif

#ifndef STAMP
#define STAMP 0
#endif
#ifndef STAMP_LJ
#define STAMP_LJ 0
#endif
namespace pg8 {
#define PG8_LAS __attribute__((address_space(3)))
typedef unsigned short bf16_t;
typedef short bf16x8 __attribute__((ext_vector_type(8)));
typedef float f32x4 __attribute__((ext_vector_type(4)));
typedef unsigned u32x4 __attribute__((ext_vector_type(4)));
constexpr int BM = 256, BK = 64, HALF = 128, HTB = HALF * BK * 2  , STAGE_BYTES = 8 * HTB, NXCD = 8, WGM = 8;

__host__ __device__ __forceinline__ int lds_byte(int r, int c) { const int st = (r >> 4) * 2 + (c >> 5), rr = r & 15, cc = c & 31, ob = rr * 64 + cc * 2; return st * 1024 + (ob ^ (((ob >> 9) & 1) << 5)); }
__host__ __device__ __forceinline__ void stage_rc(int b, int& R, int& C) { const int st = b / 1024, sb = b % 1024, swz = sb ^ (((sb >> 9) & 1) << 5); R = (st >> 1) * 16 + swz / 64; C = (st & 1) * 32 + (swz % 64) / 2; }
__host__ __device__ __forceinline__ int perm32(int rho) { const int n = rho >> 4, i = rho & 15; return 8 * (i >> 2) + 4 * n + (i & 3); }

struct Unit { int pm, pn; int kb, nt; };
struct Gemm { const bf16_t* A; const bf16_t* Bt; int M, N, K; };

struct StaticOrder {
    int nM, nN, nwg, G, c;
    __host__ __device__ void init(int M, int N, int G_, int c_) { nM = M / BM; nN = N / BM; nwg = nM * nN; G = G_; c = c_; }
    __host__ __device__ bool next(int i, Unit& u) const {
        const long L = (long)i * G + c; if (L >= nwg) return false;
        int wgid = (int)L; { const int q = nwg / NXCD, r = nwg % NXCD, xcd = wgid % NXCD, off = wgid / NXCD; wgid = (xcd < r ? xcd * (q + 1) : r * (q + 1) + (xcd - r) * q) + off; }
        const int nig = WGM * nN, gid = wgid / nig, fm = gid * WGM, gsz = (nM - fm) < WGM ? (nM - fm) : WGM;
        u.pm = fm + ((wgid % nig) % gsz); u.pn = (wgid % nig) / gsz; return true;
    }
    static constexpr bool SPLITK = false;
    __device__ __forceinline__ void a_ready(const Unit&) const {}
    __device__ __forceinline__ void done(const Unit&) const {}
};

__device__ __forceinline__ unsigned cvt_pk_bf16(float lo, float hi) { unsigned r; asm volatile("v_cvt_pk_bf16_f32 %0, %1, %2" : "=v"(r) : "v"(lo), "v"(hi)); return r; }
typedef float f32x2 __attribute__((ext_vector_type(2)));
__device__ __forceinline__ f32x2 gelu_pk(f32x2 v) {
    const f32x2 av = __builtin_elementwise_abs(v), d = av * 0.2316418882f + 1.0f;
    f32x2 t; t.x = __builtin_amdgcn_rcpf(d.x); t.y = __builtin_amdgcn_rcpf(d.y);
    f32x2 q = t * 0.5307027145f + (-0.7265760135f); q = q * t + 0.7107068705f; q = q * t + (-0.142248368f); q = q * t + 0.127414796f; q = q * t;
    const f32x2 s = (v * v) * (-0.72134752044f);
    f32x2 e; e.x = __builtin_amdgcn_exp2f(s.x); e.y = __builtin_amdgcn_exp2f(s.y);
    const f32x2 m = v * (q * e), r = v - m;
    f32x2 o; o.x = v.x < 0.f ? m.x : r.x; o.y = v.y < 0.f ? m.y : r.y; return o;
}

template <int ACT  > struct EpiBf16 {
    static constexpr bool PERM = true, AFTER_DRAIN = false; static_assert(ACT == 0 || ACT == 1, "EpiBf16: ACT is 0 (none) or 1 (gelu_pk)");
    bf16_t* O; int ldc; const float* bias; int split_cols; size_t split_stride; float scale0;
    __device__ __forceinline__ void operator()(const f32x4 (&acc)[2][2][4][2], const Unit& u, int wr, int wc, int fr, int fq) const {
        const int row0 = u.pm * BM + wr * 64 + fr; int colt = u.pn * BM; bf16_t* base = O;
        float sc = 1.f; if (split_cols) { const int t = colt / split_cols; base += (size_t)t * split_stride; colt -= t * split_cols; if (t == 0) sc = scale0; }
        const int col0 = colt + wc * 32 + 8 * fq, bcol0 = u.pn * BM + wc * 32 + 8 * fq;
        f32x4 bv[2][2];
#pragma unroll
        for (int bj = 0; bj < 2; ++bj)
#pragma unroll
            for (int n = 0; n < 2; ++n) bv[bj][n] = bias ? *(const f32x4*)(bias + bcol0 + bj * HALF + 4 * n) : (f32x4){0.f, 0.f, 0.f, 0.f};
#pragma unroll
        for (int ai = 0; ai < 2; ++ai)
#pragma unroll
            for (int m = 0; m < 4; ++m) { bf16_t* rowp = base + (size_t)(row0 + ai * HALF + m * 16) * ldc + col0;
#pragma unroll
                for (int bj = 0; bj < 2; ++bj) { f32x4 v0 = acc[ai][bj][m][0] + bv[bj][0], v1 = acc[ai][bj][m][1] + bv[bj][1];
                    if (ACT == 1) { f32x2 a = gelu_pk((f32x2){v0[0], v0[1]}), b = gelu_pk((f32x2){v0[2], v0[3]}), c = gelu_pk((f32x2){v1[0], v1[1]}), d = gelu_pk((f32x2){v1[2], v1[3]});
                        v0 = (f32x4){a.x, a.y, b.x, b.y}; v1 = (f32x4){c.x, c.y, d.x, d.y}; }
                    v0 = v0 * sc; v1 = v1 * sc; u32x4 w; w.x = cvt_pk_bf16(v0[0], v0[1]); w.y = cvt_pk_bf16(v0[2], v0[3]); w.z = cvt_pk_bf16(v1[0], v1[1]); w.w = cvt_pk_bf16(v1[2], v1[3]);
                    *(u32x4*)(rowp + bj * HALF) = w; } }
    }
};

template <bool BASE_F32> struct EpiGate {
    static constexpr bool PERM = true, AFTER_DRAIN = false;
    const void* base_l; void* out_l; float* slab; const float* gate; int out_f32;
    __device__ __forceinline__ void operator()(const f32x4 (&acc)[2][2][4][2], const Unit& u, int wr, int wc, int fr, int fq) const {
        const bool isc = u.pm >= 64; const int grp = u.pm < 32 ? 0 : (u.pm < 64 ? 1 : 2);
        const int rowt = (isc ? (u.pm - 64) : u.pm) * BM + wr * 64 + fr;
        const int col0 = u.pn * BM + wc * 32 + 8 * fq;
        if (isc) {
            const int kc = u.kb / (u.nt * BK * 2); float* sp = slab + (size_t)kc * (512 * 2048);
#pragma unroll
            for (int ai = 0; ai < 2; ++ai)
#pragma unroll
                for (int m = 0; m < 4; ++m) { const size_t off = (size_t)(rowt + ai * HALF + m * 16) * 2048 + col0;
#pragma unroll
                    for (int bj = 0; bj < 2; ++bj)
#pragma unroll
                        for (int n = 0; n < 2; ++n) *(f32x4*)(sp + off + bj * HALF + n * 4) = acc[ai][bj][m][n]; }
            return; }
        f32x4 gv[2][2];
#pragma unroll
        for (int bj = 0; bj < 2; ++bj)
#pragma unroll
            for (int n = 0; n < 2; ++n) gv[bj][n] = *(const f32x4*)(gate + grp * 12288 + col0 + bj * HALF + n * 4);
        u32x4 pball[2][4][2];
        if constexpr (!BASE_F32) {
            const unsigned long long bpu = (unsigned long long)base_l;
            const void* bps = (const void*)(((unsigned long long)(unsigned)__builtin_amdgcn_readfirstlane((int)(bpu >> 32)) << 32) | (unsigned)__builtin_amdgcn_readfirstlane((int)bpu));
            const __amdgpu_buffer_rsrc_t rs = __builtin_amdgcn_make_buffer_rsrc((void*)bps, 0, 0x7fffffff, 0x00020000);
            const int voff = ((wr * 64 + fr) * 2048 + wc * 32 + 8 * fq) * 2;
            const int sb = __builtin_amdgcn_readfirstlane((u.pm * BM * 2048 + u.pn * BM) * 2);
#pragma unroll
            for (int ai = 0; ai < 2; ++ai)
#pragma unroll
                for (int m = 0; m < 4; ++m)
#pragma unroll
                    for (int bj = 0; bj < 2; ++bj) pball[ai][m][bj] = __builtin_bit_cast(u32x4, __builtin_amdgcn_raw_buffer_load_b128(rs, voff, sb + ((ai * HALF + m * 16) * 2048 + bj * HALF) * 2, 0));
            asm volatile("" ::: "memory");
        }
#pragma unroll
        for (int ai = 0; ai < 2; ++ai) {
            f32x4 pre[4][2][2]; u32x4 pb[4][2];
            if constexpr (BASE_F32) { const float* bp = (const float*)base_l;
#pragma unroll
                for (int m = 0; m < 4; ++m) { const size_t off = (size_t)(rowt + ai * HALF + m * 16) * 2048 + col0;
#pragma unroll
                    for (int bj = 0; bj < 2; ++bj)
#pragma unroll
                        for (int n = 0; n < 2; ++n) pre[m][bj][n] = *(const f32x4*)(bp + off + bj * HALF + n * 4); }
            } else {
#pragma unroll
                for (int m = 0; m < 4; ++m)
#pragma unroll
                    for (int bj = 0; bj < 2; ++bj) pb[m][bj] = pball[ai][m][bj];
            }
            asm volatile("" ::: "memory");
#pragma unroll
            for (int m = 0; m < 4; ++m) { const size_t off = (size_t)(rowt + ai * HALF + m * 16) * 2048 + col0;
#pragma unroll
                for (int bj = 0; bj < 2; ++bj) { f32x4 x0, x1;
                    if constexpr (BASE_F32) { x0 = pre[m][bj][0]; x1 = pre[m][bj][1]; }
                    else { const u32x4 w = pb[m][bj];
                        x0 = f32x4{__uint_as_float(w.x << 16), __uint_as_float(w.x & 0xffff0000u), __uint_as_float(w.y << 16), __uint_as_float(w.y & 0xffff0000u)};
                        x1 = f32x4{__uint_as_float(w.z << 16), __uint_as_float(w.z & 0xffff0000u), __uint_as_float(w.w << 16), __uint_as_float(w.w & 0xffff0000u)}; }
                    const f32x4 a = x0 + gv[bj][0] * acc[ai][bj][m][0], b = x1 + gv[bj][1] * acc[ai][bj][m][1];
                    if (out_f32) { float* op = (float*)out_l + off + bj * HALF; *(f32x4*)op = a; *(f32x4*)(op + 4) = b; }
                    else { u32x4 w; w.x = cvt_pk_bf16(a.x, a.y); w.y = cvt_pk_bf16(a.z, a.w); w.z = cvt_pk_bf16(b.x, b.y); w.w = cvt_pk_bf16(b.z, b.w);
                        *(u32x4*)((bf16_t*)out_l + off + bj * HALF) = w; } } }
            asm volatile("" ::: "memory");
        }
    }
};
template <int KS> struct SplitOrder {
    static constexpr bool SPLITK = true;
    StaticOrder so; int G, c, ntc, ntf, nctx;
    __device__ void init(int Mlat, int N, int K, int G_, int c_, bool with_ctx) { so.init(Mlat, N, G_, c_); G = G_; c = c_; ntf = K / BK; ntc = ntf / KS; nctx = with_ctx ? 16 * KS : 0; }
    __device__ bool next(int i, Unit& u) const {
        const long L = (long)i * G + c;
        if (L < so.nwg) { so.next(i, u); u.kb = 0; u.nt = ntf; return true; }
        const int x = (int)(L - so.nwg); if (x >= nctx) return false;
        const int kc = x % KS, tile = x / KS; u.pn = tile & 7; u.pm = so.nM + (tile >> 3); u.kb = kc * ntc * BK * 2; u.nt = ntc; return true;
    }
    __device__ __forceinline__ void a_ready(const Unit&) const {}
    __device__ __forceinline__ void done(const Unit&) const {}
};
struct EpiEvenIn {
    static constexpr bool PERM = true, AFTER_DRAIN = false;
    bf16_t* P; bf16_t* QR; int ldc; const float* gains; const float* rope; PG8_LAS float* part; bf16_t* FT;
    __device__ __forceinline__ void operator()(const f32x4 (&acc)[2][2][4][2], const Unit& u, int wr, int wc, int fr, int fq) const {
        const int row0 = u.pm * BM + wr * 64 + fr; const int col0 = u.pn * BM + wc * 32 + 8 * fq;
        if (u.pn >= 18 && u.pm < 64) {
            const int cp0 = (col0 - 4608) >> 2;
#pragma unroll
            for (int ai = 0; ai < 2; ++ai)
#pragma unroll
                for (int m = 0; m < 4; ++m) { const int row = row0 + ai * HALF + m * 16; const int b = row >> 13, t = row & 8191;
#pragma unroll
                    for (int bj = 0; bj < 2; ++bj) { const f32x4 v0 = acc[ai][bj][m][0], v1 = acc[ai][bj][m][1];
                        bf16_t* fp = FT + ((size_t)(b * 256 + cp0 + 32 * bj) * 8192 + t) * 4;
                        typedef unsigned u32x2_ __attribute__((ext_vector_type(2)));
                        u32x2_ wa, wb; wa.x = cvt_pk_bf16(v0[0], v0[1]); wa.y = cvt_pk_bf16(v0[2], v0[3]); wb.x = cvt_pk_bf16(v1[0], v1[1]); wb.y = cvt_pk_bf16(v1[2], v1[3]);
                        *(u32x2_*)fp = wa; *(u32x2_*)(fp + 8192 * 4) = wb; } }
            return; }
        if (u.pn >= 12) {
#pragma unroll
            for (int ai = 0; ai < 2; ++ai)
#pragma unroll
                for (int m = 0; m < 4; ++m) { bf16_t* rowp = P + (size_t)(row0 + ai * HALF + m * 16) * ldc + col0;
#pragma unroll
                    for (int bj = 0; bj < 2; ++bj) { const f32x4 v0 = acc[ai][bj][m][0], v1 = acc[ai][bj][m][1];
                        u32x4 w; w.x = cvt_pk_bf16(v0[0], v0[1]); w.y = cvt_pk_bf16(v0[2], v0[3]); w.z = cvt_pk_bf16(v1[0], v1[1]); w.w = cvt_pk_bf16(v1[2], v1[3]);
                        *(u32x4*)(rowp + bj * HALF) = w; } }
            return; }
        const bool isq = u.pn < 6, lat = u.pm < 64;
        int rb_ = wr * 64 + fr; asm volatile("" : "+v"(rb_));
#pragma unroll
        for (int ai = 0; ai < 2; ++ai)
#pragma unroll
            for (int m = 0; m < 4; ++m)
#pragma unroll
                for (int bj = 0; bj < 2; ++bj) { const f32x4 a = acc[ai][bj][m][0], b = acc[ai][bj][m][1];
                    float s = (a[0] * a[0] + a[1] * a[1]) + (a[2] * a[2] + a[3] * a[3]) + (b[0] * b[0] + b[1] * b[1]) + (b[2] * b[2] + b[3] * b[3]);
                    s += __shfl_xor(s, 16); s += __shfl_xor(s, 32);
                    if (fq == 0) part[((ai * HALF + m * 16 + rb_) * 2 + bj) * 4 + wc] = s; }
        asm volatile("s_waitcnt lgkmcnt(0)" ::: "memory"); __builtin_amdgcn_s_barrier(); asm volatile("" ::: "memory");
        const float* gp = gains + (isq ? 0 : 64) + 32 * (wc & 1) + 8 * fq; const float qs = isq ? 0.18033688011112042f : 1.0f;
        float gn[8];
#pragma unroll
        for (int e = 0; e < 8; ++e) gn[e] = gp[e] * qs;
#pragma unroll
        for (int ai = 0; ai < 2; ++ai)
#pragma unroll
            for (int m = 0; m < 4; ++m) { const int rl = ai * HALF + m * 16 + rb_; const int row = u.pm * BM + rl;
                f32x4 cs0 = {1.f, 0.f, 1.f, 0.f}, cs1 = cs0, cs2 = cs0, cs3 = cs0;
                if (lat) { const int t = row & 8191; const int pos = (wc & 1) ? (t & 63) : (t >> 6); const float* rp = rope + (size_t)(pos * 16 + 8 * (fq & 1)) * 2;
                    cs0 = *(const f32x4*)rp; cs1 = *(const f32x4*)(rp + 4); cs2 = *(const f32x4*)(rp + 8); cs3 = *(const f32x4*)(rp + 12); }
                const float c8[8] = {cs0[0], cs0[2], cs1[0], cs1[2], cs2[0], cs2[2], cs3[0], cs3[2]}, s8[8] = {cs0[1], cs0[3], cs1[1], cs1[3], cs2[1], cs2[3], cs3[1], cs3[3]};
#pragma unroll
                for (int bj = 0; bj < 2; ++bj) {
                    const float ss = part[(rl * 2 + bj) * 4 + wc] + part[(rl * 2 + bj) * 4 + (wc ^ 1)];
                    const float rstd = rsqrtf(ss * (1.0f / 64.0f) + 1e-6f);
                    float y[8], yr[8];
#pragma unroll
                    for (int e = 0; e < 8; ++e) y[e] = acc[ai][bj][m][e >> 2][e & 3] * rstd * gn[e];
#pragma unroll
                    for (int e = 0; e < 8; ++e) { const float yp = __shfl_xor(y[e], 32); yr[e] = (fq & 2) ? (y[e] * c8[e] + yp * s8[e]) : (y[e] * c8[e] - yp * s8[e]); }
                    u32x4 wn, wrot;
                    wn.x = cvt_pk_bf16(y[0], y[1]); wn.y = cvt_pk_bf16(y[2], y[3]); wn.z = cvt_pk_bf16(y[4], y[5]); wn.w = cvt_pk_bf16(y[6], y[7]);
                    wrot.x = cvt_pk_bf16(yr[0], yr[1]); wrot.y = cvt_pk_bf16(yr[2], yr[3]); wrot.z = cvt_pk_bf16(yr[4], yr[5]); wrot.w = cvt_pk_bf16(yr[6], yr[7]);
                    bf16_t* pp = P + (size_t)row * ldc + col0 + bj * HALF;
                    if (isq) { *(u32x4*)pp = wn; if (lat) *(u32x4*)(QR + (size_t)row * 1536 + col0 + bj * HALF) = wrot; }
                    else     { *(u32x4*)pp = lat ? wrot : wn; }
                }
                asm volatile("" ::: "memory"); }
    }
};
struct EpiOddIn {
    static constexpr bool PERM = true, AFTER_DRAIN = false;
    bf16_t* P; int ldc; const float* gains; PG8_LAS float* part;
    __device__ __forceinline__ void operator()(const f32x4 (&acc)[2][2][4][2], const Unit& u, int wr, int wc, int fr, int fq) const {
        const int row0 = u.pm * BM + wr * 64 + fr; const int col0 = u.pn * BM + wc * 32 + 8 * fq;
        const bool isqk = u.pn >= 12 && u.pn < 20;
        float rs[2][4][2];
        if (isqk) {
            int rb_ = wr * 64 + fr; asm volatile("" : "+v"(rb_));
#pragma unroll
            for (int ai = 0; ai < 2; ++ai)
#pragma unroll
                for (int m = 0; m < 4; ++m)
#pragma unroll
                    for (int bj = 0; bj < 2; ++bj) { const f32x4 a = acc[ai][bj][m][0], b = acc[ai][bj][m][1];
                        float s = (a[0] * a[0] + a[1] * a[1]) + (a[2] * a[2] + a[3] * a[3]) + (b[0] * b[0] + b[1] * b[1]) + (b[2] * b[2] + b[3] * b[3]);
                        s += __shfl_xor(s, 16); s += __shfl_xor(s, 32);
                        if (fq == 0) part[((ai * HALF + m * 16 + rb_) * 2 + bj) * 4 + wc] = s; }
            asm volatile("s_waitcnt lgkmcnt(0)" ::: "memory"); __builtin_amdgcn_s_barrier(); asm volatile("" ::: "memory");
#pragma unroll
            for (int ai = 0; ai < 2; ++ai)
#pragma unroll
                for (int m = 0; m < 4; ++m)
#pragma unroll
                    for (int bj = 0; bj < 2; ++bj) { const f32x4 t = *(const PG8_LAS f32x4*)(part + ((ai * HALF + m * 16 + rb_) * 2 + bj) * 4);
                        rs[ai][m][bj] = rsqrtf(((t[0] + t[1]) + (t[2] + t[3])) * (1.0f / 128.0f) + 1e-6f); }
        }
        float gn[8];
        { const float* gp = gains + (u.pn >= 16 ? 128 : 0) + 32 * wc + 8 * fq;
          const float qs = u.pn < 16 ? 0.12751743f : 1.0f;
#pragma unroll
          for (int e = 0; e < 8; ++e) gn[e] = isqk ? gp[e] * qs : 1.0f; }
#pragma unroll
        for (int ai = 0; ai < 2; ++ai)
#pragma unroll
            for (int m = 0; m < 4; ++m) { bf16_t* rowp = P + (size_t)(row0 + ai * HALF + m * 16) * ldc + col0;
#pragma unroll
                for (int bj = 0; bj < 2; ++bj) { const float r = isqk ? rs[ai][m][bj] : 1.0f; const f32x4 v0 = acc[ai][bj][m][0], v1 = acc[ai][bj][m][1];
                    u32x4 w; w.x = cvt_pk_bf16(v0[0] * r * gn[0], v0[1] * r * gn[1]); w.y = cvt_pk_bf16(v0[2] * r * gn[2], v0[3] * r * gn[3]);
                    w.z = cvt_pk_bf16(v1[0] * r * gn[4], v1[1] * r * gn[5]); w.w = cvt_pk_bf16(v1[2] * r * gn[6], v1[3] * r * gn[7]);
                    *(u32x4*)(rowp + bj * HALF) = w; } }
    }
};
struct EpiSwiglu {
    static constexpr bool PERM = true, AFTER_DRAIN = false;
    bf16_t* O; int ldc;
    __device__ __forceinline__ void operator()(const f32x4 (&acc)[2][2][4][2], const Unit& u, int wr, int wc, int fr, int fq) const {
        const int row0 = u.pm * BM + wr * 64 + fr; const int col0 = u.pn * HALF + wc * 32 + 8 * fq;
#pragma unroll
        for (int ai = 0; ai < 2; ++ai)
#pragma unroll
            for (int m = 0; m < 4; ++m) { bf16_t* rowp = O + (size_t)(row0 + ai * HALF + m * 16) * ldc + col0;
                float hv[8];
#pragma unroll
                for (int n = 0; n < 2; ++n)
#pragma unroll
                    for (int e = 0; e < 4; ++e) { const float g = acc[ai][0][m][n][e], up = acc[ai][1][m][n][e];
                        hv[n * 4 + e] = g * __builtin_amdgcn_rcpf(1.0f + __expf(-g)) * up; }
                u32x4 w; w.x = cvt_pk_bf16(hv[0], hv[1]); w.y = cvt_pk_bf16(hv[2], hv[3]); w.z = cvt_pk_bf16(hv[4], hv[5]); w.w = cvt_pk_bf16(hv[6], hv[7]);
                *(u32x4*)rowp = w; }
    }
};

template <class Epi, class Sched, bool ALIGN_EPI = false, bool SP2 = false>
__device__ __forceinline__ void gemm_phase(PG8_LAS unsigned char* lds, const Gemm g, const Sched& S, const Epi& E) {
    int tid_ = threadIdx.x; asm volatile("" : "+v"(tid_));
    const int tid = tid_, wid = __builtin_amdgcn_readfirstlane(tid >> 6), lane = tid & 63, wr = wid >> 2, wc = wid & 3, fr = lane & 15, fq = lane >> 4;
    const int K = g.K, ntf = K / BK;
    unsigned voffA[2], voffB[2];
#pragma unroll
    for (int i = 0; i < 2; ++i) { int R, C; stage_rc(tid * 16 + i * 8192, R, C); const int Rb = Epi::PERM ? ((R & ~31) + perm32(R & 31)) : R;
        voffA[i] = (unsigned)(R * K + C) * 2u; voffB[i] = (unsigned)(Rb * K + C) * 2u; }
    const size_t kstep = (size_t)(BK * 2);
    const size_t hstep = (size_t)HALF * K * 2;
    const size_t tstep = 2 * hstep;
    const unsigned ldsw = (unsigned)wid * 1024u;
    const int aoff = lds_byte(wr * 64 + fr, fq * 8), boff = lds_byte(wc * 32 + fr, fq * 8);
#define PG8_SA(b, h) (((b) * 2 + (h)) * HTB)
#define PG8_SB(b, h) ((4 + (b) * 2 + (h)) * HTB)
#define PG8_STAGE(bufoff, gbase, voff) do { _Pragma("unroll") for (int _i = 0; _i < 2; ++_i) \
        __builtin_amdgcn_global_load_lds((const unsigned*)((const char*)(gbase) + (voff)[_i]), (PG8_LAS unsigned*)(lds + (bufoff) + ldsw + _i * 8192), 16, 0, 0); } while (0)
#define PG8_LDA(dst, b, h) do { _Pragma("unroll") for (int m = 0; m < 4; ++m) _Pragma("unroll") for (int k = 0; k < 2; ++k) dst[m][k] = *(const PG8_LAS bf16x8*)(lds + PG8_SA(b, h) + aoff + m * 2048 + k * 1024); } while (0)
#define PG8_LDB(dst, b, h) do { _Pragma("unroll") for (int n = 0; n < 2; ++n) _Pragma("unroll") for (int k = 0; k < 2; ++k) dst[n][k] = *(const PG8_LAS bf16x8*)(lds + PG8_SB(b, h) + boff + n * 2048 + k * 1024); } while (0)
#define PG8_MMA(ai, bj, At, Bt) do { __builtin_amdgcn_s_setprio(1); _Pragma("unroll") for (int m = 0; m < 4; ++m) _Pragma("unroll") for (int n = 0; n < 2; ++n) _Pragma("unroll") for (int k = 0; k < 2; ++k) \
        acc[ai][bj][m][n] = __builtin_amdgcn_mfma_f32_16x16x32_bf16(Bt[n][k], At[m][k], acc[ai][bj][m][n], 0, 0, 0); __builtin_amdgcn_s_setprio(0); } while (0)
#define PG8_WAIT_V(n) asm volatile("s_waitcnt vmcnt(" #n ")" ::: "memory")
#define PG8_WAIT_L(n) asm volatile("s_waitcnt lgkmcnt(" #n ")" ::: "memory")
#define PG8_BAR __builtin_amdgcn_s_barrier()
#define PG8_SCHED __builtin_amdgcn_sched_barrier(0)
    Unit cur, nxt; int ui = 0;
    if (!S.next(0, cur)) return;
    f32x4 acc[2][2][4][2];
#pragma unroll
    for (int a = 0; a < 2; ++a)
#pragma unroll
        for (int b = 0; b < 2; ++b)
#pragma unroll
            for (int m = 0; m < 4; ++m)
#pragma unroll
                for (int n = 0; n < 2; ++n) acc[a][b][m][n] = (f32x4){0.f, 0.f, 0.f, 0.f};
    bf16x8 At[4][2], B0[2][2], B1[2][2];
    const char* cA = (const char*)g.A + (size_t)cur.pm * tstep + (Sched::SPLITK ? cur.kb : 0); const char* cB = (const char*)g.Bt + (size_t)cur.pn * tstep + (Sched::SPLITK ? cur.kb : 0);
    S.a_ready(cur);
    if constexpr (SP2) {
        PG8_STAGE(PG8_SB(0, 0), cB, voffB); PG8_STAGE(PG8_SB(0, 1), cB + hstep, voffB); PG8_STAGE(PG8_SA(0, 0), cA, voffA); PG8_STAGE(PG8_SA(0, 1), cA + hstep, voffA);
        if (wr == 1) PG8_BAR;
        PG8_WAIT_V(2); PG8_BAR;
        PG8_STAGE(PG8_SB(1, 0), cB + kstep, voffB); PG8_STAGE(PG8_SA(1, 0), cA + kstep, voffA); PG8_STAGE(PG8_SB(1, 1), cB + hstep + kstep, voffB);
        PG8_WAIT_V(6); PG8_BAR;
    } else {
        PG8_STAGE(PG8_SB(0, 0), cB, voffB); PG8_STAGE(PG8_SA(0, 0), cA, voffA); PG8_STAGE(PG8_SB(0, 1), cB + hstep, voffB); PG8_STAGE(PG8_SA(0, 1), cA + hstep, voffA);
        if (wr == 1) PG8_BAR;
        PG8_WAIT_V(4); PG8_BAR;
        PG8_STAGE(PG8_SB(1, 0), cB + kstep, voffB); PG8_STAGE(PG8_SA(1, 0), cA + kstep, voffA); PG8_STAGE(PG8_SB(1, 1), cB + hstep + kstep, voffB);
        PG8_WAIT_V(6); PG8_BAR;
    }
    for (;;) {
        const bool has_next = S.next(ui + 1, nxt);
        const char* nA = has_next ? (const char*)g.A + (size_t)nxt.pm * tstep + (Sched::SPLITK ? nxt.kb : 0) : cA; const char* nB = has_next ? (const char*)g.Bt + (size_t)nxt.pn * tstep + (Sched::SPLITK ? nxt.kb : 0) : cB;
        const int nt = Sched::SPLITK ? cur.nt : ntf;
        for (int t = 0; t < nt; t += 2) {
            const bool last = (t == nt - 2);
            const char* a1 = cA + (size_t)(t + 1) * kstep;
            const char* a2 = last ? nA : cA + (size_t)(t + 2) * kstep; const char* b2 = last ? nB : cB + (size_t)(t + 2) * kstep;
            const char* a3 = a2 + kstep; const char* b3 = b2 + kstep;
            if (last && has_next) S.a_ready(nxt);
            if constexpr (SP2) {
            PG8_LDB(B0, 0, 0); PG8_LDB(B1, 0, 1); PG8_SCHED; PG8_LDA(At, 0, 0); PG8_STAGE(PG8_SA(1, 1), a1 + hstep, voffA);
            PG8_WAIT_V(8); PG8_WAIT_L(0); PG8_BAR; PG8_MMA(0, 0, At, B0); PG8_MMA(0, 1, At, B1); PG8_BAR; PG8_SCHED;
            PG8_LDA(At, 0, 1); PG8_STAGE(PG8_SB(0, 0), b2, voffB); PG8_STAGE(PG8_SB(0, 1), b2 + hstep, voffB); PG8_STAGE(PG8_SA(0, 0), a2, voffA);
            PG8_WAIT_V(8); PG8_WAIT_L(0); PG8_BAR; PG8_MMA(1, 0, At, B0); PG8_MMA(1, 1, At, B1); PG8_BAR; PG8_SCHED;
            PG8_LDB(B0, 1, 0); PG8_LDB(B1, 1, 1); PG8_SCHED; PG8_LDA(At, 1, 0); PG8_STAGE(PG8_SA(0, 1), a2 + hstep, voffA);
            PG8_WAIT_V(8); PG8_WAIT_L(0); PG8_BAR; PG8_MMA(0, 0, At, B0); PG8_MMA(0, 1, At, B1); PG8_BAR; PG8_SCHED;
            PG8_LDA(At, 1, 1); PG8_STAGE(PG8_SB(1, 0), b3, voffB); PG8_STAGE(PG8_SB(1, 1), b3 + hstep, voffB); PG8_STAGE(PG8_SA(1, 0), a3, voffA);
            PG8_WAIT_V(8); PG8_WAIT_L(0); PG8_BAR; PG8_MMA(1, 0, At, B0); PG8_MMA(1, 1, At, B1); PG8_BAR; PG8_SCHED;
            } else {
            PG8_LDB(B0, 0, 0); PG8_SCHED; PG8_LDA(At, 0, 0); PG8_STAGE(PG8_SA(1, 1), a1 + hstep, voffA);
            PG8_WAIT_L(8); PG8_BAR; PG8_WAIT_L(0); PG8_MMA(0, 0, At, B0); PG8_BAR; PG8_SCHED;
            PG8_LDB(B1, 0, 1); PG8_STAGE(PG8_SB(0, 0), b2, voffB);
            PG8_BAR; PG8_WAIT_L(0); PG8_MMA(0, 1, At, B1); PG8_BAR;
            PG8_LDA(At, 0, 1); PG8_STAGE(PG8_SA(0, 0), a2, voffA);
            PG8_BAR; PG8_WAIT_L(0); PG8_MMA(1, 0, At, B0); PG8_BAR; PG8_SCHED;
            PG8_STAGE(PG8_SB(0, 1), b2 + hstep, voffB);
            PG8_WAIT_V(6); PG8_BAR; PG8_MMA(1, 1, At, B1); PG8_BAR;
            PG8_LDB(B0, 1, 0); PG8_SCHED; PG8_LDA(At, 1, 0); PG8_STAGE(PG8_SA(0, 1), a2 + hstep, voffA);
            PG8_WAIT_L(8); PG8_BAR; PG8_WAIT_L(0); PG8_MMA(0, 0, At, B0); PG8_BAR; PG8_SCHED;
            PG8_LDB(B1, 1, 1); PG8_STAGE(PG8_SB(1, 0), b3, voffB);
            PG8_BAR; PG8_WAIT_L(0); PG8_MMA(0, 1, At, B1); PG8_BAR;
            PG8_LDA(At, 1, 1); PG8_STAGE(PG8_SA(1, 0), a3, voffA);
            PG8_BAR; PG8_WAIT_L(0); PG8_MMA(1, 0, At, B0); PG8_BAR; PG8_SCHED;
            PG8_STAGE(PG8_SB(1, 1), b3 + hstep, voffB);
            PG8_WAIT_V(6); PG8_BAR; PG8_MMA(1, 1, At, B1); PG8_BAR;
            }
        }
        if constexpr (ALIGN_EPI) { if (wr == 0) PG8_BAR; }
        if constexpr (!Epi::AFTER_DRAIN) { E(acc, cur, wr, wc, fr, fq); S.done(cur); }
        if (!has_next) break;
#pragma unroll
        for (int a = 0; a < 2; ++a)
#pragma unroll
            for (int b = 0; b < 2; ++b)
#pragma unroll
                for (int m = 0; m < 4; ++m)
#pragma unroll
                    for (int n = 0; n < 2; ++n) acc[a][b][m][n] = (f32x4){0.f, 0.f, 0.f, 0.f};
        cur = nxt; cA = nA; cB = nB; ++ui;
        if constexpr (ALIGN_EPI) { if (wr == 1) PG8_BAR; }
    }
    PG8_WAIT_V(0);
    if constexpr (!ALIGN_EPI) { if (wr == 0) PG8_BAR; }
    PG8_BAR;
    if constexpr (Epi::AFTER_DRAIN) { E.fused(acc, cur, wr, wc, fr, fq, lds, wid, lane); S.done(cur); }
#undef PG8_SA
#undef PG8_SB
#undef PG8_STAGE
#undef PG8_LDA
#undef PG8_LDB
#undef PG8_MMA
#undef PG8_WAIT_V
#undef PG8_WAIT_L
#undef PG8_BAR
#undef PG8_SCHED
}
}

#ifndef PG8_SP2
#define PG8_SP2 true
#endif
#ifndef PG8_ALIGN
#define PG8_ALIGN true
#endif

namespace att {
using bf16 = unsigned short;
using bf16x8 = __attribute__((ext_vector_type(8))) short;
using s16x4  = __attribute__((ext_vector_type(4))) short;
using f32x16 = __attribute__((ext_vector_type(16))) float;
using u32x4  = __attribute__((ext_vector_type(4))) unsigned;
constexpr int NW = 8, QBLK = 32, KVBLK = 64, DV = 128;
constexpr float THR = 8.f;
constexpr int SHM_V = KVBLK * DV * 2;
constexpr int LDS_WS_OFF = 2 * SHM_V + 2 * (KVBLK * 128 * 2);
constexpr int LDS_BT_OFF = LDS_WS_OFF + NW * 64 * 4;
constexpr int LDS_Q_OFF = LDS_BT_OFF + 2048;
constexpr int LDS_END = LDS_Q_OFF + NW * 8192;
#define ATT_KSWZ128(row, colB) ((row) * 256 + ((colB) ^ (((row) & 7) << 4)))
#define ATT_KSWZ64(row, colB)  ((row) * 128 + ((colB) ^ ((((row) >> 1) & 7) << 4)))
#define ATT_SBAR() __builtin_amdgcn_sched_barrier(0)
__device__ __forceinline__ int crow(int r, int hi) { return (r & 3) + 8 * (r >> 2) + 4 * hi; }
__device__ __forceinline__ unsigned cvtpk(float lo, float hi) { unsigned r; asm volatile("v_cvt_pk_bf16_f32 %0, %1, %2" : "=v"(r) : "v"(lo), "v"(hi)); return r; }
__device__ __forceinline__ bf16x8 ld8(const bf16* p) { return *reinterpret_cast<const bf16x8*>(p); }

template <int DQK> __device__ __forceinline__ void partialSM(f32x16& p0, f32x16& p1, float& m_reg, float& mn, float& alpha) {
  constexpr float SCALE = (DQK == 64) ? 0.125f : 0.088388347648318440f;
  constexpr float C = SCALE * 1.4426950408889634f;
  float pmax = p0[0];
#pragma unroll
  for (int r = 1; r < 16; ++r) pmax = fmaxf(pmax, p0[r]);
#pragma unroll
  for (int r = 0; r < 16; ++r) pmax = fmaxf(pmax, p1[r]);
  { auto rr = __builtin_amdgcn_permlane32_swap(__float_as_uint(pmax), __float_as_uint(pmax), false, false);
    pmax = fmaxf(__uint_as_float(rr[0]), __uint_as_float(rr[1])); }
  if (__builtin_expect(__all(pmax - m_reg <= THR / SCALE), 1)) { mn = m_reg; alpha = 1.f; }
  else { mn = fmaxf(m_reg, pmax); alpha = __builtin_amdgcn_exp2f((m_reg - mn) * C); m_reg = mn; }
  float mnC = -mn * C;
#pragma unroll
  for (int r = 0; r < 16; ++r) p0[r] = fmaf(p0[r], C, mnC);
#pragma unroll
  for (int r = 0; r < 16; ++r) p1[r] = fmaf(p1[r], C, mnC);
#pragma unroll
  for (int r = 0; r < 16; ++r) p0[r] = __builtin_amdgcn_exp2f(p0[r]);
}
__device__ __forceinline__ void finishSM(f32x16& p0, f32x16& p1, float alpha, float& l_reg, bf16x8& pa0, bf16x8& pa1, bf16x8& pa2, bf16x8& pa3) {
#pragma unroll
  for (int r = 0; r < 16; ++r) p1[r] = __builtin_amdgcn_exp2f(p1[r]);
  float ps = 0;
#pragma unroll
  for (int r = 0; r < 16; ++r) ps += p0[r];
#pragma unroll
  for (int r = 0; r < 16; ++r) ps += p1[r];
  { auto rr = __builtin_amdgcn_permlane32_swap(__float_as_uint(ps), __float_as_uint(ps), false, false);
    ps = __uint_as_float(rr[0]) + __uint_as_float(rr[1]); }
  l_reg = l_reg * alpha + ps;
#define ATT_PK4(P, BASE, OUT) do { unsigned a0 = cvtpk(P[BASE + 0], P[BASE + 1]), a1 = cvtpk(P[BASE + 2], P[BASE + 3]);   \
    unsigned b0 = cvtpk(P[BASE + 4], P[BASE + 5]), b1 = cvtpk(P[BASE + 6], P[BASE + 7]);                              \
    auto r0 = __builtin_amdgcn_permlane32_swap(a0, b0, false, false); auto r1 = __builtin_amdgcn_permlane32_swap(a1, b1, false, false); \
    u32x4 w = {r0[0], r1[0], r0[1], r1[1]}; OUT = *reinterpret_cast<bf16x8*>(&w); } while (0)
  ATT_PK4(p0, 0, pa0); ATT_PK4(p0, 8, pa1); ATT_PK4(p1, 0, pa2); ATT_PK4(p1, 8, pa3);
#undef ATT_PK4
}
__device__ __forceinline__ void expSM(f32x16& p) {
#pragma unroll
  for (int r = 0; r < 16; ++r) p[r] = __builtin_amdgcn_exp2f(p[r]);
}
__device__ __forceinline__ void packSM(f32x16& p0, f32x16& p1, float& l_reg, bf16x8& pa0, bf16x8& pa1, bf16x8& pa2, bf16x8& pa3) {
  float ps = 0;
#pragma unroll
  for (int r = 0; r < 16; ++r) ps += p0[r];
#pragma unroll
  for (int r = 0; r < 16; ++r) ps += p1[r];
  l_reg += ps; asm volatile("" : "+v"(l_reg));
#define ATT_PK4(P, BASE, OUT) do { unsigned a0 = cvtpk(P[BASE + 0], P[BASE + 1]), a1 = cvtpk(P[BASE + 2], P[BASE + 3]);   \
    unsigned b0 = cvtpk(P[BASE + 4], P[BASE + 5]), b1 = cvtpk(P[BASE + 6], P[BASE + 7]);                              \
    auto r0 = __builtin_amdgcn_permlane32_swap(a0, b0, false, false); auto r1 = __builtin_amdgcn_permlane32_swap(a1, b1, false, false); \
    u32x4 w = {r0[0], r1[0], r0[1], r1[1]}; OUT = *reinterpret_cast<bf16x8*>(&w); } while (0)
  ATT_PK4(p0, 0, pa0); ATT_PK4(p0, 8, pa1); ATT_PK4(p1, 0, pa2); ATT_PK4(p1, 8, pa3);
#undef ATT_PK4
}
__device__ __forceinline__ void finishSM_nm(f32x16& p0, f32x16& p1, float& l_reg, bf16x8& pa0, bf16x8& pa1, bf16x8& pa2, bf16x8& pa3) {
#pragma unroll
  for (int r = 0; r < 16; ++r) p1[r] = __builtin_amdgcn_exp2f(p1[r]);
  float ps = 0;
#pragma unroll
  for (int r = 0; r < 16; ++r) ps += p0[r];
#pragma unroll
  for (int r = 0; r < 16; ++r) ps += p1[r];
  { auto rr = __builtin_amdgcn_permlane32_swap(__float_as_uint(ps), __float_as_uint(ps), false, false);
    ps = __uint_as_float(rr[0]) + __uint_as_float(rr[1]); }
  l_reg += ps;
#define ATT_PK4(P, BASE, OUT) do { unsigned a0 = cvtpk(P[BASE + 0], P[BASE + 1]), a1 = cvtpk(P[BASE + 2], P[BASE + 3]);   \
    unsigned b0 = cvtpk(P[BASE + 4], P[BASE + 5]), b1 = cvtpk(P[BASE + 6], P[BASE + 7]);                              \
    auto r0 = __builtin_amdgcn_permlane32_swap(a0, b0, false, false); auto r1 = __builtin_amdgcn_permlane32_swap(a1, b1, false, false); \
    u32x4 w = {r0[0], r1[0], r0[1], r1[1]}; OUT = *reinterpret_cast<bf16x8*>(&w); } while (0)
  ATT_PK4(p0, 0, pa0); ATT_PK4(p0, 8, pa1); ATT_PK4(p1, 0, pa2); ATT_PK4(p1, 8, pa3);
#undef ATT_PK4
}
__device__ __forceinline__ void finish_l(float l_reg, float* li_l, int r32, int hi, float (&rli)[16]) {
  { auto rr = __builtin_amdgcn_permlane32_swap(__float_as_uint(l_reg), __float_as_uint(l_reg), false, false); l_reg = __uint_as_float(rr[0]) + __uint_as_float(rr[1]); }
  if (hi == 0) li_l[r32] = l_reg; asm volatile("s_waitcnt lgkmcnt(0)" ::: "memory");
#pragma unroll
  for (int r = 0; r < 16; ++r) rli[r] = __builtin_amdgcn_rcpf(li_l[crow(r, hi)]);
}
template <int DQK, bool QLDS, int KW> __device__ __forceinline__ void qkt(f32x16& p0, f32x16& p1, const char* Ks, const bf16x8* qr, const char* Qs, int r32, int hi, int kcb) {
  p0 = f32x16{}; p1 = f32x16{};
#pragma unroll
  for (int d0 = 0; d0 < DQK / 16; ++d0) { const int cb = (d0 * 16 + hi * 8) * 2;
    bf16x8 b0, b1, qv;
    if constexpr (QLDS) qv = *reinterpret_cast<const bf16x8*>(Qs + ATT_KSWZ128(r32, cb)); else qv = qr[d0];
    if constexpr (KW == 128) { b0 = *reinterpret_cast<const bf16x8*>(Ks + ATT_KSWZ128(r32, kcb + cb)); b1 = *reinterpret_cast<const bf16x8*>(Ks + ATT_KSWZ128(32 + r32, kcb + cb)); }
    else                      { b0 = *reinterpret_cast<const bf16x8*>(Ks + ATT_KSWZ64(r32, cb));  b1 = *reinterpret_cast<const bf16x8*>(Ks + ATT_KSWZ64(32 + r32, cb)); }
    p0 = __builtin_amdgcn_mfma_f32_32x32x16_bf16(b0, qv, p0, 0, 0, 0);
    p1 = __builtin_amdgcn_mfma_f32_32x32x16_bf16(b1, qv, p1, 0, 0, 0); }
}
__device__ __forceinline__ int v_st(int k, int c) { const int kk = (k & ~0xC) | ((k & 4) << 1) | ((k & 8) >> 1); return ((kk >> 3) * 4 + (c >> 5)) * 512 + ((kk & 7) * 32 + (c & 31)) * 2; }
__device__ __forceinline__ int v_rd_base(int lane) { return ((lane & 3) << 3) | (((lane >> 2) & 3) << 6) | (((lane >> 4) & 1) << 5) | (((lane >> 5) & 1) << 8); }
constexpr int v_rd_off(int d0, int ks, int half) { return d0 * 512 + ks * 4096 + half * 2048; }
template <int OFF> __device__ __forceinline__ s16x4 tr_read(int vb) {
  s16x4 r; asm volatile("ds_read_b64_tr_b16 %0, %1 offset:%2" : "=&v"(r) : "v"(vb), "i"(OFF) : "memory"); return r;
}
template <int D0> __device__ __forceinline__ void pv_one(f32x16& od, int vb, bf16x8 pa0, bf16x8 pa1, bf16x8 pa2, bf16x8 pa3) {
  const s16x4 l0 = tr_read<v_rd_off(D0, 0, 0)>(vb), h0 = tr_read<v_rd_off(D0, 0, 1)>(vb), l1 = tr_read<v_rd_off(D0, 1, 0)>(vb), h1 = tr_read<v_rd_off(D0, 1, 1)>(vb);
  const s16x4 l2 = tr_read<v_rd_off(D0, 2, 0)>(vb), h2 = tr_read<v_rd_off(D0, 2, 1)>(vb), l3 = tr_read<v_rd_off(D0, 3, 0)>(vb), h3 = tr_read<v_rd_off(D0, 3, 1)>(vb);
  asm volatile("s_waitcnt lgkmcnt(0)" ::: "memory"); ATT_SBAR();
#define ATT_PK(L, H) (bf16x8){L[0], L[1], L[2], L[3], H[0], H[1], H[2], H[3]}
  od = __builtin_amdgcn_mfma_f32_32x32x16_bf16(pa0, ATT_PK(l0, h0), od, 0, 0, 0);
  od = __builtin_amdgcn_mfma_f32_32x32x16_bf16(pa1, ATT_PK(l1, h1), od, 0, 0, 0);
  od = __builtin_amdgcn_mfma_f32_32x32x16_bf16(pa2, ATT_PK(l2, h2), od, 0, 0, 0);
  od = __builtin_amdgcn_mfma_f32_32x32x16_bf16(pa3, ATT_PK(l3, h3), od, 0, 0, 0);
#undef ATT_PK
}
__device__ __forceinline__ void pv_d0(f32x16* o, int vb, bf16x8 pa0, bf16x8 pa1, bf16x8 pa2, bf16x8 pa3) {
  pv_one<0>(o[0], vb, pa0, pa1, pa2, pa3); pv_one<1>(o[1], vb, pa0, pa1, pa2, pa3); pv_one<2>(o[2], vb, pa0, pa1, pa2, pa3); pv_one<3>(o[3], vb, pa0, pa1, pa2, pa3);
}

#define ATT_TR8(D0, A) do { A##0 = tr_read<v_rd_off(D0, 0, 0)>(vb); A##1 = tr_read<v_rd_off(D0, 0, 1)>(vb); A##2 = tr_read<v_rd_off(D0, 1, 0)>(vb); A##3 = tr_read<v_rd_off(D0, 1, 1)>(vb); \
    A##4 = tr_read<v_rd_off(D0, 2, 0)>(vb); A##5 = tr_read<v_rd_off(D0, 2, 1)>(vb); A##6 = tr_read<v_rd_off(D0, 3, 0)>(vb); A##7 = tr_read<v_rd_off(D0, 3, 1)>(vb); } while (0)
#define ATT_PK2(L, H) (bf16x8){L[0], L[1], L[2], L[3], H[0], H[1], H[2], H[3]}
#define ATT_MM4(OD, A) do { OD = __builtin_amdgcn_mfma_f32_32x32x16_bf16(pa0, ATT_PK2(A##0, A##1), OD, 0, 0, 0); OD = __builtin_amdgcn_mfma_f32_32x32x16_bf16(pa1, ATT_PK2(A##2, A##3), OD, 0, 0, 0); \
    OD = __builtin_amdgcn_mfma_f32_32x32x16_bf16(pa2, ATT_PK2(A##4, A##5), OD, 0, 0, 0); OD = __builtin_amdgcn_mfma_f32_32x32x16_bf16(pa3, ATT_PK2(A##6, A##7), OD, 0, 0, 0); } while (0)
struct VFrag { s16x4 a0, a1, a2, a3, a4, a5, a6, a7, b0, b1, b2, b3, b4, b5, b6, b7; };
__device__ __forceinline__ void pv_issue(VFrag& f, int vb) { ATT_TR8(0, f.a); ATT_TR8(1, f.b); }
__device__ __forceinline__ void pv_pipe(VFrag& f, f32x16* o, int vb, bf16x8 pa0, bf16x8 pa1, bf16x8 pa2, bf16x8 pa3) {
  asm volatile("s_waitcnt lgkmcnt(0)" ::: "memory"); ATT_SBAR(); ATT_MM4(o[0], f.a);
  ATT_SBAR(); ATT_TR8(2, f.a); ATT_SBAR(); ATT_MM4(o[1], f.b);
  ATT_SBAR(); ATT_TR8(3, f.b);
  asm volatile("s_waitcnt lgkmcnt(8)" ::: "memory"); ATT_SBAR(); ATT_MM4(o[2], f.a);
  asm volatile("s_waitcnt lgkmcnt(0)" ::: "memory"); ATT_SBAR(); ATT_MM4(o[3], f.b);
}

struct NoMask { __device__ __forceinline__ void operator()(f32x16&, f32x16&, int) const {} __device__ __forceinline__ bool skip(int) const { return false; } };

template <int DQK, int LDQ, int LDQ2, int LDKV, int SDEPTH, bool DUAL, bool NOMAX, class TileRow, class Mask>
__device__ __forceinline__ void attn_core(const bf16* __restrict__ Qa, const bf16* __restrict__ Qalt, int nswitch,
                                          const bf16* __restrict__ Kb, const bf16* __restrict__ Vb,
                                          const TileRow& trow, const int NT, const Mask& mask, char* lds, f32x16 (&o)[4], float (&rli)[16]) {
  static_assert(!DUAL || DQK == 64, "DUAL is the differential-attention form");
  constexpr int KW = DUAL ? 128 : DQK;
  constexpr int SHM_K = KVBLK * KW * 2;
  constexpr int NQ = DQK / 16;
  int tid_ = threadIdx.x; asm volatile("" : "+v"(tid_));
  const int tid = tid_, wid = tid >> 6, lane = tid & 63, r32 = lane & 31, hi = lane >> 5;
  const int wq = DUAL ? (wid & 3) : wid, comp = DUAL ? (wid >> 2) : 0, kcb = comp * 128;
  char* V_lds = lds; char* K_lds = lds + 2 * SHM_V;
  float* wsf = (float*)(lds + LDS_WS_OFF) + wid * 64; float* li_l = wsf; float* al_l = wsf + 32;
  float m_reg = -1e30f, l_reg = 0;
#pragma unroll
  for (int d = 0; d < 4; ++d) o[d] = f32x16{};
  constexpr bool QLDS = (DQK == 128);
  char* Qs = lds + LDS_Q_OFF + wid * 8192;
  bf16x8 qr[NQ];
  { const bf16* Qw = Qa + (long)(wq * QBLK + r32) * LDQ + comp * 64 + hi * 8;
#pragma unroll
    for (int d0 = 0; d0 < NQ; ++d0) qr[d0] = ld8(Qw + d0 * 16);
    if constexpr (QLDS) {
#pragma unroll
      for (int d0 = 0; d0 < NQ; ++d0) *reinterpret_cast<bf16x8*>(Qs + ATT_KSWZ128(r32, (d0 * 16 + hi * 8) * 2)) = qr[d0];
      asm volatile("s_waitcnt lgkmcnt(0)" ::: "memory"); } }
  const int sr = tid >> 4, sc = (tid & 15) * 8, vst0 = v_st(sr, sc), vst1 = v_st(32 + sr, sc);
  const int k64r = tid >> 3, k64c = (tid & 7) * 8;
  const unsigned voffV = (unsigned)(sr * LDKV + sc) * 2u, voffK = (KW == 128) ? voffV : (unsigned)(k64r * LDKV + k64c) * 2u;
  const int vb0 = (int)(unsigned)(uintptr_t)V_lds + v_rd_base(lane);
  struct { bf16x8 vs0, vs1, ks0, ks1; } sr_[SDEPTH];
#define ATT_SLOAD(i, jt) do { const long row0_ = (long)__builtin_amdgcn_readfirstlane(trow(jt)); const char* vt_ = (const char*)(Vb + row0_ * LDKV); const char* kt_ = (const char*)(Kb + row0_ * LDKV); \
    sr_[i].vs0 = *(const bf16x8*)(vt_ + voffV); sr_[i].vs1 = *(const bf16x8*)(vt_ + 64 * LDKV + voffV); \
    if constexpr (KW == 128) { sr_[i].ks0 = *(const bf16x8*)(kt_ + voffK); sr_[i].ks1 = *(const bf16x8*)(kt_ + 64 * LDKV + voffK); } \
    else { sr_[i].ks0 = *(const bf16x8*)(kt_ + voffK); } } while (0)
#define ATT_SWRITE(b, i) do { *(bf16x8*)(V_lds + (b) * SHM_V + vst0) = sr_[i].vs0; *(bf16x8*)(V_lds + (b) * SHM_V + vst1) = sr_[i].vs1; \
    if constexpr (KW == 128) { const int kc_ = sc * 2; *(bf16x8*)(K_lds + (b) * SHM_K + ATT_KSWZ128(sr, kc_)) = sr_[i].ks0; *(bf16x8*)(K_lds + (b) * SHM_K + ATT_KSWZ128(32 + sr, kc_)) = sr_[i].ks1; } \
    else { *(bf16x8*)(K_lds + (b) * SHM_K + ATT_KSWZ64(k64r, k64c * 2)) = sr_[i].ks0; } } while (0)
#define ATT_SWAIT() do { if constexpr (SDEPTH == 1) asm volatile("s_waitcnt vmcnt(0)" ::: "memory"); else if constexpr (KW == 128) asm volatile("s_waitcnt vmcnt(4)" ::: "memory"); else asm volatile("s_waitcnt vmcnt(3)" ::: "memory"); } while (0)
#define ATT_RESC(a) do { if (__any((a) < 1.f)) { if (hi == 0) al_l[r32] = (a); asm volatile("s_waitcnt lgkmcnt(0)" ::: "memory"); \
    _Pragma("unroll") for (int d = 0; d < 4; ++d) _Pragma("unroll") for (int r = 0; r < 16; ++r) o[d][r] *= al_l[crow(r, hi)]; } } while (0)
  f32x16 pA0, pA1, pB0, pB1; float mnA, mnB, alA, alB; bf16x8 pa0, pa1, pa2, pa3;
  constexpr int SE = 0, SO = SDEPTH - 1;
  ATT_SLOAD(SE, 0); asm volatile("s_waitcnt vmcnt(0)" ::: "memory"); ATT_SWRITE(0, SE); __syncthreads();
  bool sA = mask.skip(0), sB = false;
  if (!sA) { qkt<DQK, QLDS, KW>(pA0, pA1, K_lds, qr, Qs, r32, hi, kcb); mask(pA0, pA1, 0); if constexpr (NOMAX) { expSM(pA0); alA = 1.f; } else partialSM<DQK>(pA0, pA1, m_reg, mnA, alA); } else alA = 1.f;
  ATT_SLOAD(SO, 1); if constexpr (SDEPTH == 2) { if (2 < NT) ATT_SLOAD(SE, 2); }
  ATT_SWAIT(); ATT_SWRITE(1, SO); __syncthreads();
  for (int j = 1; j + 1 < NT; j += 2) {
    sB = mask.skip(j);
    ATT_SBAR(); if (!sB) qkt<DQK, QLDS, KW>(pB0, pB1, K_lds + SHM_K, qr, Qs, r32, hi, kcb);
    if (!sA) if constexpr (NOMAX) finishSM_nm(pA0, pA1, l_reg, pa0, pa1, pa2, pa3); else finishSM(pA0, pA1, alA, l_reg, pa0, pa1, pa2, pa3); ATT_SBAR();
    ATT_SLOAD(SO, j + SDEPTH); ATT_SBAR();
    if (!sA) pv_d0(o, vb0, pa0, pa1, pa2, pa3);
    if (!sB) { mask(pB0, pB1, j); if constexpr (NOMAX) { expSM(pB0); alB = 1.f; } else partialSM<DQK>(pB0, pB1, m_reg, mnB, alB); } else alB = 1.f;
    __syncthreads(); ATT_SWAIT(); ATT_SWRITE(0, SE);
    ATT_RESC(alB); __syncthreads();
    if constexpr (DQK == 64) { if (j + 1 == nswitch) { const bf16* Qw = Qalt + (long)(wq * QBLK + r32) * LDQ2 + comp * 64 + hi * 8;
#pragma unroll
        for (int d0 = 0; d0 < NQ; ++d0) qr[d0] = ld8(Qw + d0 * 16); } }
    sA = mask.skip(j + 1);
    ATT_SBAR(); if (!sA) qkt<DQK, QLDS, KW>(pA0, pA1, K_lds, qr, Qs, r32, hi, kcb);
    if (!sB) if constexpr (NOMAX) finishSM_nm(pB0, pB1, l_reg, pa0, pa1, pa2, pa3); else finishSM(pB0, pB1, alB, l_reg, pa0, pa1, pa2, pa3); ATT_SBAR();
    if (SDEPTH == 1 || j + 3 < NT) ATT_SLOAD(SE, j + 1 + SDEPTH); ATT_SBAR();
    if (!sB) pv_d0(o, vb0 + SHM_V, pa0, pa1, pa2, pa3);
    if (!sA) { mask(pA0, pA1, j + 1); if constexpr (NOMAX) { expSM(pA0); alA = 1.f; } else partialSM<DQK>(pA0, pA1, m_reg, mnA, alA); } else alA = 1.f;
    __syncthreads(); ATT_SWAIT(); ATT_SWRITE(1, SO);
    ATT_RESC(alA); __syncthreads();
  }
  sB = mask.skip(NT - 1);
  ATT_SBAR(); if (!sB) qkt<DQK, QLDS, KW>(pB0, pB1, K_lds + SHM_K, qr, Qs, r32, hi, kcb);
  if (!sA) if constexpr (NOMAX) finishSM_nm(pA0, pA1, l_reg, pa0, pa1, pa2, pa3); else finishSM(pA0, pA1, alA, l_reg, pa0, pa1, pa2, pa3); ATT_SBAR();
  if (!sA) pv_d0(o, vb0, pa0, pa1, pa2, pa3);
  if (!sB) { mask(pB0, pB1, NT - 1); if constexpr (NOMAX) { expSM(pB0); alB = 1.f; } else partialSM<DQK>(pB0, pB1, m_reg, mnB, alB); } else alB = 1.f;
  __syncthreads(); ATT_RESC(alB);
  if (!sB) { if constexpr (NOMAX) finishSM_nm(pB0, pB1, l_reg, pa0, pa1, pa2, pa3); else finishSM(pB0, pB1, alB, l_reg, pa0, pa1, pa2, pa3); ATT_SBAR();
  pv_d0(o, vb0 + SHM_V, pa0, pa1, pa2, pa3); }
  if (hi == 0) li_l[r32] = l_reg; asm volatile("s_waitcnt lgkmcnt(0)" ::: "memory");
#pragma unroll
  for (int r = 0; r < 16; ++r) rli[r] = __builtin_amdgcn_rcpf(li_l[crow(r, hi)]);
#undef ATT_SLOAD
#undef ATT_SWRITE
#undef ATT_SWAIT
#undef ATT_RESC
}

#if STAMP && STAMP < 6
__device__ __forceinline__ unsigned stamp_lo() { unsigned long long t; __builtin_amdgcn_sched_barrier(0); asm volatile("s_memtime %0\n\ts_waitcnt lgkmcnt(0)" : "=s"(t) :: "memory"); __builtin_amdgcn_sched_barrier(0); return (unsigned)t; }
#endif
constexpr int DS_V = 0, DS_K = 3 * 16384, DS_WS = 6 * 16384, DS_Q = DS_WS + NW * 64 * 4, DS_END = DS_Q + NW * 4096;
template <int OFF> __device__ __forceinline__ bf16x8 lds_rd128(int addr) { bf16x8 r; asm volatile("ds_read_b128 %0, %1 offset:%2" : "=&v"(r) : "v"(addr), "i"(OFF) : "memory"); return r; }
template <int LDQ, int LDQ2, int LDKV, class TileRow>
__device__ __forceinline__ void attn_dual_stag(const bf16* __restrict__ Qa, const bf16* __restrict__ Qalt, int nswitch,
                                               const bf16* __restrict__ Kb, const bf16* __restrict__ Vb,
                                               const TileRow& trow, const int NT, char* lds, f32x16 (&o)[4], float (&rli)[16], unsigned& sacc) {
  int tid_ = threadIdx.x; asm volatile("" : "+v"(tid_));
  const int tid = tid_, wid = tid >> 6, lane = tid & 63, r32 = lane & 31, hi = lane >> 5;
  const int wq = wid & 3, g = __builtin_amdgcn_readfirstlane(wid >> 2), kcb = g * 128;
  char* V_lds = lds + DS_V; char* K_lds = lds + DS_K;
  float* wsf = (float*)(lds + DS_WS) + wid * 64; float* li_l = wsf;
  float l_reg = 0;
#pragma unroll
  for (int d = 0; d < 4; ++d) o[d] = f32x16{};
  bf16x8 qr[4];
  char* Qsw = lds + DS_Q + wid * 4096 + lane * 16;
  { const bf16* Qw = Qa + (long)(wq * QBLK + r32) * LDQ + g * 64 + hi * 8;
    const bf16* Qw2 = Qalt + (long)(wq * QBLK + r32) * LDQ2 + g * 64 + hi * 8;
#pragma unroll
    for (int d0 = 0; d0 < 4; ++d0) { qr[d0] = ld8(Qw + d0 * 16); *(bf16x8*)(Qsw + d0 * 1024) = ld8(Qw2 + d0 * 16); } }
  const int tg = tid & 255, sr = 32 * g + (tg >> 4), sc = (tg & 15) * 8;
  const int vst0 = v_st(sr, sc), vst1 = v_st(sr + 16, sc), kst0 = ATT_KSWZ128(sr, sc * 2), kst1 = ATT_KSWZ128(sr + 16, sc * 2);
  const unsigned voff = (unsigned)(sr * LDKV + sc) * 2u;
  const bf16* kbu = (const bf16*)(((unsigned long long)(unsigned)__builtin_amdgcn_readfirstlane((int)((unsigned long long)Kb >> 32)) << 32) | (unsigned)__builtin_amdgcn_readfirstlane((int)(unsigned long long)Kb));
  const int vdelta = __builtin_amdgcn_readfirstlane((int)((const char*)Vb - (const char*)Kb));
  const __amdgpu_buffer_rsrc_t kvrs = __builtin_amdgcn_make_buffer_rsrc((void*)kbu, 0, 0x7fffffff, 0x00020000);
  const int vb0 = (int)(unsigned)(uintptr_t)V_lds + v_rd_base(lane);
  const int kb0 = (int)(unsigned)(uintptr_t)K_lds;
  const int ka0 = kb0 + ATT_KSWZ128(r32, kcb + (0 * 16 + hi * 8) * 2), ka1 = kb0 + ATT_KSWZ128(r32, kcb + (1 * 16 + hi * 8) * 2);
  const int ka2 = kb0 + ATT_KSWZ128(r32, kcb + (2 * 16 + hi * 8) * 2), ka3 = kb0 + ATT_KSWZ128(r32, kcb + (3 * 16 + hi * 8) * 2);
  bf16x8 svA0, svA1, skA0, skA1, svB0, svB1, skB0, skB1;
#define DS_BL(dst, so) asm volatile("buffer_load_dwordx4 %0, %1, %2, %3 offen" : "=v"(dst) : "v"(voff), "s"(kvrs), "s"(so))
#define DS_SLOAD(S, jt) do { const int so_ = __builtin_amdgcn_readfirstlane(trow(jt)) * (LDKV * 2);   \
      \
    DS_BL(sk##S##0, so_); DS_BL(sk##S##1, so_ + 32 * LDKV); DS_BL(sv##S##0, so_ + vdelta); DS_BL(sv##S##1, so_ + vdelta + 32 * LDKV); } while (0)
#define DS_VMW(n) asm volatile("s_waitcnt vmcnt(" #n ")" ::: "memory")
#define DS_SWRITE(S, slot) do { const int so_ = (slot) * 16384; *(bf16x8*)(V_lds + so_ + vst0) = sv##S##0; *(bf16x8*)(V_lds + so_ + vst1) = sv##S##1; *(bf16x8*)(K_lds + so_ + kst0) = sk##S##0; *(bf16x8*)(K_lds + so_ + kst1) = sk##S##1; } while (0)
#define DS_BAR() do { ATT_SBAR(); asm volatile("s_waitcnt lgkmcnt(0)\n\ts_barrier" ::: "memory"); ATT_SBAR(); } while (0)
#if STAMP == 2 || STAMP == 3
#define DS_BARL() do { const unsigned t0_ = stamp_lo(); DS_BAR(); const unsigned t1_ = stamp_lo(); sacc += t1_ - t0_; } while (0)
#else
#define DS_BARL() DS_BAR()
#endif
#if STAMP == 4 || STAMP == 5
#define DS_STAMP(v) do { if (g == 0) v = stamp_lo(); } while (0)
#else
#define DS_STAMP(v) (void)0
#endif
#define DS_LGKM(n) asm volatile("s_waitcnt lgkmcnt(" #n ")" ::: "memory")
#define DS_KREADS(so) do { const int o_ = (so); kf0 = lds_rd128<0>(ka0 + o_); kf1 = lds_rd128<8192>(ka0 + o_); kf2 = lds_rd128<0>(ka1 + o_); kf3 = lds_rd128<8192>(ka1 + o_); \
    kf4 = lds_rd128<0>(ka2 + o_); kf5 = lds_rd128<8192>(ka2 + o_); kf6 = lds_rd128<0>(ka3 + o_); kf7 = lds_rd128<8192>(ka3 + o_); } while (0)
#define DS_QK() do { p0 = f32x16{}; p1 = f32x16{}; \
    p0 = __builtin_amdgcn_mfma_f32_32x32x16_bf16(kf0, qr[0], p0, 0, 0, 0); p1 = __builtin_amdgcn_mfma_f32_32x32x16_bf16(kf1, qr[0], p1, 0, 0, 0); \
    p0 = __builtin_amdgcn_mfma_f32_32x32x16_bf16(kf2, qr[1], p0, 0, 0, 0); p1 = __builtin_amdgcn_mfma_f32_32x32x16_bf16(kf3, qr[1], p1, 0, 0, 0); \
    p0 = __builtin_amdgcn_mfma_f32_32x32x16_bf16(kf4, qr[2], p0, 0, 0, 0); p1 = __builtin_amdgcn_mfma_f32_32x32x16_bf16(kf5, qr[2], p1, 0, 0, 0); \
    p0 = __builtin_amdgcn_mfma_f32_32x32x16_bf16(kf6, qr[3], p0, 0, 0, 0); p1 = __builtin_amdgcn_mfma_f32_32x32x16_bf16(kf7, qr[3], p1, 0, 0, 0); } while (0)
#define DS_QKA() do { p0 = f32x16{}; p1 = f32x16{}; \
    p0 = __builtin_amdgcn_mfma_f32_32x32x16_bf16(kf0, qr[0], p0, 0, 0, 0); p1 = __builtin_amdgcn_mfma_f32_32x32x16_bf16(kf1, qr[0], p1, 0, 0, 0); \
    p0 = __builtin_amdgcn_mfma_f32_32x32x16_bf16(kf2, qr[1], p0, 0, 0, 0); p1 = __builtin_amdgcn_mfma_f32_32x32x16_bf16(kf3, qr[1], p1, 0, 0, 0); } while (0)
#define DS_QKB() do { \
    p0 = __builtin_amdgcn_mfma_f32_32x32x16_bf16(kf4, qr[2], p0, 0, 0, 0); p1 = __builtin_amdgcn_mfma_f32_32x32x16_bf16(kf5, qr[2], p1, 0, 0, 0); \
    p0 = __builtin_amdgcn_mfma_f32_32x32x16_bf16(kf6, qr[3], p0, 0, 0, 0); p1 = __builtin_amdgcn_mfma_f32_32x32x16_bf16(kf7, qr[3], p1, 0, 0, 0); } while (0)
  DS_SLOAD(A, 0); DS_SLOAD(B, 1); DS_VMW(0); DS_SWRITE(A, 0); DS_SWRITE(B, 1);
  if (g == 1 && 2 < NT) DS_SLOAD(A, 2);
  DS_BAR();
  f32x16 p0, p1; bf16x8 pa0, pa1, pa2, pa3; bf16x8 kf0, kf1, kf2, kf3, kf4, kf5, kf6, kf7;
  if (2 + g < NT) DS_SLOAD(B, 2 + g);
  ATT_SBAR(); DS_KREADS(0); DS_LGKM(0); ATT_SBAR(); DS_QK();
  if (g == 1) DS_BAR();
  int s0 = 0, s1 = 1;
#define DS_TILE(S, k_) do { unsigned ts0_ = 0, ts1_ = 0, ts2_ = 0; DS_STAMP(ts0_); \
    expSM(p0); expSM(p1); packSM(p0, p1, l_reg, pa0, pa1, pa2, pa3); \
    { const int jt = (k_) + 1 + g; if (jt >= 2 && jt < NT) { if (jt + 1 < NT) DS_VMW(4); else DS_VMW(0); int sl = s1 + g; sl = sl >= 3 ? sl - 3 : sl; DS_SWRITE(S, sl); } } \
    const int vb = vb0 + s0 * 16384; VFrag f; \
    ATT_SBAR(); ATT_TR8(0, f.a); ATT_TR8(1, f.b); ATT_SBAR(); \
    DS_STAMP(ts1_); if (g == 0) DS_BARL(); DS_STAMP(ts2_); \
    { const int jt = (k_) + 3 + g; if (jt < NT) DS_SLOAD(S, jt); } \
    if ((k_) + 1 == nswitch) { \
      const int qa_ = (int)(unsigned)(uintptr_t)Qsw; qr[0] = lds_rd128<0>(qa_); qr[1] = lds_rd128<1024>(qa_); qr[2] = lds_rd128<2048>(qa_); qr[3] = lds_rd128<3072>(qa_);   \
      asm volatile("s_waitcnt lgkmcnt(0)" ::: "memory"); } \
    ATT_SBAR(); \
    __builtin_amdgcn_s_setprio(1); DS_KREADS(s1 * 16384); \
    DS_LGKM(8); ATT_SBAR(); ATT_MM4(o[0], f.a); ATT_SBAR(); ATT_TR8(2, f.a); ATT_SBAR(); ATT_MM4(o[1], f.b); \
    ATT_SBAR(); DS_LGKM(8); ATT_SBAR();                  \
    if ((k_) + 1 < NT) { DS_QKA(); DS_QKB(); } \
    ATT_SBAR(); ATT_TR8(3, f.b); \
    ATT_SBAR(); DS_LGKM(8); ATT_SBAR(); ATT_MM4(o[2], f.a); \
    ATT_SBAR(); DS_LGKM(0); ATT_SBAR(); ATT_MM4(o[3], f.b); __builtin_amdgcn_s_setprio(0); \
    { unsigned ts3_ = 0; DS_STAMP(ts3_); if (STAMP == 4 && g == 0) sacc += ts3_ - ts2_; if (STAMP == 5 && g == 0) sacc += ts1_ - ts0_; } \
    if (g == 1 && (k_) + 1 < NT) DS_BARL(); \
    s0 = s1; s1 = s1 == 2 ? 0 : s1 + 1; } while (0)
#if STAMP == 42
  const unsigned tl0_ = (unsigned)__builtin_amdgcn_s_memrealtime();
#endif
#pragma clang loop unroll(disable)
  for (int k = 0; k < NT; k += 2) { DS_TILE(A, k); DS_TILE(B, k + 1); }
#if STAMP == 42
  { const unsigned tl1_ = (unsigned)__builtin_amdgcn_s_memrealtime(); if (tid == 0) *(volatile unsigned*)(lds + 143360 + 64) += tl1_ - tl0_; }
#endif
#undef DS_TILE
  finish_l(l_reg, li_l, r32, hi, rli);
#undef DS_SLOAD
#undef DS_BL
#undef DS_VMW
#undef DS_SWRITE
#undef DS_BAR
#undef DS_LGKM
#undef DS_BARL
#undef DS_STAMP
#undef DS_KREADS
#undef DS_QK
#undef DS_QKA
#undef DS_QKB
}
}

constexpr int DM = 2048, NBATCH = 2, SEQ = 8192, DEPTH = 4, CTXL = 256;
constexpr int ML = NBATCH * SEQ;
constexpr int MC = NBATCH * CTXL;
constexpr int MT = ML + MC;
constexpr int EV_IN = 5120;
constexpr int EVN = 4608 + 1024;
constexpr int ODN = 6144;
constexpr int FH = 5632;
constexpr int NPH = 1 + 8 * DEPTH;
#ifndef PHM
#define PHM 1023
#endif
#ifndef MXM
#define MXM 15
#endif
#ifndef MK_N_LAUNCHES
#define MK_N_LAUNCHES 1
#endif
constexpr float LAM_INIT0 = 0.2f, LAM_INIT1 = 0.47071301834370415f;

constexpr size_t MiB = 1u << 20;
constexpr size_t WS_CTL = 0, CTL_ZERO_BYTES = 64 * 1024;
constexpr size_t WS_MODV = 1 * MiB;
constexpr size_t WS_ROPE = 2 * MiB;
constexpr size_t WS_LAM = 2 * MiB + 64 * 1024;
constexpr size_t WS_FA1 = 2 * MiB + 128 * 1024;
constexpr size_t WS_FA2 = 2 * MiB + 192 * 1024;
constexpr size_t WS_FA3 = 2 * MiB + 256 * 1024;
constexpr size_t WS_WIN_E = 4 * MiB,  SZ_WIN_E = 22 * MiB;
constexpr size_t WS_WOUT_E = WS_WIN_E + 2 * SZ_WIN_E, SZ_WOUT = 8 * MiB;
constexpr size_t WS_WIN_O = WS_WOUT_E + 2 * SZ_WOUT, SZ_WIN_O = 24 * MiB;
constexpr size_t WS_WOUT_O = WS_WIN_O + 2 * SZ_WIN_O;
constexpr size_t WS_WFI = WS_WOUT_O + 2 * SZ_WOUT, SZ_WFI = 44 * MiB;
constexpr size_t WS_WFO = WS_WFI + 4 * SZ_WFI, SZ_WFO = 22 * MiB;
constexpr size_t WS_A = WS_WFO + 4 * SZ_WFO;
constexpr size_t WS_P = WS_A + 66 * MiB;
constexpr size_t WS_QR = WS_P + 198 * MiB;
constexpr size_t WS_MIX = WS_QR + 48 * MiB;
constexpr size_t WS_HID = WS_MIX + 66 * MiB;
constexpr size_t WS_HC = WS_HID + 182 * MiB;
constexpr size_t WS_STASH = WS_HC + 4 * MiB;
constexpr size_t WS_HB = WS_STASH;
constexpr size_t WS_FT = WS_STASH + 64 * MiB;
constexpr size_t WS_SLAB = WS_STASH + 128 * MiB;
constexpr size_t WS_END = WS_SLAB + 48 * MiB;
static_assert(WS_A == 392 * MiB && WS_END == 1132 * MiB, "d_ws map");
constexpr int CW_FFT = 3072;
constexpr int CW_BAR = 4096;

constexpr int GEN_BYTES = 143360;
constexpr int MISC_OFF = GEN_BYTES;
constexpr int LDS_BYTES = 147456;

#define GAS __attribute__((address_space(1)))
#define LAS __attribute__((address_space(3)))
typedef unsigned short bf16;
typedef unsigned v4u __attribute__((ext_vector_type(4)));
typedef unsigned v2u __attribute__((ext_vector_type(2)));
typedef float f32x4 __attribute__((ext_vector_type(4)));
typedef short bf16x8 __attribute__((ext_vector_type(8)));
typedef GAS unsigned gu32;
#define RLX_AGENT __ATOMIC_RELAXED, __HIP_MEMORY_SCOPE_AGENT
#define LDS_WAIT() asm volatile("s_waitcnt lgkmcnt(0)" ::: "memory")
#define VM_WAIT() asm volatile("s_waitcnt vmcnt(0)" ::: "memory")
__device__ __forceinline__ unsigned f2bf(float f) { unsigned u = __builtin_bit_cast(unsigned, f); return (u + 0x7fffu + ((u >> 16) & 1u)) >> 16; }
__device__ __forceinline__ unsigned pk2(float lo, float hi) { return f2bf(lo) | (f2bf(hi) << 16); }
__device__ __forceinline__ float bflo(unsigned w) { return __uint_as_float(w << 16); }
__device__ __forceinline__ float bfhi(unsigned w) { return __uint_as_float(w & 0xffff0000u); }
__device__ __forceinline__ float hw_cos(float rev) { return __builtin_amdgcn_cosf(rev); }
__device__ __forceinline__ float hw_sin(float rev) { return __builtin_amdgcn_sinf(rev); }
#define XB_TMO      128
#define XB_XCNT(j)  (256  + 64 * (j))
#define XB_XSUB(j)  (1280 + 64 * (j))
#define XB_XGEN(j)  (2304 + 64 * (j))
#define XB_TOP      3328
#define XB_TOPGEN   3392
#define XCD_BAR_WORDS 3456
#define XB_SPIN_CAP (1u << 18)

__device__ __forceinline__ unsigned xb_ld(unsigned* p)              { return __hip_atomic_load(p, __ATOMIC_RELAXED, __HIP_MEMORY_SCOPE_AGENT); }
__device__ __forceinline__ unsigned xb_add(unsigned* p, unsigned v) { return __hip_atomic_fetch_add(p, v, __ATOMIC_RELAXED, __HIP_MEMORY_SCOPE_AGENT); }
__device__ __forceinline__ unsigned xb_xcc_id() { return (unsigned)__builtin_amdgcn_s_getreg((3 << 11) | 20) & 0xFu; }
#define XB_SPIN(cond, bar) do { unsigned _sp = 0; while (cond) { __builtin_amdgcn_s_sleep(1); \
    if ((++_sp & 255u) == 0u) { if (xb_ld(&(bar)[XB_TMO])) break; if (_sp > XB_SPIN_CAP) { atomicAdd(&(bar)[XB_TMO], 1u); break; } } } } while (0)

struct XcdBarrier {
    unsigned* bar; unsigned x;
    volatile LAS unsigned* st;
};

__device__ __forceinline__ XcdBarrier xcd_barrier_post(unsigned* bar, volatile LAS unsigned* st) {
    XcdBarrier b; b.bar = bar; b.x = xb_xcc_id(); b.st = st;
    if (threadIdx.x == 0) (void)xb_add(&bar[XB_XCNT(b.x)], 1u);
    return b;
}
__device__ __forceinline__ void xcd_barrier_complete(unsigned* bar, unsigned x, unsigned& nloc, unsigned& nx) {
    const unsigned G = gridDim.x * gridDim.y * gridDim.z;
    unsigned sum, cnt, mine, sp = 0u;
    for (;;) {
        sum = 0u; cnt = 0u; mine = 0u;
#pragma unroll
        for (unsigned j = 0; j < 16; ++j) { const unsigned c = xb_ld(&bar[XB_XCNT(j)]); sum += c; cnt += (c > 0u) ? 1u : 0u; mine = (j == x) ? c : mine; }
        if (sum == G) break;
        __builtin_amdgcn_s_sleep(1);
        if ((++sp & 255u) == 0u) { if (xb_ld(&bar[XB_TMO])) break; if (sp > XB_SPIN_CAP) { atomicAdd(&bar[XB_TMO], 1u); break; } }
    }
    nloc = mine > 0u ? mine : 1u; nx = cnt > 0u ? cnt : 1u;
}

__device__ __forceinline__ void xcd_barrier(const XcdBarrier& b) {
    asm volatile("s_waitcnt vmcnt(0)" ::: "memory");
    __syncthreads();
    if (threadIdx.x == 0) {
        unsigned* bar = b.bar;
        __builtin_amdgcn_s_waitcnt(0);
        unsigned nloc = b.st[0], nx = b.st[1];
        if (nloc == 0u) { xcd_barrier_complete(bar, b.x, nloc, nx); b.st[0] = nloc; b.st[1] = nx; }
        const unsigned old = xb_add(&bar[XB_XSUB(b.x)], 1u);
        const unsigned gen = old / nloc;
        if (old + 1u == (gen + 1u) * nloc) {
            __builtin_amdgcn_fence(__ATOMIC_RELEASE, "agent");
            asm volatile("s_waitcnt vmcnt(0)" ::: "memory");
            const unsigned og = xb_add(&bar[XB_TOP], 1u);
            const unsigned tg = og / nx;
            if (og + 1u == (tg + 1u) * nx) xb_add(&bar[XB_TOPGEN], 1u);
            else XB_SPIN(xb_ld(&bar[XB_TOPGEN]) == tg, bar);
            __builtin_amdgcn_fence(__ATOMIC_ACQUIRE, "agent");
            xb_add(&bar[XB_XGEN(b.x)], 1u);
            asm volatile("s_waitcnt vmcnt(0)" ::: "memory");
        } else {
            XB_SPIN(xb_ld(&bar[XB_XGEN(b.x)]) == gen, bar);
            __builtin_amdgcn_fence(__ATOMIC_ACQUIRE, "agent");
            asm volatile("s_waitcnt vmcnt(0)" ::: "memory");
        }
    }
    __syncthreads();
}

struct Args { const float* in[19]; float* out; unsigned char* ws; int ph_lo, ph_hi; };
typedef const __attribute__((address_space(4))) Args* ArgsP;
struct Frame {
    LAS unsigned char* lds; unsigned char* ldsg;
    volatile LAS unsigned* MISC;
    gu32* ctl;
    int tid, lane, wave, vcu, G;
    ArgsP ap; GAS float* out; GAS unsigned char* ws;
};
#define INP(F, k) ((const float*)(const GAS float*)(F).ap->in[k])
#define WSP(F) ((unsigned char*)(F).ws)
#define OUTP(F) ((float*)(F).out)
__device__ __forceinline__ Frame site(const Frame& F0) {
    Frame F = F0;
    int t = threadIdx.x; asm volatile("" : "+v"(t)); F.tid = t; F.lane = t & 63; F.wave = __builtin_amdgcn_readfirstlane(t >> 6);
    GAS unsigned char* w = F0.ws; asm volatile("" : "+s"(w)); F.ws = w;
    GAS float* o = F0.out; asm volatile("" : "+s"(o)); F.out = o;
    ArgsP a = F0.ap; asm volatile("" : "+s"(a)); F.ap = a;
    return F;
}
__device__ __forceinline__ float wave_sum(float v) {
#pragma unroll
    for (int o = 1; o < 64; o <<= 1) v += __shfl_xor(v, o);
    return v;
}

__device__ __forceinline__ void p0_modvec(Frame& F) {
    LAS float* sv = (LAS float*)F.lds;
    LAS float* red = (LAS float*)(F.lds + 24576);
    const float* c = INP(F, 1); const float* cctx = INP(F, 3); const float* wmod = INP(F, 4); const float* bmod = INP(F, 5);
    float* modv = (float*)(WSP(F) + WS_MODV);
    bool have = false;
    for (int it = blockIdx.x; it < 4 * 48; it += F.G) {
        if (!have) {
            for (int idx = F.tid; idx < 3 * DM; idx += 512) { const int g = idx >> 11, k = idx & 2047; const float v = g < 2 ? c[g * DM + k] : cctx[k]; sv[idx] = v / (1.0f + __expf(-v)); }
            __syncthreads(); have = true;
        }
        const int li = it / 48, ch = it % 48;
        const float* wp = wmod + ((size_t)li * DM + F.wave * 256) * 12288 + ch * 256 + F.lane * 4;
        f32x4 a0 = {0.f, 0.f, 0.f, 0.f}, a1 = a0, a2 = a0;
#pragma unroll 8
        for (int k = 0; k < 256; ++k) {
            const f32x4 w = __builtin_nontemporal_load((const f32x4*)(wp + (size_t)k * 12288));
            const float s0 = sv[F.wave * 256 + k], s1 = sv[DM + F.wave * 256 + k], s2 = sv[2 * DM + F.wave * 256 + k];
            a0 += w * s0; a1 += w * s1; a2 += w * s2;
        }
        *(LAS f32x4*)(red + (F.wave * 3 + 0) * 256 + F.lane * 4) = a0;
        *(LAS f32x4*)(red + (F.wave * 3 + 1) * 256 + F.lane * 4) = a1;
        *(LAS f32x4*)(red + (F.wave * 3 + 2) * 256 + F.lane * 4) = a2;
        __syncthreads();
        for (int t = F.tid; t < 768; t += 512) { const int g = t >> 8, cc = t & 255; float s = bmod[li * 12288 + ch * 256 + cc];
#pragma unroll
            for (int w = 0; w < 8; ++w) s += red[(w * 3 + g) * 256 + cc];
            modv[(size_t)(li * 3 + g) * 12288 + ch * 256 + cc] = s; }
        __syncthreads();
    }
}
__device__ __forceinline__ void p0_tables(Frame& F) {
    const int gt = blockIdx.x * 512 + F.tid, NTH = F.G * 512;
    float* rope = (float*)(WSP(F) + WS_ROPE); float* lam = (float*)(WSP(F) + WS_LAM);
    bf16* fa1 = (bf16*)(WSP(F) + WS_FA1); bf16* fa2 = (bf16*)(WSP(F) + WS_FA2); bf16* fa3 = (bf16*)(WSP(F) + WS_FA3);
    for (int idx = gt; idx < 2048; idx += NTH) { const int pos = idx >> 4, f = idx & 15;
        const float inv = exp2f(-(float)f * (13.287712379549449f / 16.0f)); const float rev = (float)pos * inv * 0.15915494309189535f; const float fr = rev - floorf(rev);
        rope[idx * 2] = hw_cos(fr); rope[idx * 2 + 1] = hw_sin(fr); }
    for (int idx = gt; idx < 128 * 128; idx += NTH) { const int m = idx >> 7, k = idx & 127, rp = m >> 6, k1 = m & 63, ri = k >> 6, t1 = k & 63;
        const float ph = (float)((k1 * t1) & 63) * (1.0f / 64.0f); const float cs = hw_cos(ph), sn = hw_sin(ph);
        const float v = rp == 0 ? (ri == 0 ? cs : -sn) : (ri == 0 ? -sn : -cs); fa1[idx] = (bf16)f2bf(v); }
    for (int idx = gt; idx < 128 * 256; idx += NTH) { const int k2 = idx >> 8, k = idx & 255, ri = k >> 7, t2 = k & 127;
        const float ph = (float)((k2 * t2) & 127) * (1.0f / 128.0f); const float v = ri == 0 ? hw_cos(ph) : hw_sin(ph); fa2[idx] = (bf16)f2bf(v); }
    for (int idx = gt; idx < 256 * 512; idx += NTH) { const int kk = idx >> 9, k = idx & 511, ri = k >> 8, t = k & 255;
        const float ph = (float)((kk * t) & 255) * (1.0f / 256.0f); const float v = ri == 0 ? hw_cos(ph) : -hw_sin(ph); fa3[idx] = (bf16)f2bf(v); }
    if (gt < 2) { const float* lv = INP(F, 12) + gt * 256; float s01 = 0.f, s23 = 0.f;
        for (int d = 0; d < 64; ++d) { s01 += lv[d] * lv[64 + d]; s23 += lv[128 + d] * lv[192 + d]; }
        lam[gt] = __expf(s01) - __expf(s23) + (gt == 0 ? LAM_INIT0 : LAM_INIT1); }
}
__device__ __forceinline__ void p0_copy_ctx(Frame& F) {
    const f32x4* src = (const f32x4*)INP(F, 2); f32x4* dst = (f32x4*)(WSP(F) + WS_HC);
    for (int i = blockIdx.x * 512 + F.tid; i < MC * DM / 4; i += F.G * 512) dst[i] = src[i];
}
__device__ __forceinline__ void p0_fold(Frame& F) {
    LAS unsigned char* Wl = F.lds;
    LAS unsigned char* Tl = F.lds + 64 * 272;
    const int lane = F.lane, l15 = lane & 15, lq = lane >> 4;
    bool have_t = false;
    for (int it = blockIdx.x; it < 256; it += F.G) {
        const int j = it >> 7, g = (it >> 5) & 3, k0 = (it & 31) * 64;
        const float* W = INP(F, 9) + (size_t)j * DM * EV_IN;
        bf16* Bt = (bf16*)(WSP(F) + WS_WIN_E + (size_t)j * SZ_WIN_E);
        if (!have_t) { have_t = true;
            for (int idx = F.tid; idx < 256 * 128; idx += 512) { const int n = idx >> 7, cc = idx & 127, cp = n >> 1, ri = n & 1; const float ph = (float)((cc * cp) & 127) * (1.0f / 128.0f);
                *(LAS bf16*)(Tl + n * 272 + cc * 2) = (bf16)f2bf(ri ? hw_sin(ph) : hw_cos(ph)); } }
        for (int idx = F.tid; idx < 64 * 128; idx += 512) { const int r = idx >> 7, cc = idx & 127; *(LAS bf16*)(Wl + r * 272 + cc * 2) = (bf16)f2bf(W[(size_t)(k0 + r) * EV_IN + 4608 + g * 128 + cc]); }
        __syncthreads();
#pragma unroll 1
        for (int ni = 0; ni < 2; ++ni) { const int nt = F.wave * 2 + ni;
            bf16x8 bfr[4];
#pragma unroll
            for (int ks = 0; ks < 4; ++ks) bfr[ks] = *(const LAS bf16x8*)(Tl + (16 * nt + l15) * 272 + (32 * ks + 8 * lq) * 2);
#pragma unroll
            for (int mt = 0; mt < 4; ++mt) { f32x4 acc = {0.f, 0.f, 0.f, 0.f};
#pragma unroll
                for (int ks = 0; ks < 4; ++ks) { const bf16x8 af = *(const LAS bf16x8*)(Wl + (16 * mt + l15) * 272 + (32 * ks + 8 * lq) * 2); acc = __builtin_amdgcn_mfma_f32_16x16x32_bf16(af, bfr[ks], acc, 0, 0, 0); }
                v2u o; o.x = pk2(acc[0], acc[1]); o.y = pk2(acc[2], acc[3]);
                *(v2u*)(Bt + (size_t)(4608 + g * 256 + 16 * nt + l15) * DM + k0 + 16 * mt + 4 * lq) = o; } }
        __syncthreads();
    }
}
__device__ __forceinline__ void p0_transpose_item(const float* W, int K, int pitch, int ncols, bf16* WT, int mode, LAS float* scr, int item, int lane) {
    const int nblk = ncols / 32, kb = item / nblk, nb = item % nblk, k0 = 64 * kb, n0 = 32 * nb;
    float wv[32];
    const float* wp = W + (size_t)(k0 + (lane >> 5)) * pitch + n0 + (lane & 31);
#pragma unroll
    for (int i = 0; i < 32; ++i) wv[i] = __builtin_nontemporal_load(wp + (size_t)(2 * i) * pitch);
#pragma unroll
    for (int i = 0; i < 32; ++i) scr[(2 * i + (lane >> 5)) * 33 + (lane & 31)] = wv[i];
    LDS_WAIT(); asm volatile("" ::: "memory");
    int d0 = n0;
    if (mode == 1) { const int c = n0 < FH ? n0 : n0 - FH; d0 = (c >> 7) * 256 + (c & 127) + (n0 < FH ? 0 : 128); }
    const int c8 = lane & 7;
#pragma unroll
    for (int j = 0; j < 4; ++j) { const int n = (lane >> 3) + 8 * j; const LAS float* s = scr + (8 * c8) * 33 + n;
        v4u o; o.x = pk2(s[0 * 33], s[1 * 33]); o.y = pk2(s[2 * 33], s[3 * 33]); o.z = pk2(s[4 * 33], s[5 * 33]); o.w = pk2(s[6 * 33], s[7 * 33]);
        *(GAS v4u*)(WT + (size_t)(d0 + n) * K + k0 + 8 * c8) = o; }
    LDS_WAIT(); asm volatile("" ::: "memory");
}
constexpr int WQ_EVI = 32 * 144, WQ_ODI = 32 * 192, WQ_OUT = 32 * 64, WQ_FI = 32 * 352, WQ_FO = 88 * 64;
constexpr int WQ_LE = WQ_EVI + WQ_OUT + WQ_FI + WQ_FO, WQ_LO = WQ_ODI + WQ_OUT + WQ_FI + WQ_FO, WQ_N = 2 * (WQ_LE + WQ_LO);
static_assert(WQ_LE == 23552 && WQ_LO == 25088 && WQ_N == 97280, "weight queue sizes");
__device__ __forceinline__ void wq_item(Frame& F, int q, LAS float* scr) {
    int li = 0, r = q;
    if (r >= WQ_LE) { r -= WQ_LE; li = 1; if (r >= WQ_LO) { r -= WQ_LO; li = 2; if (r >= WQ_LE) { r -= WQ_LE; li = 3; } } }
    const int lj = li >> 1; const bool odd = li & 1; const int nin = odd ? WQ_ODI : WQ_EVI;
    if (r < nin) {
        if (odd) p0_transpose_item(INP(F, 14) + (size_t)lj * DM * ODN, DM, ODN, ODN, (bf16*)(WSP(F) + WS_WIN_O + (size_t)lj * SZ_WIN_O), 0, scr, r, F.lane);
        else     p0_transpose_item(INP(F, 9) + (size_t)lj * DM * EV_IN, DM, EV_IN, 4608, (bf16*)(WSP(F) + WS_WIN_E + (size_t)lj * SZ_WIN_E), 0, scr, r, F.lane);
        return; }
    r -= nin;
    if (r < WQ_OUT) { p0_transpose_item(INP(F, odd ? 15 : 10) + (size_t)lj * DM * DM, DM, DM, DM, (bf16*)(WSP(F) + (odd ? WS_WOUT_O : WS_WOUT_E) + (size_t)lj * SZ_WOUT), 0, scr, r, F.lane); return; }
    r -= WQ_OUT;
    if (r < WQ_FI) { p0_transpose_item(INP(F, 7) + (size_t)li * DM * 2 * FH, DM, 2 * FH, 2 * FH, (bf16*)(WSP(F) + WS_WFI + (size_t)li * SZ_WFI), 1, scr, r, F.lane); return; }
    r -= WQ_FI;
    p0_transpose_item(INP(F, 8) + (size_t)li * FH * DM, FH, DM, DM, (bf16*)(WSP(F) + WS_WFO + (size_t)li * SZ_WFO), 0, scr, r, F.lane);
}
constexpr int WQ_IPW = 10, WQ_P0 = 11200;
__device__ const int WQ_TAIL[8] = {11200, 17920, 31360, 48000, 61440, 68160, 81600, 97280};
static_assert(17920 - 11200 <= 84 * 8 * WQ_IPW && 31360 - 17920 <= 168 * 8 * WQ_IPW && 48000 - 31360 <= 208 * 8 * WQ_IPW && 61440 - 48000 <= 168 * 8 * WQ_IPW && 68160 - 61440 <= 84 * 8 * WQ_IPW && 81600 - 68160 <= 168 * 8 * WQ_IPW && 97280 - 81600 <= 208 * 8 * WQ_IPW, "tail capacities");
__device__ __forceinline__ void p0_weights(Frame& F) {
    LAS float* scr = (LAS float*)(F.lds + F.wave * 16384);
    const int gw = F.vcu * 8 + F.wave, NGW = F.G * 8;
    if (F.G != 256) { for (int q = gw; q < WQ_N; q += NGW) wq_item(F, q, scr); return; }
    for (int i = gw; i < WQ_P0; i += NGW) wq_item(F, i, scr);
}
__device__ __forceinline__ void wq_tail(Frame& F, int t, int units) {
    const int rem = units % F.G; const int c = (int)blockIdx.x;
    if (F.G != 256 || rem == 0 || c < rem) return;
    LAS float* scr = (LAS float*)(F.lds + F.wave * 16384);
    const int nw = (F.G - rem) * 8, wr = (c - rem) * 8 + F.wave; const int qb = WQ_TAIL[t], qe = WQ_TAIL[t + 1];
    for (int i = 0; i < WQ_IPW; ++i) { const int q = qb + wr + i * nw; if (q < qe) wq_item(F, q, scr); }
}

template <bool F32SRC>
__device__ __forceinline__ void norm_phase(Frame& F, int li, int which, const void* hlv, float* hcx, int red_ks, const float* red_gate) {
    const float* hl = (const float*)hlv; const bf16* hb = (const bf16*)hlv;
    const float* gain = INP(F, 6) + (size_t)(li * 2 + which) * DM;
    const float* modv = (const float*)(WSP(F) + WS_MODV) + (size_t)li * 3 * 12288;
    bf16* A = (bf16*)(WSP(F) + WS_A);
    LAS float* Gv = (LAS float*)F.lds; LAS float* Sv = Gv + 3 * DM;
    for (int i = F.tid; i < 3 * DM; i += 512) { const int grp = i >> 11, d = i & (DM - 1); const float* sh = modv + grp * 12288 + (which * 3) * DM;
        Gv[i] = gain[d] * (1.0f + sh[DM + d]); Sv[i] = sh[d]; }
    __syncthreads();
    const int gw = F.vcu * 8 + F.wave, NGW = F.G * 8; const int lane = F.lane;
    int r = gw;
    if constexpr (F32SRC) {
    for (; r + 3 * NGW < ML; r += 4 * NGW) {
        f32x4 v[4][8]; float q[4] = {0.f, 0.f, 0.f, 0.f};
#pragma unroll
        for (int i = 0; i < 4; ++i) { const float* sp = hl + (size_t)(r + i * NGW) * DM + 4 * lane;
#pragma unroll
            for (int j = 0; j < 8; ++j) v[i][j] = *(const f32x4*)(sp + 256 * j); }
#pragma unroll
        for (int i = 0; i < 4; ++i)
#pragma unroll
            for (int j = 0; j < 8; ++j) q[i] += (v[i][j].x * v[i][j].x + v[i][j].y * v[i][j].y) + (v[i][j].z * v[i][j].z + v[i][j].w * v[i][j].w);
#pragma unroll
        for (int i = 0; i < 4; ++i) { const int ri = r + i * NGW; const float rs = rsqrtf(wave_sum(q[i]) * (1.0f / DM) + 1e-6f); const int go = (ri < SEQ ? 0 : 1) * DM;
#pragma unroll
            for (int j = 0; j < 8; ++j) { const int d = 4 * lane + 256 * j;
                const f32x4 a = v[i][j] * rs * *(const LAS f32x4*)(Gv + go + d) + *(const LAS f32x4*)(Sv + go + d);
                v2u o; o.x = pk2(a.x, a.y); o.y = pk2(a.z, a.w);
                *(v2u*)(A + (size_t)ri * DM + d) = o; } }
    }
    } else {
    for (; r + 3 * NGW < ML; r += 4 * NGW) {
        v4u w[4][4]; float q[4];
#pragma unroll
        for (int i = 0; i < 4; ++i) { const bf16* sp = hb + (size_t)(r + i * NGW) * DM + 8 * lane;
#pragma unroll
            for (int j = 0; j < 4; ++j) w[i][j] = *(const v4u*)(sp + 512 * j); }
        asm volatile("" ::: "memory");
#pragma unroll
        for (int i = 0; i < 4; ++i) { float a = 0.f;
#pragma unroll
            for (int j = 0; j < 4; ++j) { const v4u t = w[i][j];
                a += (bflo(t.x) * bflo(t.x) + bfhi(t.x) * bfhi(t.x)) + (bflo(t.y) * bflo(t.y) + bfhi(t.y) * bfhi(t.y)) + (bflo(t.z) * bflo(t.z) + bfhi(t.z) * bfhi(t.z)) + (bflo(t.w) * bflo(t.w) + bfhi(t.w) * bfhi(t.w)); }
            q[i] = a; }
#pragma unroll
        for (int i = 0; i < 4; ++i) { const int ri = r + i * NGW; const float rs = rsqrtf(wave_sum(q[i]) * (1.0f / DM) + 1e-6f); const int go = (ri < SEQ ? 0 : 1) * DM;
#pragma unroll
            for (int j = 0; j < 4; ++j) { const int d = 8 * lane + 512 * j; const v4u t = w[i][j];
                const f32x4 x0 = f32x4{bflo(t.x), bfhi(t.x), bflo(t.y), bfhi(t.y)}, x1 = f32x4{bflo(t.z), bfhi(t.z), bflo(t.w), bfhi(t.w)};
                const f32x4 a0 = x0 * rs * *(const LAS f32x4*)(Gv + go + d) + *(const LAS f32x4*)(Sv + go + d);
                const f32x4 a1 = x1 * rs * *(const LAS f32x4*)(Gv + go + d + 4) + *(const LAS f32x4*)(Sv + go + d + 4);
                v4u o; o.x = pk2(a0.x, a0.y); o.y = pk2(a0.z, a0.w); o.z = pk2(a1.x, a1.y); o.w = pk2(a1.z, a1.w);
                *(v4u*)(A + (size_t)ri * DM + d) = o; } }
    }
    }
    if (F.G == 256 && r >= ML) {
        const int cr = F.vcu * 2 + (F.wave >> 2), qo = 4 * lane + 512 * (F.wave & 3);
        float* hrow = hcx + (size_t)cr * DM + qo;
        f32x4 v0 = *(const f32x4*)hrow, v1 = *(const f32x4*)(hrow + 256);
        if (red_ks > 0) {
            const float* sl = (const float*)(WSP(F) + WS_SLAB) + (size_t)cr * DM + qo;
            f32x4 t0[11], t1[11];
#pragma unroll
            for (int k = 0; k < 11; ++k) { const bool on = k < red_ks; const size_t ko = (size_t)(on ? k : 0) * (MC * DM); t0[k] = *(const f32x4*)(sl + ko); t1[k] = *(const f32x4*)(sl + ko + 256); }
            f32x4 s0 = t0[0], s1 = t1[0];
#pragma unroll
            for (int k = 1; k < 11; ++k) if (k < red_ks) { s0 += t0[k]; s1 += t1[k]; }
            v0 += *(const f32x4*)(red_gate + qo) * s0; v1 += *(const f32x4*)(red_gate + qo + 256) * s1;
            *(f32x4*)hrow = v0; *(f32x4*)(hrow + 256) = v1;
        }
        const float ssq = wave_sum((v0.x * v0.x + v0.y * v0.y) + (v0.z * v0.z + v0.w * v0.w) + (v1.x * v1.x + v1.y * v1.y) + (v1.z * v1.z + v1.w * v1.w));
        LAS float* red = (LAS float*)(F.lds + 49152);
        if (lane == 0) red[F.wave] = ssq;
        __syncthreads();
        const int w0 = F.wave & 4; const float rstd = rsqrtf(((red[w0] + red[w0 + 1]) + (red[w0 + 2] + red[w0 + 3])) * (1.0f / DM) + 1e-6f);
        const f32x4 a0 = v0 * rstd * *(const LAS f32x4*)(Gv + 2 * DM + qo) + *(const LAS f32x4*)(Sv + 2 * DM + qo);
        const f32x4 a1 = v1 * rstd * *(const LAS f32x4*)(Gv + 2 * DM + qo + 256) + *(const LAS f32x4*)(Sv + 2 * DM + qo + 256);
        v2u o0, o1; o0.x = pk2(a0.x, a0.y); o0.y = pk2(a0.z, a0.w); o1.x = pk2(a1.x, a1.y); o1.y = pk2(a1.z, a1.w);
        *(v2u*)(A + (size_t)(ML + cr) * DM + qo) = o0; *(v2u*)(A + (size_t)(ML + cr) * DM + qo + 256) = o1;
    } else
    for (; r < MT; r += NGW) {
        const int go = (r < SEQ ? 0 : (r < ML ? 1 : 2)) * DM;
        f32x4 v[8]; float ss = 0.f;
        if (!F32SRC && r < ML) {
#pragma unroll
            for (int j = 0; j < 8; ++j) { const v2u t = *(const v2u*)(hb + (size_t)r * DM + 4 * lane + 256 * j); v[j] = f32x4{bflo(t.x), bfhi(t.x), bflo(t.y), bfhi(t.y)}; }
        } else { const float* src = r < ML ? hl + (size_t)r * DM : hcx + (size_t)(r - ML) * DM;
#pragma unroll
            for (int j = 0; j < 8; ++j) v[j] = *(const f32x4*)(src + 4 * lane + 256 * j); }
        if (r >= ML && red_ks > 0) {
            const float* sl = (const float*)(WSP(F) + WS_SLAB) + (size_t)(r - ML) * DM + 4 * lane;
#pragma unroll
            for (int j = 0; j < 8; j += 2) { f32x4 t0[11], t1[11];
#pragma unroll
                for (int k = 0; k < 11; ++k) { const bool on = k < red_ks; const size_t ko = (size_t)(on ? k : 0) * (MC * DM);
                    t0[k] = *(const f32x4*)(sl + ko + 256 * j); t1[k] = *(const f32x4*)(sl + ko + 256 * (j + 1)); }
                f32x4 s0 = t0[0], s1 = t1[0];
#pragma unroll
                for (int k = 1; k < 11; ++k) if (k < red_ks) { s0 += t0[k]; s1 += t1[k]; }
                v[j] += *(const f32x4*)(red_gate + 4 * lane + 256 * j) * s0; v[j + 1] += *(const f32x4*)(red_gate + 4 * lane + 256 * (j + 1)) * s1;
                *(f32x4*)(hcx + (size_t)(r - ML) * DM + 4 * lane + 256 * j) = v[j]; *(f32x4*)(hcx + (size_t)(r - ML) * DM + 4 * lane + 256 * (j + 1)) = v[j + 1]; }
        }
#pragma unroll
        for (int j = 0; j < 8; ++j) ss += (v[j].x * v[j].x + v[j].y * v[j].y) + (v[j].z * v[j].z + v[j].w * v[j].w);
        const float rstd = rsqrtf(wave_sum(ss) * (1.0f / DM) + 1e-6f);
#pragma unroll
        for (int j = 0; j < 8; ++j) { const int d = 4 * lane + 256 * j;
            const f32x4 a = v[j] * rstd * *(const LAS f32x4*)(Gv + go + d) + *(const LAS f32x4*)(Sv + go + d);
            v2u o; o.x = pk2(a.x, a.y); o.y = pk2(a.z, a.w);
            *(v2u*)(A + (size_t)r * DM + d) = o; }
    }
    __syncthreads();
}

__device__ __forceinline__ void prep_even_row(bf16* P, bf16* QR, int r, bool lat, int lane, const v4u (&w6)[6], const f32x4 (&rw)[4], const float (&g0)[8], const float (&g1)[8]) {
    float cs[8], sn[8];
#pragma unroll
    for (int e = 0; e < 8; e += 2) { cs[e] = lat ? rw[e >> 1].x : 1.f; sn[e] = lat ? rw[e >> 1].y : 0.f; cs[e + 1] = lat ? rw[e >> 1].z : 1.f; sn[e + 1] = lat ? rw[e >> 1].w : 0.f; }
    bf16* prow = P + (size_t)r * EVN;
#pragma unroll
    for (int j = 0; j < 6; ++j) {
        const int ch = j * 64 + lane; const v4u w = w6[j];
        float x[8] = {bflo(w.x), bfhi(w.x), bflo(w.y), bfhi(w.y), bflo(w.z), bfhi(w.z), bflo(w.w), bfhi(w.w)};
        float ss = 0.f;
#pragma unroll
        for (int e = 0; e < 8; ++e) ss += x[e] * x[e];
        ss += __shfl_xor(ss, 1); ss += __shfl_xor(ss, 2); ss += __shfl_xor(ss, 4);
        const float rstd = rsqrtf(ss * (1.0f / 64.0f) + 1e-6f);
        float y[8], yr[8];
#pragma unroll
        for (int e = 0; e < 8; ++e) y[e] = x[e] * rstd * (j < 3 ? g0[e] * 0.18033688011112042f : g1[e]);
#pragma unroll
        for (int e = 0; e < 8; ++e) { const float yp = __shfl_xor(y[e], 2); yr[e] = (lane & 2) ? (y[e] * cs[e] + yp * sn[e]) : (y[e] * cs[e] - yp * sn[e]); }
        v4u on, orr;
        on.x = pk2(y[0], y[1]); on.y = pk2(y[2], y[3]); on.z = pk2(y[4], y[5]); on.w = pk2(y[6], y[7]);
        orr.x = pk2(yr[0], yr[1]); orr.y = pk2(yr[2], yr[3]); orr.z = pk2(yr[4], yr[5]); orr.w = pk2(yr[6], yr[7]);
        if (j < 3) { *(v4u*)(prow + ch * 8) = on; if (lat) *(v4u*)(QR + (size_t)r * 1536 + ch * 8) = orr; }
        else       { *(v4u*)(prow + ch * 8) = lat ? orr : on; }
    }
}
__device__ __forceinline__ void prep_even(Frame& F, int lj) {
    bf16* P = (bf16*)(WSP(F) + WS_P); bf16* QR = (bf16*)(WSP(F) + WS_QR);
    const float* gq = INP(F, 11) + (size_t)lj * 128; const float* rope = (const float*)(WSP(F) + WS_ROPE);
    const int gw = F.vcu * 8 + F.wave, NGW = F.G * 8; const int lane = F.lane;
    const int d0 = (lane & 7) * 8;
    float g0[8], g1[8];
#pragma unroll
    for (int e = 0; e < 8; ++e) { g0[e] = gq[d0 + e]; g1[e] = gq[64 + d0 + e]; }
    for (int r = gw; r < MT; r += 2 * NGW) {
        const int r1 = r + NGW; const bool has1 = r1 < MT; const int r1c = has1 ? r1 : r;
        v4u wa[6], wb[6]; f32x4 ra[4], rb[4];
        const int ta = r & (SEQ - 1), tb = r1c & (SEQ - 1);
        const int pa = ((lane >> 2) & 1) ? (ta & 63) : (ta >> 6), pb = ((lane >> 2) & 1) ? (tb & 63) : (tb >> 6);
#pragma unroll
        for (int j = 0; j < 6; ++j) { wa[j] = *(const v4u*)(P + (size_t)r * EVN + (j * 64 + lane) * 8); wb[j] = *(const v4u*)(P + (size_t)r1c * EVN + (j * 64 + lane) * 8); }
#pragma unroll
        for (int e = 0; e < 4; ++e) { ra[e] = *(const f32x4*)(rope + (size_t)((pa & 127) * 16 + (lane & 1) * 8) * 2 + e * 4); rb[e] = *(const f32x4*)(rope + (size_t)((pb & 127) * 16 + (lane & 1) * 8) * 2 + e * 4); }
        asm volatile("" ::: "memory");
        prep_even_row(P, QR, r, r < ML, lane, wa, ra, g0, g1);
        if (has1) prep_even_row(P, QR, r1, r1 < ML, lane, wb, rb, g0, g1);
    }
}

struct OddRow { v4u gb[2], gc[2][3], hh[2][3]; };
__device__ __forceinline__ void prep_odd_load(OddRow& R, const bf16* P, int r, int lane) {
    const bool lat = r < ML; const int t = lat ? (r & (SEQ - 1)) : ((r - ML) & (CTXL - 1)); const int n = lat ? SEQ : CTXL;
    const bf16* prow = P + (size_t)r * ODN;
#pragma unroll
    for (int j = 0; j < 2; ++j) { const int c0 = (j * 64 + lane) * 8; R.gb[j] = *(const v4u*)(prow + c0);
#pragma unroll
        for (int jj = 0; jj < 3; ++jj) { const int tt = t + jj - 1; const bool ok = tt >= 0 && tt < n; const bf16* pr = prow + (ok ? (ptrdiff_t)(jj - 1) * ODN : 0);
            R.gc[j][jj] = *(const v4u*)(pr + 1024 + c0); R.hh[j][jj] = *(const v4u*)(pr + 2048 + c0); } }
}
__device__ __forceinline__ void prep_odd_row(const OddRow& R, bf16* P, bf16* MIX, const float* cw, int r, int lane, const float (&g0)[8], const float (&g1)[8]) {
    const bool lat = r < ML; const int t = lat ? (r & (SEQ - 1)) : ((r - ML) & (CTXL - 1)); const int n = lat ? SEQ : CTXL;
    bf16* prow = P + (size_t)r * ODN;
#pragma unroll
    for (int j = 0; j < 2; ++j) {
        const int c0 = (j * 64 + lane) * 8;
        float accv[8];
#pragma unroll
        for (int e = 0; e < 8; ++e) accv[e] = 0.f;
#pragma unroll
        for (int jj = 0; jj < 3; ++jj) {
            const int tt = t + jj - 1; const float m = (tt >= 0 && tt < n) ? 1.f : 0.f;
            const v4u a = R.gc[j][jj], b = R.hh[j][jj];
            const f32x4 w0 = *(const f32x4*)(cw + jj * 1024 + c0) * m, w1 = *(const f32x4*)(cw + jj * 1024 + c0 + 4) * m;
            accv[0] += bflo(a.x) * bflo(b.x) * w0.x; accv[1] += bfhi(a.x) * bfhi(b.x) * w0.y; accv[2] += bflo(a.y) * bflo(b.y) * w0.z; accv[3] += bfhi(a.y) * bfhi(b.y) * w0.w;
            accv[4] += bflo(a.z) * bflo(b.z) * w1.x; accv[5] += bfhi(a.z) * bfhi(b.z) * w1.y; accv[6] += bflo(a.w) * bflo(b.w) * w1.z; accv[7] += bfhi(a.w) * bfhi(b.w) * w1.w;
        }
        const v4u gb = R.gb[j];
        v4u o; o.x = pk2(bflo(gb.x) * accv[0], bfhi(gb.x) * accv[1]); o.y = pk2(bflo(gb.y) * accv[2], bfhi(gb.y) * accv[3]);
        o.z = pk2(bflo(gb.z) * accv[4], bfhi(gb.z) * accv[5]); o.w = pk2(bflo(gb.w) * accv[6], bfhi(gb.w) * accv[7]);
        *(v4u*)(MIX + (size_t)r * DM + c0) = o;
    }
}
__device__ __forceinline__ void prep_odd(Frame& F, int lj) {
    const bf16* P = (const bf16*)(WSP(F) + WS_P); bf16* MIX = (bf16*)(WSP(F) + WS_MIX);
    const float* cw = INP(F, 17) + (size_t)lj * 3 * 1024;
    const int gw = F.vcu * 8 + F.wave, NGW = F.G * 8; const int lane = F.lane;
    f32x4 wt[2][3][2];
#pragma unroll
    for (int j = 0; j < 2; ++j)
#pragma unroll
        for (int jj = 0; jj < 3; ++jj) { const int c0 = (j * 64 + lane) * 8; wt[j][jj][0] = *(const f32x4*)(cw + jj * 1024 + c0); wt[j][jj][1] = *(const f32x4*)(cw + jj * 1024 + c0 + 4); }
    for (int g = gw; g < MT / 4; g += NGW) {
        const int r0 = 4 * g; const bool lat = r0 < ML; const int t0 = lat ? (r0 & (SEQ - 1)) : ((r0 - ML) & (CTXL - 1)); const int n = lat ? SEQ : CTXL;
        const bf16* pb = P + (size_t)r0 * ODN;
        v4u gb[4][2], gc[6][2], hh[6][2];
#pragma unroll
        for (int i = 0; i < 6; ++i) { const int tt = t0 + i - 1; const bool ok = tt >= 0 && tt < n; const bf16* pr = pb + (ok ? (ptrdiff_t)(i - 1) * ODN : 0);
#pragma unroll
            for (int j = 0; j < 2; ++j) { const int c0 = (j * 64 + lane) * 8; gc[i][j] = *(const v4u*)(pr + 1024 + c0); hh[i][j] = *(const v4u*)(pr + 2048 + c0); } }
#pragma unroll
        for (int i = 0; i < 4; ++i)
#pragma unroll
            for (int j = 0; j < 2; ++j) gb[i][j] = *(const v4u*)(pb + (size_t)i * ODN + (j * 64 + lane) * 8);
        asm volatile("" ::: "memory");
#pragma unroll
        for (int i = 0; i < 4; ++i)
#pragma unroll
            for (int j = 0; j < 2; ++j) { const int c0 = (j * 64 + lane) * 8;
                float accv[8];
#pragma unroll
                for (int e = 0; e < 8; ++e) accv[e] = 0.f;
#pragma unroll
                for (int jj = 0; jj < 3; ++jj) { const int tt = t0 + i + jj - 1; const float m = (tt >= 0 && tt < n) ? 1.f : 0.f;
                    const v4u a = gc[i + jj][j], b = hh[i + jj][j]; const f32x4 w0 = wt[j][jj][0] * m, w1 = wt[j][jj][1] * m;
                    accv[0] += bflo(a.x) * bflo(b.x) * w0.x; accv[1] += bfhi(a.x) * bfhi(b.x) * w0.y; accv[2] += bflo(a.y) * bflo(b.y) * w0.z; accv[3] += bfhi(a.y) * bfhi(b.y) * w0.w;
                    accv[4] += bflo(a.z) * bflo(b.z) * w1.x; accv[5] += bfhi(a.z) * bfhi(b.z) * w1.y; accv[6] += bflo(a.w) * bflo(b.w) * w1.z; accv[7] += bfhi(a.w) * bfhi(b.w) * w1.w; }
                const v4u q = gb[i][j];
                v4u o; o.x = pk2(bflo(q.x) * accv[0], bfhi(q.x) * accv[1]); o.y = pk2(bflo(q.y) * accv[2], bfhi(q.y) * accv[3]);
                o.z = pk2(bflo(q.z) * accv[4], bfhi(q.z) * accv[5]); o.w = pk2(bflo(q.w) * accv[6], bfhi(q.w) * accv[7]);
                *(v4u*)(MIX + (size_t)(r0 + i) * DM + c0) = o; }
    }
}

struct EvenTileRow { int ctx0, lat0; __device__ __forceinline__ int operator()(int j) const { return j < 4 ? ctx0 + 64 * j : lat0 + 64 * (j - 4); } };
__device__ __forceinline__ void even_attn_unit(Frame& F, int lj, int b, int h, int qrow0, bool is_ctx, unsigned& sacc) {
    const bf16* P = (const bf16*)(WSP(F) + WS_P); const bf16* QR = (const bf16*)(WSP(F) + WS_QR); bf16* MIX = (bf16*)(WSP(F) + WS_MIX);
    const int lane = F.lane, r32 = lane & 31, hi = lane >> 5, wq = F.wave & 3, comp = F.wave >> 2;
    EvenTileRow trow{ML + b * CTXL, b * SEQ};
    att::f32x16 o[4]; float rli[16];
    att::attn_dual_stag<EVN, 1536, EVN>(P + (size_t)qrow0 * EVN + h * 128, QR + (size_t)(is_ctx ? 0 : qrow0) * 1536 + h * 128, is_ctx ? 1000 : 4,
                                        P + 1536 + h * 128, P + 3072 + h * 128, trow, is_ctx ? 4 : 132, (char*)F.ldsg, o, rli, sacc);
    __syncthreads();
    LAS float* xch = (LAS float*)F.lds + (size_t)wq * 4096 + lane;
    if (comp == 1) {
#pragma unroll
        for (int d = 0; d < 4; ++d)
#pragma unroll
            for (int r = 0; r < 16; ++r) xch[(d * 16 + r) * 64] = o[d][r] * rli[r];
    }
    __syncthreads();
    if (comp == 0) {
        const float lam = ((const float*)(WSP(F) + WS_LAM))[lj];
        const float cfac = 1.0f - (lj == 0 ? LAM_INIT0 : LAM_INIT1);
        const float* gsub = INP(F, 13) + (size_t)lj * 128;
        float ssq[16];
#pragma unroll
        for (int r = 0; r < 16; ++r) ssq[r] = 0.f;
#pragma unroll
        for (int d = 0; d < 4; ++d)
#pragma unroll
            for (int r = 0; r < 16; ++r) { const float v = o[d][r] * rli[r] - lam * xch[(d * 16 + r) * 64]; o[d][r] = v; ssq[r] += v * v; }
#pragma unroll
        for (int r = 0; r < 16; ++r) { float s = ssq[r]; s += __shfl_xor(s, 1); s += __shfl_xor(s, 2); s += __shfl_xor(s, 4); s += __shfl_xor(s, 8); s += __shfl_xor(s, 16);
            ssq[r] = rsqrtf(s * (1.0f / 128.0f) + 1e-6f) * cfac; }
        int r32s = r32; asm volatile("" : "+v"(r32s));
#pragma unroll
        for (int d = 0; d < 4; ++d) { const float g = gsub[32 * d + r32s];
#pragma unroll
            for (int r = 0; r < 16; ++r) MIX[(size_t)(qrow0 + wq * 32 + att::crow(r, hi)) * DM + h * 128 + 32 * d + r32s] = (bf16)f2bf(o[d][r] * ssq[r] * g); }
    }
}

__device__ __forceinline__ void fft_unit(Frame& F, int b, int cp) {
    LAS unsigned char* Vl = F.lds;
    LAS unsigned char* Yl = F.lds + 69632;
    const bf16* P = (const bf16*)(WSP(F) + WS_P); bf16* MIX = (bf16*)(WSP(F) + WS_MIX);
    const bf16* FA1 = (const bf16*)(WSP(F) + WS_FA1); const bf16* FA2 = (const bf16*)(WSP(F) + WS_FA2);
    const int lane = F.lane, l15 = lane & 15, lq = lane >> 4;
    v2u wl[16];
    const bf16* FT = (const bf16*)(WSP(F) + WS_FT) + (size_t)(b * 256 + cp) * 8192 * 4;
#pragma unroll
    for (int jj = 0; jj < 16; ++jj) wl[jj] = *(const v2u*)(FT + (size_t)(F.tid + 512 * jj) * 4);
#pragma unroll
    for (int jj = 0; jj < 16; ++jj) { const int t = F.tid + 512 * jj; const v2u w = wl[jj];
        const int t1 = t >> 7, t2 = t & 127;
        *(LAS bf16*)(Vl + (2 * t2 + 0) * 272 + (t1) * 2) = (bf16)(w.x & 0xffffu);       *(LAS bf16*)(Vl + (2 * t2 + 0) * 272 + (64 + t1) * 2) = (bf16)(w.x >> 16);
        *(LAS bf16*)(Vl + (2 * t2 + 1) * 272 + (t1) * 2) = (bf16)(w.y & 0xffffu);       *(LAS bf16*)(Vl + (2 * t2 + 1) * 272 + (64 + t1) * 2) = (bf16)(w.y >> 16); }
    __syncthreads();
    {
        const int mt = F.wave & 3, nt0 = (F.wave >> 2) * 8;
        bf16x8 aR[4], aI[4];
#pragma unroll
        for (int ks = 0; ks < 4; ++ks) { aR[ks] = *(const bf16x8*)(FA1 + (size_t)(16 * mt + l15) * 128 + 32 * ks + 8 * lq); aI[ks] = *(const bf16x8*)(FA1 + (size_t)(64 + 16 * mt + l15) * 128 + 32 * ks + 8 * lq); }
        for (int nt = nt0; nt < nt0 + 8; ++nt) {
            f32x4 accR = {0.f, 0.f, 0.f, 0.f}, accI = accR;
#pragma unroll
            for (int ks = 0; ks < 4; ++ks) { const bf16x8 bf = *(const LAS bf16x8*)(Vl + (16 * nt + l15) * 272 + (32 * ks + 8 * lq) * 2);
                accR = __builtin_amdgcn_mfma_f32_16x16x32_bf16(aR[ks], bf, accR, 0, 0, 0); accI = __builtin_amdgcn_mfma_f32_16x16x32_bf16(aI[ks], bf, accI, 0, 0, 0); }
            const int n1 = 16 * nt + l15, t2 = n1 >> 1, cc = n1 & 1;
#pragma unroll
            for (int r = 0; r < 4; ++r) { const int k1 = 16 * mt + lq * 4 + r; const float ph = (float)((t2 * k1) & 8191) * (1.0f / 8192.0f); const float cs = hw_cos(ph), sn = hw_sin(ph);
                const float yr = accR[r] * cs + accI[r] * sn, yi = accI[r] * cs - accR[r] * sn; const int n2 = k1 * 2 + cc;
                *(LAS bf16*)(Yl + n2 * 528 + t2 * 2) = (bf16)f2bf(yr); *(LAS bf16*)(Yl + n2 * 528 + (128 + t2) * 2) = (bf16)f2bf(yi); }
        }
    }
    __syncthreads();
    {
        const int mt = F.wave;
        bf16x8 a2[8];
#pragma unroll
        for (int ks = 0; ks < 8; ++ks) a2[ks] = *(const bf16x8*)(FA2 + (size_t)(16 * mt + l15) * 256 + 32 * ks + 8 * lq);
        for (int nt = 0; nt < 8; ++nt) {
            f32x4 acc = {0.f, 0.f, 0.f, 0.f};
#pragma unroll
            for (int ks = 0; ks < 8; ++ks) { const bf16x8 bf = *(const LAS bf16x8*)(Yl + (16 * nt + l15) * 528 + (32 * ks + 8 * lq) * 2); acc = __builtin_amdgcn_mfma_f32_16x16x32_bf16(a2[ks], bf, acc, 0, 0, 0); }
            const int n2 = 16 * nt + l15, k1 = n2 >> 1, cc = n2 & 1;
#pragma unroll
            for (int r = 0; r < 4; ++r) { const int k2 = 16 * mt + lq * 4 + r; const int tok = k1 + 64 * k2; const unsigned me = f2bf(acc[r] * (1.0f / 1024.0f)); const unsigned other = (unsigned)__shfl_xor((int)me, 1);
                if (cc == 0) *(unsigned*)(MIX + (size_t)(b * SEQ + tok) * DM + 1536 + 2 * cp) = me | (other << 16); }
        }
    }
    __syncthreads();
}
__device__ __forceinline__ void ctx_dft_unit(Frame& F, int b, int cb) {
    LAS unsigned char* Vc = F.lds;
    const bf16* P = (const bf16*)(WSP(F) + WS_P); bf16* MIX = (bf16*)(WSP(F) + WS_MIX); const bf16* FA3 = (const bf16*)(WSP(F) + WS_FA3);
    const int lane = F.lane, l15 = lane & 15, lq = lane >> 4;
    { const int t = F.tid >> 1, half = F.tid & 1; const bf16* src = P + (size_t)(ML + b * CTXL + t) * EVN + 4608 + 32 * cb + 16 * half;
      const v4u w0 = *(const v4u*)src, w1 = *(const v4u*)(src + 8);
      const unsigned ww[8] = {w0.x, w0.y, w0.z, w0.w, w1.x, w1.y, w1.z, w1.w};
#pragma unroll
      for (int i = 0; i < 8; ++i) { const int cl = half * 8 + i; *(LAS bf16*)(Vc + cl * 1040 + t * 2) = (bf16)(ww[i] & 0xffffu); *(LAS bf16*)(Vc + cl * 1040 + (256 + t) * 2) = (bf16)(ww[i] >> 16); } }
    __syncthreads();
#pragma unroll 1
    for (int mi = 0; mi < 2; ++mi) { const int mt = F.wave * 2 + mi; f32x4 acc = {0.f, 0.f, 0.f, 0.f};
#pragma unroll 4
        for (int ks = 0; ks < 16; ++ks) { const bf16x8 a = *(const bf16x8*)(FA3 + (size_t)(16 * mt + l15) * 512 + 32 * ks + 8 * lq); const bf16x8 bf = *(const LAS bf16x8*)(Vc + l15 * 1040 + (32 * ks + 8 * lq) * 2);
            acc = __builtin_amdgcn_mfma_f32_16x16x32_bf16(a, bf, acc, 0, 0, 0); }
#pragma unroll
        for (int r = 0; r < 4; ++r) { const int k = 16 * mt + lq * 4 + r; MIX[(size_t)(ML + b * CTXL + k) * DM + 1536 + 16 * cb + l15] = (bf16)f2bf(acc[r] * 0.005524271728019903f); } }
    __syncthreads();
}
__device__ __forceinline__ void mixer_even(Frame& F, int lj) {
    unsigned sacc = 0;
#if STAMP == 1
    const unsigned long long sm0_ = __builtin_amdgcn_s_memtime(), sr0_ = __builtin_amdgcn_s_memrealtime(); __builtin_amdgcn_s_waitcnt(0xC07F);
#endif
#if STAMP == 40 || STAMP == 41
    const unsigned tA_ = (unsigned)__builtin_amdgcn_s_memrealtime();
#endif
    if (MXM & 1) {
        for (int uu = F.vcu; uu < ((DUP & 1) ? 2 : 1) * (1536 + 48); uu += F.G) { const int u = (DUP & 1) ? uu % (1536 + 48) : uu; const bool is_ctx = u >= 1536;
            const int pair = is_ctx ? (u - 1536) >> 1 : (u >> 6), qb = is_ctx ? (u & 1) : (u & 63); const int b = pair / 12, h = pair % 12;
            even_attn_unit(F, lj, b, h, is_ctx ? ML + b * CTXL + qb * 128 : b * SEQ + qb * 128, is_ctx, sacc); __syncthreads(); } }
#if STAMP && STAMP < 6
    if (lj == (STAMP_LJ) && blockIdx.x == 0) {
#if STAMP == 1
        const unsigned long long sm1_ = __builtin_amdgcn_s_memtime(), sr1_ = __builtin_amdgcn_s_memrealtime(); __builtin_amdgcn_s_waitcnt(0xC07F);
        sacc = (unsigned)(((sm1_ - sm0_) * 100ull) / (sr1_ - sr0_));
#endif
        if (F.wave == ((STAMP == 3) ? 4 : 0) && F.lane == 0) __hip_atomic_store((GAS unsigned*)(WSP(F) + WS_LAM + 1024), sacc, RLX_AGENT);
    }
#endif
#if STAMP == 40 || STAMP == 41
    const unsigned tB_ = (unsigned)__builtin_amdgcn_s_memrealtime();
#endif
    if ((MXM & 12) == 12) {
        gu32* cnt = (gu32*)(WSP(F) + WS_CTL) + CW_FFT + lj;
        for (;;) {
            if (F.tid == 0) F.MISC[20] = __hip_atomic_fetch_add(cnt, 1u, RLX_AGENT);
            __syncthreads();
            const int u = (int)F.MISC[20];
            if (u >= 512 + 64) break;
            if (u < 512) fft_unit(F, u >> 8, u & 255); else { ctx_dft_unit(F, (u - 512) >> 5, (u - 512) & 31); __syncthreads(); }
        }
    }
#if STAMP == 40 || STAMP == 41
    { const unsigned tC_ = (unsigned)__builtin_amdgcn_s_memrealtime(); if (F.tid == 0) F.MISC[16] += (STAMP == 40) ? tB_ - tA_ : tC_ - tB_; }
#endif
}

struct OddTileRow { int ctx0, lat0; __device__ __forceinline__ int operator()(int j) const { return j < 4 ? ctx0 + 64 * j : lat0 + 64 * (j - 4); } };
struct NaMask {
    int R0, rw, cq, rs, cs, hi; const LAS float* bt; bool off;
    __device__ __forceinline__ bool skip(int j) const { if (off || j < 4) return false; const int kr = R0 + j - 4; return __builtin_amdgcn_readfirstlane((int)(kr < rs || kr >= rs + 8)) != 0; }
    __device__ __forceinline__ void operator()(att::f32x16& p0, att::f32x16& p1, int j) const {
        if (off || j < 4) return;
        const int kr = R0 + j - 4;
        if (kr < rs || kr >= rs + 8) {
#pragma unroll
            for (int r = 0; r < 16; ++r) { p0[r] = -1e30f; p1[r] = -1e30f; }
            return; }
        int cq_ = cq, hi_ = hi; asm volatile("" : "+v"(cq_), "+v"(hi_));
        int cs_ = cq_ - 8; cs_ = cs_ < 0 ? 0 : (cs_ > 48 ? 48 : cs_);
        const int rowoff = (kr - rw + 7) * 31 + 15 - cq_;
#pragma unroll
        for (int r = 0; r < 16; ++r) { const int c0 = att::crow(r, hi_), c1 = 32 + c0; const int cs = cs_;
            const bool ok0 = c0 >= cs && c0 < cs + 16, ok1 = c1 >= cs && c1 < cs + 16;
            const float b0 = bt[ok0 ? rowoff + c0 : 0], b1 = bt[ok1 ? rowoff + c1 : 0];
            p0[r] = ok0 ? p0[r] + b0 : -1e30f; p1[r] = ok1 ? p1[r] + b1 : -1e30f;
            if ((r & 7) == 7) __builtin_amdgcn_sched_barrier(0); }
    }
};
__device__ __forceinline__ void odd_attn_unit(Frame& F, int lj, int b, int h, int rb, bool is_ctx) {
    const bf16* P = (const bf16*)(WSP(F) + WS_P); bf16* MIX = (bf16*)(WSP(F) + WS_MIX);
    const int lane = F.lane, r32 = lane & 31, hi = lane >> 5, wid = F.wave;
    const int qrow0 = is_ctx ? ML + b * CTXL : b * SEQ + rb * 256;
    int R0 = 4 * rb - 4; R0 = R0 < 0 ? 0 : (R0 > 116 ? 116 : R0);
    OddTileRow trow{ML + b * CTXL, b * SEQ + R0 * 64};
    LAS float* bt = (LAS float*)(F.lds + att::LDS_BT_OFF);
    if (!is_ctx) { const float* rpb = INP(F, 18) + (size_t)(lj * 8 + h) * 465; for (int t = F.tid; t < 465; t += 512) bt[t] = rpb[t] * 1.4426950408889634f; }
    __syncthreads();
    NaMask mk; mk.R0 = R0; mk.rw = 4 * rb + (wid >> 1); mk.cq = 32 * (wid & 1) + r32; mk.hi = hi; mk.bt = bt; mk.off = is_ctx;
    { int rs = mk.rw - 4; rs = rs < 0 ? 0 : (rs > 120 ? 120 : rs); mk.rs = rs; int cs = mk.cq - 8; cs = cs < 0 ? 0 : (cs > 48 ? 48 : cs); mk.cs = cs; }
    att::f32x16 o[4]; float rli[16];
    att::attn_core<128, ODN, ODN, ODN, 1, false, true>(P + (size_t)qrow0 * ODN + 3072 + h * 128, (const bf16*)nullptr, 1000,
                        P + 4096 + h * 128, P + 5120 + h * 128, trow, is_ctx ? 4 : 16, mk, (char*)F.ldsg, o, rli);
#pragma unroll
    for (int d = 0; d < 4; ++d)
#pragma unroll
        for (int r = 0; r < 16; ++r) MIX[(size_t)(qrow0 + wid * 32 + att::crow(r, hi)) * DM + 1024 + h * 128 + 32 * d + r32] = (bf16)f2bf(o[d][r] * rli[r]);
}
__device__ __forceinline__ void mixer_odd(Frame& F, int lj, bool with_ctx) {
    const int nun = 512 + (with_ctx ? 16 : 0);
    if (MXM & 1) for (int uu = F.vcu; uu < ((DUP & 2) ? 2 : 1) * nun; uu += F.G) { const int u = (DUP & 2) ? uu % nun : uu; const bool is_ctx = u >= 512; const int pair = is_ctx ? u - 512 : (u >> 5), rb = is_ctx ? 0 : (u & 31);
        odd_attn_unit(F, lj, pair >> 3, pair & 7, rb, is_ctx); __syncthreads(); }
}

#if STAMP >= 6
constexpr bool seam_sel(int ph) {
    if (STAMP == 50) return ph == 3;
    if (STAMP >= 20) return ph == STAMP - 20;
    if (STAMP == 13 || STAMP == 14) return false;
    return STAMP == 6 ? true : STAMP == 7 ? (ph == 1) : STAMP == 8 ? (ph == 3) : STAMP == 9 ? (ph == 6) : STAMP == 10 ? (ph == 4 || ph == 7) : STAMP == 11 ? (ph == 0 || ph == 5) : (ph == 8);
}
#endif
__global__ void __launch_bounds__(512, 2) mk_fwd(Args args) {
    extern __shared__ __attribute__((aligned(16))) unsigned char lds[];
    Frame F;
    F.lds = (LAS unsigned char*)lds; F.ldsg = lds;
    F.MISC = (volatile LAS unsigned*)(F.lds + MISC_OFF);
    F.tid = threadIdx.x; F.lane = F.tid & 63; F.wave = __builtin_amdgcn_readfirstlane(F.tid >> 6);
    F.G = gridDim.x; { const int bx = blockIdx.x; F.vcu = (F.G % 8 == 0) ? (bx % 8) * (F.G / 8) + bx / 8 : bx; }
    F.ap = (ArgsP)__builtin_amdgcn_kernarg_segment_ptr();
    F.ws = (GAS unsigned char*)args.ws; F.out = (GAS float*)args.out; F.ctl = (gu32*)(F.ws + WS_CTL);
    for (int u = F.tid; u < (LDS_BYTES - MISC_OFF) / 4; u += 512) ((LAS unsigned*)(F.lds + MISC_OFF))[u] = 0u;
    __syncthreads();
    XcdBarrier bar = xcd_barrier_post((unsigned*)(F.ctl + CW_BAR), F.MISC + 8);
#if STAMP >= 20
    if (F.tid == 0) F.MISC[17] = (unsigned)__builtin_amdgcn_s_memrealtime();
#endif
    const int lo = args.ph_lo, hi = args.ph_hi;
#define IN(k) (lo <= (k) && (k) < hi)
#if STAMP >= 6
#define SEAMC(k, cat) do { if (IN(k) && IN((k) + 1)) { const unsigned long long tb0_ = __builtin_amdgcn_s_memrealtime(); xcd_barrier(bar); const unsigned long long tb1_ = __builtin_amdgcn_s_memrealtime(); \
        if (F.tid == 0) { if (STAMP >= 20) { F.MISC[16] += (seam_sel(cat) && (STAMP != 50 || (((k) & 8) != 0))) ? (unsigned)tb1_ - F.MISC[17] : 0u; F.MISC[17] = (unsigned)tb1_; } else F.MISC[16] += seam_sel(cat) ? (unsigned)(tb1_ - tb0_) : 0u; } } } while (0)
#else
#define SEAMC(k, cat) do { if (IN(k) && IN((k) + 1)) xcd_barrier(bar); } while (0)
#endif
    if (IN(0) && (PHM & 1)) { Frame L = site(F); p0_modvec(L); __syncthreads(); p0_tables(L); p0_copy_ctx(L); p0_fold(L); __syncthreads(); p0_weights(L); __syncthreads(); }
    SEAMC(0, 8);
    for (int li = 0; li < DEPTH; ++li) {
        const int pb = 1 + 8 * li, lj = li >> 1; const bool even = (li & 1) == 0;
        if (IN(pb + 0) && (PHM & 2)) { Frame L = site(F); const float* rg = (const float*)(WSP(L) + WS_MODV) + (size_t)((li - 1) * 3 + 2) * 12288 + 5 * DM;
            if (li == 0) norm_phase<true>(L, li, 0, INP(L, 0), (float*)(WSP(L) + WS_HC), 0, rg); else norm_phase<false>(L, li, 0, WSP(L) + WS_HB, (float*)(WSP(L) + WS_HC), 11, rg);
            if (DUP & 32) { if (li == 0) norm_phase<true>(L, li, 0, INP(L, 0), (float*)(WSP(L) + WS_HC), 0, nullptr); else norm_phase<false>(L, li, 0, WSP(L) + WS_HB, (float*)(WSP(L) + WS_HC), 0, nullptr); } }
        SEAMC(pb + 0, 0);
        if (IN(pb + 1) && (PHM & 4)) { Frame L = site(F);
            const int N = even ? EVN : ODN;
            const bf16* Bt = even ? (const bf16*)(WSP(L) + WS_WIN_E + (size_t)lj * SZ_WIN_E) : (const bf16*)(WSP(L) + WS_WIN_O + (size_t)lj * SZ_WIN_O);
            pg8::Gemm g{(const bf16*)(WSP(L) + WS_A), Bt, MT, N, DM}; pg8::StaticOrder S; S.init(MT, N, L.G, (int)blockIdx.x);
            if (even) {
                pg8::EpiEvenIn E{(bf16*)(WSP(L) + WS_P), (bf16*)(WSP(L) + WS_QR), N, INP(L, 11) + (size_t)lj * 128, (const float*)(WSP(L) + WS_ROPE), (LAS float*)(L.lds + pg8::STAGE_BYTES), (bf16*)(WSP(L) + WS_FT)};
                pg8::gemm_phase<pg8::EpiEvenIn, pg8::StaticOrder, PG8_ALIGN, PG8_SP2>(L.lds, g, S, E);
            } else {
            pg8::EpiOddIn E{(bf16*)(WSP(L) + WS_P), N, INP(L, 16) + (size_t)lj * 256, (LAS float*)(L.lds + pg8::STAGE_BYTES)};
            pg8::gemm_phase<pg8::EpiOddIn, pg8::StaticOrder, PG8_ALIGN, PG8_SP2>(L.lds, g, S, E);
            }
            wq_tail(L, 2 * li, (MT / 256) * (N / 256));
        }
        SEAMC(pb + 1, 1);
        if (IN(pb + 3)) { Frame L = site(F); if (even) { if (PHM & 32) mixer_even(L, lj); } else {
#if STAMP == 13 || STAMP == 14
            if (F.tid == 0) F.MISC[18] = (unsigned)__builtin_amdgcn_s_memrealtime();
#endif
            if (PHM & 16) prep_odd(L, lj);
#if STAMP == 14
            if (F.tid == 0) F.MISC[16] += (unsigned)__builtin_amdgcn_s_memrealtime() - F.MISC[18];
#endif
#if STAMP == 13
            if (F.tid == 0) F.MISC[18] = (unsigned)__builtin_amdgcn_s_memrealtime();
#endif
            if (PHM & 64) mixer_odd(L, lj, li != DEPTH - 1);
#if STAMP == 13
            if (F.tid == 0) F.MISC[16] += (unsigned)__builtin_amdgcn_s_memrealtime() - F.MISC[18];
#endif
            } }
        SEAMC(pb + 3, 3);
        if (IN(pb + 4) && (PHM & 128)) { Frame L = site(F);
            const bf16* Bt = even ? (const bf16*)(WSP(L) + WS_WOUT_E + (size_t)lj * SZ_WOUT) : (const bf16*)(WSP(L) + WS_WOUT_O + (size_t)lj * SZ_WOUT);
            const float* modl = (const float*)(WSP(L) + WS_MODV) + (size_t)li * 3 * 12288;
            pg8::Gemm g{(const bf16*)(WSP(L) + WS_MIX), Bt, MT, DM, DM}; pg8::SplitOrder<8> S; S.init(ML, DM, DM, L.G, (int)blockIdx.x, li != 3);
            if (li == 0) {
                pg8::EpiGate<true> E{(const void*)INP(L, 0), (void*)(WSP(L) + WS_HB), (float*)(WSP(L) + WS_SLAB), modl + 2 * DM, 0};
                pg8::gemm_phase<pg8::EpiGate<true>, pg8::SplitOrder<8>, PG8_ALIGN, PG8_SP2>(L.lds, g, S, E);
            } else {
                pg8::EpiGate<false> E{(const void*)(WSP(L) + WS_HB), (void*)(WSP(L) + WS_HB), (float*)(WSP(L) + WS_SLAB), modl + 2 * DM, 0};
                pg8::gemm_phase<pg8::EpiGate<false>, pg8::SplitOrder<8>, PG8_ALIGN, PG8_SP2>(L.lds, g, S, E);
            }
        }
        SEAMC(pb + 4, 4);
        if (IN(pb + 5) && (PHM & 2)) { Frame L = site(F); norm_phase<false>(L, li, 1, WSP(L) + WS_HB, (float*)(WSP(L) + WS_HC), li == 3 ? 0 : 8, (const float*)(WSP(L) + WS_MODV) + (size_t)(li * 3 + 2) * 12288 + 2 * DM); if (DUP & 32) norm_phase<false>(L, li, 1, WSP(L) + WS_HB, (float*)(WSP(L) + WS_HC), 0, nullptr); }
        SEAMC(pb + 5, 5);
        if (IN(pb + 6) && (PHM & 256)) { Frame L = site(F);
            const int Mr = li == 3 ? ML : MT;
            pg8::Gemm g{(const bf16*)(WSP(L) + WS_A), (const bf16*)(WSP(L) + WS_WFI + (size_t)li * SZ_WFI), Mr, 2 * FH, DM}; pg8::StaticOrder S; S.init(Mr, 2 * FH, L.G, (int)blockIdx.x);
            pg8::EpiSwiglu E{(bf16*)(WSP(L) + WS_HID), FH};
            for (int rep = 0; rep < ((DUP & 4) ? 2 : 1); ++rep)
            pg8::gemm_phase<pg8::EpiSwiglu, pg8::StaticOrder, PG8_ALIGN, PG8_SP2>(L.lds, g, S, E);
            if (li < 3) wq_tail(L, 2 * li + 1, (Mr / 256) * (2 * FH / 256));
        }
        SEAMC(pb + 6, 6);
        if (IN(pb + 7) && (PHM & 512)) { Frame L = site(F);
            const float* modl = (const float*)(WSP(L) + WS_MODV) + (size_t)li * 3 * 12288;
            pg8::Gemm g{(const bf16*)(WSP(L) + WS_HID), (const bf16*)(WSP(L) + WS_WFO + (size_t)li * SZ_WFO), MT, DM, FH}; pg8::SplitOrder<11> S; S.init(ML, DM, FH, L.G, (int)blockIdx.x, li != 3);
            pg8::EpiGate<false> E{(const void*)(WSP(L) + WS_HB), li == 3 ? (void*)OUTP(L) : (void*)(WSP(L) + WS_HB), (float*)(WSP(L) + WS_SLAB), modl + 5 * DM, li == 3 ? 1 : 0};
            pg8::gemm_phase<pg8::EpiGate<false>, pg8::SplitOrder<11>, PG8_ALIGN, PG8_SP2>(L.lds, g, S, E);
        }
        SEAMC(pb + 7, 7);
    }
#if STAMP >= 6
    if (STAMP >= 20 && F.tid == 0) { if (seam_sel(7)) F.MISC[16] += (unsigned)__builtin_amdgcn_s_memrealtime() - F.MISC[17]; if (blockIdx.x != 0) F.MISC[16] = 0u; else F.MISC[16] *= F.G; }
    if (F.tid == 0) __hip_atomic_fetch_add((GAS unsigned*)(F.ctl + 2048), (unsigned)F.MISC[16], RLX_AGENT);
    __syncthreads(); xcd_barrier(bar);
    if (blockIdx.x == 0 && F.wave == 0) {
        const unsigned v = __hip_atomic_load((GAS unsigned*)(F.ctl + 2048), RLX_AGENT);
        const unsigned long long ticks = (unsigned long long)v / F.G;
        const unsigned long long t0 = __builtin_amdgcn_s_memrealtime();
        while (__builtin_amdgcn_s_memrealtime() - t0 < ticks) __builtin_amdgcn_s_sleep(64);
    }
#elif STAMP
    if (blockIdx.x == 0 && F.wave == 0) {
        const unsigned v = __hip_atomic_load((GAS unsigned*)(F.ws + WS_LAM + 1024), RLX_AGENT);
        const unsigned long long ticks = (STAMP == 1) ? (unsigned long long)v * 100ull : ((unsigned long long)v * 100ull) >> 10;
        const unsigned long long t0 = __builtin_amdgcn_s_memrealtime();
        while (__builtin_amdgcn_s_memrealtime() - t0 < ticks) __builtin_amdgcn_s_sleep(64);
    }
#endif
#undef IN
#undef SEAMC
}

extern "C" void kernel_launch(void* const* d_in, const int* in_sizes, int n_in, void* d_out, int out_size, void* d_ws, size_t ws_size, hipStream_t stream) {
    static int grid = 0;
    if (grid == 0) {
        if (n_in != 19 || in_sizes[0] != ML * DM || out_size != ML * DM || ws_size < WS_END) { fprintf(stderr, "kernel_launch: shape mismatch (n_in %d, in0 %d, out %d, ws %zu < %zu); nothing launched\n", n_in, n_in > 0 ? in_sizes[0] : -1, out_size, ws_size, (size_t)WS_END); grid = -1; return; }
        int dev = 0, cus = 0, per_cu = 0;
        if (hipGetDevice(&dev) != hipSuccess || hipDeviceGetAttribute(&cus, hipDeviceAttributeMultiprocessorCount, dev) != hipSuccess) { fprintf(stderr, "kernel_launch: device query failed\n"); grid = -1; return; }
        if (hipFuncSetAttribute((const void*)mk_fwd, hipFuncAttributeMaxDynamicSharedMemorySize, LDS_BYTES) != hipSuccess) { fprintf(stderr, "kernel_launch: hipFuncSetAttribute failed\n"); grid = -1; return; }
        if (hipOccupancyMaxActiveBlocksPerMultiprocessor(&per_cu, (const void*)mk_fwd, 512, LDS_BYTES) != hipSuccess || per_cu < 1) fprintf(stderr, "kernel_launch: note: occupancy query reports %d workgroups per CU\n", per_cu);
        (void)hipGetLastError();
        grid = cus;
    }
    if (grid < 0) return;
    if (hipMemsetAsync((char*)d_ws + WS_CTL, 0, CTL_ZERO_BYTES, stream) != hipSuccess) { fprintf(stderr, "kernel_launch: memset failed\n"); return; }
    Args a{};
    for (int i = 0; i < 19; ++i) a.in[i] = (const float*)d_in[i];
    a.out = (float*)d_out; a.ws = (unsigned char*)d_ws;
    constexpr int NL = MK_N_LAUNCHES;
    for (int l = 0; l < NL; ++l) {
        a.ph_lo = (NL == 1) ? 0 : l; a.ph_hi = (NL == 1) ? NPH : l + 1;
        hipLaunchKernelGGL(mk_fwd, dim3(grid), dim3(512), LDS_BYTES, stream, a);
        const hipError_t le = hipPeekAtLastError();
        if (le != hipSuccess) { fprintf(stderr, "kernel_launch: launch %d failed: %s\n", l, hipGetErrorName(le)); break; }
    }
}
```

```cpp
#include <hip/hip_runtime.h>
#include <cstdio>
#include <cstdint>
#include <cstddef>
#ifndef DUP
#define DUP 0
#endif

#ifndef STAMP
#define STAMP 0
#endif
#ifndef STAMP_LJ
#define STAMP_LJ 0
#endif
namespace pg8 {
#define PG8_LAS __attribute__((address_space(3)))
typedef unsigned short bf16_t;
typedef short bf16x8 __attribute__((ext_vector_type(8)));
typedef float f32x4 __attribute__((ext_vector_type(4)));
typedef unsigned u32x4 __attribute__((ext_vector_type(4)));
constexpr int BM = 256, BK = 64, HALF = 128, HTB = HALF * BK * 2  , STAGE_BYTES = 8 * HTB, NXCD = 8, WGM = 8;

__host__ __device__ __forceinline__ int lds_byte(int r, int c) { const int st = (r >> 4) * 2 + (c >> 5), rr = r & 15, cc = c & 31, ob = rr * 64 + cc * 2; return st * 1024 + (ob ^ (((ob >> 9) & 1) << 5)); }
__host__ __device__ __forceinline__ void stage_rc(int b, int& R, int& C) { const int st = b / 1024, sb = b % 1024, swz = sb ^ (((sb >> 9) & 1) << 5); R = (st >> 1) * 16 + swz / 64; C = (st & 1) * 32 + (swz % 64) / 2; }
__host__ __device__ __forceinline__ int perm32(int rho) { const int n = rho >> 4, i = rho & 15; return 8 * (i >> 2) + 4 * n + (i & 3); }

struct Unit { int pm, pn; int kb, nt; };
struct Gemm { const bf16_t* A; const bf16_t* Bt; int M, N, K; };

struct StaticOrder {
    int nM, nN, nwg, G, c;
    __host__ __device__ void init(int M, int N, int G_, int c_) { nM = M / BM; nN = N / BM; nwg = nM * nN; G = G_; c = c_; }
    __host__ __device__ bool next(int i, Unit& u) const {
        const long L = (long)i * G + c; if (L >= nwg) return false;
        int wgid = (int)L; { const int q = nwg / NXCD, r = nwg % NXCD, xcd = wgid % NXCD, off = wgid / NXCD; wgid = (xcd < r ? xcd * (q + 1) : r * (q + 1) + (xcd - r) * q) + off; }
        const int nig = WGM * nN, gid = wgid / nig, fm = gid * WGM, gsz = (nM - fm) < WGM ? (nM - fm) : WGM;
        u.pm = fm + ((wgid % nig) % gsz); u.pn = (wgid % nig) / gsz; return true;
    }
    static constexpr bool SPLITK = false;
    __device__ __forceinline__ void a_ready(const Unit&) const {}
    __device__ __forceinline__ void done(const Unit&) const {}
};

__device__ __forceinline__ unsigned cvt_pk_bf16(float lo, float hi) { unsigned r; asm volatile("v_cvt_pk_bf16_f32 %0, %1, %2" : "=v"(r) : "v"(lo), "v"(hi)); return r; }
typedef float f32x2 __attribute__((ext_vector_type(2)));
__device__ __forceinline__ f32x2 gelu_pk(f32x2 v) {
    const f32x2 av = __builtin_elementwise_abs(v), d = av * 0.2316418882f + 1.0f;
    f32x2 t; t.x = __builtin_amdgcn_rcpf(d.x); t.y = __builtin_amdgcn_rcpf(d.y);
    f32x2 q = t * 0.5307027145f + (-0.7265760135f); q = q * t + 0.7107068705f; q = q * t + (-0.142248368f); q = q * t + 0.127414796f; q = q * t;
    const f32x2 s = (v * v) * (-0.72134752044f);
    f32x2 e; e.x = __builtin_amdgcn_exp2f(s.x); e.y = __builtin_amdgcn_exp2f(s.y);
    const f32x2 m = v * (q * e), r = v - m;
    f32x2 o; o.x = v.x < 0.f ? m.x : r.x; o.y = v.y < 0.f ? m.y : r.y; return o;
}

template <int ACT  > struct EpiBf16 {
    static constexpr bool PERM = true, AFTER_DRAIN = false; static_assert(ACT == 0 || ACT == 1, "EpiBf16: ACT is 0 (none) or 1 (gelu_pk)");
    bf16_t* O; int ldc; const float* bias; int split_cols; size_t split_stride; float scale0;
    __device__ __forceinline__ void operator()(const f32x4 (&acc)[2][2][4][2], const Unit& u, int wr, int wc, int fr, int fq) const {
        const int row0 = u.pm * BM + wr * 64 + fr; int colt = u.pn * BM; bf16_t* base = O;
        float sc = 1.f; if (split_cols) { const int t = colt / split_cols; base += (size_t)t * split_stride; colt -= t * split_cols; if (t == 0) sc = scale0; }
        const int col0 = colt + wc * 32 + 8 * fq, bcol0 = u.pn * BM + wc * 32 + 8 * fq;
        f32x4 bv[2][2];
#pragma unroll
        for (int bj = 0; bj < 2; ++bj)
#pragma unroll
            for (int n = 0; n < 2; ++n) bv[bj][n] = bias ? *(const f32x4*)(bias + bcol0 + bj * HALF + 4 * n) : (f32x4){0.f, 0.f, 0.f, 0.f};
#pragma unroll
        for (int ai = 0; ai < 2; ++ai)
#pragma unroll
            for (int m = 0; m < 4; ++m) { bf16_t* rowp = base + (size_t)(row0 + ai * HALF + m * 16) * ldc + col0;
#pragma unroll
                for (int bj = 0; bj < 2; ++bj) { f32x4 v0 = acc[ai][bj][m][0] + bv[bj][0], v1 = acc[ai][bj][m][1] + bv[bj][1];
                    if (ACT == 1) { f32x2 a = gelu_pk((f32x2){v0[0], v0[1]}), b = gelu_pk((f32x2){v0[2], v0[3]}), c = gelu_pk((f32x2){v1[0], v1[1]}), d = gelu_pk((f32x2){v1[2], v1[3]});
                        v0 = (f32x4){a.x, a.y, b.x, b.y}; v1 = (f32x4){c.x, c.y, d.x, d.y}; }
                    v0 = v0 * sc; v1 = v1 * sc; u32x4 w; w.x = cvt_pk_bf16(v0[0], v0[1]); w.y = cvt_pk_bf16(v0[2], v0[3]); w.z = cvt_pk_bf16(v1[0], v1[1]); w.w = cvt_pk_bf16(v1[2], v1[3]);
                    *(u32x4*)(rowp + bj * HALF) = w; } }
    }
};

template <bool BASE_F32> struct EpiGate {
    static constexpr bool PERM = true, AFTER_DRAIN = false;
    const void* base_l; void* out_l; float* slab; const float* gate; int out_f32;
    __device__ __forceinline__ void operator()(const f32x4 (&acc)[2][2][4][2], const Unit& u, int wr, int wc, int fr, int fq) const {
        const bool isc = u.pm >= 64; const int grp = u.pm < 32 ? 0 : (u.pm < 64 ? 1 : 2);
        const int rowt = (isc ? (u.pm - 64) : u.pm) * BM + wr * 64 + fr;
        const int col0 = u.pn * BM + wc * 32 + 8 * fq;
        if (isc) {
            const int kc = u.kb / (u.nt * BK * 2); float* sp = slab + (size_t)kc * (512 * 2048);
#pragma unroll
            for (int ai = 0; ai < 2; ++ai)
#pragma unroll
                for (int m = 0; m < 4; ++m) { const size_t off = (size_t)(rowt + ai * HALF + m * 16) * 2048 + col0;
#pragma unroll
                    for (int bj = 0; bj < 2; ++bj)
#pragma unroll
                        for (int n = 0; n < 2; ++n) *(f32x4*)(sp + off + bj * HALF + n * 4) = acc[ai][bj][m][n]; }
            return; }
        f32x4 gv[2][2];
#pragma unroll
        for (int bj = 0; bj < 2; ++bj)
#pragma unroll
            for (int n = 0; n < 2; ++n) gv[bj][n] = *(const f32x4*)(gate + grp * 12288 + col0 + bj * HALF + n * 4);
        u32x4 pball[2][4][2];
        if constexpr (!BASE_F32) {
            const unsigned long long bpu = (unsigned long long)base_l;
            const void* bps = (const void*)(((unsigned long long)(unsigned)__builtin_amdgcn_readfirstlane((int)(bpu >> 32)) << 32) | (unsigned)__builtin_amdgcn_readfirstlane((int)bpu));
            const __amdgpu_buffer_rsrc_t rs = __builtin_amdgcn_make_buffer_rsrc((void*)bps, 0, 0x7fffffff, 0x00020000);
            const int voff = ((wr * 64 + fr) * 2048 + wc * 32 + 8 * fq) * 2;
            const int sb = __builtin_amdgcn_readfirstlane((u.pm * BM * 2048 + u.pn * BM) * 2);
#pragma unroll
            for (int ai = 0; ai < 2; ++ai)
#pragma unroll
                for (int m = 0; m < 4; ++m)
#pragma unroll
                    for (int bj = 0; bj < 2; ++bj) pball[ai][m][bj] = __builtin_bit_cast(u32x4, __builtin_amdgcn_raw_buffer_load_b128(rs, voff, sb + ((ai * HALF + m * 16) * 2048 + bj * HALF) * 2, 0));
            asm volatile("" ::: "memory");
        }
#pragma unroll
        for (int ai = 0; ai < 2; ++ai) {
            f32x4 pre[4][2][2]; u32x4 pb[4][2];
            if constexpr (BASE_F32) { const float* bp = (const float*)base_l;
#pragma unroll
                for (int m = 0; m < 4; ++m) { const size_t off = (size_t)(rowt + ai * HALF + m * 16) * 2048 + col0;
#pragma unroll
                    for (int bj = 0; bj < 2; ++bj)
#pragma unroll
                        for (int n = 0; n < 2; ++n) pre[m][bj][n] = *(const f32x4*)(bp + off + bj * HALF + n * 4); }
            } else {
#pragma unroll
                for (int m = 0; m < 4; ++m)
#pragma unroll
                    for (int bj = 0; bj < 2; ++bj) pb[m][bj] = pball[ai][m][bj];
            }
            asm volatile("" ::: "memory");
#pragma unroll
            for (int m = 0; m < 4; ++m) { const size_t off = (size_t)(rowt + ai * HALF + m * 16) * 2048 + col0;
#pragma unroll
                for (int bj = 0; bj < 2; ++bj) { f32x4 x0, x1;
                    if constexpr (BASE_F32) { x0 = pre[m][bj][0]; x1 = pre[m][bj][1]; }
                    else { const u32x4 w = pb[m][bj];
                        x0 = f32x4{__uint_as_float(w.x << 16), __uint_as_float(w.x & 0xffff0000u), __uint_as_float(w.y << 16), __uint_as_float(w.y & 0xffff0000u)};
                        x1 = f32x4{__uint_as_float(w.z << 16), __uint_as_float(w.z & 0xffff0000u), __uint_as_float(w.w << 16), __uint_as_float(w.w & 0xffff0000u)}; }
                    const f32x4 a = x0 + gv[bj][0] * acc[ai][bj][m][0], b = x1 + gv[bj][1] * acc[ai][bj][m][1];
                    if (out_f32) { float* op = (float*)out_l + off + bj * HALF; *(f32x4*)op = a; *(f32x4*)(op + 4) = b; }
                    else { u32x4 w; w.x = cvt_pk_bf16(a.x, a.y); w.y = cvt_pk_bf16(a.z, a.w); w.z = cvt_pk_bf16(b.x, b.y); w.w = cvt_pk_bf16(b.z, b.w);
                        *(u32x4*)((bf16_t*)out_l + off + bj * HALF) = w; } } }
            asm volatile("" ::: "memory");
        }
    }
};
template <int KS> struct SplitOrder {
    static constexpr bool SPLITK = true;
    StaticOrder so; int G, c, ntc, ntf, nctx;
    __device__ void init(int Mlat, int N, int K, int G_, int c_, bool with_ctx) { so.init(Mlat, N, G_, c_); G = G_; c = c_; ntf = K / BK; ntc = ntf / KS; nctx = with_ctx ? 16 * KS : 0; }
    __device__ bool next(int i, Unit& u) const {
        const long L = (long)i * G + c;
        if (L < so.nwg) { so.next(i, u); u.kb = 0; u.nt = ntf; return true; }
        const int x = (int)(L - so.nwg); if (x >= nctx) return false;
        const int kc = x % KS, tile = x / KS; u.pn = tile & 7; u.pm = so.nM + (tile >> 3); u.kb = kc * ntc * BK * 2; u.nt = ntc; return true;
    }
    __device__ __forceinline__ void a_ready(const Unit&) const {}
    __device__ __forceinline__ void done(const Unit&) const {}
};
struct EpiEvenIn {
    static constexpr bool PERM = true, AFTER_DRAIN = false;
    bf16_t* P; bf16_t* QR; int ldc; const float* gains; const float* rope; PG8_LAS float* part; bf16_t* FT;
    __device__ __forceinline__ void operator()(const f32x4 (&acc)[2][2][4][2], const Unit& u, int wr, int wc, int fr, int fq) const {
        const int row0 = u.pm * BM + wr * 64 + fr; const int col0 = u.pn * BM + wc * 32 + 8 * fq;
        if (u.pn >= 18 && u.pm < 64) {
            const int cp0 = (col0 - 4608) >> 2;
#pragma unroll
            for (int ai = 0; ai < 2; ++ai)
#pragma unroll
                for (int m = 0; m < 4; ++m) { const int row = row0 + ai * HALF + m * 16; const int b = row >> 13, t = row & 8191;
#pragma unroll
                    for (int bj = 0; bj < 2; ++bj) { const f32x4 v0 = acc[ai][bj][m][0], v1 = acc[ai][bj][m][1];
                        bf16_t* fp = FT + ((size_t)(b * 256 + cp0 + 32 * bj) * 8192 + t) * 4;
                        typedef unsigned u32x2_ __attribute__((ext_vector_type(2)));
                        u32x2_ wa, wb; wa.x = cvt_pk_bf16(v0[0], v0[1]); wa.y = cvt_pk_bf16(v0[2], v0[3]); wb.x = cvt_pk_bf16(v1[0], v1[1]); wb.y = cvt_pk_bf16(v1[2], v1[3]);
                        *(u32x2_*)fp = wa; *(u32x2_*)(fp + 8192 * 4) = wb; } }
            return; }
        if (u.pn >= 12) {
#pragma unroll
            for (int ai = 0; ai < 2; ++ai)
#pragma unroll
                for (int m = 0; m < 4; ++m) { bf16_t* rowp = P + (size_t)(row0 + ai * HALF + m * 16) * ldc + col0;
#pragma unroll
                    for (int bj = 0; bj < 2; ++bj) { const f32x4 v0 = acc[ai][bj][m][0], v1 = acc[ai][bj][m][1];
                        u32x4 w; w.x = cvt_pk_bf16(v0[0], v0[1]); w.y = cvt_pk_bf16(v0[2], v0[3]); w.z = cvt_pk_bf16(v1[0], v1[1]); w.w = cvt_pk_bf16(v1[2], v1[3]);
                        *(u32x4*)(rowp + bj * HALF) = w; } }
            return; }
        const bool isq = u.pn < 6, lat = u.pm < 64;
        int rb_ = wr * 64 + fr; asm volatile("" : "+v"(rb_));
#pragma unroll
        for (int ai = 0; ai < 2; ++ai)
#pragma unroll
            for (int m = 0; m < 4; ++m)
#pragma unroll
                for (int bj = 0; bj < 2; ++bj) { const f32x4 a = acc[ai][bj][m][0], b = acc[ai][bj][m][1];
                    float s = (a[0] * a[0] + a[1] * a[1]) + (a[2] * a[2] + a[3] * a[3]) + (b[0] * b[0] + b[1] * b[1]) + (b[2] * b[2] + b[3] * b[3]);
                    s += __shfl_xor(s, 16); s += __shfl_xor(s, 32);
                    if (fq == 0) part[((ai * HALF + m * 16 + rb_) * 2 + bj) * 4 + wc] = s; }
        asm volatile("s_waitcnt lgkmcnt(0)" ::: "memory"); __builtin_amdgcn_s_barrier(); asm volatile("" ::: "memory");
        const float* gp = gains + (isq ? 0 : 64) + 32 * (wc & 1) + 8 * fq; const float qs = isq ? 0.18033688011112042f : 1.0f;
        float gn[8];
#pragma unroll
        for (int e = 0; e < 8; ++e) gn[e] = gp[e] * qs;
#pragma unroll
        for (int ai = 0; ai < 2; ++ai)
#pragma unroll
            for (int m = 0; m < 4; ++m) { const int rl = ai * HALF + m * 16 + rb_; const int row = u.pm * BM + rl;
                f32x4 cs0 = {1.f, 0.f, 1.f, 0.f}, cs1 = cs0, cs2 = cs0, cs3 = cs0;
                if (lat) { const int t = row & 8191; const int pos = (wc & 1) ? (t & 63) : (t >> 6); const float* rp = rope + (size_t)(pos * 16 + 8 * (fq & 1)) * 2;
                    cs0 = *(const f32x4*)rp; cs1 = *(const f32x4*)(rp + 4); cs2 = *(const f32x4*)(rp + 8); cs3 = *(const f32x4*)(rp + 12); }
                const float c8[8] = {cs0[0], cs0[2], cs1[0], cs1[2], cs2[0], cs2[2], cs3[0], cs3[2]}, s8[8] = {cs0[1], cs0[3], cs1[1], cs1[3], cs2[1], cs2[3], cs3[1], cs3[3]};
#pragma unroll
                for (int bj = 0; bj < 2; ++bj) {
                    const float ss = part[(rl * 2 + bj) * 4 + wc] + part[(rl * 2 + bj) * 4 + (wc ^ 1)];
                    const float rstd = rsqrtf(ss * (1.0f / 64.0f) + 1e-6f);
                    float y[8], yr[8];
#pragma unroll
                    for (int e = 0; e < 8; ++e) y[e] = acc[ai][bj][m][e >> 2][e & 3] * rstd * gn[e];
#pragma unroll
                    for (int e = 0; e < 8; ++e) { const float yp = __shfl_xor(y[e], 32); yr[e] = (fq & 2) ? (y[e] * c8[e] + yp * s8[e]) : (y[e] * c8[e] - yp * s8[e]); }
                    u32x4 wn, wrot;
                    wn.x = cvt_pk_bf16(y[0], y[1]); wn.y = cvt_pk_bf16(y[2], y[3]); wn.z = cvt_pk_bf16(y[4], y[5]); wn.w = cvt_pk_bf16(y[6], y[7]);
                    wrot.x = cvt_pk_bf16(yr[0], yr[1]); wrot.y = cvt_pk_bf16(yr[2], yr[3]); wrot.z = cvt_pk_bf16(yr[4], yr[5]); wrot.w = cvt_pk_bf16(yr[6], yr[7]);
                    bf16_t* pp = P + (size_t)row * ldc + col0 + bj * HALF;
                    if (isq) { *(u32x4*)pp = wn; if (lat) *(u32x4*)(QR + (size_t)row * 1536 + col0 + bj * HALF) = wrot; }
                    else     { *(u32x4*)pp = lat ? wrot : wn; }
                }
                asm volatile("" ::: "memory"); }
    }
};
struct EpiOddIn {
    static constexpr bool PERM = true, AFTER_DRAIN = false;
    bf16_t* P; int ldc; const float* gains; PG8_LAS float* part;
    __device__ __forceinline__ void operator()(const f32x4 (&acc)[2][2][4][2], const Unit& u, int wr, int wc, int fr, int fq) const {
        const int row0 = u.pm * BM + wr * 64 + fr; const int col0 = u.pn * BM + wc * 32 + 8 * fq;
        const bool isqk = u.pn >= 12 && u.pn < 20;
        float rs[2][4][2];
        if (isqk) {
            int rb_ = wr * 64 + fr; asm volatile("" : "+v"(rb_));
#pragma unroll
            for (int ai = 0; ai < 2; ++ai)
#pragma unroll
                for (int m = 0; m < 4; ++m)
#pragma unroll
                    for (int bj = 0; bj < 2; ++bj) { const f32x4 a = acc[ai][bj][m][0], b = acc[ai][bj][m][1];
                        float s = (a[0] * a[0] + a[1] * a[1]) + (a[2] * a[2] + a[3] * a[3]) + (b[0] * b[0] + b[1] * b[1]) + (b[2] * b[2] + b[3] * b[3]);
                        s += __shfl_xor(s, 16); s += __shfl_xor(s, 32);
                        if (fq == 0) part[((ai * HALF + m * 16 + rb_) * 2 + bj) * 4 + wc] = s; }
            asm volatile("s_waitcnt lgkmcnt(0)" ::: "memory"); __builtin_amdgcn_s_barrier(); asm volatile("" ::: "memory");
#pragma unroll
            for (int ai = 0; ai < 2; ++ai)
#pragma unroll
                for (int m = 0; m < 4; ++m)
#pragma unroll
                    for (int bj = 0; bj < 2; ++bj) { const f32x4 t = *(const PG8_LAS f32x4*)(part + ((ai * HALF + m * 16 + rb_) * 2 + bj) * 4);
                        rs[ai][m][bj] = rsqrtf(((t[0] + t[1]) + (t[2] + t[3])) * (1.0f / 128.0f) + 1e-6f); }
        }
        float gn[8];
        { const float* gp = gains + (u.pn >= 16 ? 128 : 0) + 32 * wc + 8 * fq;
          const float qs = u.pn < 16 ? 0.12751743f : 1.0f;
#pragma unroll
          for (int e = 0; e < 8; ++e) gn[e] = isqk ? gp[e] * qs : 1.0f; }
#pragma unroll
        for (int ai = 0; ai < 2; ++ai)
#pragma unroll
            for (int m = 0; m < 4; ++m) { bf16_t* rowp = P + (size_t)(row0 + ai * HALF + m * 16) * ldc + col0;
#pragma unroll
                for (int bj = 0; bj < 2; ++bj) { const float r = isqk ? rs[ai][m][bj] : 1.0f; const f32x4 v0 = acc[ai][bj][m][0], v1 = acc[ai][bj][m][1];
                    u32x4 w; w.x = cvt_pk_bf16(v0[0] * r * gn[0], v0[1] * r * gn[1]); w.y = cvt_pk_bf16(v0[2] * r * gn[2], v0[3] * r * gn[3]);
                    w.z = cvt_pk_bf16(v1[0] * r * gn[4], v1[1] * r * gn[5]); w.w = cvt_pk_bf16(v1[2] * r * gn[6], v1[3] * r * gn[7]);
                    *(u32x4*)(rowp + bj * HALF) = w; } }
    }
};
struct EpiSwiglu {
    static constexpr bool PERM = true, AFTER_DRAIN = false;
    bf16_t* O; int ldc;
    __device__ __forceinline__ void operator()(const f32x4 (&acc)[2][2][4][2], const Unit& u, int wr, int wc, int fr, int fq) const {
        const int row0 = u.pm * BM + wr * 64 + fr; const int col0 = u.pn * HALF + wc * 32 + 8 * fq;
#pragma unroll
        for (int ai = 0; ai < 2; ++ai)
#pragma unroll
            for (int m = 0; m < 4; ++m) { bf16_t* rowp = O + (size_t)(row0 + ai * HALF + m * 16) * ldc + col0;
                float hv[8];
#pragma unroll
                for (int n = 0; n < 2; ++n)
#pragma unroll
                    for (int e = 0; e < 4; ++e) { const float g = acc[ai][0][m][n][e], up = acc[ai][1][m][n][e];
                        hv[n * 4 + e] = g * __builtin_amdgcn_rcpf(1.0f + __expf(-g)) * up; }
                u32x4 w; w.x = cvt_pk_bf16(hv[0], hv[1]); w.y = cvt_pk_bf16(hv[2], hv[3]); w.z = cvt_pk_bf16(hv[4], hv[5]); w.w = cvt_pk_bf16(hv[6], hv[7]);
                *(u32x4*)rowp = w; }
    }
};

template <class Epi, class Sched, bool ALIGN_EPI = false, bool SP2 = false>
__device__ __forceinline__ void gemm_phase(PG8_LAS unsigned char* lds, const Gemm g, const Sched& S, const Epi& E) {
    int tid_ = threadIdx.x; asm volatile("" : "+v"(tid_));
    const int tid = tid_, wid = __builtin_amdgcn_readfirstlane(tid >> 6), lane = tid & 63, wr = wid >> 2, wc = wid & 3, fr = lane & 15, fq = lane >> 4;
    const int K = g.K, ntf = K / BK;
    unsigned voffA[2], voffB[2];
#pragma unroll
    for (int i = 0; i < 2; ++i) { int R, C; stage_rc(tid * 16 + i * 8192, R, C); const int Rb = Epi::PERM ? ((R & ~31) + perm32(R & 31)) : R;
        voffA[i] = (unsigned)(R * K + C) * 2u; voffB[i] = (unsigned)(Rb * K + C) * 2u; }
    const size_t kstep = (size_t)(BK * 2);
    const size_t hstep = (size_t)HALF * K * 2;
    const size_t tstep = 2 * hstep;
    const unsigned ldsw = (unsigned)wid * 1024u;
    const int aoff = lds_byte(wr * 64 + fr, fq * 8), boff = lds_byte(wc * 32 + fr, fq * 8);
#define PG8_SA(b, h) (((b) * 2 + (h)) * HTB)
#define PG8_SB(b, h) ((4 + (b) * 2 + (h)) * HTB)
#define PG8_STAGE(bufoff, gbase, voff) do { _Pragma("unroll") for (int _i = 0; _i < 2; ++_i) \
        __builtin_amdgcn_global_load_lds((const unsigned*)((const char*)(gbase) + (voff)[_i]), (PG8_LAS unsigned*)(lds + (bufoff) + ldsw + _i * 8192), 16, 0, 0); } while (0)
#define PG8_LDA(dst, b, h) do { _Pragma("unroll") for (int m = 0; m < 4; ++m) _Pragma("unroll") for (int k = 0; k < 2; ++k) dst[m][k] = *(const PG8_LAS bf16x8*)(lds + PG8_SA(b, h) + aoff + m * 2048 + k * 1024); } while (0)
#define PG8_LDB(dst, b, h) do { _Pragma("unroll") for (int n = 0; n < 2; ++n) _Pragma("unroll") for (int k = 0; k < 2; ++k) dst[n][k] = *(const PG8_LAS bf16x8*)(lds + PG8_SB(b, h) + boff + n * 2048 + k * 1024); } while (0)
#define PG8_MMA(ai, bj, At, Bt) do { __builtin_amdgcn_s_setprio(1); _Pragma("unroll") for (int m = 0; m < 4; ++m) _Pragma("unroll") for (int n = 0; n < 2; ++n) _Pragma("unroll") for (int k = 0; k < 2; ++k) \
        acc[ai][bj][m][n] = __builtin_amdgcn_mfma_f32_16x16x32_bf16(Bt[n][k], At[m][k], acc[ai][bj][m][n], 0, 0, 0); __builtin_amdgcn_s_setprio(0); } while (0)
#define PG8_WAIT_V(n) asm volatile("s_waitcnt vmcnt(" #n ")" ::: "memory")
#define PG8_WAIT_L(n) asm volatile("s_waitcnt lgkmcnt(" #n ")" ::: "memory")
#define PG8_BAR __builtin_amdgcn_s_barrier()
#define PG8_SCHED __builtin_amdgcn_sched_barrier(0)
    Unit cur, nxt; int ui = 0;
    if (!S.next(0, cur)) return;
    f32x4 acc[2][2][4][2];
#pragma unroll
    for (int a = 0; a < 2; ++a)
#pragma unroll
        for (int b = 0; b < 2; ++b)
#pragma unroll
            for (int m = 0; m < 4; ++m)
#pragma unroll
                for (int n = 0; n < 2; ++n) acc[a][b][m][n] = (f32x4){0.f, 0.f, 0.f, 0.f};
    bf16x8 At[4][2], B0[2][2], B1[2][2];
    const char* cA = (const char*)g.A + (size_t)cur.pm * tstep + (Sched::SPLITK ? cur.kb : 0); const char* cB = (const char*)g.Bt + (size_t)cur.pn * tstep + (Sched::SPLITK ? cur.kb : 0);
    S.a_ready(cur);
    if constexpr (SP2) {
        PG8_STAGE(PG8_SB(0, 0), cB, voffB); PG8_STAGE(PG8_SB(0, 1), cB + hstep, voffB); PG8_STAGE(PG8_SA(0, 0), cA, voffA); PG8_STAGE(PG8_SA(0, 1), cA + hstep, voffA);
        if (wr == 1) PG8_BAR;
        PG8_WAIT_V(2); PG8_BAR;
        PG8_STAGE(PG8_SB(1, 0), cB + kstep, voffB); PG8_STAGE(PG8_SA(1, 0), cA + kstep, voffA); PG8_STAGE(PG8_SB(1, 1), cB + hstep + kstep, voffB);
        PG8_WAIT_V(6); PG8_BAR;
    } else {
        PG8_STAGE(PG8_SB(0, 0), cB, voffB); PG8_STAGE(PG8_SA(0, 0), cA, voffA); PG8_STAGE(PG8_SB(0, 1), cB + hstep, voffB); PG8_STAGE(PG8_SA(0, 1), cA + hstep, voffA);
        if (wr == 1) PG8_BAR;
        PG8_WAIT_V(4); PG8_BAR;
        PG8_STAGE(PG8_SB(1, 0), cB + kstep, voffB); PG8_STAGE(PG8_SA(1, 0), cA + kstep, voffA); PG8_STAGE(PG8_SB(1, 1), cB + hstep + kstep, voffB);
        PG8_WAIT_V(6); PG8_BAR;
    }
    for (;;) {
        const bool has_next = S.next(ui + 1, nxt);
        const char* nA = has_next ? (const char*)g.A + (size_t)nxt.pm * tstep + (Sched::SPLITK ? nxt.kb : 0) : cA; const char* nB = has_next ? (const char*)g.Bt + (size_t)nxt.pn * tstep + (Sched::SPLITK ? nxt.kb : 0) : cB;
        const int nt = Sched::SPLITK ? cur.nt : ntf;
        for (int t = 0; t < nt; t += 2) {
            const bool last = (t == nt - 2);
            const char* a1 = cA + (size_t)(t + 1) * kstep;
            const char* a2 = last ? nA : cA + (size_t)(t + 2) * kstep; const char* b2 = last ? nB : cB + (size_t)(t + 2) * kstep;
            const char* a3 = a2 + kstep; const char* b3 = b2 + kstep;
            if (last && has_next) S.a_ready(nxt);
            if constexpr (SP2) {
            PG8_LDB(B0, 0, 0); PG8_LDB(B1, 0, 1); PG8_SCHED; PG8_LDA(At, 0, 0); PG8_STAGE(PG8_SA(1, 1), a1 + hstep, voffA);
            PG8_WAIT_V(8); PG8_WAIT_L(0); PG8_BAR; PG8_MMA(0, 0, At, B0); PG8_MMA(0, 1, At, B1); PG8_BAR; PG8_SCHED;
            PG8_LDA(At, 0, 1); PG8_STAGE(PG8_SB(0, 0), b2, voffB); PG8_STAGE(PG8_SB(0, 1), b2 + hstep, voffB); PG8_STAGE(PG8_SA(0, 0), a2, voffA);
            PG8_WAIT_V(8); PG8_WAIT_L(0); PG8_BAR; PG8_MMA(1, 0, At, B0); PG8_MMA(1, 1, At, B1); PG8_BAR; PG8_SCHED;
            PG8_LDB(B0, 1, 0); PG8_LDB(B1, 1, 1); PG8_SCHED; PG8_LDA(At, 1, 0); PG8_STAGE(PG8_SA(0, 1), a2 + hstep, voffA);
            PG8_WAIT_V(8); PG8_WAIT_L(0); PG8_BAR; PG8_MMA(0, 0, At, B0); PG8_MMA(0, 1, At, B1); PG8_BAR; PG8_SCHED;
            PG8_LDA(At, 1, 1); PG8_STAGE(PG8_SB(1, 0), b3, voffB); PG8_STAGE(PG8_SB(1, 1), b3 + hstep, voffB); PG8_STAGE(PG8_SA(1, 0), a3, voffA);
            PG8_WAIT_V(8); PG8_WAIT_L(0); PG8_BAR; PG8_MMA(1, 0, At, B0); PG8_MMA(1, 1, At, B1); PG8_BAR; PG8_SCHED;
            } else {
            PG8_LDB(B0, 0, 0); PG8_SCHED; PG8_LDA(At, 0, 0); PG8_STAGE(PG8_SA(1, 1), a1 + hstep, voffA);
            PG8_WAIT_L(8); PG8_BAR; PG8_WAIT_L(0); PG8_MMA(0, 0, At, B0); PG8_BAR; PG8_SCHED;
            PG8_LDB(B1, 0, 1); PG8_STAGE(PG8_SB(0, 0), b2, voffB);
            PG8_BAR; PG8_WAIT_L(0); PG8_MMA(0, 1, At, B1); PG8_BAR;
            PG8_LDA(At, 0, 1); PG8_STAGE(PG8_SA(0, 0), a2, voffA);
            PG8_BAR; PG8_WAIT_L(0); PG8_MMA(1, 0, At, B0); PG8_BAR; PG8_SCHED;
            PG8_STAGE(PG8_SB(0, 1), b2 + hstep, voffB);
            PG8_WAIT_V(6); PG8_BAR; PG8_MMA(1, 1, At, B1); PG8_BAR;
            PG8_LDB(B0, 1, 0); PG8_SCHED; PG8_LDA(At, 1, 0); PG8_STAGE(PG8_SA(0, 1), a2 + hstep, voffA);
            PG8_WAIT_L(8); PG8_BAR; PG8_WAIT_L(0); PG8_MMA(0, 0, At, B0); PG8_BAR; PG8_SCHED;
            PG8_LDB(B1, 1, 1); PG8_STAGE(PG8_SB(1, 0), b3, voffB);
            PG8_BAR; PG8_WAIT_L(0); PG8_MMA(0, 1, At, B1); PG8_BAR;
            PG8_LDA(At, 1, 1); PG8_STAGE(PG8_SA(1, 0), a3, voffA);
            PG8_BAR; PG8_WAIT_L(0); PG8_MMA(1, 0, At, B0); PG8_BAR; PG8_SCHED;
            PG8_STAGE(PG8_SB(1, 1), b3 + hstep, voffB);
            PG8_WAIT_V(6); PG8_BAR; PG8_MMA(1, 1, At, B1); PG8_BAR;
            }
        }
        if constexpr (ALIGN_EPI) { if (wr == 0) PG8_BAR; }
        if constexpr (!Epi::AFTER_DRAIN) { E(acc, cur, wr, wc, fr, fq); S.done(cur); }
        if (!has_next) break;
#pragma unroll
        for (int a = 0; a < 2; ++a)
#pragma unroll
            for (int b = 0; b < 2; ++b)
#pragma unroll
                for (int m = 0; m < 4; ++m)
#pragma unroll
                    for (int n = 0; n < 2; ++n) acc[a][b][m][n] = (f32x4){0.f, 0.f, 0.f, 0.f};
        cur = nxt; cA = nA; cB = nB; ++ui;
        if constexpr (ALIGN_EPI) { if (wr == 1) PG8_BAR; }
    }
    PG8_WAIT_V(0);
    if constexpr (!ALIGN_EPI) { if (wr == 0) PG8_BAR; }
    PG8_BAR;
    if constexpr (Epi::AFTER_DRAIN) { E.fused(acc, cur, wr, wc, fr, fq, lds, wid, lane); S.done(cur); }
#undef PG8_SA
#undef PG8_SB
#undef PG8_STAGE
#undef PG8_LDA
#undef PG8_LDB
#undef PG8_MMA
#undef PG8_WAIT_V
#undef PG8_WAIT_L
#undef PG8_BAR
#undef PG8_SCHED
}
}

#ifndef PG8_SP2
#define PG8_SP2 true
#endif
#ifndef PG8_ALIGN
#define PG8_ALIGN true
#endif

namespace att {
using bf16 = unsigned short;
using bf16x8 = __attribute__((ext_vector_type(8))) short;
using s16x4  = __attribute__((ext_vector_type(4))) short;
using f32x16 = __attribute__((ext_vector_type(16))) float;
using u32x4  = __attribute__((ext_vector_type(4))) unsigned;
constexpr int NW = 8, QBLK = 32, KVBLK = 64, DV = 128;
constexpr float THR = 8.f;
constexpr int SHM_V = KVBLK * DV * 2;
constexpr int LDS_WS_OFF = 2 * SHM_V + 2 * (KVBLK * 128 * 2);
constexpr int LDS_BT_OFF = LDS_WS_OFF + NW * 64 * 4;
constexpr int LDS_Q_OFF = LDS_BT_OFF + 2048;
constexpr int LDS_END = LDS_Q_OFF + NW * 8192;
#define ATT_KSWZ128(row, colB) ((row) * 256 + ((colB) ^ (((row) & 7) << 4)))
#define ATT_KSWZ64(row, colB)  ((row) * 128 + ((colB) ^ ((((row) >> 1) & 7) << 4)))
#define ATT_SBAR() __builtin_amdgcn_sched_barrier(0)
__device__ __forceinline__ int crow(int r, int hi) { return (r & 3) + 8 * (r >> 2) + 4 * hi; }
__device__ __forceinline__ unsigned cvtpk(float lo, float hi) { unsigned r; asm volatile("v_cvt_pk_bf16_f32 %0, %1, %2" : "=v"(r) : "v"(lo), "v"(hi)); return r; }
__device__ __forceinline__ bf16x8 ld8(const bf16* p) { return *reinterpret_cast<const bf16x8*>(p); }

template <int DQK> __device__ __forceinline__ void partialSM(f32x16& p0, f32x16& p1, float& m_reg, float& mn, float& alpha) {
  constexpr float SCALE = (DQK == 64) ? 0.125f : 0.088388347648318440f;
  constexpr float C = SCALE * 1.4426950408889634f;
  float pmax = p0[0];
#pragma unroll
  for (int r = 1; r < 16; ++r) pmax = fmaxf(pmax, p0[r]);
#pragma unroll
  for (int r = 0; r < 16; ++r) pmax = fmaxf(pmax, p1[r]);
  { auto rr = __builtin_amdgcn_permlane32_swap(__float_as_uint(pmax), __float_as_uint(pmax), false, false);
    pmax = fmaxf(__uint_as_float(rr[0]), __uint_as_float(rr[1])); }
  if (__builtin_expect(__all(pmax - m_reg <= THR / SCALE), 1)) { mn = m_reg; alpha = 1.f; }
  else { mn = fmaxf(m_reg, pmax); alpha = __builtin_amdgcn_exp2f((m_reg - mn) * C); m_reg = mn; }
  float mnC = -mn * C;
#pragma unroll
  for (int r = 0; r < 16; ++r) p0[r] = fmaf(p0[r], C, mnC);
#pragma unroll
  for (int r = 0; r < 16; ++r) p1[r] = fmaf(p1[r], C, mnC);
#pragma unroll
  for (int r = 0; r < 16; ++r) p0[r] = __builtin_amdgcn_exp2f(p0[r]);
}
__device__ __forceinline__ void finishSM(f32x16& p0, f32x16& p1, float alpha, float& l_reg, bf16x8& pa0, bf16x8& pa1, bf16x8& pa2, bf16x8& pa3) {
#pragma unroll
  for (int r = 0; r < 16; ++r) p1[r] = __builtin_amdgcn_exp2f(p1[r]);
  float ps = 0;
#pragma unroll
  for (int r = 0; r < 16; ++r) ps += p0[r];
#pragma unroll
  for (int r = 0; r < 16; ++r) ps += p1[r];
  { auto rr = __builtin_amdgcn_permlane32_swap(__float_as_uint(ps), __float_as_uint(ps), false, false);
    ps = __uint_as_float(rr[0]) + __uint_as_float(rr[1]); }
  l_reg = l_reg * alpha + ps;
#define ATT_PK4(P, BASE, OUT) do { unsigned a0 = cvtpk(P[BASE + 0], P[BASE + 1]), a1 = cvtpk(P[BASE + 2], P[BASE + 3]);   \
    unsigned b0 = cvtpk(P[BASE + 4], P[BASE + 5]), b1 = cvtpk(P[BASE + 6], P[BASE + 7]);                              \
    auto r0 = __builtin_amdgcn_permlane32_swap(a0, b0, false, false); auto r1 = __builtin_amdgcn_permlane32_swap(a1, b1, false, false); \
    u32x4 w = {r0[0], r1[0], r0[1], r1[1]}; OUT = *reinterpret_cast<bf16x8*>(&w); } while (0)
  ATT_PK4(p0, 0, pa0); ATT_PK4(p0, 8, pa1); ATT_PK4(p1, 0, pa2); ATT_PK4(p1, 8, pa3);
#undef ATT_PK4
}
__device__ __forceinline__ void expSM(f32x16& p) {
#pragma unroll
  for (int r = 0; r < 16; ++r) p[r] = __builtin_amdgcn_exp2f(p[r]);
}
__device__ __forceinline__ void packSM(f32x16& p0, f32x16& p1, float& l_reg, bf16x8& pa0, bf16x8& pa1, bf16x8& pa2, bf16x8& pa3) {
  float ps = 0;
#pragma unroll
  for (int r = 0; r < 16; ++r) ps += p0[r];
#pragma unroll
  for (int r = 0; r < 16; ++r) ps += p1[r];
  l_reg += ps; asm volatile("" : "+v"(l_reg));
#define ATT_PK4(P, BASE, OUT) do { unsigned a0 = cvtpk(P[BASE + 0], P[BASE + 1]), a1 = cvtpk(P[BASE + 2], P[BASE + 3]);   \
    unsigned b0 = cvtpk(P[BASE + 4], P[BASE + 5]), b1 = cvtpk(P[BASE + 6], P[BASE + 7]);                              \
    auto r0 = __builtin_amdgcn_permlane32_swap(a0, b0, false, false); auto r1 = __builtin_amdgcn_permlane32_swap(a1, b1, false, false); \
    u32x4 w = {r0[0], r1[0], r0[1], r1[1]}; OUT = *reinterpret_cast<bf16x8*>(&w); } while (0)
  ATT_PK4(p0, 0, pa0); ATT_PK4(p0, 8, pa1); ATT_PK4(p1, 0, pa2); ATT_PK4(p1, 8, pa3);
#undef ATT_PK4
}
__device__ __forceinline__ void finishSM_nm(f32x16& p0, f32x16& p1, float& l_reg, bf16x8& pa0, bf16x8& pa1, bf16x8& pa2, bf16x8& pa3) {
#pragma unroll
  for (int r = 0; r < 16; ++r) p1[r] = __builtin_amdgcn_exp2f(p1[r]);
  float ps = 0;
#pragma unroll
  for (int r = 0; r < 16; ++r) ps += p0[r];
#pragma unroll
  for (int r = 0; r < 16; ++r) ps += p1[r];
  { auto rr = __builtin_amdgcn_permlane32_swap(__float_as_uint(ps), __float_as_uint(ps), false, false);
    ps = __uint_as_float(rr[0]) + __uint_as_float(rr[1]); }
  l_reg += ps;
#define ATT_PK4(P, BASE, OUT) do { unsigned a0 = cvtpk(P[BASE + 0], P[BASE + 1]), a1 = cvtpk(P[BASE + 2], P[BASE + 3]);   \
    unsigned b0 = cvtpk(P[BASE + 4], P[BASE + 5]), b1 = cvtpk(P[BASE + 6], P[BASE + 7]);                              \
    auto r0 = __builtin_amdgcn_permlane32_swap(a0, b0, false, false); auto r1 = __builtin_amdgcn_permlane32_swap(a1, b1, false, false); \
    u32x4 w = {r0[0], r1[0], r0[1], r1[1]}; OUT = *reinterpret_cast<bf16x8*>(&w); } while (0)
  ATT_PK4(p0, 0, pa0); ATT_PK4(p0, 8, pa1); ATT_PK4(p1, 0, pa2); ATT_PK4(p1, 8, pa3);
#undef ATT_PK4
}
__device__ __forceinline__ void finish_l(float l_reg, float* li_l, int r32, int hi, float (&rli)[16]) {
  { auto rr = __builtin_amdgcn_permlane32_swap(__float_as_uint(l_reg), __float_as_uint(l_reg), false, false); l_reg = __uint_as_float(rr[0]) + __uint_as_float(rr[1]); }
  if (hi == 0) li_l[r32] = l_reg; asm volatile("s_waitcnt lgkmcnt(0)" ::: "memory");
#pragma unroll
  for (int r = 0; r < 16; ++r) rli[r] = __builtin_amdgcn_rcpf(li_l[crow(r, hi)]);
}
template <int DQK, bool QLDS, int KW> __device__ __forceinline__ void qkt(f32x16& p0, f32x16& p1, const char* Ks, const bf16x8* qr, const char* Qs, int r32, int hi, int kcb) {
  p0 = f32x16{}; p1 = f32x16{};
#pragma unroll
  for (int d0 = 0; d0 < DQK / 16; ++d0) { const int cb = (d0 * 16 + hi * 8) * 2;
    bf16x8 b0, b1, qv;
    if constexpr (QLDS) qv = *reinterpret_cast<const bf16x8*>(Qs + ATT_KSWZ128(r32, cb)); else qv = qr[d0];
    if constexpr (KW == 128) { b0 = *reinterpret_cast<const bf16x8*>(Ks + ATT_KSWZ128(r32, kcb + cb)); b1 = *reinterpret_cast<const bf16x8*>(Ks + ATT_KSWZ128(32 + r32, kcb + cb)); }
    else                      { b0 = *reinterpret_cast<const bf16x8*>(Ks + ATT_KSWZ64(r32, cb));  b1 = *reinterpret_cast<const bf16x8*>(Ks + ATT_KSWZ64(32 + r32, cb)); }
    p0 = __builtin_amdgcn_mfma_f32_32x32x16_bf16(b0, qv, p0, 0, 0, 0);
    p1 = __builtin_amdgcn_mfma_f32_32x32x16_bf16(b1, qv, p1, 0, 0, 0); }
}
__device__ __forceinline__ int v_st(int k, int c) { const int kk = (k & ~0xC) | ((k & 4) << 1) | ((k & 8) >> 1); return ((kk >> 3) * 4 + (c >> 5)) * 512 + ((kk & 7) * 32 + (c & 31)) * 2; }
__device__ __forceinline__ int v_rd_base(int lane) { return ((lane & 3) << 3) | (((lane >> 2) & 3) << 6) | (((lane >> 4) & 1) << 5) | (((lane >> 5) & 1) << 8); }
constexpr int v_rd_off(int d0, int ks, int half) { return d0 * 512 + ks * 4096 + half * 2048; }
template <int OFF> __device__ __forceinline__ s16x4 tr_read(int vb) {
  s16x4 r; asm volatile("ds_read_b64_tr_b16 %0, %1 offset:%2" : "=&v"(r) : "v"(vb), "i"(OFF) : "memory"); return r;
}
template <int D0> __device__ __forceinline__ void pv_one(f32x16& od, int vb, bf16x8 pa0, bf16x8 pa1, bf16x8 pa2, bf16x8 pa3) {
  const s16x4 l0 = tr_read<v_rd_off(D0, 0, 0)>(vb), h0 = tr_read<v_rd_off(D0, 0, 1)>(vb), l1 = tr_read<v_rd_off(D0, 1, 0)>(vb), h1 = tr_read<v_rd_off(D0, 1, 1)>(vb);
  const s16x4 l2 = tr_read<v_rd_off(D0, 2, 0)>(vb), h2 = tr_read<v_rd_off(D0, 2, 1)>(vb), l3 = tr_read<v_rd_off(D0, 3, 0)>(vb), h3 = tr_read<v_rd_off(D0, 3, 1)>(vb);
  asm volatile("s_waitcnt lgkmcnt(0)" ::: "memory"); ATT_SBAR();
#define ATT_PK(L, H) (bf16x8){L[0], L[1], L[2], L[3], H[0], H[1], H[2], H[3]}
  od = __builtin_amdgcn_mfma_f32_32x32x16_bf16(pa0, ATT_PK(l0, h0), od, 0, 0, 0);
  od = __builtin_amdgcn_mfma_f32_32x32x16_bf16(pa1, ATT_PK(l1, h1), od, 0, 0, 0);
  od = __builtin_amdgcn_mfma_f32_32x32x16_bf16(pa2, ATT_PK(l2, h2), od, 0, 0, 0);
  od = __builtin_amdgcn_mfma_f32_32x32x16_bf16(pa3, ATT_PK(l3, h3), od, 0, 0, 0);
#undef ATT_PK
}
__device__ __forceinline__ void pv_d0(f32x16* o, int vb, bf16x8 pa0, bf16x8 pa1, bf16x8 pa2, bf16x8 pa3) {
  pv_one<0>(o[0], vb, pa0, pa1, pa2, pa3); pv_one<1>(o[1], vb, pa0, pa1, pa2, pa3); pv_one<2>(o[2], vb, pa0, pa1, pa2, pa3); pv_one<3>(o[3], vb, pa0, pa1, pa2, pa3);
}

#define ATT_TR8(D0, A) do { A##0 = tr_read<v_rd_off(D0, 0, 0)>(vb); A##1 = tr_read<v_rd_off(D0, 0, 1)>(vb); A##2 = tr_read<v_rd_off(D0, 1, 0)>(vb); A##3 = tr_read<v_rd_off(D0, 1, 1)>(vb); \
    A##4 = tr_read<v_rd_off(D0, 2, 0)>(vb); A##5 = tr_read<v_rd_off(D0, 2, 1)>(vb); A##6 = tr_read<v_rd_off(D0, 3, 0)>(vb); A##7 = tr_read<v_rd_off(D0, 3, 1)>(vb); } while (0)
#define ATT_PK2(L, H) (bf16x8){L[0], L[1], L[2], L[3], H[0], H[1], H[2], H[3]}
#define ATT_MM4(OD, A) do { OD = __builtin_amdgcn_mfma_f32_32x32x16_bf16(pa0, ATT_PK2(A##0, A##1), OD, 0, 0, 0); OD = __builtin_amdgcn_mfma_f32_32x32x16_bf16(pa1, ATT_PK2(A##2, A##3), OD, 0, 0, 0); \
    OD = __builtin_amdgcn_mfma_f32_32x32x16_bf16(pa2, ATT_PK2(A##4, A##5), OD, 0, 0, 0); OD = __builtin_amdgcn_mfma_f32_32x32x16_bf16(pa3, ATT_PK2(A##6, A##7), OD, 0, 0, 0); } while (0)
struct VFrag { s16x4 a0, a1, a2, a3, a4, a5, a6, a7, b0, b1, b2, b3, b4, b5, b6, b7; };
__device__ __forceinline__ void pv_issue(VFrag& f, int vb) { ATT_TR8(0, f.a); ATT_TR8(1, f.b); }
__device__ __forceinline__ void pv_pipe(VFrag& f, f32x16* o, int vb, bf16x8 pa0, bf16x8 pa1, bf16x8 pa2, bf16x8 pa3) {
  asm volatile("s_waitcnt lgkmcnt(0)" ::: "memory"); ATT_SBAR(); ATT_MM4(o[0], f.a);
  ATT_SBAR(); ATT_TR8(2, f.a); ATT_SBAR(); ATT_MM4(o[1], f.b);
  ATT_SBAR(); ATT_TR8(3, f.b);
  asm volatile("s_waitcnt lgkmcnt(8)" ::: "memory"); ATT_SBAR(); ATT_MM4(o[2], f.a);
  asm volatile("s_waitcnt lgkmcnt(0)" ::: "memory"); ATT_SBAR(); ATT_MM4(o[3], f.b);
}

struct NoMask { __device__ __forceinline__ void operator()(f32x16&, f32x16&, int) const {} __device__ __forceinline__ bool skip(int) const { return false; } };

template <int DQK, int LDQ, int LDQ2, int LDKV, int SDEPTH, bool DUAL, bool NOMAX, class TileRow, class Mask>
__device__ __forceinline__ void attn_core(const bf16* __restrict__ Qa, const bf16* __restrict__ Qalt, int nswitch,
                                          const bf16* __restrict__ Kb, const bf16* __restrict__ Vb,
                                          const TileRow& trow, const int NT, const Mask& mask, char* lds, f32x16 (&o)[4], float (&rli)[16]) {
  static_assert(!DUAL || DQK == 64, "DUAL is the differential-attention form");
  constexpr int KW = DUAL ? 128 : DQK;
  constexpr int SHM_K = KVBLK * KW * 2;
  constexpr int NQ = DQK / 16;
  int tid_ = threadIdx.x; asm volatile("" : "+v"(tid_));
  const int tid = tid_, wid = tid >> 6, lane = tid & 63, r32 = lane & 31, hi = lane >> 5;
  const int wq = DUAL ? (wid & 3) : wid, comp = DUAL ? (wid >> 2) : 0, kcb = comp * 128;
  char* V_lds = lds; char* K_lds = lds + 2 * SHM_V;
  float* wsf = (float*)(lds + LDS_WS_OFF) + wid * 64; float* li_l = wsf; float* al_l = wsf + 32;
  float m_reg = -1e30f, l_reg = 0;
#pragma unroll
  for (int d = 0; d < 4; ++d) o[d] = f32x16{};
  constexpr bool QLDS = (DQK == 128);
  char* Qs = lds + LDS_Q_OFF + wid * 8192;
  bf16x8 qr[NQ];
  { const bf16* Qw = Qa + (long)(wq * QBLK + r32) * LDQ + comp * 64 + hi * 8;
#pragma unroll
    for (int d0 = 0; d0 < NQ; ++d0) qr[d0] = ld8(Qw + d0 * 16);
    if constexpr (QLDS) {
#pragma unroll
      for (int d0 = 0; d0 < NQ; ++d0) *reinterpret_cast<bf16x8*>(Qs + ATT_KSWZ128(r32, (d0 * 16 + hi * 8) * 2)) = qr[d0];
      asm volatile("s_waitcnt lgkmcnt(0)" ::: "memory"); } }
  const int sr = tid >> 4, sc = (tid & 15) * 8, vst0 = v_st(sr, sc), vst1 = v_st(32 + sr, sc);
  const int k64r = tid >> 3, k64c = (tid & 7) * 8;
  const unsigned voffV = (unsigned)(sr * LDKV + sc) * 2u, voffK = (KW == 128) ? voffV : (unsigned)(k64r * LDKV + k64c) * 2u;
  const int vb0 = (int)(unsigned)(uintptr_t)V_lds + v_rd_base(lane);
  struct { bf16x8 vs0, vs1, ks0, ks1; } sr_[SDEPTH];
#define ATT_SLOAD(i, jt) do { const long row0_ = (long)__builtin_amdgcn_readfirstlane(trow(jt)); const char* vt_ = (const char*)(Vb + row0_ * LDKV); const char* kt_ = (const char*)(Kb + row0_ * LDKV); \
    sr_[i].vs0 = *(const bf16x8*)(vt_ + voffV); sr_[i].vs1 = *(const bf16x8*)(vt_ + 64 * LDKV + voffV); \
    if constexpr (KW == 128) { sr_[i].ks0 = *(const bf16x8*)(kt_ + voffK); sr_[i].ks1 = *(const bf16x8*)(kt_ + 64 * LDKV + voffK); } \
    else { sr_[i].ks0 = *(const bf16x8*)(kt_ + voffK); } } while (0)
#define ATT_SWRITE(b, i) do { *(bf16x8*)(V_lds + (b) * SHM_V + vst0) = sr_[i].vs0; *(bf16x8*)(V_lds + (b) * SHM_V + vst1) = sr_[i].vs1; \
    if constexpr (KW == 128) { const int kc_ = sc * 2; *(bf16x8*)(K_lds + (b) * SHM_K + ATT_KSWZ128(sr, kc_)) = sr_[i].ks0; *(bf16x8*)(K_lds + (b) * SHM_K + ATT_KSWZ128(32 + sr, kc_)) = sr_[i].ks1; } \
    else { *(bf16x8*)(K_lds + (b) * SHM_K + ATT_KSWZ64(k64r, k64c * 2)) = sr_[i].ks0; } } while (0)
#define ATT_SWAIT() do { if constexpr (SDEPTH == 1) asm volatile("s_waitcnt vmcnt(0)" ::: "memory"); else if constexpr (KW == 128) asm volatile("s_waitcnt vmcnt(4)" ::: "memory"); else asm volatile("s_waitcnt vmcnt(3)" ::: "memory"); } while (0)
#define ATT_RESC(a) do { if (__any((a) < 1.f)) { if (hi == 0) al_l[r32] = (a); asm volatile("s_waitcnt lgkmcnt(0)" ::: "memory"); \
    _Pragma("unroll") for (int d = 0; d < 4; ++d) _Pragma("unroll") for (int r = 0; r < 16; ++r) o[d][r] *= al_l[crow(r, hi)]; } } while (0)
  f32x16 pA0, pA1, pB0, pB1; float mnA, mnB, alA, alB; bf16x8 pa0, pa1, pa2, pa3;
  constexpr int SE = 0, SO = SDEPTH - 1;
  ATT_SLOAD(SE, 0); asm volatile("s_waitcnt vmcnt(0)" ::: "memory"); ATT_SWRITE(0, SE); __syncthreads();
  bool sA = mask.skip(0), sB = false;
  if (!sA) { qkt<DQK, QLDS, KW>(pA0, pA1, K_lds, qr, Qs, r32, hi, kcb); mask(pA0, pA1, 0); if constexpr (NOMAX) { expSM(pA0); alA = 1.f; } else partialSM<DQK>(pA0, pA1, m_reg, mnA, alA); } else alA = 1.f;
  ATT_SLOAD(SO, 1); if constexpr (SDEPTH == 2) { if (2 < NT) ATT_SLOAD(SE, 2); }
  ATT_SWAIT(); ATT_SWRITE(1, SO); __syncthreads();
  for (int j = 1; j + 1 < NT; j += 2) {
    sB = mask.skip(j);
    ATT_SBAR(); if (!sB) qkt<DQK, QLDS, KW>(pB0, pB1, K_lds + SHM_K, qr, Qs, r32, hi, kcb);
    if (!sA) if constexpr (NOMAX) finishSM_nm(pA0, pA1, l_reg, pa0, pa1, pa2, pa3); else finishSM(pA0, pA1, alA, l_reg, pa0, pa1, pa2, pa3); ATT_SBAR();
    ATT_SLOAD(SO, j + SDEPTH); ATT_SBAR();
    if (!sA) pv_d0(o, vb0, pa0, pa1, pa2, pa3);
    if (!sB) { mask(pB0, pB1, j); if constexpr (NOMAX) { expSM(pB0); alB = 1.f; } else partialSM<DQK>(pB0, pB1, m_reg, mnB, alB); } else alB = 1.f;
    __syncthreads(); ATT_SWAIT(); ATT_SWRITE(0, SE);
    ATT_RESC(alB); __syncthreads();
    if constexpr (DQK == 64) { if (j + 1 == nswitch) { const bf16* Qw = Qalt + (long)(wq * QBLK + r32) * LDQ2 + comp * 64 + hi * 8;
#pragma unroll
        for (int d0 = 0; d0 < NQ; ++d0) qr[d0] = ld8(Qw + d0 * 16); } }
    sA = mask.skip(j + 1);
    ATT_SBAR(); if (!sA) qkt<DQK, QLDS, KW>(pA0, pA1, K_lds, qr, Qs, r32, hi, kcb);
    if (!sB) if constexpr (NOMAX) finishSM_nm(pB0, pB1, l_reg, pa0, pa1, pa2, pa3); else finishSM(pB0, pB1, alB, l_reg, pa0, pa1, pa2, pa3); ATT_SBAR();
    if (SDEPTH == 1 || j + 3 < NT) ATT_SLOAD(SE, j + 1 + SDEPTH); ATT_SBAR();
    if (!sB) pv_d0(o, vb0 + SHM_V, pa0, pa1, pa2, pa3);
    if (!sA) { mask(pA0, pA1, j + 1); if constexpr (NOMAX) { expSM(pA0); alA = 1.f; } else partialSM<DQK>(pA0, pA1, m_reg, mnA, alA); } else alA = 1.f;
    __syncthreads(); ATT_SWAIT(); ATT_SWRITE(1, SO);
    ATT_RESC(alA); __syncthreads();
  }
  sB = mask.skip(NT - 1);
  ATT_SBAR(); if (!sB) qkt<DQK, QLDS, KW>(pB0, pB1, K_lds + SHM_K, qr, Qs, r32, hi, kcb);
  if (!sA) if constexpr (NOMAX) finishSM_nm(pA0, pA1, l_reg, pa0, pa1, pa2, pa3); else finishSM(pA0, pA1, alA, l_reg, pa0, pa1, pa2, pa3); ATT_SBAR();
  if (!sA) pv_d0(o, vb0, pa0, pa1, pa2, pa3);
  if (!sB) { mask(pB0, pB1, NT - 1); if constexpr (NOMAX) { expSM(pB0); alB = 1.f; } else partialSM<DQK>(pB0, pB1, m_reg, mnB, alB); } else alB = 1.f;
  __syncthreads(); ATT_RESC(alB);
  if (!sB) { if constexpr (NOMAX) finishSM_nm(pB0, pB1, l_reg, pa0, pa1, pa2, pa3); else finishSM(pB0, pB1, alB, l_reg, pa0, pa1, pa2, pa3); ATT_SBAR();
  pv_d0(o, vb0 + SHM_V, pa0, pa1, pa2, pa3); }
  if (hi == 0) li_l[r32] = l_reg; asm volatile("s_waitcnt lgkmcnt(0)" ::: "memory");
#pragma unroll
  for (int r = 0; r < 16; ++r) rli[r] = __builtin_amdgcn_rcpf(li_l[crow(r, hi)]);
#undef ATT_SLOAD
#undef ATT_SWRITE
#undef ATT_SWAIT
#undef ATT_RESC
}

#if STAMP && STAMP < 6
__device__ __forceinline__ unsigned stamp_lo() { unsigned long long t; __builtin_amdgcn_sched_barrier(0); asm volatile("s_memtime %0\n\ts_waitcnt lgkmcnt(0)" : "=s"(t) :: "memory"); __builtin_amdgcn_sched_barrier(0); return (unsigned)t; }
#endif
constexpr int DS_V = 0, DS_K = 3 * 16384, DS_WS = 6 * 16384, DS_Q = DS_WS + NW * 64 * 4, DS_END = DS_Q + NW * 4096;
template <int OFF> __device__ __forceinline__ bf16x8 lds_rd128(int addr) { bf16x8 r; asm volatile("ds_read_b128 %0, %1 offset:%2" : "=&v"(r) : "v"(addr), "i"(OFF) : "memory"); return r; }
template <int LDQ, int LDQ2, int LDKV, class TileRow>
__device__ __forceinline__ void attn_dual_stag(const bf16* __restrict__ Qa, const bf16* __restrict__ Qalt, int nswitch,
                                               const bf16* __restrict__ Kb, const bf16* __restrict__ Vb,
                                               const TileRow& trow, const int NT, char* lds, f32x16 (&o)[4], float (&rli)[16], unsigned& sacc) {
  int tid_ = threadIdx.x; asm volatile("" : "+v"(tid_));
  const int tid = tid_, wid = tid >> 6, lane = tid & 63, r32 = lane & 31, hi = lane >> 5;
  const int wq = wid & 3, g = __builtin_amdgcn_readfirstlane(wid >> 2), kcb = g * 128;
  char* V_lds = lds + DS_V; char* K_lds = lds + DS_K;
  float* wsf = (float*)(lds + DS_WS) + wid * 64; float* li_l = wsf;
  float l_reg = 0;
#pragma unroll
  for (int d = 0; d < 4; ++d) o[d] = f32x16{};
  bf16x8 qr[4];
  char* Qsw = lds + DS_Q + wid * 4096 + lane * 16;
  { const bf16* Qw = Qa + (long)(wq * QBLK + r32) * LDQ + g * 64 + hi * 8;
    const bf16* Qw2 = Qalt + (long)(wq * QBLK + r32) * LDQ2 + g * 64 + hi * 8;
#pragma unroll
    for (int d0 = 0; d0 < 4; ++d0) { qr[d0] = ld8(Qw + d0 * 16); *(bf16x8*)(Qsw + d0 * 1024) = ld8(Qw2 + d0 * 16); } }
  const int tg = tid & 255, sr = 32 * g + (tg >> 4), sc = (tg & 15) * 8;
  const int vst0 = v_st(sr, sc), vst1 = v_st(sr + 16, sc), kst0 = ATT_KSWZ128(sr, sc * 2), kst1 = ATT_KSWZ128(sr + 16, sc * 2);
  const unsigned voff = (unsigned)(sr * LDKV + sc) * 2u;
  const bf16* kbu = (const bf16*)(((unsigned long long)(unsigned)__builtin_amdgcn_readfirstlane((int)((unsigned long long)Kb >> 32)) << 32) | (unsigned)__builtin_amdgcn_readfirstlane((int)(unsigned long long)Kb));
  const int vdelta = __builtin_amdgcn_readfirstlane((int)((const char*)Vb - (const char*)Kb));
  const __amdgpu_buffer_rsrc_t kvrs = __builtin_amdgcn_make_buffer_rsrc((void*)kbu, 0, 0x7fffffff, 0x00020000);
  const int vb0 = (int)(unsigned)(uintptr_t)V_lds + v_rd_base(lane);
  const int kb0 = (int)(unsigned)(uintptr_t)K_lds;
  const int ka0 = kb0 + ATT_KSWZ128(r32, kcb + (0 * 16 + hi * 8) * 2), ka1 = kb0 + ATT_KSWZ128(r32, kcb + (1 * 16 + hi * 8) * 2);
  const int ka2 = kb0 + ATT_KSWZ128(r32, kcb + (2 * 16 + hi * 8) * 2), ka3 = kb0 + ATT_KSWZ128(r32, kcb + (3 * 16 + hi * 8) * 2);
  bf16x8 svA0, svA1, skA0, skA1, svB0, svB1, skB0, skB1;
#define DS_BL(dst, so) asm volatile("buffer_load_dwordx4 %0, %1, %2, %3 offen" : "=v"(dst) : "v"(voff), "s"(kvrs), "s"(so))
#define DS_SLOAD(S, jt) do { const int so_ = __builtin_amdgcn_readfirstlane(trow(jt)) * (LDKV * 2);   \
      \
    DS_BL(sk##S##0, so_); DS_BL(sk##S##1, so_ + 32 * LDKV); DS_BL(sv##S##0, so_ + vdelta); DS_BL(sv##S##1, so_ + vdelta + 32 * LDKV); } while (0)
#define DS_VMW(n) asm volatile("s_waitcnt vmcnt(" #n ")" ::: "memory")
#define DS_SWRITE(S, slot) do { const int so_ = (slot) * 16384; *(bf16x8*)(V_lds + so_ + vst0) = sv##S##0; *(bf16x8*)(V_lds + so_ + vst1) = sv##S##1; *(bf16x8*)(K_lds + so_ + kst0) = sk##S##0; *(bf16x8*)(K_lds + so_ + kst1) = sk##S##1; } while (0)
#define DS_BAR() do { ATT_SBAR(); asm volatile("s_waitcnt lgkmcnt(0)\n\ts_barrier" ::: "memory"); ATT_SBAR(); } while (0)
#if STAMP == 2 || STAMP == 3
#define DS_BARL() do { const unsigned t0_ = stamp_lo(); DS_BAR(); const unsigned t1_ = stamp_lo(); sacc += t1_ - t0_; } while (0)
#else
#define DS_BARL() DS_BAR()
#endif
#if STAMP == 4 || STAMP == 5
#define DS_STAMP(v) do { if (g == 0) v = stamp_lo(); } while (0)
#else
#define DS_STAMP(v) (void)0
#endif
#define DS_LGKM(n) asm volatile("s_waitcnt lgkmcnt(" #n ")" ::: "memory")
#define DS_KREADS(so) do { const int o_ = (so); kf0 = lds_rd128<0>(ka0 + o_); kf1 = lds_rd128<8192>(ka0 + o_); kf2 = lds_rd128<0>(ka1 + o_); kf3 = lds_rd128<8192>(ka1 + o_); \
    kf4 = lds_rd128<0>(ka2 + o_); kf5 = lds_rd128<8192>(ka2 + o_); kf6 = lds_rd128<0>(ka3 + o_); kf7 = lds_rd128<8192>(ka3 + o_); } while (0)
#define DS_QK() do { p0 = f32x16{}; p1 = f32x16{}; \
    p0 = __builtin_amdgcn_mfma_f32_32x32x16_bf16(kf0, qr[0], p0, 0, 0, 0); p1 = __builtin_amdgcn_mfma_f32_32x32x16_bf16(kf1, qr[0], p1, 0, 0, 0); \
    p0 = __builtin_amdgcn_mfma_f32_32x32x16_bf16(kf2, qr[1], p0, 0, 0, 0); p1 = __builtin_amdgcn_mfma_f32_32x32x16_bf16(kf3, qr[1], p1, 0, 0, 0); \
    p0 = __builtin_amdgcn_mfma_f32_32x32x16_bf16(kf4, qr[2], p0, 0, 0, 0); p1 = __builtin_amdgcn_mfma_f32_32x32x16_bf16(kf5, qr[2], p1, 0, 0, 0); \
    p0 = __builtin_amdgcn_mfma_f32_32x32x16_bf16(kf6, qr[3], p0, 0, 0, 0); p1 = __builtin_amdgcn_mfma_f32_32x32x16_bf16(kf7, qr[3], p1, 0, 0, 0); } while (0)
#define DS_QKA() do { p0 = f32x16{}; p1 = f32x16{}; \
    p0 = __builtin_amdgcn_mfma_f32_32x32x16_bf16(kf0, qr[0], p0, 0, 0, 0); p1 = __builtin_amdgcn_mfma_f32_32x32x16_bf16(kf1, qr[0], p1, 0, 0, 0); \
    p0 = __builtin_amdgcn_mfma_f32_32x32x16_bf16(kf2, qr[1], p0, 0, 0, 0); p1 = __builtin_amdgcn_mfma_f32_32x32x16_bf16(kf3, qr[1], p1, 0, 0, 0); } while (0)
#define DS_QKB() do { \
    p0 = __builtin_amdgcn_mfma_f32_32x32x16_bf16(kf4, qr[2], p0, 0, 0, 0); p1 = __builtin_amdgcn_mfma_f32_32x32x16_bf16(kf5, qr[2], p1, 0, 0, 0); \
    p0 = __builtin_amdgcn_mfma_f32_32x32x16_bf16(kf6, qr[3], p0, 0, 0, 0); p1 = __builtin_amdgcn_mfma_f32_32x32x16_bf16(kf7, qr[3], p1, 0, 0, 0); } while (0)
  DS_SLOAD(A, 0); DS_SLOAD(B, 1); DS_VMW(0); DS_SWRITE(A, 0); DS_SWRITE(B, 1);
  if (g == 1 && 2 < NT) DS_SLOAD(A, 2);
  DS_BAR();
  f32x16 p0, p1; bf16x8 pa0, pa1, pa2, pa3; bf16x8 kf0, kf1, kf2, kf3, kf4, kf5, kf6, kf7;
  if (2 + g < NT) DS_SLOAD(B, 2 + g);
  ATT_SBAR(); DS_KREADS(0); DS_LGKM(0); ATT_SBAR(); DS_QK();
  if (g == 1) DS_BAR();
  int s0 = 0, s1 = 1;
#define DS_TILE(S, k_) do { unsigned ts0_ = 0, ts1_ = 0, ts2_ = 0; DS_STAMP(ts0_); \
    expSM(p0); expSM(p1); packSM(p0, p1, l_reg, pa0, pa1, pa2, pa3); \
    { const int jt = (k_) + 1 + g; if (jt >= 2 && jt < NT) { if (jt + 1 < NT) DS_VMW(4); else DS_VMW(0); int sl = s1 + g; sl = sl >= 3 ? sl - 3 : sl; DS_SWRITE(S, sl); } } \
    const int vb = vb0 + s0 * 16384; VFrag f; \
    ATT_SBAR(); ATT_TR8(0, f.a); ATT_TR8(1, f.b); ATT_SBAR(); \
    DS_STAMP(ts1_); if (g == 0) DS_BARL(); DS_STAMP(ts2_); \
    { const int jt = (k_) + 3 + g; if (jt < NT) DS_SLOAD(S, jt); } \
    if ((k_) + 1 == nswitch) { \
      const int qa_ = (int)(unsigned)(uintptr_t)Qsw; qr[0] = lds_rd128<0>(qa_); qr[1] = lds_rd128<1024>(qa_); qr[2] = lds_rd128<2048>(qa_); qr[3] = lds_rd128<3072>(qa_);   \
      asm volatile("s_waitcnt lgkmcnt(0)" ::: "memory"); } \
    ATT_SBAR(); \
    __builtin_amdgcn_s_setprio(1); DS_KREADS(s1 * 16384); \
    DS_LGKM(8); ATT_SBAR(); ATT_MM4(o[0], f.a); ATT_SBAR(); ATT_TR8(2, f.a); ATT_SBAR(); ATT_MM4(o[1], f.b); \
    ATT_SBAR(); DS_LGKM(8); ATT_SBAR();                  \
    if ((k_) + 1 < NT) { DS_QKA(); DS_QKB(); } \
    ATT_SBAR(); ATT_TR8(3, f.b); \
    ATT_SBAR(); DS_LGKM(8); ATT_SBAR(); ATT_MM4(o[2], f.a); \
    ATT_SBAR(); DS_LGKM(0); ATT_SBAR(); ATT_MM4(o[3], f.b); __builtin_amdgcn_s_setprio(0); \
    { unsigned ts3_ = 0; DS_STAMP(ts3_); if (STAMP == 4 && g == 0) sacc += ts3_ - ts2_; if (STAMP == 5 && g == 0) sacc += ts1_ - ts0_; } \
    if (g == 1 && (k_) + 1 < NT) DS_BARL(); \
    s0 = s1; s1 = s1 == 2 ? 0 : s1 + 1; } while (0)
#if STAMP == 42
  const unsigned tl0_ = (unsigned)__builtin_amdgcn_s_memrealtime();
#endif
#pragma clang loop unroll(disable)
  for (int k = 0; k < NT; k += 2) { DS_TILE(A, k); DS_TILE(B, k + 1); }
#if STAMP == 42
  { const unsigned tl1_ = (unsigned)__builtin_amdgcn_s_memrealtime(); if (tid == 0) *(volatile unsigned*)(lds + 143360 + 64) += tl1_ - tl0_; }
#endif
#undef DS_TILE
  finish_l(l_reg, li_l, r32, hi, rli);
#undef DS_SLOAD
#undef DS_BL
#undef DS_VMW
#undef DS_SWRITE
#undef DS_BAR
#undef DS_LGKM
#undef DS_BARL
#undef DS_STAMP
#undef DS_KREADS
#undef DS_QK
#undef DS_QKA
#undef DS_QKB
}
}

constexpr int DM = 2048, NBATCH = 2, SEQ = 8192, DEPTH = 4, CTXL = 256;
constexpr int ML = NBATCH * SEQ;
constexpr int MC = NBATCH * CTXL;
constexpr int MT = ML + MC;
constexpr int EV_IN = 5120;
constexpr int EVN = 4608 + 1024;
constexpr int ODN = 6144;
constexpr int FH = 5632;
constexpr int NPH = 1 + 8 * DEPTH;
#ifndef PHM
#define PHM 1023
#endif
#ifndef MXM
#define MXM 15
#endif
#ifndef MK_N_LAUNCHES
#define MK_N_LAUNCHES 1
#endif
constexpr float LAM_INIT0 = 0.2f, LAM_INIT1 = 0.47071301834370415f;

constexpr size_t MiB = 1u << 20;
constexpr size_t WS_CTL = 0, CTL_ZERO_BYTES = 64 * 1024;
constexpr size_t WS_MODV = 1 * MiB;
constexpr size_t WS_ROPE = 2 * MiB;
constexpr size_t WS_LAM = 2 * MiB + 64 * 1024;
constexpr size_t WS_FA1 = 2 * MiB + 128 * 1024;
constexpr size_t WS_FA2 = 2 * MiB + 192 * 1024;
constexpr size_t WS_FA3 = 2 * MiB + 256 * 1024;
constexpr size_t WS_WIN_E = 4 * MiB,  SZ_WIN_E = 22 * MiB;
constexpr size_t WS_WOUT_E = WS_WIN_E + 2 * SZ_WIN_E, SZ_WOUT = 8 * MiB;
constexpr size_t WS_WIN_O = WS_WOUT_E + 2 * SZ_WOUT, SZ_WIN_O = 24 * MiB;
constexpr size_t WS_WOUT_O = WS_WIN_O + 2 * SZ_WIN_O;
constexpr size_t WS_WFI = WS_WOUT_O + 2 * SZ_WOUT, SZ_WFI = 44 * MiB;
constexpr size_t WS_WFO = WS_WFI + 4 * SZ_WFI, SZ_WFO = 22 * MiB;
constexpr size_t WS_A = WS_WFO + 4 * SZ_WFO;
constexpr size_t WS_P = WS_A + 66 * MiB;
constexpr size_t WS_QR = WS_P + 198 * MiB;
constexpr size_t WS_MIX = WS_QR + 48 * MiB;
constexpr size_t WS_HID = WS_MIX + 66 * MiB;
constexpr size_t WS_HC = WS_HID + 182 * MiB;
constexpr size_t WS_STASH = WS_HC + 4 * MiB;
constexpr size_t WS_HB = WS_STASH;
constexpr size_t WS_FT = WS_STASH + 64 * MiB;
constexpr size_t WS_SLAB = WS_STASH + 128 * MiB;
constexpr size_t WS_END = WS_SLAB + 48 * MiB;
static_assert(WS_A == 392 * MiB && WS_END == 1132 * MiB, "d_ws map");
constexpr int CW_FFT = 3072;
constexpr int CW_BAR = 4096;

constexpr int GEN_BYTES = 143360;
constexpr int MISC_OFF = GEN_BYTES;
constexpr int LDS_BYTES = 147456;

#define GAS __attribute__((address_space(1)))
#define LAS __attribute__((address_space(3)))
typedef unsigned short bf16;
typedef unsigned v4u __attribute__((ext_vector_type(4)));
typedef unsigned v2u __attribute__((ext_vector_type(2)));
typedef float f32x4 __attribute__((ext_vector_type(4)));
typedef short bf16x8 __attribute__((ext_vector_type(8)));
typedef GAS unsigned gu32;
#define RLX_AGENT __ATOMIC_RELAXED, __HIP_MEMORY_SCOPE_AGENT
#define LDS_WAIT() asm volatile("s_waitcnt lgkmcnt(0)" ::: "memory")
#define VM_WAIT() asm volatile("s_waitcnt vmcnt(0)" ::: "memory")
__device__ __forceinline__ unsigned f2bf(float f) { unsigned u = __builtin_bit_cast(unsigned, f); return (u + 0x7fffu + ((u >> 16) & 1u)) >> 16; }
__device__ __forceinline__ unsigned pk2(float lo, float hi) { return f2bf(lo) | (f2bf(hi) << 16); }
__device__ __forceinline__ float bflo(unsigned w) { return __uint_as_float(w << 16); }
__device__ __forceinline__ float bfhi(unsigned w) { return __uint_as_float(w & 0xffff0000u); }
__device__ __forceinline__ float hw_cos(float rev) { return __builtin_amdgcn_cosf(rev); }
__device__ __forceinline__ float hw_sin(float rev) { return __builtin_amdgcn_sinf(rev); }
#define XB_TMO      128
#define XB_XCNT(j)  (256  + 64 * (j))
#define XB_XSUB(j)  (1280 + 64 * (j))
#define XB_XGEN(j)  (2304 + 64 * (j))
#define XB_TOP      3328
#define XB_TOPGEN   3392
#define XCD_BAR_WORDS 3456
#define XB_SPIN_CAP (1u << 18)

__device__ __forceinline__ unsigned xb_ld(unsigned* p)              { return __hip_atomic_load(p, __ATOMIC_RELAXED, __HIP_MEMORY_SCOPE_AGENT); }
__device__ __forceinline__ unsigned xb_add(unsigned* p, unsigned v) { return __hip_atomic_fetch_add(p, v, __ATOMIC_RELAXED, __HIP_MEMORY_SCOPE_AGENT); }
__device__ __forceinline__ unsigned xb_xcc_id() { return (unsigned)__builtin_amdgcn_s_getreg((3 << 11) | 20) & 0xFu; }
#define XB_SPIN(cond, bar) do { unsigned _sp = 0; while (cond) { __builtin_amdgcn_s_sleep(1); \
    if ((++_sp & 255u) == 0u) { if (xb_ld(&(bar)[XB_TMO])) break; if (_sp > XB_SPIN_CAP) { atomicAdd(&(bar)[XB_TMO], 1u); break; } } } } while (0)

struct XcdBarrier {
    unsigned* bar; unsigned x;
    volatile LAS unsigned* st;
};

__device__ __forceinline__ XcdBarrier xcd_barrier_post(unsigned* bar, volatile LAS unsigned* st) {
    XcdBarrier b; b.bar = bar; b.x = xb_xcc_id(); b.st = st;
    if (threadIdx.x == 0) (void)xb_add(&bar[XB_XCNT(b.x)], 1u);
    return b;
}
__device__ __forceinline__ void xcd_barrier_complete(unsigned* bar, unsigned x, unsigned& nloc, unsigned& nx) {
    const unsigned G = gridDim.x * gridDim.y * gridDim.z;
    unsigned sum, cnt, mine, sp = 0u;
    for (;;) {
        sum = 0u; cnt = 0u; mine = 0u;
#pragma unroll
        for (unsigned j = 0; j < 16; ++j) { const unsigned c = xb_ld(&bar[XB_XCNT(j)]); sum += c; cnt += (c > 0u) ? 1u : 0u; mine = (j == x) ? c : mine; }
        if (sum == G) break;
        __builtin_amdgcn_s_sleep(1);
        if ((++sp & 255u) == 0u) { if (xb_ld(&bar[XB_TMO])) break; if (sp > XB_SPIN_CAP) { atomicAdd(&bar[XB_TMO], 1u); break; } }
    }
    nloc = mine > 0u ? mine : 1u; nx = cnt > 0u ? cnt : 1u;
}

__device__ __forceinline__ void xcd_barrier(const XcdBarrier& b) {
    asm volatile("s_waitcnt vmcnt(0)" ::: "memory");
    __syncthreads();
    if (threadIdx.x == 0) {
        unsigned* bar = b.bar;
        __builtin_amdgcn_s_waitcnt(0);
        unsigned nloc = b.st[0], nx = b.st[1];
        if (nloc == 0u) { xcd_barrier_complete(bar, b.x, nloc, nx); b.st[0] = nloc; b.st[1] = nx; }
        const unsigned old = xb_add(&bar[XB_XSUB(b.x)], 1u);
        const unsigned gen = old / nloc;
        if (old + 1u == (gen + 1u) * nloc) {
            __builtin_amdgcn_fence(__ATOMIC_RELEASE, "agent");
            asm volatile("s_waitcnt vmcnt(0)" ::: "memory");
            const unsigned og = xb_add(&bar[XB_TOP], 1u);
            const unsigned tg = og / nx;
            if (og + 1u == (tg + 1u) * nx) xb_add(&bar[XB_TOPGEN], 1u);
            else XB_SPIN(xb_ld(&bar[XB_TOPGEN]) == tg, bar);
            __builtin_amdgcn_fence(__ATOMIC_ACQUIRE, "agent");
            xb_add(&bar[XB_XGEN(b.x)], 1u);
            asm volatile("s_waitcnt vmcnt(0)" ::: "memory");
        } else {
            XB_SPIN(xb_ld(&bar[XB_XGEN(b.x)]) == gen, bar);
            __builtin_amdgcn_fence(__ATOMIC_ACQUIRE, "agent");
            asm volatile("s_waitcnt vmcnt(0)" ::: "memory");
        }
    }
    __syncthreads();
}

struct Args { const float* in[19]; float* out; unsigned char* ws; int ph_lo, ph_hi; };
typedef const __attribute__((address_space(4))) Args* ArgsP;
struct Frame {
    LAS unsigned char* lds; unsigned char* ldsg;
    volatile LAS unsigned* MISC;
    gu32* ctl;
    int tid, lane, wave, vcu, G;
    ArgsP ap; GAS float* out; GAS unsigned char* ws;
};
#define INP(F, k) ((const float*)(const GAS float*)(F).ap->in[k])
#define WSP(F) ((unsigned char*)(F).ws)
#define OUTP(F) ((float*)(F).out)
__device__ __forceinline__ Frame site(const Frame& F0) {
    Frame F = F0;
    int t = threadIdx.x; asm volatile("" : "+v"(t)); F.tid = t; F.lane = t & 63; F.wave = __builtin_amdgcn_readfirstlane(t >> 6);
    GAS unsigned char* w = F0.ws; asm volatile("" : "+s"(w)); F.ws = w;
    GAS float* o = F0.out; asm volatile("" : "+s"(o)); F.out = o;
    ArgsP a = F0.ap; asm volatile("" : "+s"(a)); F.ap = a;
    return F;
}
__device__ __forceinline__ float wave_sum(float v) {
#pragma unroll
    for (int o = 1; o < 64; o <<= 1) v += __shfl_xor(v, o);
    return v;
}

__device__ __forceinline__ void p0_modvec(Frame& F) {
    LAS float* sv = (LAS float*)F.lds;
    LAS float* red = (LAS float*)(F.lds + 24576);
    const float* c = INP(F, 1); const float* cctx = INP(F, 3); const float* wmod = INP(F, 4); const float* bmod = INP(F, 5);
    float* modv = (float*)(WSP(F) + WS_MODV);
    bool have = false;
    for (int it = blockIdx.x; it < 4 * 48; it += F.G) {
        if (!have) {
            for (int idx = F.tid; idx < 3 * DM; idx += 512) { const int g = idx >> 11, k = idx & 2047; const float v = g < 2 ? c[g * DM + k] : cctx[k]; sv[idx] = v / (1.0f + __expf(-v)); }
            __syncthreads(); have = true;
        }
        const int li = it / 48, ch = it % 48;
        const float* wp = wmod + ((size_t)li * DM + F.wave * 256) * 12288 + ch * 256 + F.lane * 4;
        f32x4 a0 = {0.f, 0.f, 0.f, 0.f}, a1 = a0, a2 = a0;
#pragma unroll 8
        for (int k = 0; k < 256; ++k) {
            const f32x4 w = __builtin_nontemporal_load((const f32x4*)(wp + (size_t)k * 12288));
            const float s0 = sv[F.wave * 256 + k], s1 = sv[DM + F.wave * 256 + k], s2 = sv[2 * DM + F.wave * 256 + k];
            a0 += w * s0; a1 += w * s1; a2 += w * s2;
        }
        *(LAS f32x4*)(red + (F.wave * 3 + 0) * 256 + F.lane * 4) = a0;
        *(LAS f32x4*)(red + (F.wave * 3 + 1) * 256 + F.lane * 4) = a1;
        *(LAS f32x4*)(red + (F.wave * 3 + 2) * 256 + F.lane * 4) = a2;
        __syncthreads();
        for (int t = F.tid; t < 768; t += 512) { const int g = t >> 8, cc = t & 255; float s = bmod[li * 12288 + ch * 256 + cc];
#pragma unroll
            for (int w = 0; w < 8; ++w) s += red[(w * 3 + g) * 256 + cc];
            modv[(size_t)(li * 3 + g) * 12288 + ch * 256 + cc] = s; }
        __syncthreads();
    }
}
__device__ __forceinline__ void p0_tables(Frame& F) {
    const int gt = blockIdx.x * 512 + F.tid, NTH = F.G * 512;
    float* rope = (float*)(WSP(F) + WS_ROPE); float* lam = (float*)(WSP(F) + WS_LAM);
    bf16* fa1 = (bf16*)(WSP(F) + WS_FA1); bf16* fa2 = (bf16*)(WSP(F) + WS_FA2); bf16* fa3 = (bf16*)(WSP(F) + WS_FA3);
    for (int idx = gt; idx < 2048; idx += NTH) { const int pos = idx >> 4, f = idx & 15;
        const float inv = exp2f(-(float)f * (13.287712379549449f / 16.0f)); const float rev = (float)pos * inv * 0.15915494309189535f; const float fr = rev - floorf(rev);
        rope[idx * 2] = hw_cos(fr); rope[idx * 2 + 1] = hw_sin(fr); }
    for (int idx = gt; idx < 128 * 128; idx += NTH) { const int m = idx >> 7, k = idx & 127, rp = m >> 6, k1 = m & 63, ri = k >> 6, t1 = k & 63;
        const float ph = (float)((k1 * t1) & 63) * (1.0f / 64.0f); const float cs = hw_cos(ph), sn = hw_sin(ph);
        const float v = rp == 0 ? (ri == 0 ? cs : -sn) : (ri == 0 ? -sn : -cs); fa1[idx] = (bf16)f2bf(v); }
    for (int idx = gt; idx < 128 * 256; idx += NTH) { const int k2 = idx >> 8, k = idx & 255, ri = k >> 7, t2 = k & 127;
        const float ph = (float)((k2 * t2) & 127) * (1.0f / 128.0f); const float v = ri == 0 ? hw_cos(ph) : hw_sin(ph); fa2[idx] = (bf16)f2bf(v); }
    for (int idx = gt; idx < 256 * 512; idx += NTH) { const int kk = idx >> 9, k = idx & 511, ri = k >> 8, t = k & 255;
        const float ph = (float)((kk * t) & 255) * (1.0f / 256.0f); const float v = ri == 0 ? hw_cos(ph) : -hw_sin(ph); fa3[idx] = (bf16)f2bf(v); }
    if (gt < 2) { const float* lv = INP(F, 12) + gt * 256; float s01 = 0.f, s23 = 0.f;
        for (int d = 0; d < 64; ++d) { s01 += lv[d] * lv[64 + d]; s23 += lv[128 + d] * lv[192 + d]; }
        lam[gt] = __expf(s01) - __expf(s23) + (gt == 0 ? LAM_INIT0 : LAM_INIT1); }
}
__device__ __forceinline__ void p0_copy_ctx(Frame& F) {
    const f32x4* src = (const f32x4*)INP(F, 2); f32x4* dst = (f32x4*)(WSP(F) + WS_HC);
    for (int i = blockIdx.x * 512 + F.tid; i < MC * DM / 4; i += F.G * 512) dst[i] = src[i];
}
__device__ __forceinline__ void p0_fold(Frame& F) {
    LAS unsigned char* Wl = F.lds;
    LAS unsigned char* Tl = F.lds + 64 * 272;
    const int lane = F.lane, l15 = lane & 15, lq = lane >> 4;
    bool have_t = false;
    for (int it = blockIdx.x; it < 256; it += F.G) {
        const int j = it >> 7, g = (it >> 5) & 3, k0 = (it & 31) * 64;
        const float* W = INP(F, 9) + (size_t)j * DM * EV_IN;
        bf16* Bt = (bf16*)(WSP(F) + WS_WIN_E + (size_t)j * SZ_WIN_E);
        if (!have_t) { have_t = true;
            for (int idx = F.tid; idx < 256 * 128; idx += 512) { const int n = idx >> 7, cc = idx & 127, cp = n >> 1, ri = n & 1; const float ph = (float)((cc * cp) & 127) * (1.0f / 128.0f);
                *(LAS bf16*)(Tl + n * 272 + cc * 2) = (bf16)f2bf(ri ? hw_sin(ph) : hw_cos(ph)); } }
        for (int idx = F.tid; idx < 64 * 128; idx += 512) { const int r = idx >> 7, cc = idx & 127; *(LAS bf16*)(Wl + r * 272 + cc * 2) = (bf16)f2bf(W[(size_t)(k0 + r) * EV_IN + 4608 + g * 128 + cc]); }
        __syncthreads();
#pragma unroll 1
        for (int ni = 0; ni < 2; ++ni) { const int nt = F.wave * 2 + ni;
            bf16x8 bfr[4];
#pragma unroll
            for (int ks = 0; ks < 4; ++ks) bfr[ks] = *(const LAS bf16x8*)(Tl + (16 * nt + l15) * 272 + (32 * ks + 8 * lq) * 2);
#pragma unroll
            for (int mt = 0; mt < 4; ++mt) { f32x4 acc = {0.f, 0.f, 0.f, 0.f};
#pragma unroll
                for (int ks = 0; ks < 4; ++ks) { const bf16x8 af = *(const LAS bf16x8*)(Wl + (16 * mt + l15) * 272 + (32 * ks + 8 * lq) * 2); acc = __builtin_amdgcn_mfma_f32_16x16x32_bf16(af, bfr[ks], acc, 0, 0, 0); }
                v2u o; o.x = pk2(acc[0], acc[1]); o.y = pk2(acc[2], acc[3]);
                *(v2u*)(Bt + (size_t)(4608 + g * 256 + 16 * nt + l15) * DM + k0 + 16 * mt + 4 * lq) = o; } }
        __syncthreads();
    }
}
__device__ __forceinline__ void p0_transpose_item(const float* W, int K, int pitch, int ncols, bf16* WT, int mode, LAS float* scr, int item, int lane) {
    const int nblk = ncols / 32, kb = item / nblk, nb = item % nblk, k0 = 64 * kb, n0 = 32 * nb;
    float wv[32];
    const float* wp = W + (size_t)(k0 + (lane >> 5)) * pitch + n0 + (lane & 31);
#pragma unroll
    for (int i = 0; i < 32; ++i) wv[i] = __builtin_nontemporal_load(wp + (size_t)(2 * i) * pitch);
#pragma unroll
    for (int i = 0; i < 32; ++i) scr[(2 * i + (lane >> 5)) * 33 + (lane & 31)] = wv[i];
    LDS_WAIT(); asm volatile("" ::: "memory");
    int d0 = n0;
    if (mode == 1) { const int c = n0 < FH ? n0 : n0 - FH; d0 = (c >> 7) * 256 + (c & 127) + (n0 < FH ? 0 : 128); }
    const int c8 = lane & 7;
#pragma unroll
    for (int j = 0; j < 4; ++j) { const int n = (lane >> 3) + 8 * j; const LAS float* s = scr + (8 * c8) * 33 + n;
        v4u o; o.x = pk2(s[0 * 33], s[1 * 33]); o.y = pk2(s[2 * 33], s[3 * 33]); o.z = pk2(s[4 * 33], s[5 * 33]); o.w = pk2(s[6 * 33], s[7 * 33]);
        *(GAS v4u*)(WT + (size_t)(d0 + n) * K + k0 + 8 * c8) = o; }
    LDS_WAIT(); asm volatile("" ::: "memory");
}
constexpr int WQ_EVI = 32 * 144, WQ_ODI = 32 * 192, WQ_OUT = 32 * 64, WQ_FI = 32 * 352, WQ_FO = 88 * 64;
constexpr int WQ_LE = WQ_EVI + WQ_OUT + WQ_FI + WQ_FO, WQ_LO = WQ_ODI + WQ_OUT + WQ_FI + WQ_FO, WQ_N = 2 * (WQ_LE + WQ_LO);
static_assert(WQ_LE == 23552 && WQ_LO == 25088 && WQ_N == 97280, "weight queue sizes");
__device__ __forceinline__ void wq_item(Frame& F, int q, LAS float* scr) {
    int li = 0, r = q;
    if (r >= WQ_LE) { r -= WQ_LE; li = 1; if (r >= WQ_LO) { r -= WQ_LO; li = 2; if (r >= WQ_LE) { r -= WQ_LE; li = 3; } } }
    const int lj = li >> 1; const bool odd = li & 1; const int nin = odd ? WQ_ODI : WQ_EVI;
    if (r < nin) {
        if (odd) p0_transpose_item(INP(F, 14) + (size_t)lj * DM * ODN, DM, ODN, ODN, (bf16*)(WSP(F) + WS_WIN_O + (size_t)lj * SZ_WIN_O), 0, scr, r, F.lane);
        else     p0_transpose_item(INP(F, 9) + (size_t)lj * DM * EV_IN, DM, EV_IN, 4608, (bf16*)(WSP(F) + WS_WIN_E + (size_t)lj * SZ_WIN_E), 0, scr, r, F.lane);
        return; }
    r -= nin;
    if (r < WQ_OUT) { p0_transpose_item(INP(F, odd ? 15 : 10) + (size_t)lj * DM * DM, DM, DM, DM, (bf16*)(WSP(F) + (odd ? WS_WOUT_O : WS_WOUT_E) + (size_t)lj * SZ_WOUT), 0, scr, r, F.lane); return; }
    r -= WQ_OUT;
    if (r < WQ_FI) { p0_transpose_item(INP(F, 7) + (size_t)li * DM * 2 * FH, DM, 2 * FH, 2 * FH, (bf16*)(WSP(F) + WS_WFI + (size_t)li * SZ_WFI), 1, scr, r, F.lane); return; }
    r -= WQ_FI;
    p0_transpose_item(INP(F, 8) + (size_t)li * FH * DM, FH, DM, DM, (bf16*)(WSP(F) + WS_WFO + (size_t)li * SZ_WFO), 0, scr, r, F.lane);
}
constexpr int WQ_IPW = 10, WQ_P0 = 11200;
__device__ const int WQ_TAIL[8] = {11200, 17920, 31360, 48000, 61440, 68160, 81600, 97280};
static_assert(17920 - 11200 <= 84 * 8 * WQ_IPW && 31360 - 17920 <= 168 * 8 * WQ_IPW && 48000 - 31360 <= 208 * 8 * WQ_IPW && 61440 - 48000 <= 168 * 8 * WQ_IPW && 68160 - 61440 <= 84 * 8 * WQ_IPW && 81600 - 68160 <= 168 * 8 * WQ_IPW && 97280 - 81600 <= 208 * 8 * WQ_IPW, "tail capacities");
__device__ __forceinline__ void p0_weights(Frame& F) {
    LAS float* scr = (LAS float*)(F.lds + F.wave * 16384);
    const int gw = F.vcu * 8 + F.wave, NGW = F.G * 8;
    if (F.G != 256) { for (int q = gw; q < WQ_N; q += NGW) wq_item(F, q, scr); return; }
    for (int i = gw; i < WQ_P0; i += NGW) wq_item(F, i, scr);
}
__device__ __forceinline__ void wq_tail(Frame& F, int t, int units) {
    const int rem = units % F.G; const int c = (int)blockIdx.x;
    if (F.G != 256 || rem == 0 || c < rem) return;
    LAS float* scr = (LAS float*)(F.lds + F.wave * 16384);
    const int nw = (F.G - rem) * 8, wr = (c - rem) * 8 + F.wave; const int qb = WQ_TAIL[t], qe = WQ_TAIL[t + 1];
    for (int i = 0; i < WQ_IPW; ++i) { const int q = qb + wr + i * nw; if (q < qe) wq_item(F, q, scr); }
}

template <bool F32SRC>
__device__ __forceinline__ void norm_phase(Frame& F, int li, int which, const void* hlv, float* hcx, int red_ks, const float* red_gate) {
    const float* hl = (const float*)hlv; const bf16* hb = (const bf16*)hlv;
    const float* gain = INP(F, 6) + (size_t)(li * 2 + which) * DM;
    const float* modv = (const float*)(WSP(F) + WS_MODV) + (size_t)li * 3 * 12288;
    bf16* A = (bf16*)(WSP(F) + WS_A);
    LAS float* Gv = (LAS float*)F.lds; LAS float* Sv = Gv + 3 * DM;
    for (int i = F.tid; i < 3 * DM; i += 512) { const int grp = i >> 11, d = i & (DM - 1); const float* sh = modv + grp * 12288 + (which * 3) * DM;
        Gv[i] = gain[d] * (1.0f + sh[DM + d]); Sv[i] = sh[d]; }
    __syncthreads();
    const int gw = F.vcu * 8 + F.wave, NGW = F.G * 8; const int lane = F.lane;
    int r = gw;
    if constexpr (F32SRC) {
    for (; r + 3 * NGW < ML; r += 4 * NGW) {
        f32x4 v[4][8]; float q[4] = {0.f, 0.f, 0.f, 0.f};
#pragma unroll
        for (int i = 0; i < 4; ++i) { const float* sp = hl + (size_t)(r + i * NGW) * DM + 4 * lane;
#pragma unroll
            for (int j = 0; j < 8; ++j) v[i][j] = *(const f32x4*)(sp + 256 * j); }
#pragma unroll
        for (int i = 0; i < 4; ++i)
#pragma unroll
            for (int j = 0; j < 8; ++j) q[i] += (v[i][j].x * v[i][j].x + v[i][j].y * v[i][j].y) + (v[i][j].z * v[i][j].z + v[i][j].w * v[i][j].w);
#pragma unroll
        for (int i = 0; i < 4; ++i) { const int ri = r + i * NGW; const float rs = rsqrtf(wave_sum(q[i]) * (1.0f / DM) + 1e-6f); const int go = (ri < SEQ ? 0 : 1) * DM;
#pragma unroll
            for (int j = 0; j < 8; ++j) { const int d = 4 * lane + 256 * j;
                const f32x4 a = v[i][j] * rs * *(const LAS f32x4*)(Gv + go + d) + *(const LAS f32x4*)(Sv + go + d);
                v2u o; o.x = pk2(a.x, a.y); o.y = pk2(a.z, a.w);
                *(v2u*)(A + (size_t)ri * DM + d) = o; } }
    }
    } else {
    for (; r + 3 * NGW < ML; r += 4 * NGW) {
        v4u w[4][4]; float q[4];
#pragma unroll
        for (int i = 0; i < 4; ++i) { const bf16* sp = hb + (size_t)(r + i * NGW) * DM + 8 * lane;
#pragma unroll
            for (int j = 0; j < 4; ++j) w[i][j] = *(const v4u*)(sp + 512 * j); }
        asm volatile("" ::: "memory");
#pragma unroll
        for (int i = 0; i < 4; ++i) { float a = 0.f;
#pragma unroll
            for (int j = 0; j < 4; ++j) { const v4u t = w[i][j];
                a += (bflo(t.x) * bflo(t.x) + bfhi(t.x) * bfhi(t.x)) + (bflo(t.y) * bflo(t.y) + bfhi(t.y) * bfhi(t.y)) + (bflo(t.z) * bflo(t.z) + bfhi(t.z) * bfhi(t.z)) + (bflo(t.w) * bflo(t.w) + bfhi(t.w) * bfhi(t.w)); }
            q[i] = a; }
#pragma unroll
        for (int i = 0; i < 4; ++i) { const int ri = r + i * NGW; const float rs = rsqrtf(wave_sum(q[i]) * (1.0f / DM) + 1e-6f); const int go = (ri < SEQ ? 0 : 1) * DM;
#pragma unroll
            for (int j = 0; j < 4; ++j) { const int d = 8 * lane + 512 * j; const v4u t = w[i][j];
                const f32x4 x0 = f32x4{bflo(t.x), bfhi(t.x), bflo(t.y), bfhi(t.y)}, x1 = f32x4{bflo(t.z), bfhi(t.z), bflo(t.w), bfhi(t.w)};
                const f32x4 a0 = x0 * rs * *(const LAS f32x4*)(Gv + go + d) + *(const LAS f32x4*)(Sv + go + d);
                const f32x4 a1 = x1 * rs * *(const LAS f32x4*)(Gv + go + d + 4) + *(const LAS f32x4*)(Sv + go + d + 4);
                v4u o; o.x = pk2(a0.x, a0.y); o.y = pk2(a0.z, a0.w); o.z = pk2(a1.x, a1.y); o.w = pk2(a1.z, a1.w);
                *(v4u*)(A + (size_t)ri * DM + d) = o; } }
    }
    }
    if (F.G == 256 && r >= ML) {
        const int cr = F.vcu * 2 + (F.wave >> 2), qo = 4 * lane + 512 * (F.wave & 3);
        float* hrow = hcx + (size_t)cr * DM + qo;
        f32x4 v0 = *(const f32x4*)hrow, v1 = *(const f32x4*)(hrow + 256);
        if (red_ks > 0) {
            const float* sl = (const float*)(WSP(F) + WS_SLAB) + (size_t)cr * DM + qo;
            f32x4 t0[11], t1[11];
#pragma unroll
            for (int k = 0; k < 11; ++k) { const bool on = k < red_ks; const size_t ko = (size_t)(on ? k : 0) * (MC * DM); t0[k] = *(const f32x4*)(sl + ko); t1[k] = *(const f32x4*)(sl + ko + 256); }
            f32x4 s0 = t0[0], s1 = t1[0];
#pragma unroll
            for (int k = 1; k < 11; ++k) if (k < red_ks) { s0 += t0[k]; s1 += t1[k]; }
            v0 += *(const f32x4*)(red_gate + qo) * s0; v1 += *(const f32x4*)(red_gate + qo + 256) * s1;
            *(f32x4*)hrow = v0; *(f32x4*)(hrow + 256) = v1;
        }
        const float ssq = wave_sum((v0.x * v0.x + v0.y * v0.y) + (v0.z * v0.z + v0.w * v0.w) + (v1.x * v1.x + v1.y * v1.y) + (v1.z * v1.z + v1.w * v1.w));
        LAS float* red = (LAS float*)(F.lds + 49152);
        if (lane == 0) red[F.wave] = ssq;
        __syncthreads();
        const int w0 = F.wave & 4; const float rstd = rsqrtf(((red[w0] + red[w0 + 1]) + (red[w0 + 2] + red[w0 + 3])) * (1.0f / DM) + 1e-6f);
        const f32x4 a0 = v0 * rstd * *(const LAS f32x4*)(Gv + 2 * DM + qo) + *(const LAS f32x4*)(Sv + 2 * DM + qo);
        const f32x4 a1 = v1 * rstd * *(const LAS f32x4*)(Gv + 2 * DM + qo + 256) + *(const LAS f32x4*)(Sv + 2 * DM + qo + 256);
        v2u o0, o1; o0.x = pk2(a0.x, a0.y); o0.y = pk2(a0.z, a0.w); o1.x = pk2(a1.x, a1.y); o1.y = pk2(a1.z, a1.w);
        *(v2u*)(A + (size_t)(ML + cr) * DM + qo) = o0; *(v2u*)(A + (size_t)(ML + cr) * DM + qo + 256) = o1;
    } else
    for (; r < MT; r += NGW) {
        const int go = (r < SEQ ? 0 : (r < ML ? 1 : 2)) * DM;
        f32x4 v[8]; float ss = 0.f;
        if (!F32SRC && r < ML) {
#pragma unroll
            for (int j = 0; j < 8; ++j) { const v2u t = *(const v2u*)(hb + (size_t)r * DM + 4 * lane + 256 * j); v[j] = f32x4{bflo(t.x), bfhi(t.x), bflo(t.y), bfhi(t.y)}; }
        } else { const float* src = r < ML ? hl + (size_t)r * DM : hcx + (size_t)(r - ML) * DM;
#pragma unroll
            for (int j = 0; j < 8; ++j) v[j] = *(const f32x4*)(src + 4 * lane + 256 * j); }
        if (r >= ML && red_ks > 0) {
            const float* sl = (const float*)(WSP(F) + WS_SLAB) + (size_t)(r - ML) * DM + 4 * lane;
#pragma unroll
            for (int j = 0; j < 8; j += 2) { f32x4 t0[11], t1[11];
#pragma unroll
                for (int k = 0; k < 11; ++k) { const bool on = k < red_ks; const size_t ko = (size_t)(on ? k : 0) * (MC * DM);
                    t0[k] = *(const f32x4*)(sl + ko + 256 * j); t1[k] = *(const f32x4*)(sl + ko + 256 * (j + 1)); }
                f32x4 s0 = t0[0], s1 = t1[0];
#pragma unroll
                for (int k = 1; k < 11; ++k) if (k < red_ks) { s0 += t0[k]; s1 += t1[k]; }
                v[j] += *(const f32x4*)(red_gate + 4 * lane + 256 * j) * s0; v[j + 1] += *(const f32x4*)(red_gate + 4 * lane + 256 * (j + 1)) * s1;
                *(f32x4*)(hcx + (size_t)(r - ML) * DM + 4 * lane + 256 * j) = v[j]; *(f32x4*)(hcx + (size_t)(r - ML) * DM + 4 * lane + 256 * (j + 1)) = v[j + 1]; }
        }
#pragma unroll
        for (int j = 0; j < 8; ++j) ss += (v[j].x * v[j].x + v[j].y * v[j].y) + (v[j].z * v[j].z + v[j].w * v[j].w);
        const float rstd = rsqrtf(wave_sum(ss) * (1.0f / DM) + 1e-6f);
#pragma unroll
        for (int j = 0; j < 8; ++j) { const int d = 4 * lane + 256 * j;
            const f32x4 a = v[j] * rstd * *(const LAS f32x4*)(Gv + go + d) + *(const LAS f32x4*)(Sv + go + d);
            v2u o; o.x = pk2(a.x, a.y); o.y = pk2(a.z, a.w);
            *(v2u*)(A + (size_t)r * DM + d) = o; }
    }
    __syncthreads();
}

__device__ __forceinline__ void prep_even_row(bf16* P, bf16* QR, int r, bool lat, int lane, const v4u (&w6)[6], const f32x4 (&rw)[4], const float (&g0)[8], const float (&g1)[8]) {
    float cs[8], sn[8];
#pragma unroll
    for (int e = 0; e < 8; e += 2) { cs[e] = lat ? rw[e >> 1].x : 1.f; sn[e] = lat ? rw[e >> 1].y : 0.f; cs[e + 1] = lat ? rw[e >> 1].z : 1.f; sn[e + 1] = lat ? rw[e >> 1].w : 0.f; }
    bf16* prow = P + (size_t)r * EVN;
#pragma unroll
    for (int j = 0; j < 6; ++j) {
        const int ch = j * 64 + lane; const v4u w = w6[j];
        float x[8] = {bflo(w.x), bfhi(w.x), bflo(w.y), bfhi(w.y), bflo(w.z), bfhi(w.z), bflo(w.w), bfhi(w.w)};
        float ss = 0.f;
#pragma unroll
        for (int e = 0; e < 8; ++e) ss += x[e] * x[e];
        ss += __shfl_xor(ss, 1); ss += __shfl_xor(ss, 2); ss += __shfl_xor(ss, 4);
        const float rstd = rsqrtf(ss * (1.0f / 64.0f) + 1e-6f);
        float y[8], yr[8];
#pragma unroll
        for (int e = 0; e < 8; ++e) y[e] = x[e] * rstd * (j < 3 ? g0[e] * 0.18033688011112042f : g1[e]);
#pragma unroll
        for (int e = 0; e < 8; ++e) { const float yp = __shfl_xor(y[e], 2); yr[e] = (lane & 2) ? (y[e] * cs[e] + yp * sn[e]) : (y[e] * cs[e] - yp * sn[e]); }
        v4u on, orr;
        on.x = pk2(y[0], y[1]); on.y = pk2(y[2], y[3]); on.z = pk2(y[4], y[5]); on.w = pk2(y[6], y[7]);
        orr.x = pk2(yr[0], yr[1]); orr.y = pk2(yr[2], yr[3]); orr.z = pk2(yr[4], yr[5]); orr.w = pk2(yr[6], yr[7]);
        if (j < 3) { *(v4u*)(prow + ch * 8) = on; if (lat) *(v4u*)(QR + (size_t)r * 1536 + ch * 8) = orr; }
        else       { *(v4u*)(prow + ch * 8) = lat ? orr : on; }
    }
}
__device__ __forceinline__ void prep_even(Frame& F, int lj) {
    bf16* P = (bf16*)(WSP(F) + WS_P); bf16* QR = (bf16*)(WSP(F) + WS_QR);
    const float* gq = INP(F, 11) + (size_t)lj * 128; const float* rope = (const float*)(WSP(F) + WS_ROPE);
    const int gw = F.vcu * 8 + F.wave, NGW = F.G * 8; const int lane = F.lane;
    const int d0 = (lane & 7) * 8;
    float g0[8], g1[8];
#pragma unroll
    for (int e = 0; e < 8; ++e) { g0[e] = gq[d0 + e]; g1[e] = gq[64 + d0 + e]; }
    for (int r = gw; r < MT; r += 2 * NGW) {
        const int r1 = r + NGW; const bool has1 = r1 < MT; const int r1c = has1 ? r1 : r;
        v4u wa[6], wb[6]; f32x4 ra[4], rb[4];
        const int ta = r & (SEQ - 1), tb = r1c & (SEQ - 1);
        const int pa = ((lane >> 2) & 1) ? (ta & 63) : (ta >> 6), pb = ((lane >> 2) & 1) ? (tb & 63) : (tb >> 6);
#pragma unroll
        for (int j = 0; j < 6; ++j) { wa[j] = *(const v4u*)(P + (size_t)r * EVN + (j * 64 + lane) * 8); wb[j] = *(const v4u*)(P + (size_t)r1c * EVN + (j * 64 + lane) * 8); }
#pragma unroll
        for (int e = 0; e < 4; ++e) { ra[e] = *(const f32x4*)(rope + (size_t)((pa & 127) * 16 + (lane & 1) * 8) * 2 + e * 4); rb[e] = *(const f32x4*)(rope + (size_t)((pb & 127) * 16 + (lane & 1) * 8) * 2 + e * 4); }
        asm volatile("" ::: "memory");
        prep_even_row(P, QR, r, r < ML, lane, wa, ra, g0, g1);
        if (has1) prep_even_row(P, QR, r1, r1 < ML, lane, wb, rb, g0, g1);
    }
}

struct OddRow { v4u gb[2], gc[2][3], hh[2][3]; };
__device__ __forceinline__ void prep_odd_load(OddRow& R, const bf16* P, int r, int lane) {
    const bool lat = r < ML; const int t = lat ? (r & (SEQ - 1)) : ((r - ML) & (CTXL - 1)); const int n = lat ? SEQ : CTXL;
    const bf16* prow = P + (size_t)r * ODN;
#pragma unroll
    for (int j = 0; j < 2; ++j) { const int c0 = (j * 64 + lane) * 8; R.gb[j] = *(const v4u*)(prow + c0);
#pragma unroll
        for (int jj = 0; jj < 3; ++jj) { const int tt = t + jj - 1; const bool ok = tt >= 0 && tt < n; const bf16* pr = prow + (ok ? (ptrdiff_t)(jj - 1) * ODN : 0);
            R.gc[j][jj] = *(const v4u*)(pr + 1024 + c0); R.hh[j][jj] = *(const v4u*)(pr + 2048 + c0); } }
}
__device__ __forceinline__ void prep_odd_row(const OddRow& R, bf16* P, bf16* MIX, const float* cw, int r, int lane, const float (&g0)[8], const float (&g1)[8]) {
    const bool lat = r < ML; const int t = lat ? (r & (SEQ - 1)) : ((r - ML) & (CTXL - 1)); const int n = lat ? SEQ : CTXL;
    bf16* prow = P + (size_t)r * ODN;
#pragma unroll
    for (int j = 0; j < 2; ++j) {
        const int c0 = (j * 64 + lane) * 8;
        float accv[8];
#pragma unroll
        for (int e = 0; e < 8; ++e) accv[e] = 0.f;
#pragma unroll
        for (int jj = 0; jj < 3; ++jj) {
            const int tt = t + jj - 1; const float m = (tt >= 0 && tt < n) ? 1.f : 0.f;
            const v4u a = R.gc[j][jj], b = R.hh[j][jj];
            const f32x4 w0 = *(const f32x4*)(cw + jj * 1024 + c0) * m, w1 = *(const f32x4*)(cw + jj * 1024 + c0 + 4) * m;
            accv[0] += bflo(a.x) * bflo(b.x) * w0.x; accv[1] += bfhi(a.x) * bfhi(b.x) * w0.y; accv[2] += bflo(a.y) * bflo(b.y) * w0.z; accv[3] += bfhi(a.y) * bfhi(b.y) * w0.w;
            accv[4] += bflo(a.z) * bflo(b.z) * w1.x; accv[5] += bfhi(a.z) * bfhi(b.z) * w1.y; accv[6] += bflo(a.w) * bflo(b.w) * w1.z; accv[7] += bfhi(a.w) * bfhi(b.w) * w1.w;
        }
        const v4u gb = R.gb[j];
        v4u o; o.x = pk2(bflo(gb.x) * accv[0], bfhi(gb.x) * accv[1]); o.y = pk2(bflo(gb.y) * accv[2], bfhi(gb.y) * accv[3]);
        o.z = pk2(bflo(gb.z) * accv[4], bfhi(gb.z) * accv[5]); o.w = pk2(bflo(gb.w) * accv[6], bfhi(gb.w) * accv[7]);
        *(v4u*)(MIX + (size_t)r * DM + c0) = o;
    }
}
__device__ __forceinline__ void prep_odd(Frame& F, int lj) {
    const bf16* P = (const bf16*)(WSP(F) + WS_P); bf16* MIX = (bf16*)(WSP(F) + WS_MIX);
    const float* cw = INP(F, 17) + (size_t)lj * 3 * 1024;
    const int gw = F.vcu * 8 + F.wave, NGW = F.G * 8; const int lane = F.lane;
    f32x4 wt[2][3][2];
#pragma unroll
    for (int j = 0; j < 2; ++j)
#pragma unroll
        for (int jj = 0; jj < 3; ++jj) { const int c0 = (j * 64 + lane) * 8; wt[j][jj][0] = *(const f32x4*)(cw + jj * 1024 + c0); wt[j][jj][1] = *(const f32x4*)(cw + jj * 1024 + c0 + 4); }
    for (int g = gw; g < MT / 4; g += NGW) {
        const int r0 = 4 * g; const bool lat = r0 < ML; const int t0 = lat ? (r0 & (SEQ - 1)) : ((r0 - ML) & (CTXL - 1)); const int n = lat ? SEQ : CTXL;
        const bf16* pb = P + (size_t)r0 * ODN;
        v4u gb[4][2], gc[6][2], hh[6][2];
#pragma unroll
        for (int i = 0; i < 6; ++i) { const int tt = t0 + i - 1; const bool ok = tt >= 0 && tt < n; const bf16* pr = pb + (ok ? (ptrdiff_t)(i - 1) * ODN : 0);
#pragma unroll
            for (int j = 0; j < 2; ++j) { const int c0 = (j * 64 + lane) * 8; gc[i][j] = *(const v4u*)(pr + 1024 + c0); hh[i][j] = *(const v4u*)(pr + 2048 + c0); } }
#pragma unroll
        for (int i = 0; i < 4; ++i)
#pragma unroll
            for (int j = 0; j < 2; ++j) gb[i][j] = *(const v4u*)(pb + (size_t)i * ODN + (j * 64 + lane) * 8);
        asm volatile("" ::: "memory");
#pragma unroll
        for (int i = 0; i < 4; ++i)
#pragma unroll
            for (int j = 0; j < 2; ++j) { const int c0 = (j * 64 + lane) * 8;
                float accv[8];
#pragma unroll
                for (int e = 0; e < 8; ++e) accv[e] = 0.f;
#pragma unroll
                for (int jj = 0; jj < 3; ++jj) { const int tt = t0 + i + jj - 1; const float m = (tt >= 0 && tt < n) ? 1.f : 0.f;
                    const v4u a = gc[i + jj][j], b = hh[i + jj][j]; const f32x4 w0 = wt[j][jj][0] * m, w1 = wt[j][jj][1] * m;
                    accv[0] += bflo(a.x) * bflo(b.x) * w0.x; accv[1] += bfhi(a.x) * bfhi(b.x) * w0.y; accv[2] += bflo(a.y) * bflo(b.y) * w0.z; accv[3] += bfhi(a.y) * bfhi(b.y) * w0.w;
                    accv[4] += bflo(a.z) * bflo(b.z) * w1.x; accv[5] += bfhi(a.z) * bfhi(b.z) * w1.y; accv[6] += bflo(a.w) * bflo(b.w) * w1.z; accv[7] += bfhi(a.w) * bfhi(b.w) * w1.w; }
                const v4u q = gb[i][j];
                v4u o; o.x = pk2(bflo(q.x) * accv[0], bfhi(q.x) * accv[1]); o.y = pk2(bflo(q.y) * accv[2], bfhi(q.y) * accv[3]);
                o.z = pk2(bflo(q.z) * accv[4], bfhi(q.z) * accv[5]); o.w = pk2(bflo(q.w) * accv[6], bfhi(q.w) * accv[7]);
                *(v4u*)(MIX + (size_t)(r0 + i) * DM + c0) = o; }
    }
}

struct EvenTileRow { int ctx0, lat0; __device__ __forceinline__ int operator()(int j) const { return j < 4 ? ctx0 + 64 * j : lat0 + 64 * (j - 4); } };
__device__ __forceinline__ void even_attn_unit(Frame& F, int lj, int b, int h, int qrow0, bool is_ctx, unsigned& sacc) {
    const bf16* P = (const bf16*)(WSP(F) + WS_P); const bf16* QR = (const bf16*)(WSP(F) + WS_QR); bf16* MIX = (bf16*)(WSP(F) + WS_MIX);
    const int lane = F.lane, r32 = lane & 31, hi = lane >> 5, wq = F.wave & 3, comp = F.wave >> 2;
    EvenTileRow trow{ML + b * CTXL, b * SEQ};
    att::f32x16 o[4]; float rli[16];
    att::attn_dual_stag<EVN, 1536, EVN>(P + (size_t)qrow0 * EVN + h * 128, QR + (size_t)(is_ctx ? 0 : qrow0) * 1536 + h * 128, is_ctx ? 1000 : 4,
                                        P + 1536 + h * 128, P + 3072 + h * 128, trow, is_ctx ? 4 : 132, (char*)F.ldsg, o, rli, sacc);
    __syncthreads();
    LAS float* xch = (LAS float*)F.lds + (size_t)wq * 4096 + lane;
    if (comp == 1) {
#pragma unroll
        for (int d = 0; d < 4; ++d)
#pragma unroll
            for (int r = 0; r < 16; ++r) xch[(d * 16 + r) * 64] = o[d][r] * rli[r];
    }
    __syncthreads();
    if (comp == 0) {
        const float lam = ((const float*)(WSP(F) + WS_LAM))[lj];
        const float cfac = 1.0f - (lj == 0 ? LAM_INIT0 : LAM_INIT1);
        const float* gsub = INP(F, 13) + (size_t)lj * 128;
        float ssq[16];
#pragma unroll
        for (int r = 0; r < 16; ++r) ssq[r] = 0.f;
#pragma unroll
        for (int d = 0; d < 4; ++d)
#pragma unroll
            for (int r = 0; r < 16; ++r) { const float v = o[d][r] * rli[r] - lam * xch[(d * 16 + r) * 64]; o[d][r] = v; ssq[r] += v * v; }
#pragma unroll
        for (int r = 0; r < 16; ++r) { float s = ssq[r]; s += __shfl_xor(s, 1); s += __shfl_xor(s, 2); s += __shfl_xor(s, 4); s += __shfl_xor(s, 8); s += __shfl_xor(s, 16);
            ssq[r] = rsqrtf(s * (1.0f / 128.0f) + 1e-6f) * cfac; }
        int r32s = r32; asm volatile("" : "+v"(r32s));
#pragma unroll
        for (int d = 0; d < 4; ++d) { const float g = gsub[32 * d + r32s];
#pragma unroll
            for (int r = 0; r < 16; ++r) MIX[(size_t)(qrow0 + wq * 32 + att::crow(r, hi)) * DM + h * 128 + 32 * d + r32s] = (bf16)f2bf(o[d][r] * ssq[r] * g); }
    }
}

__device__ __forceinline__ void fft_unit(Frame& F, int b, int cp) {
    LAS unsigned char* Vl = F.lds;
    LAS unsigned char* Yl = F.lds + 69632;
    const bf16* P = (const bf16*)(WSP(F) + WS_P); bf16* MIX = (bf16*)(WSP(F) + WS_MIX);
    const bf16* FA1 = (const bf16*)(WSP(F) + WS_FA1); const bf16* FA2 = (const bf16*)(WSP(F) + WS_FA2);
    const int lane = F.lane, l15 = lane & 15, lq = lane >> 4;
    v2u wl[16];
    const bf16* FT = (const bf16*)(WSP(F) + WS_FT) + (size_t)(b * 256 + cp) * 8192 * 4;
#pragma unroll
    for (int jj = 0; jj < 16; ++jj) wl[jj] = *(const v2u*)(FT + (size_t)(F.tid + 512 * jj) * 4);
#pragma unroll
    for (int jj = 0; jj < 16; ++jj) { const int t = F.tid + 512 * jj; const v2u w = wl[jj];
        const int t1 = t >> 7, t2 = t & 127;
        *(LAS bf16*)(Vl + (2 * t2 + 0) * 272 + (t1) * 2) = (bf16)(w.x & 0xffffu);       *(LAS bf16*)(Vl + (2 * t2 + 0) * 272 + (64 + t1) * 2) = (bf16)(w.x >> 16);
        *(LAS bf16*)(Vl + (2 * t2 + 1) * 272 + (t1) * 2) = (bf16)(w.y & 0xffffu);       *(LAS bf16*)(Vl + (2 * t2 + 1) * 272 + (64 + t1) * 2) = (bf16)(w.y >> 16); }
    __syncthreads();
    {
        const int mt = F.wave & 3, nt0 = (F.wave >> 2) * 8;
        bf16x8 aR[4], aI[4];
#pragma unroll
        for (int ks = 0; ks < 4; ++ks) { aR[ks] = *(const bf16x8*)(FA1 + (size_t)(16 * mt + l15) * 128 + 32 * ks + 8 * lq); aI[ks] = *(const bf16x8*)(FA1 + (size_t)(64 + 16 * mt + l15) * 128 + 32 * ks + 8 * lq); }
        for (int nt = nt0; nt < nt0 + 8; ++nt) {
            f32x4 accR = {0.f, 0.f, 0.f, 0.f}, accI = accR;
#pragma unroll
            for (int ks = 0; ks < 4; ++ks) { const bf16x8 bf = *(const LAS bf16x8*)(Vl + (16 * nt + l15) * 272 + (32 * ks + 8 * lq) * 2);
                accR = __builtin_amdgcn_mfma_f32_16x16x32_bf16(aR[ks], bf, accR, 0, 0, 0); accI = __builtin_amdgcn_mfma_f32_16x16x32_bf16(aI[ks], bf, accI, 0, 0, 0); }
            const int n1 = 16 * nt + l15, t2 = n1 >> 1, cc = n1 & 1;
#pragma unroll
            for (int r = 0; r < 4; ++r) { const int k1 = 16 * mt + lq * 4 + r; const float ph = (float)((t2 * k1) & 8191) * (1.0f / 8192.0f); const float cs = hw_cos(ph), sn = hw_sin(ph);
                const float yr = accR[r] * cs + accI[r] * sn, yi = accI[r] * cs - accR[r] * sn; const int n2 = k1 * 2 + cc;
                *(LAS bf16*)(Yl + n2 * 528 + t2 * 2) = (bf16)f2bf(yr); *(LAS bf16*)(Yl + n2 * 528 + (128 + t2) * 2) = (bf16)f2bf(yi); }
        }
    }
    __syncthreads();
    {
        const int mt = F.wave;
        bf16x8 a2[8];
#pragma unroll
        for (int ks = 0; ks < 8; ++ks) a2[ks] = *(const bf16x8*)(FA2 + (size_t)(16 * mt + l15) * 256 + 32 * ks + 8 * lq);
        for (int nt = 0; nt < 8; ++nt) {
            f32x4 acc = {0.f, 0.f, 0.f, 0.f};
#pragma unroll
            for (int ks = 0; ks < 8; ++ks) { const bf16x8 bf = *(const LAS bf16x8*)(Yl + (16 * nt + l15) * 528 + (32 * ks + 8 * lq) * 2); acc = __builtin_amdgcn_mfma_f32_16x16x32_bf16(a2[ks], bf, acc, 0, 0, 0); }
            const int n2 = 16 * nt + l15, k1 = n2 >> 1, cc = n2 & 1;
#pragma unroll
            for (int r = 0; r < 4; ++r) { const int k2 = 16 * mt + lq * 4 + r; const int tok = k1 + 64 * k2; const unsigned me = f2bf(acc[r] * (1.0f / 1024.0f)); const unsigned other = (unsigned)__shfl_xor((int)me, 1);
                if (cc == 0) *(unsigned*)(MIX + (size_t)(b * SEQ + tok) * DM + 1536 + 2 * cp) = me | (other << 16); }
        }
    }
    __syncthreads();
}
__device__ __forceinline__ void ctx_dft_unit(Frame& F, int b, int cb) {
    LAS unsigned char* Vc = F.lds;
    const bf16* P = (const bf16*)(WSP(F) + WS_P); bf16* MIX = (bf16*)(WSP(F) + WS_MIX); const bf16* FA3 = (const bf16*)(WSP(F) + WS_FA3);
    const int lane = F.lane, l15 = lane & 15, lq = lane >> 4;
    { const int t = F.tid >> 1, half = F.tid & 1; const bf16* src = P + (size_t)(ML + b * CTXL + t) * EVN + 4608 + 32 * cb + 16 * half;
      const v4u w0 = *(const v4u*)src, w1 = *(const v4u*)(src + 8);
      const unsigned ww[8] = {w0.x, w0.y, w0.z, w0.w, w1.x, w1.y, w1.z, w1.w};
#pragma unroll
      for (int i = 0; i < 8; ++i) { const int cl = half * 8 + i; *(LAS bf16*)(Vc + cl * 1040 + t * 2) = (bf16)(ww[i] & 0xffffu); *(LAS bf16*)(Vc + cl * 1040 + (256 + t) * 2) = (bf16)(ww[i] >> 16); } }
    __syncthreads();
#pragma unroll 1
    for (int mi = 0; mi < 2; ++mi) { const int mt = F.wave * 2 + mi; f32x4 acc = {0.f, 0.f, 0.f, 0.f};
#pragma unroll 4
        for (int ks = 0; ks < 16; ++ks) { const bf16x8 a = *(const bf16x8*)(FA3 + (size_t)(16 * mt + l15) * 512 + 32 * ks + 8 * lq); const bf16x8 bf = *(const LAS bf16x8*)(Vc + l15 * 1040 + (32 * ks + 8 * lq) * 2);
            acc = __builtin_amdgcn_mfma_f32_16x16x32_bf16(a, bf, acc, 0, 0, 0); }
#pragma unroll
        for (int r = 0; r < 4; ++r) { const int k = 16 * mt + lq * 4 + r; MIX[(size_t)(ML + b * CTXL + k) * DM + 1536 + 16 * cb + l15] = (bf16)f2bf(acc[r] * 0.005524271728019903f); } }
    __syncthreads();
}
__device__ __forceinline__ void mixer_even(Frame& F, int lj) {
    unsigned sacc = 0;
#if STAMP == 1
    const unsigned long long sm0_ = __builtin_amdgcn_s_memtime(), sr0_ = __builtin_amdgcn_s_memrealtime(); __builtin_amdgcn_s_waitcnt(0xC07F);
#endif
#if STAMP == 40 || STAMP == 41
    const unsigned tA_ = (unsigned)__builtin_amdgcn_s_memrealtime();
#endif
    if (MXM & 1) {
        for (int uu = F.vcu; uu < ((DUP & 1) ? 2 : 1) * (1536 + 48); uu += F.G) { const int u = (DUP & 1) ? uu % (1536 + 48) : uu; const bool is_ctx = u >= 1536;
            const int pair = is_ctx ? (u - 1536) >> 1 : (u >> 6), qb = is_ctx ? (u & 1) : (u & 63); const int b = pair / 12, h = pair % 12;
            even_attn_unit(F, lj, b, h, is_ctx ? ML + b * CTXL + qb * 128 : b * SEQ + qb * 128, is_ctx, sacc); __syncthreads(); } }
#if STAMP && STAMP < 6
    if (lj == (STAMP_LJ) && blockIdx.x == 0) {
#if STAMP == 1
        const unsigned long long sm1_ = __builtin_amdgcn_s_memtime(), sr1_ = __builtin_amdgcn_s_memrealtime(); __builtin_amdgcn_s_waitcnt(0xC07F);
        sacc = (unsigned)(((sm1_ - sm0_) * 100ull) / (sr1_ - sr0_));
#endif
        if (F.wave == ((STAMP == 3) ? 4 : 0) && F.lane == 0) __hip_atomic_store((GAS unsigned*)(WSP(F) + WS_LAM + 1024), sacc, RLX_AGENT);
    }
#endif
#if STAMP == 40 || STAMP == 41
    const unsigned tB_ = (unsigned)__builtin_amdgcn_s_memrealtime();
#endif
    if ((MXM & 12) == 12) {
        gu32* cnt = (gu32*)(WSP(F) + WS_CTL) + CW_FFT + lj;
        for (;;) {
            if (F.tid == 0) F.MISC[20] = __hip_atomic_fetch_add(cnt, 1u, RLX_AGENT);
            __syncthreads();
            const int u = (int)F.MISC[20];
            if (u >= 512 + 64) break;
            if (u < 512) fft_unit(F, u >> 8, u & 255); else { ctx_dft_unit(F, (u - 512) >> 5, (u - 512) & 31); __syncthreads(); }
        }
    }
#if STAMP == 40 || STAMP == 41
    { const unsigned tC_ = (unsigned)__builtin_amdgcn_s_memrealtime(); if (F.tid == 0) F.MISC[16] += (STAMP == 40) ? tB_ - tA_ : tC_ - tB_; }
#endif
}

struct OddTileRow { int ctx0, lat0; __device__ __forceinline__ int operator()(int j) const { return j < 4 ? ctx0 + 64 * j : lat0 + 64 * (j - 4); } };
struct NaMask {
    int R0, rw, cq, rs, cs, hi; const LAS float* bt; bool off;
    __device__ __forceinline__ bool skip(int j) const { if (off || j < 4) return false; const int kr = R0 + j - 4; return __builtin_amdgcn_readfirstlane((int)(kr < rs || kr >= rs + 8)) != 0; }
    __device__ __forceinline__ void operator()(att::f32x16& p0, att::f32x16& p1, int j) const {
        if (off || j < 4) return;
        const int kr = R0 + j - 4;
        if (kr < rs || kr >= rs + 8) {
#pragma unroll
            for (int r = 0; r < 16; ++r) { p0[r] = -1e30f; p1[r] = -1e30f; }
            return; }
        int cq_ = cq, hi_ = hi; asm volatile("" : "+v"(cq_), "+v"(hi_));
        int cs_ = cq_ - 8; cs_ = cs_ < 0 ? 0 : (cs_ > 48 ? 48 : cs_);
        const int rowoff = (kr - rw + 7) * 31 + 15 - cq_;
#pragma unroll
        for (int r = 0; r < 16; ++r) { const int c0 = att::crow(r, hi_), c1 = 32 + c0; const int cs = cs_;
            const bool ok0 = c0 >= cs && c0 < cs + 16, ok1 = c1 >= cs && c1 < cs + 16;
            const float b0 = bt[ok0 ? rowoff + c0 : 0], b1 = bt[ok1 ? rowoff + c1 : 0];
            p0[r] = ok0 ? p0[r] + b0 : -1e30f; p1[r] = ok1 ? p1[r] + b1 : -1e30f;
            if ((r & 7) == 7) __builtin_amdgcn_sched_barrier(0); }
    }
};
__device__ __forceinline__ void odd_attn_unit(Frame& F, int lj, int b, int h, int rb, bool is_ctx) {
    const bf16* P = (const bf16*)(WSP(F) + WS_P); bf16* MIX = (bf16*)(WSP(F) + WS_MIX);
    const int lane = F.lane, r32 = lane & 31, hi = lane >> 5, wid = F.wave;
    const int qrow0 = is_ctx ? ML + b * CTXL : b * SEQ + rb * 256;
    int R0 = 4 * rb - 4; R0 = R0 < 0 ? 0 : (R0 > 116 ? 116 : R0);
    OddTileRow trow{ML + b * CTXL, b * SEQ + R0 * 64};
    LAS float* bt = (LAS float*)(F.lds + att::LDS_BT_OFF);
    if (!is_ctx) { const float* rpb = INP(F, 18) + (size_t)(lj * 8 + h) * 465; for (int t = F.tid; t < 465; t += 512) bt[t] = rpb[t] * 1.4426950408889634f; }
    NaMask mk; mk.R0 = R0; mk.rw = 4 * rb + (wid >> 1); mk.cq = 32 * (wid & 1) + r32; mk.hi = hi; mk.bt = bt; mk.off = is_ctx;
    { int rs = mk.rw - 4; rs = rs < 0 ? 0 : (rs > 120 ? 120 : rs); mk.rs = rs; int cs = mk.cq - 8; cs = cs < 0 ? 0 : (cs > 48 ? 48 : cs); mk.cs = cs; }
    att::f32x16 o[4]; float rli[16];
    att::attn_core<128, ODN, ODN, ODN, 1, false, true>(P + (size_t)qrow0 * ODN + 3072 + h * 128, (const bf16*)nullptr, 1000,
                        P + 4096 + h * 128, P + 5120 + h * 128, trow, is_ctx ? 4 : 16, mk, (char*)F.ldsg, o, rli);
#pragma unroll
    for (int d = 0; d < 4; ++d)
#pragma unroll
        for (int r = 0; r < 16; ++r) MIX[(size_t)(qrow0 + wid * 32 + att::crow(r, hi)) * DM + 1024 + h * 128 + 32 * d + r32] = (bf16)f2bf(o[d][r] * rli[r]);
}
__device__ __forceinline__ void mixer_odd(Frame& F, int lj, bool with_ctx) {
    const int nun = 512 + (with_ctx ? 16 : 0);
    if (MXM & 1) for (int uu = F.vcu; uu < ((DUP & 2) ? 2 : 1) * nun; uu += F.G) { const int u = (DUP & 2) ? uu % nun : uu; const bool is_ctx = u >= 512; const int pair = is_ctx ? u - 512 : (u >> 5), rb = is_ctx ? 0 : (u & 31);
        odd_attn_unit(F, lj, pair >> 3, pair & 7, rb, is_ctx); __syncthreads(); }
}

#if STAMP >= 6
constexpr bool seam_sel(int ph) {
    if (STAMP == 50) return ph == 3;
    if (STAMP >= 20) return ph == STAMP - 20;
    if (STAMP == 13 || STAMP == 14) return false;
    return STAMP == 6 ? true : STAMP == 7 ? (ph == 1) : STAMP == 8 ? (ph == 3) : STAMP == 9 ? (ph == 6) : STAMP == 10 ? (ph == 4 || ph == 7) : STAMP == 11 ? (ph == 0 || ph == 5) : (ph == 8);
}
#endif
__global__ void __launch_bounds__(512, 2) mk_fwd(Args args) {
    extern __shared__ __attribute__((aligned(16))) unsigned char lds[];
    Frame F;
    F.lds = (LAS unsigned char*)lds; F.ldsg = lds;
    F.MISC = (volatile LAS unsigned*)(F.lds + MISC_OFF);
    F.tid = threadIdx.x; F.lane = F.tid & 63; F.wave = __builtin_amdgcn_readfirstlane(F.tid >> 6);
    F.G = gridDim.x; { const int bx = blockIdx.x; F.vcu = (F.G % 8 == 0) ? (bx % 8) * (F.G / 8) + bx / 8 : bx; }
    F.ap = (ArgsP)__builtin_amdgcn_kernarg_segment_ptr();
    F.ws = (GAS unsigned char*)args.ws; F.out = (GAS float*)args.out; F.ctl = (gu32*)(F.ws + WS_CTL);
    for (int u = F.tid; u < (LDS_BYTES - MISC_OFF) / 4; u += 512) ((LAS unsigned*)(F.lds + MISC_OFF))[u] = 0u;
    __syncthreads();
    XcdBarrier bar = xcd_barrier_post((unsigned*)(F.ctl + CW_BAR), F.MISC + 8);
#if STAMP >= 20
    if (F.tid == 0) F.MISC[17] = (unsigned)__builtin_amdgcn_s_memrealtime();
#endif
    const int lo = args.ph_lo, hi = args.ph_hi;
#define IN(k) (lo <= (k) && (k) < hi)
#if STAMP >= 6
#define SEAMC(k, cat) do { if (IN(k) && IN((k) + 1)) { const unsigned long long tb0_ = __builtin_amdgcn_s_memrealtime(); xcd_barrier(bar); const unsigned long long tb1_ = __builtin_amdgcn_s_memrealtime(); \
        if (F.tid == 0) { if (STAMP >= 20) { F.MISC[16] += (seam_sel(cat) && (STAMP != 50 || (((k) & 8) != 0))) ? (unsigned)tb1_ - F.MISC[17] : 0u; F.MISC[17] = (unsigned)tb1_; } else F.MISC[16] += seam_sel(cat) ? (unsigned)(tb1_ - tb0_) : 0u; } } } while (0)
#else
#define SEAMC(k, cat) do { if (IN(k) && IN((k) + 1)) xcd_barrier(bar); } while (0)
#endif
    if (IN(0) && (PHM & 1)) { Frame L = site(F); p0_modvec(L); __syncthreads(); p0_tables(L); p0_copy_ctx(L); p0_fold(L); __syncthreads(); p0_weights(L); __syncthreads(); }
    SEAMC(0, 8);
    for (int li = 0; li < DEPTH; ++li) {
        const int pb = 1 + 8 * li, lj = li >> 1; const bool even = (li & 1) == 0;
        if (IN(pb + 0) && (PHM & 2)) { Frame L = site(F); const float* rg = (const float*)(WSP(L) + WS_MODV) + (size_t)((li - 1) * 3 + 2) * 12288 + 5 * DM;
            if (li == 0) norm_phase<true>(L, li, 0, INP(L, 0), (float*)(WSP(L) + WS_HC), 0, rg); else norm_phase<false>(L, li, 0, WSP(L) + WS_HB, (float*)(WSP(L) + WS_HC), 11, rg);
            if (DUP & 32) { if (li == 0) norm_phase<true>(L, li, 0, INP(L, 0), (float*)(WSP(L) + WS_HC), 0, nullptr); else norm_phase<false>(L, li, 0, WSP(L) + WS_HB, (float*)(WSP(L) + WS_HC), 0, nullptr); } }
        SEAMC(pb + 0, 0);
        if (IN(pb + 1) && (PHM & 4)) { Frame L = site(F);
            const int N = even ? EVN : ODN;
            const bf16* Bt = even ? (const bf16*)(WSP(L) + WS_WIN_E + (size_t)lj * SZ_WIN_E) : (const bf16*)(WSP(L) + WS_WIN_O + (size_t)lj * SZ_WIN_O);
            pg8::Gemm g{(const bf16*)(WSP(L) + WS_A), Bt, MT, N, DM}; pg8::StaticOrder S; S.init(MT, N, L.G, (int)blockIdx.x);
            if (even) {
                pg8::EpiEvenIn E{(bf16*)(WSP(L) + WS_P), (bf16*)(WSP(L) + WS_QR), N, INP(L, 11) + (size_t)lj * 128, (const float*)(WSP(L) + WS_ROPE), (LAS float*)(L.lds + pg8::STAGE_BYTES), (bf16*)(WSP(L) + WS_FT)};
                pg8::gemm_phase<pg8::EpiEvenIn, pg8::StaticOrder, PG8_ALIGN, PG8_SP2>(L.lds, g, S, E);
            } else {
            pg8::EpiOddIn E{(bf16*)(WSP(L) + WS_P), N, INP(L, 16) + (size_t)lj * 256, (LAS float*)(L.lds + pg8::STAGE_BYTES)};
            pg8::gemm_phase<pg8::EpiOddIn, pg8::StaticOrder, PG8_ALIGN, PG8_SP2>(L.lds, g, S, E);
            }
            wq_tail(L, 2 * li, (MT / 256) * (N / 256));
        }
        SEAMC(pb + 1, 1);
        if (IN(pb + 3)) { Frame L = site(F); if (even) { if (PHM & 32) mixer_even(L, lj); } else {
#if STAMP == 13 || STAMP == 14
            if (F.tid == 0) F.MISC[18] = (unsigned)__builtin_amdgcn_s_memrealtime();
#endif
            if (PHM & 16) prep_odd(L, lj);
#if STAMP == 14
            if (F.tid == 0) F.MISC[16] += (unsigned)__builtin_amdgcn_s_memrealtime() - F.MISC[18];
#endif
#if STAMP == 13
            if (F.tid == 0) F.MISC[18] = (unsigned)__builtin_amdgcn_s_memrealtime();
#endif
            if (PHM & 64) mixer_odd(L, lj, li != DEPTH - 1);
#if STAMP == 13
            if (F.tid == 0) F.MISC[16] += (unsigned)__builtin_amdgcn_s_memrealtime() - F.MISC[18];
#endif
            } }
        SEAMC(pb + 3, 3);
        if (IN(pb + 4) && (PHM & 128)) { Frame L = site(F);
            const bf16* Bt = even ? (const bf16*)(WSP(L) + WS_WOUT_E + (size_t)lj * SZ_WOUT) : (const bf16*)(WSP(L) + WS_WOUT_O + (size_t)lj * SZ_WOUT);
            const float* modl = (const float*)(WSP(L) + WS_MODV) + (size_t)li * 3 * 12288;
            pg8::Gemm g{(const bf16*)(WSP(L) + WS_MIX), Bt, MT, DM, DM}; pg8::SplitOrder<8> S; S.init(ML, DM, DM, L.G, (int)blockIdx.x, li != 3);
            if (li == 0) {
                pg8::EpiGate<true> E{(const void*)INP(L, 0), (void*)(WSP(L) + WS_HB), (float*)(WSP(L) + WS_SLAB), modl + 2 * DM, 0};
                pg8::gemm_phase<pg8::EpiGate<true>, pg8::SplitOrder<8>, PG8_ALIGN, PG8_SP2>(L.lds, g, S, E);
            } else {
                pg8::EpiGate<false> E{(const void*)(WSP(L) + WS_HB), (void*)(WSP(L) + WS_HB), (float*)(WSP(L) + WS_SLAB), modl + 2 * DM, 0};
                pg8::gemm_phase<pg8::EpiGate<false>, pg8::SplitOrder<8>, PG8_ALIGN, PG8_SP2>(L.lds, g, S, E);
            }
        }
        SEAMC(pb + 4, 4);
        if (IN(pb + 5) && (PHM & 2)) { Frame L = site(F); norm_phase<false>(L, li, 1, WSP(L) + WS_HB, (float*)(WSP(L) + WS_HC), li == 3 ? 0 : 8, (const float*)(WSP(L) + WS_MODV) + (size_t)(li * 3 + 2) * 12288 + 2 * DM); if (DUP & 32) norm_phase<false>(L, li, 1, WSP(L) + WS_HB, (float*)(WSP(L) + WS_HC), 0, nullptr); }
        SEAMC(pb + 5, 5);
        if (IN(pb + 6) && (PHM & 256)) { Frame L = site(F);
            const int Mr = li == 3 ? ML : MT;
            pg8::Gemm g{(const bf16*)(WSP(L) + WS_A), (const bf16*)(WSP(L) + WS_WFI + (size_t)li * SZ_WFI), Mr, 2 * FH, DM}; pg8::StaticOrder S; S.init(Mr, 2 * FH, L.G, (int)blockIdx.x);
            pg8::EpiSwiglu E{(bf16*)(WSP(L) + WS_HID), FH};
            for (int rep = 0; rep < ((DUP & 4) ? 2 : 1); ++rep)
            pg8::gemm_phase<pg8::EpiSwiglu, pg8::StaticOrder, PG8_ALIGN, PG8_SP2>(L.lds, g, S, E);
            if (li < 3) wq_tail(L, 2 * li + 1, (Mr / 256) * (2 * FH / 256));
        }
        SEAMC(pb + 6, 6);
        if (IN(pb + 7) && (PHM & 512)) { Frame L = site(F);
            const float* modl = (const float*)(WSP(L) + WS_MODV) + (size_t)li * 3 * 12288;
            pg8::Gemm g{(const bf16*)(WSP(L) + WS_HID), (const bf16*)(WSP(L) + WS_WFO + (size_t)li * SZ_WFO), MT, DM, FH}; pg8::SplitOrder<11> S; S.init(ML, DM, FH, L.G, (int)blockIdx.x, li != 3);
            pg8::EpiGate<false> E{(const void*)(WSP(L) + WS_HB), li == 3 ? (void*)OUTP(L) : (void*)(WSP(L) + WS_HB), (float*)(WSP(L) + WS_SLAB), modl + 5 * DM, li == 3 ? 1 : 0};
            pg8::gemm_phase<pg8::EpiGate<false>, pg8::SplitOrder<11>, PG8_ALIGN, PG8_SP2>(L.lds, g, S, E);
        }
        SEAMC(pb + 7, 7);
    }
#if STAMP >= 6
    if (STAMP >= 20 && F.tid == 0) { if (seam_sel(7)) F.MISC[16] += (unsigned)__builtin_amdgcn_s_memrealtime() - F.MISC[17]; if (blockIdx.x != 0) F.MISC[16] = 0u; else F.MISC[16] *= F.G; }
    if (F.tid == 0) __hip_atomic_fetch_add((GAS unsigned*)(F.ctl + 2048), (unsigned)F.MISC[16], RLX_AGENT);
    __syncthreads(); xcd_barrier(bar);
    if (blockIdx.x == 0 && F.wave == 0) {
        const unsigned v = __hip_atomic_load((GAS unsigned*)(F.ctl + 2048), RLX_AGENT);
        const unsigned long long ticks = (unsigned long long)v / F.G;
        const unsigned long long t0 = __builtin_amdgcn_s_memrealtime();
        while (__builtin_amdgcn_s_memrealtime() - t0 < ticks) __builtin_amdgcn_s_sleep(64);
    }
#elif STAMP
    if (blockIdx.x == 0 && F.wave == 0) {
        const unsigned v = __hip_atomic_load((GAS unsigned*)(F.ws + WS_LAM + 1024), RLX_AGENT);
        const unsigned long long ticks = (STAMP == 1) ? (unsigned long long)v * 100ull : ((unsigned long long)v * 100ull) >> 10;
        const unsigned long long t0 = __builtin_amdgcn_s_memrealtime();
        while (__builtin_amdgcn_s_memrealtime() - t0 < ticks) __builtin_amdgcn_s_sleep(64);
    }
#endif
#undef IN
#undef SEAMC
}

extern "C" void kernel_launch(void* const* d_in, const int* in_sizes, int n_in, void* d_out, int out_size, void* d_ws, size_t ws_size, hipStream_t stream) {
    static int grid = 0;
    if (grid == 0) {
        if (n_in != 19 || in_sizes[0] != ML * DM || out_size != ML * DM || ws_size < WS_END) { fprintf(stderr, "kernel_launch: shape mismatch (n_in %d, in0 %d, out %d, ws %zu < %zu); nothing launched\n", n_in, n_in > 0 ? in_sizes[0] : -1, out_size, ws_size, (size_t)WS_END); grid = -1; return; }
        int dev = 0, cus = 0, per_cu = 0;
        if (hipGetDevice(&dev) != hipSuccess || hipDeviceGetAttribute(&cus, hipDeviceAttributeMultiprocessorCount, dev) != hipSuccess) { fprintf(stderr, "kernel_launch: device query failed\n"); grid = -1; return; }
        if (hipFuncSetAttribute((const void*)mk_fwd, hipFuncAttributeMaxDynamicSharedMemorySize, LDS_BYTES) != hipSuccess) { fprintf(stderr, "kernel_launch: hipFuncSetAttribute failed\n"); grid = -1; return; }
        if (hipOccupancyMaxActiveBlocksPerMultiprocessor(&per_cu, (const void*)mk_fwd, 512, LDS_BYTES) != hipSuccess || per_cu < 1) fprintf(stderr, "kernel_launch: note: occupancy query reports %d workgroups per CU\n", per_cu);
        (void)hipGetLastError();
        grid = cus;
    }
    if (grid < 0) return;
    if (hipMemsetAsync((char*)d_ws + WS_CTL, 0, CTL_ZERO_BYTES, stream) != hipSuccess) { fprintf(stderr, "kernel_launch: memset failed\n"); return; }
    Args a{};
    for (int i = 0; i < 19; ++i) a.in[i] = (const float*)d_in[i];
    a.out = (float*)d_out; a.ws = (unsigned char*)d_ws;
    constexpr int NL = MK_N_LAUNCHES;
    for (int l = 0; l < NL; ++l) {
        a.ph_lo = (NL == 1) ? 0 : l; a.ph_hi = (NL == 1) ? NPH : l + 1;
        hipLaunchKernelGGL(mk_fwd, dim3(grid), dim3(512), LDS_BYTES, stream, a);
        const hipError_t le = hipPeekAtLastError();
        if (le != hipSuccess) { fprintf(stderr, "kernel_launch: launch %d failed: %s\n", l, hipGetErrorName(le)); break; }
    }
}
```

```cpp
#include <hip/hip_runtime.h>
#include <cstdio>
#include <cstdint>
#include <cstddef>
#ifndef DUP
#define DUP 0
#endif

#ifndef STAMP
#define STAMP 0
#endif
#ifndef STAMP_LJ
#define STAMP_LJ 0
#endif
namespace pg8 {
#define PG8_LAS __attribute__((address_space(3)))
typedef unsigned short bf16_t;
typedef short bf16x8 __attribute__((ext_vector_type(8)));
typedef float f32x4 __attribute__((ext_vector_type(4)));
typedef unsigned u32x4 __attribute__((ext_vector_type(4)));
constexpr int BM = 256, BK = 64, HALF = 128, HTB = HALF * BK * 2  , STAGE_BYTES = 8 * HTB, NXCD = 8, WGM = 8;

__host__ __device__ __forceinline__ int lds_byte(int r, int c) { const int st = (r >> 4) * 2 + (c >> 5), rr = r & 15, cc = c & 31, ob = rr * 64 + cc * 2; return st * 1024 + (ob ^ (((ob >> 9) & 1) << 5)); }
__host__ __device__ __forceinline__ void stage_rc(int b, int& R, int& C) { const int st = b / 1024, sb = b % 1024, swz = sb ^ (((sb >> 9) & 1) << 5); R = (st >> 1) * 16 + swz / 64; C = (st & 1) * 32 + (swz % 64) / 2; }
__host__ __device__ __forceinline__ int perm32(int rho) { const int n = rho >> 4, i = rho & 15; return 8 * (i >> 2) + 4 * n + (i & 3); }

struct Unit { int pm, pn; int kb, nt; };
struct Gemm { const bf16_t* A; const bf16_t* Bt; int M, N, K; };

struct StaticOrder {
    int nM, nN, nwg, G, c;
    __host__ __device__ void init(int M, int N, int G_, int c_) { nM = M / BM; nN = N / BM; nwg = nM * nN; G = G_; c = c_; }
    __host__ __device__ bool next(int i, Unit& u) const {
        const long L = (long)i * G + c; if (L >= nwg) return false;
        int wgid = (int)L; { const int q = nwg / NXCD, r = nwg % NXCD, xcd = wgid % NXCD, off = wgid / NXCD; wgid = (xcd < r ? xcd * (q + 1) : r * (q + 1) + (xcd - r) * q) + off; }
        const int nig = WGM * nN, gid = wgid / nig, fm = gid * WGM, gsz = (nM - fm) < WGM ? (nM - fm) : WGM;
        u.pm = fm + ((wgid % nig) % gsz); u.pn = (wgid % nig) / gsz; return true;
    }
    static constexpr bool SPLITK = false;
    __device__ __forceinline__ void a_ready(const Unit&) const {}
    __device__ __forceinline__ void done(const Unit&) const {}
};

__device__ __forceinline__ unsigned cvt_pk_bf16(float lo, float hi) { unsigned r; asm volatile("v_cvt_pk_bf16_f32 %0, %1, %2" : "=v"(r) : "v"(lo), "v"(hi)); return r; }
typedef float f32x2 __attribute__((ext_vector_type(2)));
__device__ __forceinline__ f32x2 gelu_pk(f32x2 v) {
    const f32x2 av = __builtin_elementwise_abs(v), d = av * 0.2316418882f + 1.0f;
    f32x2 t; t.x = __builtin_amdgcn_rcpf(d.x); t.y = __builtin_amdgcn_rcpf(d.y);
    f32x2 q = t * 0.5307027145f + (-0.7265760135f); q = q * t + 0.7107068705f; q = q * t + (-0.142248368f); q = q * t + 0.127414796f; q = q * t;
    const f32x2 s = (v * v) * (-0.72134752044f);
    f32x2 e; e.x = __builtin_amdgcn_exp2f(s.x); e.y = __builtin_amdgcn_exp2f(s.y);
    const f32x2 m = v * (q * e), r = v - m;
    f32x2 o; o.x = v.x < 0.f ? m.x : r.x; o.y = v.y < 0.f ? m.y : r.y; return o;
}

template <int ACT  > struct EpiBf16 {
    static constexpr bool PERM = true, AFTER_DRAIN = false; static_assert(ACT == 0 || ACT == 1, "EpiBf16: ACT is 0 (none) or 1 (gelu_pk)");
    bf16_t* O; int ldc; const float* bias; int split_cols; size_t split_stride; float scale0;
    __device__ __forceinline__ void operator()(const f32x4 (&acc)[2][2][4][2], const Unit& u, int wr, int wc, int fr, int fq) const {
        const int row0 = u.pm * BM + wr * 64 + fr; int colt = u.pn * BM; bf16_t* base = O;
        float sc = 1.f; if (split_cols) { const int t = colt / split_cols; base += (size_t)t * split_stride; colt -= t * split_cols; if (t == 0) sc = scale0; }
        const int col0 = colt + wc * 32 + 8 * fq, bcol0 = u.pn * BM + wc * 32 + 8 * fq;
        f32x4 bv[2][2];
#pragma unroll
        for (int bj = 0; bj < 2; ++bj)
#pragma unroll
            for (int n = 0; n < 2; ++n) bv[bj][n] = bias ? *(const f32x4*)(bias + bcol0 + bj * HALF + 4 * n) : (f32x4){0.f, 0.f, 0.f, 0.f};
#pragma unroll
        for (int ai = 0; ai < 2; ++ai)
#pragma unroll
            for (int m = 0; m < 4; ++m) { bf16_t* rowp = base + (size_t)(row0 + ai * HALF + m * 16) * ldc + col0;
#pragma unroll
                for (int bj = 0; bj < 2; ++bj) { f32x4 v0 = acc[ai][bj][m][0] + bv[bj][0], v1 = acc[ai][bj][m][1] + bv[bj][1];
                    if (ACT == 1) { f32x2 a = gelu_pk((f32x2){v0[0], v0[1]}), b = gelu_pk((f32x2){v0[2], v0[3]}), c = gelu_pk((f32x2){v1[0], v1[1]}), d = gelu_pk((f32x2){v1[2], v1[3]});
                        v0 = (f32x4){a.x, a.y, b.x, b.y}; v1 = (f32x4){c.x, c.y, d.x, d.y}; }
                    v0 = v0 * sc; v1 = v1 * sc; u32x4 w; w.x = cvt_pk_bf16(v0[0], v0[1]); w.y = cvt_pk_bf16(v0[2], v0[3]); w.z = cvt_pk_bf16(v1[0], v1[1]); w.w = cvt_pk_bf16(v1[2], v1[3]);
                    *(u32x4*)(rowp + bj * HALF) = w; } }
    }
};

template <bool BASE_F32> struct EpiGate {
    static constexpr bool PERM = true, AFTER_DRAIN = false;
    const void* base_l; void* out_l; float* slab; const float* gate; int out_f32;
    __device__ __forceinline__ void operator()(const f32x4 (&acc)[2][2][4][2], const Unit& u, int wr, int wc, int fr, int fq) const {
        const bool isc = u.pm >= 64; const int grp = u.pm < 32 ? 0 : (u.pm < 64 ? 1 : 2);
        const int rowt = (isc ? (u.pm - 64) : u.pm) * BM + wr * 64 + fr;
        const int col0 = u.pn * BM + wc * 32 + 8 * fq;
        if (isc) {
            const int kc = u.kb / (u.nt * BK * 2); float* sp = slab + (size_t)kc * (512 * 2048);
#pragma unroll
            for (int ai = 0; ai < 2; ++ai)
#pragma unroll
                for (int m = 0; m < 4; ++m) { const size_t off = (size_t)(rowt + ai * HALF + m * 16) * 2048 + col0;
#pragma unroll
                    for (int bj = 0; bj < 2; ++bj)
#pragma unroll
                        for (int n = 0; n < 2; ++n) *(f32x4*)(sp + off + bj * HALF + n * 4) = acc[ai][bj][m][n]; }
            return; }
        f32x4 gv[2][2];
#pragma unroll
        for (int bj = 0; bj < 2; ++bj)
#pragma unroll
            for (int n = 0; n < 2; ++n) gv[bj][n] = *(const f32x4*)(gate + grp * 12288 + col0 + bj * HALF + n * 4);
        u32x4 pball[2][4][2];
        if constexpr (!BASE_F32) {
            const unsigned long long bpu = (unsigned long long)base_l;
            const void* bps = (const void*)(((unsigned long long)(unsigned)__builtin_amdgcn_readfirstlane((int)(bpu >> 32)) << 32) | (unsigned)__builtin_amdgcn_readfirstlane((int)bpu));
            const __amdgpu_buffer_rsrc_t rs = __builtin_amdgcn_make_buffer_rsrc((void*)bps, 0, 0x7fffffff, 0x00020000);
            const int voff = ((wr * 64 + fr) * 2048 + wc * 32 + 8 * fq) * 2;
            const int sb = __builtin_amdgcn_readfirstlane((u.pm * BM * 2048 + u.pn * BM) * 2);
#pragma unroll
            for (int ai = 0; ai < 2; ++ai)
#pragma unroll
                for (int m = 0; m < 4; ++m)
#pragma unroll
                    for (int bj = 0; bj < 2; ++bj) pball[ai][m][bj] = __builtin_bit_cast(u32x4, __builtin_amdgcn_raw_buffer_load_b128(rs, voff, sb + ((ai * HALF + m * 16) * 2048 + bj * HALF) * 2, 0));
            asm volatile("" ::: "memory");
        }
#pragma unroll
        for (int ai = 0; ai < 2; ++ai) {
            f32x4 pre[4][2][2]; u32x4 pb[4][2];
            if constexpr (BASE_F32) { const float* bp = (const float*)base_l;
#pragma unroll
                for (int m = 0; m < 4; ++m) { const size_t off = (size_t)(rowt + ai * HALF + m * 16) * 2048 + col0;
#pragma unroll
                    for (int bj = 0; bj < 2; ++bj)
#pragma unroll
                        for (int n = 0; n < 2; ++n) pre[m][bj][n] = *(const f32x4*)(bp + off + bj * HALF + n * 4); }
            } else {
#pragma unroll
                for (int m = 0; m < 4; ++m)
#pragma unroll
                    for (int bj = 0; bj < 2; ++bj) pb[m][bj] = pball[ai][m][bj];
            }
            asm volatile("" ::: "memory");
#pragma unroll
            for (int m = 0; m < 4; ++m) { const size_t off = (size_t)(rowt + ai * HALF + m * 16) * 2048 + col0;
#pragma unroll
                for (int bj = 0; bj < 2; ++bj) { f32x4 x0, x1;
                    if constexpr (BASE_F32) { x0 = pre[m][bj][0]; x1 = pre[m][bj][1]; }
                    else { const u32x4 w = pb[m][bj];
                        x0 = f32x4{__uint_as_float(w.x << 16), __uint_as_float(w.x & 0xffff0000u), __uint_as_float(w.y << 16), __uint_as_float(w.y & 0xffff0000u)};
                        x1 = f32x4{__uint_as_float(w.z << 16), __uint_as_float(w.z & 0xffff0000u), __uint_as_float(w.w << 16), __uint_as_float(w.w & 0xffff0000u)}; }
                    const f32x4 a = x0 + gv[bj][0] * acc[ai][bj][m][0], b = x1 + gv[bj][1] * acc[ai][bj][m][1];
                    if (out_f32) { float* op = (float*)out_l + off + bj * HALF; *(f32x4*)op = a; *(f32x4*)(op + 4) = b; }
                    else { u32x4 w; w.x = cvt_pk_bf16(a.x, a.y); w.y = cvt_pk_bf16(a.z, a.w); w.z = cvt_pk_bf16(b.x, b.y); w.w = cvt_pk_bf16(b.z, b.w);
                        *(u32x4*)((bf16_t*)out_l + off + bj * HALF) = w; } } }
            asm volatile("" ::: "memory");
        }
    }
};
template <int KS> struct SplitOrder {
    static constexpr bool SPLITK = true;
    StaticOrder so; int G, c, ntc, ntf, nctx;
    __device__ void init(int Mlat, int N, int K, int G_, int c_, bool with_ctx) { so.init(Mlat, N, G_, c_); G = G_; c = c_; ntf = K / BK; ntc = ntf / KS; nctx = with_ctx ? 16 * KS : 0; }
    __device__ bool next(int i, Unit& u) const {
        const long L = (long)i * G + c;
        if (L < so.nwg) { so.next(i, u); u.kb = 0; u.nt = ntf; return true; }
        const int x = (int)(L - so.nwg); if (x >= nctx) return false;
        const int kc = x % KS, tile = x / KS; u.pn = tile & 7; u.pm = so.nM + (tile >> 3); u.kb = kc * ntc * BK * 2; u.nt = ntc; return true;
    }
    __device__ __forceinline__ void a_ready(const Unit&) const {}
    __device__ __forceinline__ void done(const Unit&) const {}
};
struct EpiEvenIn {
    static constexpr bool PERM = true, AFTER_DRAIN = false;
    bf16_t* P; bf16_t* QR; int ldc; const float* gains; const float* rope; PG8_LAS float* part; bf16_t* FT;
    __device__ __forceinline__ void operator()(const f32x4 (&acc)[2][2][4][2], const Unit& u, int wr, int wc, int fr, int fq) const {
        const int row0 = u.pm * BM + wr * 64 + fr; const int col0 = u.pn * BM + wc * 32 + 8 * fq;
        if (u.pn >= 18 && u.pm < 64) {
            const int cp0 = (col0 - 4608) >> 2;
#pragma unroll
            for (int ai = 0; ai < 2; ++ai)
#pragma unroll
                for (int m = 0; m < 4; ++m) { const int row = row0 + ai * HALF + m * 16; const int b = row >> 13, t = row & 8191;
#pragma unroll
                    for (int bj = 0; bj < 2; ++bj) { const f32x4 v0 = acc[ai][bj][m][0], v1 = acc[ai][bj][m][1];
                        bf16_t* fp = FT + ((size_t)(b * 256 + cp0 + 32 * bj) * 8192 + t) * 4;
                        typedef unsigned u32x2_ __attribute__((ext_vector_type(2)));
                        u32x2_ wa, wb; wa.x = cvt_pk_bf16(v0[0], v0[1]); wa.y = cvt_pk_bf16(v0[2], v0[3]); wb.x = cvt_pk_bf16(v1[0], v1[1]); wb.y = cvt_pk_bf16(v1[2], v1[3]);
                        *(u32x2_*)fp = wa; *(u32x2_*)(fp + 8192 * 4) = wb; } }
            return; }
        if (u.pn >= 12) {
#pragma unroll
            for (int ai = 0; ai < 2; ++ai)
#pragma unroll
                for (int m = 0; m < 4; ++m) { bf16_t* rowp = P + (size_t)(row0 + ai * HALF + m * 16) * ldc + col0;
#pragma unroll
                    for (int bj = 0; bj < 2; ++bj) { const f32x4 v0 = acc[ai][bj][m][0], v1 = acc[ai][bj][m][1];
                        u32x4 w; w.x = cvt_pk_bf16(v0[0], v0[1]); w.y = cvt_pk_bf16(v0[2], v0[3]); w.z = cvt_pk_bf16(v1[0], v1[1]); w.w = cvt_pk_bf16(v1[2], v1[3]);
                        *(u32x4*)(rowp + bj * HALF) = w; } }
            return; }
        const bool isq = u.pn < 6, lat = u.pm < 64;
        int rb_ = wr * 64 + fr; asm volatile("" : "+v"(rb_));
#pragma unroll
        for (int ai = 0; ai < 2; ++ai)
#pragma unroll
            for (int m = 0; m < 4; ++m)
#pragma unroll
                for (int bj = 0; bj < 2; ++bj) { const f32x4 a = acc[ai][bj][m][0], b = acc[ai][bj][m][1];
                    float s = (a[0] * a[0] + a[1] * a[1]) + (a[2] * a[2] + a[3] * a[3]) + (b[0] * b[0] + b[1] * b[1]) + (b[2] * b[2] + b[3] * b[3]);
                    s += __shfl_xor(s, 16); s += __shfl_xor(s, 32);
                    if (fq == 0) part[((ai * HALF + m * 16 + rb_) * 2 + bj) * 4 + wc] = s; }
        asm volatile("s_waitcnt lgkmcnt(0)" ::: "memory"); __builtin_amdgcn_s_barrier(); asm volatile("" ::: "memory");
        const float* gp = gains + (isq ? 0 : 64) + 32 * (wc & 1) + 8 * fq; const float qs = isq ? 0.18033688011112042f : 1.0f;
        float gn[8];
#pragma unroll
        for (int e = 0; e < 8; ++e) gn[e] = gp[e] * qs;
#pragma unroll
        for (int ai = 0; ai < 2; ++ai)
#pragma unroll
            for (int m = 0; m < 4; ++m) { const int rl = ai * HALF + m * 16 + rb_; const int row = u.pm * BM + rl;
                f32x4 cs0 = {1.f, 0.f, 1.f, 0.f}, cs1 = cs0, cs2 = cs0, cs3 = cs0;
                if (lat) { const int t = row & 8191; const int pos = (wc & 1) ? (t & 63) : (t >> 6); const float* rp = rope + (size_t)(pos * 16 + 8 * (fq & 1)) * 2;
                    cs0 = *(const f32x4*)rp; cs1 = *(const f32x4*)(rp + 4); cs2 = *(const f32x4*)(rp + 8); cs3 = *(const f32x4*)(rp + 12); }
                const float c8[8] = {cs0[0], cs0[2], cs1[0], cs1[2], cs2[0], cs2[2], cs3[0], cs3[2]}, s8[8] = {cs0[1], cs0[3], cs1[1], cs1[3], cs2[1], cs2[3], cs3[1], cs3[3]};
#pragma unroll
                for (int bj = 0; bj < 2; ++bj) {
                    const float ss = part[(rl * 2 + bj) * 4 + wc] + part[(rl * 2 + bj) * 4 + (wc ^ 1)];
                    const float rstd = rsqrtf(ss * (1.0f / 64.0f) + 1e-6f);
                    float y[8], yr[8];
#pragma unroll
                    for (int e = 0; e < 8; ++e) y[e] = acc[ai][bj][m][e >> 2][e & 3] * rstd * gn[e];
#pragma unroll
                    for (int e = 0; e < 8; ++e) { const float yp = __shfl_xor(y[e], 32); yr[e] = (fq & 2) ? (y[e] * c8[e] + yp * s8[e]) : (y[e] * c8[e] - yp * s8[e]); }
                    u32x4 wn, wrot;
                    wn.x = cvt_pk_bf16(y[0], y[1]); wn.y = cvt_pk_bf16(y[2], y[3]); wn.z = cvt_pk_bf16(y[4], y[5]); wn.w = cvt_pk_bf16(y[6], y[7]);
                    wrot.x = cvt_pk_bf16(yr[0], yr[1]); wrot.y = cvt_pk_bf16(yr[2], yr[3]); wrot.z = cvt_pk_bf16(yr[4], yr[5]); wrot.w = cvt_pk_bf16(yr[6], yr[7]);
                    bf16_t* pp = P + (size_t)row * ldc + col0 + bj * HALF;
                    if (isq) { *(u32x4*)pp = wn; if (lat) *(u32x4*)(QR + (size_t)row * 1536 + col0 + bj * HALF) = wrot; }
                    else     { *(u32x4*)pp = lat ? wrot : wn; }
                }
                asm volatile("" ::: "memory"); }
    }
};
struct EpiOddIn {
    static constexpr bool PERM = true, AFTER_DRAIN = false;
    bf16_t* P; int ldc; const float* gains; PG8_LAS float* part;
    __device__ __forceinline__ void operator()(const f32x4 (&acc)[2][2][4][2], const Unit& u, int wr, int wc, int fr, int fq) const {
        const int row0 = u.pm * BM + wr * 64 + fr; const int col0 = u.pn * BM + wc * 32 + 8 * fq;
        const bool isqk = u.pn >= 12 && u.pn < 20;
        float rs[2][4][2];
        if (isqk) {
            int rb_ = wr * 64 + fr; asm volatile("" : "+v"(rb_));
#pragma unroll
            for (int ai = 0; ai < 2; ++ai)
#pragma unroll
                for (int m = 0; m < 4; ++m)
#pragma unroll
                    for (int bj = 0; bj < 2; ++bj) { const f32x4 a = acc[ai][bj][m][0], b = acc[ai][bj][m][1];
                        float s = (a[0] * a[0] + a[1] * a[1]) + (a[2] * a[2] + a[3] * a[3]) + (b[0] * b[0] + b[1] * b[1]) + (b[2] * b[2] + b[3] * b[3]);
                        s += __shfl_xor(s, 16); s += __shfl_xor(s, 32);
                        if (fq == 0) part[((ai * HALF + m * 16 + rb_) * 2 + bj) * 4 + wc] = s; }
            asm volatile("s_waitcnt lgkmcnt(0)" ::: "memory"); __builtin_amdgcn_s_barrier(); asm volatile("" ::: "memory");
#pragma unroll
            for (int ai = 0; ai < 2; ++ai)
#pragma unroll
                for (int m = 0; m < 4; ++m)
#pragma unroll
                    for (int bj = 0; bj < 2; ++bj) { const f32x4 t = *(const PG8_LAS f32x4*)(part + ((ai * HALF + m * 16 + rb_) * 2 + bj) * 4);
                        rs[ai][m][bj] = rsqrtf(((t[0] + t[1]) + (t[2] + t[3])) * (1.0f / 128.0f) + 1e-6f); }
        }
        float gn[8];
        { const float* gp = gains + (u.pn >= 16 ? 128 : 0) + 32 * wc + 8 * fq;
          const float qs = u.pn < 16 ? 0.12751743f : 1.0f;
#pragma unroll
          for (int e = 0; e < 8; ++e) gn[e] = isqk ? gp[e] * qs : 1.0f; }
#pragma unroll
        for (int ai = 0; ai < 2; ++ai)
#pragma unroll
            for (int m = 0; m < 4; ++m) { bf16_t* rowp = P + (size_t)(row0 + ai * HALF + m * 16) * ldc + col0;
#pragma unroll
                for (int bj = 0; bj < 2; ++bj) { const float r = isqk ? rs[ai][m][bj] : 1.0f; const f32x4 v0 = acc[ai][bj][m][0], v1 = acc[ai][bj][m][1];
                    u32x4 w; w.x = cvt_pk_bf16(v0[0] * r * gn[0], v0[1] * r * gn[1]); w.y = cvt_pk_bf16(v0[2] * r * gn[2], v0[3] * r * gn[3]);
                    w.z = cvt_pk_bf16(v1[0] * r * gn[4], v1[1] * r * gn[5]); w.w = cvt_pk_bf16(v1[2] * r * gn[6], v1[3] * r * gn[7]);
                    *(u32x4*)(rowp + bj * HALF) = w; } }
    }
};
struct EpiSwiglu {
    static constexpr bool PERM = true, AFTER_DRAIN = false;
    bf16_t* O; int ldc;
    __device__ __forceinline__ void operator()(const f32x4 (&acc)[2][2][4][2], const Unit& u, int wr, int wc, int fr, int fq) const {
        const int row0 = u.pm * BM + wr * 64 + fr; const int col0 = u.pn * HALF + wc * 32 + 8 * fq;
#pragma unroll
        for (int ai = 0; ai < 2; ++ai)
#pragma unroll
            for (int m = 0; m < 4; ++m) { bf16_t* rowp = O + (size_t)(row0 + ai * HALF + m * 16) * ldc + col0;
                float hv[8];
#pragma unroll
                for (int n = 0; n < 2; ++n)
#pragma unroll
                    for (int e = 0; e < 4; ++e) { const float g = acc[ai][0][m][n][e], up = acc[ai][1][m][n][e];
                        hv[n * 4 + e] = g * __builtin_amdgcn_rcpf(1.0f + __expf(-g)) * up; }
                u32x4 w; w.x = cvt_pk_bf16(hv[0], hv[1]); w.y = cvt_pk_bf16(hv[2], hv[3]); w.z = cvt_pk_bf16(hv[4], hv[5]); w.w = cvt_pk_bf16(hv[6], hv[7]);
                *(u32x4*)rowp = w; }
    }
};

template <class Epi, class Sched, bool ALIGN_EPI = false, bool SP2 = false>
__device__ __forceinline__ void gemm_phase(PG8_LAS unsigned char* lds, const Gemm g, const Sched& S, const Epi& E) {
    int tid_ = threadIdx.x; asm volatile("" : "+v"(tid_));
    const int tid = tid_, wid = __builtin_amdgcn_readfirstlane(tid >> 6), lane = tid & 63, wr = wid >> 2, wc = wid & 3, fr = lane & 15, fq = lane >> 4;
    const int K = g.K, ntf = K / BK;
    unsigned voffA[2], voffB[2];
#pragma unroll
    for (int i = 0; i < 2; ++i) { int R, C; stage_rc(tid * 16 + i * 8192, R, C); const int Rb = Epi::PERM ? ((R & ~31) + perm32(R & 31)) : R;
        voffA[i] = (unsigned)(R * K + C) * 2u; voffB[i] = (unsigned)(Rb * K + C) * 2u; }
    const size_t kstep = (size_t)(BK * 2);
    const size_t hstep = (size_t)HALF * K * 2;
    const size_t tstep = 2 * hstep;
    const unsigned ldsw = (unsigned)wid * 1024u;
    const int aoff = lds_byte(wr * 64 + fr, fq * 8), boff = lds_byte(wc * 32 + fr, fq * 8);
#define PG8_SA(b, h) (((b) * 2 + (h)) * HTB)
#define PG8_SB(b, h) ((4 + (b) * 2 + (h)) * HTB)
#define PG8_STAGE(bufoff, gbase, voff) do { _Pragma("unroll") for (int _i = 0; _i < 2; ++_i) \
        __builtin_amdgcn_global_load_lds((const unsigned*)((const char*)(gbase) + (voff)[_i]), (PG8_LAS unsigned*)(lds + (bufoff) + ldsw + _i * 8192), 16, 0, 0); } while (0)
#define PG8_LDA(dst, b, h) do { _Pragma("unroll") for (int m = 0; m < 4; ++m) _Pragma("unroll") for (int k = 0; k < 2; ++k) dst[m][k] = *(const PG8_LAS bf16x8*)(lds + PG8_SA(b, h) + aoff + m * 2048 + k * 1024); } while (0)
#define PG8_LDB(dst, b, h) do { _Pragma("unroll") for (int n = 0; n < 2; ++n) _Pragma("unroll") for (int k = 0; k < 2; ++k) dst[n][k] = *(const PG8_LAS bf16x8*)(lds + PG8_SB(b, h) + boff + n * 2048 + k * 1024); } while (0)
#define PG8_MMA(ai, bj, At, Bt) do { __builtin_amdgcn_s_setprio(1); _Pragma("unroll") for (int m = 0; m < 4; ++m) _Pragma("unroll") for (int n = 0; n < 2; ++n) _Pragma("unroll") for (int k = 0; k < 2; ++k) \
        acc[ai][bj][m][n] = __builtin_amdgcn_mfma_f32_16x16x32_bf16(Bt[n][k], At[m][k], acc[ai][bj][m][n], 0, 0, 0); __builtin_amdgcn_s_setprio(0); } while (0)
#define PG8_WAIT_V(n) asm volatile("s_waitcnt vmcnt(" #n ")" ::: "memory")
#define PG8_WAIT_L(n) asm volatile("s_waitcnt lgkmcnt(" #n ")" ::: "memory")
#define PG8_BAR __builtin_amdgcn_s_barrier()
#define PG8_SCHED __builtin_amdgcn_sched_barrier(0)
    Unit cur, nxt; int ui = 0;
    if (!S.next(0, cur)) return;
    f32x4 acc[2][2][4][2];
#pragma unroll
    for (int a = 0; a < 2; ++a)
#pragma unroll
        for (int b = 0; b < 2; ++b)
#pragma unroll
            for (int m = 0; m < 4; ++m)
#pragma unroll
                for (int n = 0; n < 2; ++n) acc[a][b][m][n] = (f32x4){0.f, 0.f, 0.f, 0.f};
    bf16x8 At[4][2], B0[2][2], B1[2][2];
    const char* cA = (const char*)g.A + (size_t)cur.pm * tstep + (Sched::SPLITK ? cur.kb : 0); const char* cB = (const char*)g.Bt + (size_t)cur.pn * tstep + (Sched::SPLITK ? cur.kb : 0);
    S.a_ready(cur);
    if constexpr (SP2) {
        PG8_STAGE(PG8_SB(0, 0), cB, voffB); PG8_STAGE(PG8_SB(0, 1), cB + hstep, voffB); PG8_STAGE(PG8_SA(0, 0), cA, voffA); PG8_STAGE(PG8_SA(0, 1), cA + hstep, voffA);
        if (wr == 1) PG8_BAR;
        PG8_WAIT_V(2); PG8_BAR;
        PG8_STAGE(PG8_SB(1, 0), cB + kstep, voffB); PG8_STAGE(PG8_SA(1, 0), cA + kstep, voffA); PG8_STAGE(PG8_SB(1, 1), cB + hstep + kstep, voffB);
        PG8_WAIT_V(6); PG8_BAR;
    } else {
        PG8_STAGE(PG8_SB(0, 0), cB, voffB); PG8_STAGE(PG8_SA(0, 0), cA, voffA); PG8_STAGE(PG8_SB(0, 1), cB + hstep, voffB); PG8_STAGE(PG8_SA(0, 1), cA + hstep, voffA);
        if (wr == 1) PG8_BAR;
        PG8_WAIT_V(4); PG8_BAR;
        PG8_STAGE(PG8_SB(1, 0), cB + kstep, voffB); PG8_STAGE(PG8_SA(1, 0), cA + kstep, voffA); PG8_STAGE(PG8_SB(1, 1), cB + hstep + kstep, voffB);
        PG8_WAIT_V(6); PG8_BAR;
    }
    for (;;) {
        const bool has_next = S.next(ui + 1, nxt);
        const char* nA = has_next ? (const char*)g.A + (size_t)nxt.pm * tstep + (Sched::SPLITK ? nxt.kb : 0) : cA; const char* nB = has_next ? (const char*)g.Bt + (size_t)nxt.pn * tstep + (Sched::SPLITK ? nxt.kb : 0) : cB;
        const int nt = Sched::SPLITK ? cur.nt : ntf;
        for (int t = 0; t < nt; t += 2) {
            const bool last = (t == nt - 2);
            const char* a1 = cA + (size_t)(t + 1) * kstep;
            const char* a2 = last ? nA : cA + (size_t)(t + 2) * kstep; const char* b2 = last ? nB : cB + (size_t)(t + 2) * kstep;
            const char* a3 = a2 + kstep; const char* b3 = b2 + kstep;
            if (last && has_next) S.a_ready(nxt);
            if constexpr (SP2) {
            PG8_LDB(B0, 0, 0); PG8_LDB(B1, 0, 1); PG8_SCHED; PG8_LDA(At, 0, 0); PG8_STAGE(PG8_SA(1, 1), a1 + hstep, voffA);
            PG8_WAIT_V(8); PG8_WAIT_L(0); PG8_BAR; PG8_MMA(0, 0, At, B0); PG8_MMA(0, 1, At, B1); PG8_BAR; PG8_SCHED;
            PG8_LDA(At, 0, 1); PG8_STAGE(PG8_SB(0, 0), b2, voffB); PG8_STAGE(PG8_SB(0, 1), b2 + hstep, voffB); PG8_STAGE(PG8_SA(0, 0), a2, voffA);
            PG8_WAIT_V(8); PG8_WAIT_L(0); PG8_BAR; PG8_MMA(1, 0, At, B0); PG8_MMA(1, 1, At, B1); PG8_BAR; PG8_SCHED;
            PG8_LDB(B0, 1, 0); PG8_LDB(B1, 1, 1); PG8_SCHED; PG8_LDA(At, 1, 0); PG8_STAGE(PG8_SA(0, 1), a2 + hstep, voffA);
            PG8_WAIT_V(8); PG8_WAIT_L(0); PG8_BAR; PG8_MMA(0, 0, At, B0); PG8_MMA(0, 1, At, B1); PG8_BAR; PG8_SCHED;
            PG8_LDA(At, 1, 1); PG8_STAGE(PG8_SB(1, 0), b3, voffB); PG8_STAGE(PG8_SB(1, 1), b3 + hstep, voffB); PG8_STAGE(PG8_SA(1, 0), a3, voffA);
            PG8_WAIT_V(8); PG8_WAIT_L(0); PG8_BAR; PG8_MMA(1, 0, At, B0); PG8_MMA(1, 1, At, B1); PG8_BAR; PG8_SCHED;
            } else {
            PG8_LDB(B0, 0, 0); PG8_SCHED; PG8_LDA(At, 0, 0); PG8_STAGE(PG8_SA(1, 1), a1 + hstep, voffA);
            PG8_WAIT_L(8); PG8_BAR; PG8_WAIT_L(0); PG8_MMA(0, 0, At, B0); PG8_BAR; PG8_SCHED;
            PG8_LDB(B1, 0, 1); PG8_STAGE(PG8_SB(0, 0), b2, voffB);
            PG8_BAR; PG8_WAIT_L(0); PG8_MMA(0, 1, At, B1); PG8_BAR;
            PG8_LDA(At, 0, 1); PG8_STAGE(PG8_SA(0, 0), a2, voffA);
            PG8_BAR; PG8_WAIT_L(0); PG8_MMA(1, 0, At, B0); PG8_BAR; PG8_SCHED;
            PG8_STAGE(PG8_SB(0, 1), b2 + hstep, voffB);
            PG8_WAIT_V(6); PG8_BAR; PG8_MMA(1, 1, At, B1); PG8_BAR;
            PG8_LDB(B0, 1, 0); PG8_SCHED; PG8_LDA(At, 1, 0); PG8_STAGE(PG8_SA(0, 1), a2 + hstep, voffA);
            PG8_WAIT_L(8); PG8_BAR; PG8_WAIT_L(0); PG8_MMA(0, 0, At, B0); PG8_BAR; PG8_SCHED;
            PG8_LDB(B1, 1, 1); PG8_STAGE(PG8_SB(1, 0), b3, voffB);
            PG8_BAR; PG8_WAIT_L(0); PG8_MMA(0, 1, At, B1); PG8_BAR;
            PG8_LDA(At, 1, 1); PG8_STAGE(PG8_SA(1, 0), a3, voffA);
            PG8_BAR; PG8_WAIT_L(0); PG8_MMA(1, 0, At, B0); PG8_BAR; PG8_SCHED;
            PG8_STAGE(PG8_SB(1, 1), b3 + hstep, voffB);
            PG8_WAIT_V(6); PG8_BAR; PG8_MMA(1, 1, At, B1); PG8_BAR;
            }
        }
        if constexpr (ALIGN_EPI) { if (wr == 0) PG8_BAR; }
        if constexpr (!Epi::AFTER_DRAIN) { E(acc, cur, wr, wc, fr, fq); S.done(cur); }
        if (!has_next) break;
#pragma unroll
        for (int a = 0; a < 2; ++a)
#pragma unroll
            for (int b = 0; b < 2; ++b)
#pragma unroll
                for (int m = 0; m < 4; ++m)
#pragma unroll
                    for (int n = 0; n < 2; ++n) acc[a][b][m][n] = (f32x4){0.f, 0.f, 0.f, 0.f};
        cur = nxt; cA = nA; cB = nB; ++ui;
        if constexpr (ALIGN_EPI) { if (wr == 1) PG8_BAR; }
    }
    PG8_WAIT_V(0);
    if constexpr (!ALIGN_EPI) { if (wr == 0) PG8_BAR; }
    PG8_BAR;
    if constexpr (Epi::AFTER_DRAIN) { E.fused(acc, cur, wr, wc, fr, fq, lds, wid, lane); S.done(cur); }
#undef PG8_SA
#undef PG8_SB
#undef PG8_STAGE
#undef PG8_LDA
#undef PG8_LDB
#undef PG8_MMA
#undef PG8_WAIT_V
#undef PG8_WAIT_L
#undef PG8_BAR
#undef PG8_SCHED
}
}

#ifndef PG8_SP2
#define PG8_SP2 true
#endif
#ifndef PG8_ALIGN
#define PG8_ALIGN true
#endif

namespace att {
using bf16 = unsigned short;
using bf16x8 = __attribute__((ext_vector_type(8))) short;
using s16x4  = __attribute__((ext_vector_type(4))) short;
using f32x16 = __attribute__((ext_vector_type(16))) float;
using u32x4  = __attribute__((ext_vector_type(4))) unsigned;
constexpr int NW = 8, QBLK = 32, KVBLK = 64, DV = 128;
constexpr float THR = 8.f;
constexpr int SHM_V = KVBLK * DV * 2;
constexpr int LDS_WS_OFF = 2 * SHM_V + 2 * (KVBLK * 128 * 2);
constexpr int LDS_BT_OFF = LDS_WS_OFF + NW * 64 * 4;
constexpr int LDS_Q_OFF = LDS_BT_OFF + 2048;
constexpr int LDS_END = LDS_Q_OFF + NW * 8192;
#define ATT_KSWZ128(row, colB) ((row) * 256 + ((colB) ^ (((row) & 7) << 4)))
#define ATT_KSWZ64(row, colB)  ((row) * 128 + ((colB) ^ ((((row) >> 1) & 7) << 4)))
#define ATT_SBAR() __builtin_amdgcn_sched_barrier(0)
__device__ __forceinline__ int crow(int r, int hi) { return (r & 3) + 8 * (r >> 2) + 4 * hi; }
__device__ __forceinline__ unsigned cvtpk(float lo, float hi) { unsigned r; asm volatile("v_cvt_pk_bf16_f32 %0, %1, %2" : "=v"(r) : "v"(lo), "v"(hi)); return r; }
__device__ __forceinline__ bf16x8 ld8(const bf16* p) { return *reinterpret_cast<const bf16x8*>(p); }

template <int DQK> __device__ __forceinline__ void partialSM(f32x16& p0, f32x16& p1, float& m_reg, float& mn, float& alpha) {
  constexpr float SCALE = (DQK == 64) ? 0.125f : 0.088388347648318440f;
  constexpr float C = SCALE * 1.4426950408889634f;
  float pmax = p0[0];
#pragma unroll
  for (int r = 1; r < 16; ++r) pmax = fmaxf(pmax, p0[r]);
#pragma unroll
  for (int r = 0; r < 16; ++r) pmax = fmaxf(pmax, p1[r]);
  { auto rr = __builtin_amdgcn_permlane32_swap(__float_as_uint(pmax), __float_as_uint(pmax), false, false);
    pmax = fmaxf(__uint_as_float(rr[0]), __uint_as_float(rr[1])); }
  if (__builtin_expect(__all(pmax - m_reg <= THR / SCALE), 1)) { mn = m_reg; alpha = 1.f; }
  else { mn = fmaxf(m_reg, pmax); alpha = __builtin_amdgcn_exp2f((m_reg - mn) * C); m_reg = mn; }
  float mnC = -mn * C;
#pragma unroll
  for (int r = 0; r < 16; ++r) p0[r] = fmaf(p0[r], C, mnC);
#pragma unroll
  for (int r = 0; r < 16; ++r) p1[r] = fmaf(p1[r], C, mnC);
#pragma unroll
  for (int r = 0; r < 16; ++r) p0[r] = __builtin_amdgcn_exp2f(p0[r]);
}
__device__ __forceinline__ void finishSM(f32x16& p0, f32x16& p1, float alpha, float& l_reg, bf16x8& pa0, bf16x8& pa1, bf16x8& pa2, bf16x8& pa3) {
#pragma unroll
  for (int r = 0; r < 16; ++r) p1[r] = __builtin_amdgcn_exp2f(p1[r]);
  float ps = 0;
#pragma unroll
  for (int r = 0; r < 16; ++r) ps += p0[r];
#pragma unroll
  for (int r = 0; r < 16; ++r) ps += p1[r];
  { auto rr = __builtin_amdgcn_permlane32_swap(__float_as_uint(ps), __float_as_uint(ps), false, false);
    ps = __uint_as_float(rr[0]) + __uint_as_float(rr[1]); }
  l_reg = l_reg * alpha + ps;
#define ATT_PK4(P, BASE, OUT) do { unsigned a0 = cvtpk(P[BASE + 0], P[BASE + 1]), a1 = cvtpk(P[BASE + 2], P[BASE + 3]);   \
    unsigned b0 = cvtpk(P[BASE + 4], P[BASE + 5]), b1 = cvtpk(P[BASE + 6], P[BASE + 7]);                              \
    auto r0 = __builtin_amdgcn_permlane32_swap(a0, b0, false, false); auto r1 = __builtin_amdgcn_permlane32_swap(a1, b1, false, false); \
    u32x4 w = {r0[0], r1[0], r0[1], r1[1]}; OUT = *reinterpret_cast<bf16x8*>(&w); } while (0)
  ATT_PK4(p0, 0, pa0); ATT_PK4(p0, 8, pa1); ATT_PK4(p1, 0, pa2); ATT_PK4(p1, 8, pa3);
#undef ATT_PK4
}
__device__ __forceinline__ void expSM(f32x16& p) {
#pragma unroll
  for (int r = 0; r < 16; ++r) p[r] = __builtin_amdgcn_exp2f(p[r]);
}
__device__ __forceinline__ void packSM(f32x16& p0, f32x16& p1, float& l_reg, bf16x8& pa0, bf16x8& pa1, bf16x8& pa2, bf16x8& pa3) {
  float ps = 0;
#pragma unroll
  for (int r = 0; r < 16; ++r) ps += p0[r];
#pragma unroll
  for (int r = 0; r < 16; ++r) ps += p1[r];
  l_reg += ps; asm volatile("" : "+v"(l_reg));
#define ATT_PK4(P, BASE, OUT) do { unsigned a0 = cvtpk(P[BASE + 0], P[BASE + 1]), a1 = cvtpk(P[BASE + 2], P[BASE + 3]);   \
    unsigned b0 = cvtpk(P[BASE + 4], P[BASE + 5]), b1 = cvtpk(P[BASE + 6], P[BASE + 7]);                              \
    auto r0 = __builtin_amdgcn_permlane32_swap(a0, b0, false, false); auto r1 = __builtin_amdgcn_permlane32_swap(a1, b1, false, false); \
    u32x4 w = {r0[0], r1[0], r0[1], r1[1]}; OUT = *reinterpret_cast<bf16x8*>(&w); } while (0)
  ATT_PK4(p0, 0, pa0); ATT_PK4(p0, 8, pa1); ATT_PK4(p1, 0, pa2); ATT_PK4(p1, 8, pa3);
#undef ATT_PK4
}
__device__ __forceinline__ void finishSM_nm(f32x16& p0, f32x16& p1, float& l_reg, bf16x8& pa0, bf16x8& pa1, bf16x8& pa2, bf16x8& pa3) {
#pragma unroll
  for (int r = 0; r < 16; ++r) p1[r] = __builtin_amdgcn_exp2f(p1[r]);
  float ps = 0;
#pragma unroll
  for (int r = 0; r < 16; ++r) ps += p0[r];
#pragma unroll
  for (int r = 0; r < 16; ++r) ps += p1[r];
  { auto rr = __builtin_amdgcn_permlane32_swap(__float_as_uint(ps), __float_as_uint(ps), false, false);
    ps = __uint_as_float(rr[0]) + __uint_as_float(rr[1]); }
  l_reg += ps;
#define ATT_PK4(P, BASE, OUT) do { unsigned a0 = cvtpk(P[BASE + 0], P[BASE + 1]), a1 = cvtpk(P[BASE + 2], P[BASE + 3]);   \
    unsigned b0 = cvtpk(P[BASE + 4], P[BASE + 5]), b1 = cvtpk(P[BASE + 6], P[BASE + 7]);                              \
    auto r0 = __builtin_amdgcn_permlane32_swap(a0, b0, false, false); auto r1 = __builtin_amdgcn_permlane32_swap(a1, b1, false, false); \
    u32x4 w = {r0[0], r1[0], r0[1], r1[1]}; OUT = *reinterpret_cast<bf16x8*>(&w); } while (0)
  ATT_PK4(p0, 0, pa0); ATT_PK4(p0, 8, pa1); ATT_PK4(p1, 0, pa2); ATT_PK4(p1, 8, pa3);
#undef ATT_PK4
}
__device__ __forceinline__ void finish_l(float l_reg, float* li_l, int r32, int hi, float (&rli)[16]) {
  { auto rr = __builtin_amdgcn_permlane32_swap(__float_as_uint(l_reg), __float_as_uint(l_reg), false, false); l_reg = __uint_as_float(rr[0]) + __uint_as_float(rr[1]); }
  if (hi == 0) li_l[r32] = l_reg; asm volatile("s_waitcnt lgkmcnt(0)" ::: "memory");
#pragma unroll
  for (int r = 0; r < 16; ++r) rli[r] = __builtin_amdgcn_rcpf(li_l[crow(r, hi)]);
}
template <int DQK, bool QLDS, int KW> __device__ __forceinline__ void qkt(f32x16& p0, f32x16& p1, const char* Ks, const bf16x8* qr, const char* Qs, int r32, int hi, int kcb) {
  p0 = f32x16{}; p1 = f32x16{};
#pragma unroll
  for (int d0 = 0; d0 < DQK / 16; ++d0) { const int cb = (d0 * 16 + hi * 8) * 2;
    bf16x8 b0, b1, qv;
    if constexpr (QLDS) qv = *reinterpret_cast<const bf16x8*>(Qs + ATT_KSWZ128(r32, cb)); else qv = qr[d0];
    if constexpr (KW == 128) { b0 = *reinterpret_cast<const bf16x8*>(Ks + ATT_KSWZ128(r32, kcb + cb)); b1 = *reinterpret_cast<const bf16x8*>(Ks + ATT_KSWZ128(32 + r32, kcb + cb)); }
    else                      { b0 = *reinterpret_cast<const bf16x8*>(Ks + ATT_KSWZ64(r32, cb));  b1 = *reinterpret_cast<const bf16x8*>(Ks + ATT_KSWZ64(32 + r32, cb)); }
    p0 = __builtin_amdgcn_mfma_f32_32x32x16_bf16(b0, qv, p0, 0, 0, 0);
    p1 = __builtin_amdgcn_mfma_f32_32x32x16_bf16(b1, qv, p1, 0, 0, 0); }
}
__device__ __forceinline__ int v_st(int k, int c) { const int kk = (k & ~0xC) | ((k & 4) << 1) | ((k & 8) >> 1); return ((kk >> 3) * 4 + (c >> 5)) * 512 + ((kk & 7) * 32 + (c & 31)) * 2; }
__device__ __forceinline__ int v_rd_base(int lane) { return ((lane & 3) << 3) | (((lane >> 2) & 3) << 6) | (((lane >> 4) & 1) << 5) | (((lane >> 5) & 1) << 8); }
constexpr int v_rd_off(int d0, int ks, int half) { return d0 * 512 + ks * 4096 + half * 2048; }
template <int OFF> __device__ __forceinline__ s16x4 tr_read(int vb) {
  s16x4 r; asm volatile("ds_read_b64_tr_b16 %0, %1 offset:%2" : "=&v"(r) : "v"(vb), "i"(OFF) : "memory"); return r;
}
template <int D0> __device__ __forceinline__ void pv_one(f32x16& od, int vb, bf16x8 pa0, bf16x8 pa1, bf16x8 pa2, bf16x8 pa3) {
  const s16x4 l0 = tr_read<v_rd_off(D0, 0, 0)>(vb), h0 = tr_read<v_rd_off(D0, 0, 1)>(vb), l1 = tr_read<v_rd_off(D0, 1, 0)>(vb), h1 = tr_read<v_rd_off(D0, 1, 1)>(vb);
  const s16x4 l2 = tr_read<v_rd_off(D0, 2, 0)>(vb), h2 = tr_read<v_rd_off(D0, 2, 1)>(vb), l3 = tr_read<v_rd_off(D0, 3, 0)>(vb), h3 = tr_read<v_rd_off(D0, 3, 1)>(vb);
  asm volatile("s_waitcnt lgkmcnt(0)" ::: "memory"); ATT_SBAR();
#define ATT_PK(L, H) (bf16x8){L[0], L[1], L[2], L[3], H[0], H[1], H[2], H[3]}
  od = __builtin_amdgcn_mfma_f32_32x32x16_bf16(pa0, ATT_PK(l0, h0), od, 0, 0, 0);
  od = __builtin_amdgcn_mfma_f32_32x32x16_bf16(pa1, ATT_PK(l1, h1), od, 0, 0, 0);
  od = __builtin_amdgcn_mfma_f32_32x32x16_bf16(pa2, ATT_PK(l2, h2), od, 0, 0, 0);
  od = __builtin_amdgcn_mfma_f32_32x32x16_bf16(pa3, ATT_PK(l3, h3), od, 0, 0, 0);
#undef ATT_PK
}
__device__ __forceinline__ void pv_d0(f32x16* o, int vb, bf16x8 pa0, bf16x8 pa1, bf16x8 pa2, bf16x8 pa3) {
  pv_one<0>(o[0], vb, pa0, pa1, pa2, pa3); pv_one<1>(o[1], vb, pa0, pa1, pa2, pa3); pv_one<2>(o[2], vb, pa0, pa1, pa2, pa3); pv_one<3>(o[3], vb, pa0, pa1, pa2, pa3);
}

#define ATT_TR8(D0, A) do { A##0 = tr_read<v_rd_off(D0, 0, 0)>(vb); A##1 = tr_read<v_rd_off(D0, 0, 1)>(vb); A##2 = tr_read<v_rd_off(D0, 1, 0)>(vb); A##3 = tr_read<v_rd_off(D0, 1, 1)>(vb); \
    A##4 = tr_read<v_rd_off(D0, 2, 0)>(vb); A##5 = tr_read<v_rd_off(D0, 2, 1)>(vb); A##6 = tr_read<v_rd_off(D0, 3, 0)>(vb); A##7 = tr_read<v_rd_off(D0, 3, 1)>(vb); } while (0)
#define ATT_PK2(L, H) (bf16x8){L[0], L[1], L[2], L[3], H[0], H[1], H[2], H[3]}
#define ATT_MM4(OD, A) do { OD = __builtin_amdgcn_mfma_f32_32x32x16_bf16(pa0, ATT_PK2(A##0, A##1), OD, 0, 0, 0); OD = __builtin_amdgcn_mfma_f32_32x32x16_bf16(pa1, ATT_PK2(A##2, A##3), OD, 0, 0, 0); \
    OD = __builtin_amdgcn_mfma_f32_32x32x16_bf16(pa2, ATT_PK2(A##4, A##5), OD, 0, 0, 0); OD = __builtin_amdgcn_mfma_f32_32x32x16_bf16(pa3, ATT_PK2(A##6, A##7), OD, 0, 0, 0); } while (0)
struct VFrag { s16x4 a0, a1, a2, a3, a4, a5, a6, a7, b0, b1, b2, b3, b4, b5, b6, b7; };
__device__ __forceinline__ void pv_issue(VFrag& f, int vb) { ATT_TR8(0, f.a); ATT_TR8(1, f.b); }
__device__ __forceinline__ void pv_pipe(VFrag& f, f32x16* o, int vb, bf16x8 pa0, bf16x8 pa1, bf16x8 pa2, bf16x8 pa3) {
  asm volatile("s_waitcnt lgkmcnt(0)" ::: "memory"); ATT_SBAR(); ATT_MM4(o[0], f.a);
  ATT_SBAR(); ATT_TR8(2, f.a); ATT_SBAR(); ATT_MM4(o[1], f.b);
  ATT_SBAR(); ATT_TR8(3, f.b);
  asm volatile("s_waitcnt lgkmcnt(8)" ::: "memory"); ATT_SBAR(); ATT_MM4(o[2], f.a);
  asm volatile("s_waitcnt lgkmcnt(0)" ::: "memory"); ATT_SBAR(); ATT_MM4(o[3], f.b);
}

struct NoMask { __device__ __forceinline__ void operator()(f32x16&, f32x16&, int) const {} __device__ __forceinline__ bool skip(int) const { return false; } };

template <int DQK, int LDQ, int LDQ2, int LDKV, int SDEPTH, bool DUAL, bool NOMAX, class TileRow, class Mask>
__device__ __forceinline__ void attn_core(const bf16* __restrict__ Qa, const bf16* __restrict__ Qalt, int nswitch,
                                          const bf16* __restrict__ Kb, const bf16* __restrict__ Vb,
                                          const TileRow& trow, const int NT, const Mask& mask, char* lds, f32x16 (&o)[4], float (&rli)[16]) {
  static_assert(!DUAL || DQK == 64, "DUAL is the differential-attention form");
  constexpr int KW = DUAL ? 128 : DQK;
  constexpr int SHM_K = KVBLK * KW * 2;
  constexpr int NQ = DQK / 16;
  int tid_ = threadIdx.x; asm volatile("" : "+v"(tid_));
  const int tid = tid_, wid = tid >> 6, lane = tid & 63, r32 = lane & 31, hi = lane >> 5;
  const int wq = DUAL ? (wid & 3) : wid, comp = DUAL ? (wid >> 2) : 0, kcb = comp * 128;
  char* V_lds = lds; char* K_lds = lds + 2 * SHM_V;
  float* wsf = (float*)(lds + LDS_WS_OFF) + wid * 64; float* li_l = wsf; float* al_l = wsf + 32;
  float m_reg = -1e30f, l_reg = 0;
#pragma unroll
  for (int d = 0; d < 4; ++d) o[d] = f32x16{};
  constexpr bool QLDS = (DQK == 128);
  char* Qs = lds + LDS_Q_OFF + wid * 8192;
  bf16x8 qr[NQ];
  { const bf16* Qw = Qa + (long)(wq * QBLK + r32) * LDQ + comp * 64 + hi * 8;
#pragma unroll
    for (int d0 = 0; d0 < NQ; ++d0) qr[d0] = ld8(Qw + d0 * 16);
    if constexpr (QLDS) {
#pragma unroll
      for (int d0 = 0; d0 < NQ; ++d0) *reinterpret_cast<bf16x8*>(Qs + ATT_KSWZ128(r32, (d0 * 16 + hi * 8) * 2)) = qr[d0];
      asm volatile("s_waitcnt lgkmcnt(0)" ::: "memory"); } }
  const int sr = tid >> 4, sc = (tid & 15) * 8, vst0 = v_st(sr, sc), vst1 = v_st(32 + sr, sc);
  const int k64r = tid >> 3, k64c = (tid & 7) * 8;
  const unsigned voffV = (unsigned)(sr * LDKV + sc) * 2u, voffK = (KW == 128) ? voffV : (unsigned)(k64r * LDKV + k64c) * 2u;
  const int vb0 = (int)(unsigned)(uintptr_t)V_lds + v_rd_base(lane);
  struct { bf16x8 vs0, vs1, ks0, ks1; } sr_[SDEPTH];
#define ATT_SLOAD(i, jt) do { const long row0_ = (long)__builtin_amdgcn_readfirstlane(trow(jt)); const char* vt_ = (const char*)(Vb + row0_ * LDKV); const char* kt_ = (const char*)(Kb + row0_ * LDKV); \
    sr_[i].vs0 = *(const bf16x8*)(vt_ + voffV); sr_[i].vs1 = *(const bf16x8*)(vt_ + 64 * LDKV + voffV); \
    if constexpr (KW == 128) { sr_[i].ks0 = *(const bf16x8*)(kt_ + voffK); sr_[i].ks1 = *(const bf16x8*)(kt_ + 64 * LDKV + voffK); } \
    else { sr_[i].ks0 = *(const bf16x8*)(kt_ + voffK); } } while (0)
#define ATT_SWRITE(b, i) do { *(bf16x8*)(V_lds + (b) * SHM_V + vst0) = sr_[i].vs0; *(bf16x8*)(V_lds + (b) * SHM_V + vst1) = sr_[i].vs1; \
    if constexpr (KW == 128) { const int kc_ = sc * 2; *(bf16x8*)(K_lds + (b) * SHM_K + ATT_KSWZ128(sr, kc_)) = sr_[i].ks0; *(bf16x8*)(K_lds + (b) * SHM_K + ATT_KSWZ128(32 + sr, kc_)) = sr_[i].ks1; } \
    else { *(bf16x8*)(K_lds + (b) * SHM_K + ATT_KSWZ64(k64r, k64c * 2)) = sr_[i].ks0; } } while (0)
#define ATT_SWAIT() do { if constexpr (SDEPTH == 1) asm volatile("s_waitcnt vmcnt(0)" ::: "memory"); else if constexpr (KW == 128) asm volatile("s_waitcnt vmcnt(4)" ::: "memory"); else asm volatile("s_waitcnt vmcnt(3)" ::: "memory"); } while (0)
#define ATT_RESC(a) do { if (__any((a) < 1.f)) { if (hi == 0) al_l[r32] = (a); asm volatile("s_waitcnt lgkmcnt(0)" ::: "memory"); \
    _Pragma("unroll") for (int d = 0; d < 4; ++d) _Pragma("unroll") for (int r = 0; r < 16; ++r) o[d][r] *= al_l[crow(r, hi)]; } } while (0)
  f32x16 pA0, pA1, pB0, pB1; float mnA, mnB, alA, alB; bf16x8 pa0, pa1, pa2, pa3;
  constexpr int SE = 0, SO = SDEPTH - 1;
  ATT_SLOAD(SE, 0); asm volatile("s_waitcnt vmcnt(0)" ::: "memory"); ATT_SWRITE(0, SE); __syncthreads();
  bool sA = mask.skip(0), sB = false;
  if (!sA) { qkt<DQK, QLDS, KW>(pA0, pA1, K_lds, qr, Qs, r32, hi, kcb); mask(pA0, pA1, 0); if constexpr (NOMAX) { expSM(pA0); alA = 1.f; } else partialSM<DQK>(pA0, pA1, m_reg, mnA, alA); } else alA = 1.f;
  ATT_SLOAD(SO, 1); if constexpr (SDEPTH == 2) { if (2 < NT) ATT_SLOAD(SE, 2); }
  ATT_SWAIT(); ATT_SWRITE(1, SO); __syncthreads();
  for (int j = 1; j + 1 < NT; j += 2) {
    sB = mask.skip(j);
    ATT_SBAR(); if (!sB) qkt<DQK, QLDS, KW>(pB0, pB1, K_lds + SHM_K, qr, Qs, r32, hi, kcb);
    if (!sA) if constexpr (NOMAX) finishSM_nm(pA0, pA1, l_reg, pa0, pa1, pa2, pa3); else finishSM(pA0, pA1, alA, l_reg, pa0, pa1, pa2, pa3); ATT_SBAR();
    ATT_SLOAD(SO, j + SDEPTH); ATT_SBAR();
    if (!sA) pv_d0(o, vb0, pa0, pa1, pa2, pa3);
    if (!sB) { mask(pB0, pB1, j); if constexpr (NOMAX) { expSM(pB0); alB = 1.f; } else partialSM<DQK>(pB0, pB1, m_reg, mnB, alB); } else alB = 1.f;
    __syncthreads(); ATT_SWAIT(); ATT_SWRITE(0, SE);
    ATT_RESC(alB); __syncthreads();
    if constexpr (DQK == 64) { if (j + 1 == nswitch) { const bf16* Qw = Qalt + (long)(wq * QBLK + r32) * LDQ2 + comp * 64 + hi * 8;
#pragma unroll
        for (int d0 = 0; d0 < NQ; ++d0) qr[d0] = ld8(Qw + d0 * 16); } }
    sA = mask.skip(j + 1);
    ATT_SBAR(); if (!sA) qkt<DQK, QLDS, KW>(pA0, pA1, K_lds, qr, Qs, r32, hi, kcb);
    if (!sB) if constexpr (NOMAX) finishSM_nm(pB0, pB1, l_reg, pa0, pa1, pa2, pa3); else finishSM(pB0, pB1, alB, l_reg, pa0, pa1, pa2, pa3); ATT_SBAR();
    if (SDEPTH == 1 || j + 3 < NT) ATT_SLOAD(SE, j + 1 + SDEPTH); ATT_SBAR();
    if (!sB) pv_d0(o, vb0 + SHM_V, pa0, pa1, pa2, pa3);
    if (!sA) { mask(pA0, pA1, j + 1); if constexpr (NOMAX) { expSM(pA0); alA = 1.f; } else partialSM<DQK>(pA0, pA1, m_reg, mnA, alA); } else alA = 1.f;
    __syncthreads(); ATT_SWAIT(); ATT_SWRITE(1, SO);
    ATT_RESC(alA); __syncthreads();
  }
  sB = mask.skip(NT - 1);
  ATT_SBAR(); if (!sB) qkt<DQK, QLDS, KW>(pB0, pB1, K_lds + SHM_K, qr, Qs, r32, hi, kcb);
  if (!sA) if constexpr (NOMAX) finishSM_nm(pA0, pA1, l_reg, pa0, pa1, pa2, pa3); else finishSM(pA0, pA1, alA, l_reg, pa0, pa1, pa2, pa3); ATT_SBAR();
  if (!sA) pv_d0(o, vb0, pa0, pa1, pa2, pa3);
  if (!sB) { mask(pB0, pB1, NT - 1); if constexpr (NOMAX) { expSM(pB0); alB = 1.f; } else partialSM<DQK>(pB0, pB1, m_reg, mnB, alB); } else alB = 1.f;
  __syncthreads(); ATT_RESC(alB);
  if (!sB) { if constexpr (NOMAX) finishSM_nm(pB0, pB1, l_reg, pa0, pa1, pa2, pa3); else finishSM(pB0, pB1, alB, l_reg, pa0, pa1, pa2, pa3); ATT_SBAR();
  pv_d0(o, vb0 + SHM_V, pa0, pa1, pa2, pa3); }
  if (hi == 0) li_l[r32] = l_reg; asm volatile("s_waitcnt lgkmcnt(0)" ::: "memory");
#pragma unroll
  for (int r = 0; r < 16; ++r) rli[r] = __builtin_amdgcn_rcpf(li_l[crow(r, hi)]);
#undef ATT_SLOAD
#undef ATT_SWRITE
#undef ATT_SWAIT
#undef ATT_RESC
}

#if STAMP && STAMP < 6
__device__ __forceinline__ unsigned stamp_lo() { unsigned long long t; __builtin_amdgcn_sched_barrier(0); asm volatile("s_memtime %0\n\ts_waitcnt lgkmcnt(0)" : "=s"(t) :: "memory"); __builtin_amdgcn_sched_barrier(0); return (unsigned)t; }
#endif
constexpr int DS_V = 0, DS_K = 3 * 16384, DS_WS = 6 * 16384, DS_Q = DS_WS + NW * 64 * 4, DS_END = DS_Q + NW * 4096;
template <int OFF> __device__ __forceinline__ bf16x8 lds_rd128(int addr) { bf16x8 r; asm volatile("ds_read_b128 %0, %1 offset:%2" : "=&v"(r) : "v"(addr), "i"(OFF) : "memory"); return r; }
template <int LDQ, int LDQ2, int LDKV, class TileRow>
__device__ __forceinline__ void attn_dual_stag(const bf16* __restrict__ Qa, const bf16* __restrict__ Qalt, int nswitch,
                                               const bf16* __restrict__ Kb, const bf16* __restrict__ Vb,
                                               const TileRow& trow, const int NT, char* lds, f32x16 (&o)[4], float (&rli)[16], unsigned& sacc) {
  int tid_ = threadIdx.x; asm volatile("" : "+v"(tid_));
  const int tid = tid_, wid = tid >> 6, lane = tid & 63, r32 = lane & 31, hi = lane >> 5;
  const int wq = wid & 3, g = __builtin_amdgcn_readfirstlane(wid >> 2), kcb = g * 128;
  char* V_lds = lds + DS_V; char* K_lds = lds + DS_K;
  float* wsf = (float*)(lds + DS_WS) + wid * 64; float* li_l = wsf;
  float l_reg = 0;
#pragma unroll
  for (int d = 0; d < 4; ++d) o[d] = f32x16{};
  bf16x8 qr[4];
  char* Qsw = lds + DS_Q + wid * 4096 + lane * 16;
  { const bf16* Qw = Qa + (long)(wq * QBLK + r32) * LDQ + g * 64 + hi * 8;
    const bf16* Qw2 = Qalt + (long)(wq * QBLK + r32) * LDQ2 + g * 64 + hi * 8;
#pragma unroll
    for (int d0 = 0; d0 < 4; ++d0) { qr[d0] = ld8(Qw + d0 * 16); *(bf16x8*)(Qsw + d0 * 1024) = ld8(Qw2 + d0 * 16); } }
  const int tg = tid & 255, sr = 32 * g + (tg >> 4), sc = (tg & 15) * 8;
  const int vst0 = v_st(sr, sc), vst1 = v_st(sr + 16, sc), kst0 = ATT_KSWZ128(sr, sc * 2), kst1 = ATT_KSWZ128(sr + 16, sc * 2);
  const unsigned voff = (unsigned)(sr * LDKV + sc) * 2u;
  const bf16* kbu = (const bf16*)(((unsigned long long)(unsigned)__builtin_amdgcn_readfirstlane((int)((unsigned long long)Kb >> 32)) << 32) | (unsigned)__builtin_amdgcn_readfirstlane((int)(unsigned long long)Kb));
  const int vdelta = __builtin_amdgcn_readfirstlane((int)((const char*)Vb - (const char*)Kb));
  const __amdgpu_buffer_rsrc_t kvrs = __builtin_amdgcn_make_buffer_rsrc((void*)kbu, 0, 0x7fffffff, 0x00020000);
  const int vb0 = (int)(unsigned)(uintptr_t)V_lds + v_rd_base(lane);
  const int kb0 = (int)(unsigned)(uintptr_t)K_lds;
  const int ka0 = kb0 + ATT_KSWZ128(r32, kcb + (0 * 16 + hi * 8) * 2), ka1 = kb0 + ATT_KSWZ128(r32, kcb + (1 * 16 + hi * 8) * 2);
  const int ka2 = kb0 + ATT_KSWZ128(r32, kcb + (2 * 16 + hi * 8) * 2), ka3 = kb0 + ATT_KSWZ128(r32, kcb + (3 * 16 + hi * 8) * 2);
  bf16x8 svA0, svA1, skA0, skA1, svB0, svB1, skB0, skB1;
#define DS_BL(dst, so) asm volatile("buffer_load_dwordx4 %0, %1, %2, %3 offen" : "=v"(dst) : "v"(voff), "s"(kvrs), "s"(so))
#define DS_SLOAD(S, jt) do { const int so_ = __builtin_amdgcn_readfirstlane(trow(jt)) * (LDKV * 2);   \
      \
    DS_BL(sk##S##0, so_); DS_BL(sk##S##1, so_ + 32 * LDKV); DS_BL(sv##S##0, so_ + vdelta); DS_BL(sv##S##1, so_ + vdelta + 32 * LDKV); } while (0)
#define DS_VMW(n) asm volatile("s_waitcnt vmcnt(" #n ")" ::: "memory")
#define DS_SWRITE(S, slot) do { const int so_ = (slot) * 16384; *(bf16x8*)(V_lds + so_ + vst0) = sv##S##0; *(bf16x8*)(V_lds + so_ + vst1) = sv##S##1; *(bf16x8*)(K_lds + so_ + kst0) = sk##S##0; *(bf16x8*)(K_lds + so_ + kst1) = sk##S##1; } while (0)
#define DS_BAR() do { ATT_SBAR(); asm volatile("s_waitcnt lgkmcnt(0)\n\ts_barrier" ::: "memory"); ATT_SBAR(); } while (0)
#if STAMP == 2 || STAMP == 3
#define DS_BARL() do { const unsigned t0_ = stamp_lo(); DS_BAR(); const unsigned t1_ = stamp_lo(); sacc += t1_ - t0_; } while (0)
#else
#define DS_BARL() DS_BAR()
#endif
#if STAMP == 4 || STAMP == 5
#define DS_STAMP(v) do { if (g == 0) v = stamp_lo(); } while (0)
#else
#define DS_STAMP(v) (void)0
#endif
#define DS_LGKM(n) asm volatile("s_waitcnt lgkmcnt(" #n ")" ::: "memory")
#define DS_KREADS(so) do { const int o_ = (so); kf0 = lds_rd128<0>(ka0 + o_); kf1 = lds_rd128<8192>(ka0 + o_); kf2 = lds_rd128<0>(ka1 + o_); kf3 = lds_rd128<8192>(ka1 + o_); \
    kf4 = lds_rd128<0>(ka2 + o_); kf5 = lds_rd128<8192>(ka2 + o_); kf6 = lds_rd128<0>(ka3 + o_); kf7 = lds_rd128<8192>(ka3 + o_); } while (0)
#define DS_QK() do { p0 = f32x16{}; p1 = f32x16{}; \
    p0 = __builtin_amdgcn_mfma_f32_32x32x16_bf16(kf0, qr[0], p0, 0, 0, 0); p1 = __builtin_amdgcn_mfma_f32_32x32x16_bf16(kf1, qr[0], p1, 0, 0, 0); \
    p0 = __builtin_amdgcn_mfma_f32_32x32x16_bf16(kf2, qr[1], p0, 0, 0, 0); p1 = __builtin_amdgcn_mfma_f32_32x32x16_bf16(kf3, qr[1], p1, 0, 0, 0); \
    p0 = __builtin_amdgcn_mfma_f32_32x32x16_bf16(kf4, qr[2], p0, 0, 0, 0); p1 = __builtin_amdgcn_mfma_f32_32x32x16_bf16(kf5, qr[2], p1, 0, 0, 0); \
    p0 = __builtin_amdgcn_mfma_f32_32x32x16_bf16(kf6, qr[3], p0, 0, 0, 0); p1 = __builtin_amdgcn_mfma_f32_32x32x16_bf16(kf7, qr[3], p1, 0, 0, 0); } while (0)
#define DS_QKA() do { p0 = f32x16{}; p1 = f32x16{}; \
    p0 = __builtin_amdgcn_mfma_f32_32x32x16_bf16(kf0, qr[0], p0, 0, 0, 0); p1 = __builtin_amdgcn_mfma_f32_32x32x16_bf16(kf1, qr[0], p1, 0, 0, 0); \
    p0 = __builtin_amdgcn_mfma_f32_32x32x16_bf16(kf2, qr[1], p0, 0, 0, 0); p1 = __builtin_amdgcn_mfma_f32_32x32x16_bf16(kf3, qr[1], p1, 0, 0, 0); } while (0)
#define DS_QKB() do { \
    p0 = __builtin_amdgcn_mfma_f32_32x32x16_bf16(kf4, qr[2], p0, 0, 0, 0); p1 = __builtin_amdgcn_mfma_f32_32x32x16_bf16(kf5, qr[2], p1, 0, 0, 0); \
    p0 = __builtin_amdgcn_mfma_f32_32x32x16_bf16(kf6, qr[3], p0, 0, 0, 0); p1 = __builtin_amdgcn_mfma_f32_32x32x16_bf16(kf7, qr[3], p1, 0, 0, 0); } while (0)
  DS_SLOAD(A, 0); DS_SLOAD(B, 1); DS_VMW(0); DS_SWRITE(A, 0); DS_SWRITE(B, 1);
  if (g == 1 && 2 < NT) DS_SLOAD(A, 2);
  DS_BAR();
  f32x16 p0, p1; bf16x8 pa0, pa1, pa2, pa3; bf16x8 kf0, kf1, kf2, kf3, kf4, kf5, kf6, kf7;
  if (2 + g < NT) DS_SLOAD(B, 2 + g);
  ATT_SBAR(); DS_KREADS(0); DS_LGKM(0); ATT_SBAR(); DS_QK();
  if (g == 1) DS_BAR();
  int s0 = 0, s1 = 1;
#define DS_TILE(S, k_) do { unsigned ts0_ = 0, ts1_ = 0, ts2_ = 0; DS_STAMP(ts0_); \
    expSM(p0); expSM(p1); packSM(p0, p1, l_reg, pa0, pa1, pa2, pa3); \
    { const int jt = (k_) + 1 + g; if (jt >= 2 && jt < NT) { if (jt + 1 < NT) DS_VMW(4); else DS_VMW(0); int sl = s1 + g; sl = sl >= 3 ? sl - 3 : sl; DS_SWRITE(S, sl); } } \
    const int vb = vb0 + s0 * 16384; VFrag f; \
    ATT_SBAR(); ATT_TR8(0, f.a); ATT_TR8(1, f.b); ATT_SBAR(); \
    DS_STAMP(ts1_); if (g == 0) DS_BARL(); DS_STAMP(ts2_); \
    { const int jt = (k_) + 3 + g; if (jt < NT) DS_SLOAD(S, jt); } \
    if ((k_) + 1 == nswitch) { \
      const int qa_ = (int)(unsigned)(uintptr_t)Qsw; qr[0] = lds_rd128<0>(qa_); qr[1] = lds_rd128<1024>(qa_); qr[2] = lds_rd128<2048>(qa_); qr[3] = lds_rd128<3072>(qa_);   \
      asm volatile("s_waitcnt lgkmcnt(0)" ::: "memory"); } \
    ATT_SBAR(); \
    __builtin_amdgcn_s_setprio(1); DS_KREADS(s1 * 16384); \
    DS_LGKM(8); ATT_SBAR(); ATT_MM4(o[0], f.a); ATT_SBAR(); ATT_TR8(2, f.a); ATT_SBAR(); ATT_MM4(o[1], f.b); \
    ATT_SBAR(); DS_LGKM(8); ATT_SBAR();                  \
    if ((k_) + 1 < NT) { DS_QKA(); DS_QKB(); } \
    ATT_SBAR(); ATT_TR8(3, f.b); \
    ATT_SBAR(); DS_LGKM(8); ATT_SBAR(); ATT_MM4(o[2], f.a); \
    ATT_SBAR(); DS_LGKM(0); ATT_SBAR(); ATT_MM4(o[3], f.b); __builtin_amdgcn_s_setprio(0); \
    { unsigned ts3_ = 0; DS_STAMP(ts3_); if (STAMP == 4 && g == 0) sacc += ts3_ - ts2_; if (STAMP == 5 && g == 0) sacc += ts1_ - ts0_; } \
    if (g == 1 && (k_) + 1 < NT) DS_BARL(); \
    s0 = s1; s1 = s1 == 2 ? 0 : s1 + 1; } while (0)
#if STAMP == 42
  const unsigned tl0_ = (unsigned)__builtin_amdgcn_s_memrealtime();
#endif
#pragma clang loop unroll(disable)
  for (int k = 0; k < NT; k += 2) { DS_TILE(A, k); DS_TILE(B, k + 1); }
#if STAMP == 42
  { const unsigned tl1_ = (unsigned)__builtin_amdgcn_s_memrealtime(); if (tid == 0) *(volatile unsigned*)(lds + 143360 + 64) += tl1_ - tl0_; }
#endif
#undef DS_TILE
  finish_l(l_reg, li_l, r32, hi, rli);
#undef DS_SLOAD
#undef DS_BL
#undef DS_VMW
#undef DS_SWRITE
#undef DS_BAR
#undef DS_LGKM
#undef DS_BARL
#undef DS_STAMP
#undef DS_KREADS
#undef DS_QK
#undef DS_QKA
#undef DS_QKB
}
}

constexpr int DM = 2048, NBATCH = 2, SEQ = 8192, DEPTH = 4, CTXL = 256;
constexpr int ML = NBATCH * SEQ;
constexpr int MC = NBATCH * CTXL;
constexpr int MT = ML + MC;
constexpr int EV_IN = 5120;
constexpr int EVN = 4608 + 1024;
constexpr int ODN = 6144;
constexpr int FH = 5632;
constexpr int NPH = 1 + 8 * DEPTH;
#ifndef PHM
#define PHM 1023
#endif
#ifndef MXM
#define MXM 15
#endif
#ifndef MK_N_LAUNCHES
#define MK_N_LAUNCHES 1
#endif
constexpr float LAM_INIT0 = 0.2f, LAM_INIT1 = 0.47071301834370415f;

constexpr size_t MiB = 1u << 20;
constexpr size_t WS_CTL = 0, CTL_ZERO_BYTES = 64 * 1024;
constexpr size_t WS_MODV = 1 * MiB;
constexpr size_t WS_ROPE = 2 * MiB;
constexpr size_t WS_LAM = 2 * MiB + 64 * 1024;
constexpr size_t WS_FA1 = 2 * MiB + 128 * 1024;
constexpr size_t WS_FA2 = 2 * MiB + 192 * 1024;
constexpr size_t WS_FA3 = 2 * MiB + 256 * 1024;
constexpr size_t WS_WIN_E = 4 * MiB,  SZ_WIN_E = 22 * MiB;
constexpr size_t WS_WOUT_E = WS_WIN_E + 2 * SZ_WIN_E, SZ_WOUT = 8 * MiB;
constexpr size_t WS_WIN_O = WS_WOUT_E + 2 * SZ_WOUT, SZ_WIN_O = 24 * MiB;
constexpr size_t WS_WOUT_O = WS_WIN_O + 2 * SZ_WIN_O;
constexpr size_t WS_WFI = WS_WOUT_O + 2 * SZ_WOUT, SZ_WFI = 44 * MiB;
constexpr size_t WS_WFO = WS_WFI + 4 * SZ_WFI, SZ_WFO = 22 * MiB;
constexpr size_t WS_A = WS_WFO + 4 * SZ_WFO;
constexpr size_t WS_P = WS_A + 66 * MiB;
constexpr size_t WS_QR = WS_P + 198 * MiB;
constexpr size_t WS_MIX = WS_QR + 48 * MiB;
constexpr size_t WS_HID = WS_MIX + 66 * MiB;
constexpr size_t WS_HC = WS_HID + 182 * MiB;
constexpr size_t WS_STASH = WS_HC + 4 * MiB;
constexpr size_t WS_HB = WS_STASH;
constexpr size_t WS_FT = WS_STASH + 64 * MiB;
constexpr size_t WS_SLAB = WS_STASH + 128 * MiB;
constexpr size_t WS_END = WS_SLAB + 48 * MiB;
static_assert(WS_A == 392 * MiB && WS_END == 1132 * MiB, "d_ws map");
constexpr int CW_FFT = 3072;
constexpr int CW_BAR = 4096;

constexpr int GEN_BYTES = 143360;
constexpr int MISC_OFF = GEN_BYTES;
constexpr int LDS_BYTES = 147456;

#define GAS __attribute__((address_space(1)))
#define LAS __attribute__((address_space(3)))
typedef unsigned short bf16;
typedef unsigned v4u __attribute__((ext_vector_type(4)));
typedef unsigned v2u __attribute__((ext_vector_type(2)));
typedef float f32x4 __attribute__((ext_vector_type(4)));
typedef short bf16x8 __attribute__((ext_vector_type(8)));
typedef GAS unsigned gu32;
#define RLX_AGENT __ATOMIC_RELAXED, __HIP_MEMORY_SCOPE_AGENT
#define LDS_WAIT() asm volatile("s_waitcnt lgkmcnt(0)" ::: "memory")
#define VM_WAIT() asm volatile("s_waitcnt vmcnt(0)" ::: "memory")
__device__ __forceinline__ unsigned f2bf(float f) { unsigned u = __builtin_bit_cast(unsigned, f); return (u + 0x7fffu + ((u >> 16) & 1u)) >> 16; }
__device__ __forceinline__ unsigned pk2(float lo, float hi) { return f2bf(lo) | (f2bf(hi) << 16); }
__device__ __forceinline__ float bflo(unsigned w) { return __uint_as_float(w << 16); }
__device__ __forceinline__ float bfhi(unsigned w) { return __uint_as_float(w & 0xffff0000u); }
__device__ __forceinline__ float hw_cos(float rev) { return __builtin_amdgcn_cosf(rev); }
__device__ __forceinline__ float hw_sin(float rev) { return __builtin_amdgcn_sinf(rev); }
#define XB_TMO      128
#define XB_XCNT(j)  (256  + 64 * (j))
#define XB_XSUB(j)  (1280 + 64 * (j))
#define XB_XGEN(j)  (2304 + 64 * (j))
#define XB_TOP      3328
#define XB_TOPGEN   3392
#define XCD_BAR_WORDS 3456
#define XB_SPIN_CAP (1u << 18)

__device__ __forceinline__ unsigned xb_ld(unsigned* p)              { return __hip_atomic_load(p, __ATOMIC_RELAXED, __HIP_MEMORY_SCOPE_AGENT); }
__device__ __forceinline__ unsigned xb_add(unsigned* p, unsigned v) { return __hip_atomic_fetch_add(p, v, __ATOMIC_RELAXED, __HIP_MEMORY_SCOPE_AGENT); }
__device__ __forceinline__ unsigned xb_xcc_id() { return (unsigned)__builtin_amdgcn_s_getreg((3 << 11) | 20) & 0xFu; }
#define XB_SPIN(cond, bar) do { unsigned _sp = 0; while (cond) { __builtin_amdgcn_s_sleep(1); \
    if ((++_sp & 255u) == 0u) { if (xb_ld(&(bar)[XB_TMO])) break; if (_sp > XB_SPIN_CAP) { atomicAdd(&(bar)[XB_TMO], 1u); break; } } } } while (0)

struct XcdBarrier {
    unsigned* bar; unsigned x;
    volatile LAS unsigned* st;
};

__device__ __forceinline__ XcdBarrier xcd_barrier_post(unsigned* bar, volatile LAS unsigned* st) {
    XcdBarrier b; b.bar = bar; b.x = xb_xcc_id(); b.st = st;
    if (threadIdx.x == 0) (void)xb_add(&bar[XB_XCNT(b.x)], 1u);
    return b;
}
__device__ __forceinline__ void xcd_barrier_complete(unsigned* bar, unsigned x, unsigned& nloc, unsigned& nx) {
    const unsigned G = gridDim.x * gridDim.y * gridDim.z;
    unsigned sum, cnt, mine, sp = 0u;
    for (;;) {
        sum = 0u; cnt = 0u; mine = 0u;
#pragma unroll
        for (unsigned j = 0; j < 16; ++j) { const unsigned c = xb_ld(&bar[XB_XCNT(j)]); sum += c; cnt += (c > 0u) ? 1u : 0u; mine = (j == x) ? c : mine; }
        if (sum == G) break;
        __builtin_amdgcn_s_sleep(1);
        if ((++sp & 255u) == 0u) { if (xb_ld(&bar[XB_TMO])) break; if (sp > XB_SPIN_CAP) { atomicAdd(&bar[XB_TMO], 1u); break; } }
    }
    nloc = mine > 0u ? mine : 1u; nx = cnt > 0u ? cnt : 1u;
}

__device__ __forceinline__ void xcd_barrier(const XcdBarrier& b) {
    asm volatile("s_waitcnt vmcnt(0)" ::: "memory");
    __syncthreads();
    if (threadIdx.x == 0) {
        unsigned* bar = b.bar;
        __builtin_amdgcn_s_waitcnt(0);
        unsigned nloc = b.st[0], nx = b.st[1];
        if (nloc == 0u) { xcd_barrier_complete(bar, b.x, nloc, nx); b.st[0] = nloc; b.st[1] = nx; }
        const unsigned old = xb_add(&bar[XB_XSUB(b.x)], 1u);
        const unsigned gen = old / nloc;
        if (old + 1u == (gen + 1u) * nloc) {
            __builtin_amdgcn_fence(__ATOMIC_RELEASE, "agent");
            asm volatile("s_waitcnt vmcnt(0)" ::: "memory");
            const unsigned og = xb_add(&bar[XB_TOP], 1u);
            const unsigned tg = og / nx;
            if (og + 1u == (tg + 1u) * nx) xb_add(&bar[XB_TOPGEN], 1u);
            else XB_SPIN(xb_ld(&bar[XB_TOPGEN]) == tg, bar);
            __builtin_amdgcn_fence(__ATOMIC_ACQUIRE, "agent");
            xb_add(&bar[XB_XGEN(b.x)], 1u);
            asm volatile("s_waitcnt vmcnt(0)" ::: "memory");
        } else {
            XB_SPIN(xb_ld(&bar[XB_XGEN(b.x)]) == gen, bar);
            __builtin_amdgcn_fence(__ATOMIC_ACQUIRE, "agent");
            asm volatile("s_waitcnt vmcnt(0)" ::: "memory");
        }
    }
    __syncthreads();
}

struct Args { const float* in[19]; float* out; unsigned char* ws; int ph_lo, ph_hi; };
typedef const __attribute__((address_space(4))) Args* ArgsP;
struct Frame {
    LAS unsigned char* lds; unsigned char* ldsg;
    volatile LAS unsigned* MISC;
    gu32* ctl;
    int tid, lane, wave, vcu, G;
    ArgsP ap; GAS float* out; GAS unsigned char* ws;
};
#define INP(F, k) ((const float*)(const GAS float*)(F).ap->in[k])
#define WSP(F) ((unsigned char*)(F).ws)
#define OUTP(F) ((float*)(F).out)
__device__ __forceinline__ Frame site(const Frame& F0) {
    Frame F = F0;
    int t = threadIdx.x; asm volatile("" : "+v"(t)); F.tid = t; F.lane = t & 63; F.wave = __builtin_amdgcn_readfirstlane(t >> 6);
    GAS unsigned char* w = F0.ws; asm volatile("" : "+s"(w)); F.ws = w;
    GAS float* o = F0.out; asm volatile("" : "+s"(o)); F.out = o;
    ArgsP a = F0.ap; asm volatile("" : "+s"(a)); F.ap = a;
    return F;
}
__device__ __forceinline__ float wave_sum(float v) {
#pragma unroll
    for (int o = 1; o < 64; o <<= 1) v += __shfl_xor(v, o);
    return v;
}

__device__ __forceinline__ void p0_modvec(Frame& F) {
    LAS float* sv = (LAS float*)F.lds;
    LAS float* red = (LAS float*)(F.lds + 24576);
    const float* c = INP(F, 1); const float* cctx = INP(F, 3); const float* wmod = INP(F, 4); const float* bmod = INP(F, 5);
    float* modv = (float*)(WSP(F) + WS_MODV);
    bool have = false;
    for (int it = blockIdx.x; it < 4 * 48; it += F.G) {
        if (!have) {
            for (int idx = F.tid; idx < 3 * DM; idx += 512) { const int g = idx >> 11, k = idx & 2047; const float v = g < 2 ? c[g * DM + k] : cctx[k]; sv[idx] = v / (1.0f + __expf(-v)); }
            __syncthreads(); have = true;
        }
        const int li = it / 48, ch = it % 48;
        const float* wp = wmod + ((size_t)li * DM + F.wave * 256) * 12288 + ch * 256 + F.lane * 4;
        f32x4 a0 = {0.f, 0.f, 0.f, 0.f}, a1 = a0, a2 = a0;
#pragma unroll 8
        for (int k = 0; k < 256; ++k) {
            const f32x4 w = __builtin_nontemporal_load((const f32x4*)(wp + (size_t)k * 12288));
            const float s0 = sv[F.wave * 256 + k], s1 = sv[DM + F.wave * 256 + k], s2 = sv[2 * DM + F.wave * 256 + k];
            a0 += w * s0; a1 += w * s1; a2 += w * s2;
        }
        *(LAS f32x4*)(red + (F.wave * 3 + 0) * 256 + F.lane * 4) = a0;
        *(LAS f32x4*)(red + (F.wave * 3 + 1) * 256 + F.lane * 4) = a1;
        *(LAS f32x4*)(red + (F.wave * 3 + 2) * 256 + F.lane * 4) = a2;
        __syncthreads();
        for (int t = F.tid; t < 768; t += 512) { const int g = t >> 8, cc = t & 255; float s = bmod[li * 12288 + ch * 256 + cc];
#pragma unroll
            for (int w = 0; w < 8; ++w) s += red[(w * 3 + g) * 256 + cc];
            modv[(size_t)(li * 3 + g) * 12288 + ch * 256 + cc] = s; }
        __syncthreads();
    }
}
__device__ __forceinline__ void p0_tables(Frame& F) {
    const int gt = blockIdx.x * 512 + F.tid, NTH = F.G * 512;
    float* rope = (float*)(WSP(F) + WS_ROPE); float* lam = (float*)(WSP(F) + WS_LAM);
    bf16* fa1 = (bf16*)(WSP(F) + WS_FA1); bf16* fa2 = (bf16*)(WSP(F) + WS_FA2); bf16* fa3 = (bf16*)(WSP(F) + WS_FA3);
    for (int idx = gt; idx < 2048; idx += NTH) { const int pos = idx >> 4, f = idx & 15;
        const float inv = exp2f(-(float)f * (13.287712379549449f / 16.0f)); const float rev = (float)pos * inv * 0.15915494309189535f; const float fr = rev - floorf(rev);
        rope[idx * 2] = hw_cos(fr); rope[idx * 2 + 1] = hw_sin(fr); }
    for (int idx = gt; idx < 128 * 128; idx += NTH) { const int m = idx >> 7, k = idx & 127, rp = m >> 6, k1 = m & 63, ri = k >> 6, t1 = k & 63;
        const float ph = (float)((k1 * t1) & 63) * (1.0f / 64.0f); const float cs = hw_cos(ph), sn = hw_sin(ph);
        const float v = rp == 0 ? (ri == 0 ? cs : -sn) : (ri == 0 ? -sn : -cs); fa1[idx] = (bf16)f2bf(v); }
    for (int idx = gt; idx < 128 * 256; idx += NTH) { const int k2 = idx >> 8, k = idx & 255, ri = k >> 7, t2 = k & 127;
        const float ph = (float)((k2 * t2) & 127) * (1.0f / 128.0f); const float v = ri == 0 ? hw_cos(ph) : hw_sin(ph); fa2[idx] = (bf16)f2bf(v); }
    for (int idx = gt; idx < 256 * 512; idx += NTH) { const int kk = idx >> 9, k = idx & 511, ri = k >> 8, t = k & 255;
        const float ph = (float)((kk * t) & 255) * (1.0f / 256.0f); const float v = ri == 0 ? hw_cos(ph) : -hw_sin(ph); fa3[idx] = (bf16)f2bf(v); }
    if (gt < 2) { const float* lv = INP(F, 12) + gt * 256; float s01 = 0.f, s23 = 0.f;
        for (int d = 0; d < 64; ++d) { s01 += lv[d] * lv[64 + d]; s23 += lv[128 + d] * lv[192 + d]; }
        lam[gt] = __expf(s01) - __expf(s23) + (gt == 0 ? LAM_INIT0 : LAM_INIT1); }
}
__device__ __forceinline__ void p0_copy_ctx(Frame& F) {
    const f32x4* src = (const f32x4*)INP(F, 2); f32x4* dst = (f32x4*)(WSP(F) + WS_HC);
    for (int i = blockIdx.x * 512 + F.tid; i < MC * DM / 4; i += F.G * 512) dst[i] = src[i];
}
__device__ __forceinline__ void p0_fold(Frame& F) {
    LAS unsigned char* Wl = F.lds;
    LAS unsigned char* Tl = F.lds + 64 * 272;
    const int lane = F.lane, l15 = lane & 15, lq = lane >> 4;
    bool have_t = false;
    for (int it = blockIdx.x; it < 256; it += F.G) {
        const int j = it >> 7, g = (it >> 5) & 3, k0 = (it & 31) * 64;
        const float* W = INP(F, 9) + (size_t)j * DM * EV_IN;
        bf16* Bt = (bf16*)(WSP(F) + WS_WIN_E + (size_t)j * SZ_WIN_E);
        if (!have_t) { have_t = true;
            for (int idx = F.tid; idx < 256 * 128; idx += 512) { const int n = idx >> 7, cc = idx & 127, cp = n >> 1, ri = n & 1; const float ph = (float)((cc * cp) & 127) * (1.0f / 128.0f);
                *(LAS bf16*)(Tl + n * 272 + cc * 2) = (bf16)f2bf(ri ? hw_sin(ph) : hw_cos(ph)); } }
        for (int idx = F.tid; idx < 64 * 128; idx += 512) { const int r = idx >> 7, cc = idx & 127; *(LAS bf16*)(Wl + r * 272 + cc * 2) = (bf16)f2bf(W[(size_t)(k0 + r) * EV_IN + 4608 + g * 128 + cc]); }
        __syncthreads();
#pragma unroll 1
        for (int ni = 0; ni < 2; ++ni) { const int nt = F.wave * 2 + ni;
            bf16x8 bfr[4];
#pragma unroll
            for (int ks = 0; ks < 4; ++ks) bfr[ks] = *(const LAS bf16x8*)(Tl + (16 * nt + l15) * 272 + (32 * ks + 8 * lq) * 2);
#pragma unroll
            for (int mt = 0; mt < 4; ++mt) { f32x4 acc = {0.f, 0.f, 0.f, 0.f};
#pragma unroll
                for (int ks = 0; ks < 4; ++ks) { const bf16x8 af = *(const LAS bf16x8*)(Wl + (16 * mt + l15) * 272 + (32 * ks + 8 * lq) * 2); acc = __builtin_amdgcn_mfma_f32_16x16x32_bf16(af, bfr[ks], acc, 0, 0, 0); }
                v2u o; o.x = pk2(acc[0], acc[1]); o.y = pk2(acc[2], acc[3]);
                *(v2u*)(Bt + (size_t)(4608 + g * 256 + 16 * nt + l15) * DM + k0 + 16 * mt + 4 * lq) = o; } }
        __syncthreads();
    }
}
__device__ __forceinline__ void p0_transpose_item(const float* W, int K, int pitch, int ncols, bf16* WT, int mode, LAS float* scr, int item, int lane) {
    const int nblk = ncols / 32, kb = item / nblk, nb = item % nblk, k0 = 64 * kb, n0 = 32 * nb;
    float wv[32];
    const float* wp = W + (size_t)(k0 + (lane >> 5)) * pitch + n0 + (lane & 31);
#pragma unroll
    for (int i = 0; i < 32; ++i) wv[i] = __builtin_nontemporal_load(wp + (size_t)(2 * i) * pitch);
#pragma unroll
    for (int i = 0; i < 32; ++i) scr[(2 * i + (lane >> 5)) * 33 + (lane & 31)] = wv[i];
    LDS_WAIT(); asm volatile("" ::: "memory");
    int d0 = n0;
    if (mode == 1) { const int c = n0 < FH ? n0 : n0 - FH; d0 = (c >> 7) * 256 + (c & 127) + (n0 < FH ? 0 : 128); }
    const int c8 = lane & 7;
#pragma unroll
    for (int j = 0; j < 4; ++j) { const int n = (lane >> 3) + 8 * j; const LAS float* s = scr + (8 * c8) * 33 + n;
        v4u o; o.x = pk2(s[0 * 33], s[1 * 33]); o.y = pk2(s[2 * 33], s[3 * 33]); o.z = pk2(s[4 * 33], s[5 * 33]); o.w = pk2(s[6 * 33], s[7 * 33]);
        *(GAS v4u*)(WT + (size_t)(d0 + n) * K + k0 + 8 * c8) = o; }
    LDS_WAIT(); asm volatile("" ::: "memory");
}
constexpr int WQ_EVI = 32 * 144, WQ_ODI = 32 * 192, WQ_OUT = 32 * 64, WQ_FI = 32 * 352, WQ_FO = 88 * 64;
constexpr int WQ_LE = WQ_EVI + WQ_OUT + WQ_FI + WQ_FO, WQ_LO = WQ_ODI + WQ_OUT + WQ_FI + WQ_FO, WQ_N = 2 * (WQ_LE + WQ_LO);
static_assert(WQ_LE == 23552 && WQ_LO == 25088 && WQ_N == 97280, "weight queue sizes");
__device__ __forceinline__ void wq_item(Frame& F, int q, LAS float* scr) {
    int li = 0, r = q;
    if (r >= WQ_LE) { r -= WQ_LE; li = 1; if (r >= WQ_LO) { r -= WQ_LO; li = 2; if (r >= WQ_LE) { r -= WQ_LE; li = 3; } } }
    const int lj = li >> 1; const bool odd = li & 1; const int nin = odd ? WQ_ODI : WQ_EVI;
    if (r < nin) {
        if (odd) p0_transpose_item(INP(F, 14) + (size_t)lj * DM * ODN, DM, ODN, ODN, (bf16*)(WSP(F) + WS_WIN_O + (size_t)lj * SZ_WIN_O), 0, scr, r, F.lane);
        else     p0_transpose_item(INP(F, 9) + (size_t)lj * DM * EV_IN, DM, EV_IN, 4608, (bf16*)(WSP(F) + WS_WIN_E + (size_t)lj * SZ_WIN_E), 0, scr, r, F.lane);
        return; }
    r -= nin;
    if (r < WQ_OUT) { p0_transpose_item(INP(F, odd ? 15 : 10) + (size_t)lj * DM * DM, DM, DM, DM, (bf16*)(WSP(F) + (odd ? WS_WOUT_O : WS_WOUT_E) + (size_t)lj * SZ_WOUT), 0, scr, r, F.lane); return; }
    r -= WQ_OUT;
    if (r < WQ_FI) { p0_transpose_item(INP(F, 7) + (size_t)li * DM * 2 * FH, DM, 2 * FH, 2 * FH, (bf16*)(WSP(F) + WS_WFI + (size_t)li * SZ_WFI), 1, scr, r, F.lane); return; }
    r -= WQ_FI;
    p0_transpose_item(INP(F, 8) + (size_t)li * FH * DM, FH, DM, DM, (bf16*)(WSP(F) + WS_WFO + (size_t)li * SZ_WFO), 0, scr, r, F.lane);
}
constexpr int WQ_IPW = 10, WQ_P0 = 11200;
__device__ const int WQ_TAIL[8] = {11200, 17920, 31360, 48000, 61440, 68160, 81600, 97280};
static_assert(17920 - 11200 <= 84 * 8 * WQ_IPW && 31360 - 17920 <= 168 * 8 * WQ_IPW && 48000 - 31360 <= 208 * 8 * WQ_IPW && 61440 - 48000 <= 168 * 8 * WQ_IPW && 68160 - 61440 <= 84 * 8 * WQ_IPW && 81600 - 68160 <= 168 * 8 * WQ_IPW && 97280 - 81600 <= 208 * 8 * WQ_IPW, "tail capacities");
__device__ __forceinline__ void p0_weights(Frame& F) {
    LAS float* scr = (LAS float*)(F.lds + F.wave * 16384);
    const int gw = F.vcu * 8 + F.wave, NGW = F.G * 8;
    if (F.G != 256) { for (int q = gw; q < WQ_N; q += NGW) wq_item(F, q, scr); return; }
    for (int i = gw; i < WQ_P0; i += NGW) wq_item(F, i, scr);
}
__device__ __forceinline__ void wq_tail(Frame& F, int t, int units) {
    const int rem = units % F.G; const int c = (int)blockIdx.x;
    if (F.G != 256 || rem == 0 || c < rem) return;
    LAS float* scr = (LAS float*)(F.lds + F.wave * 16384);
    const int nw = (F.G - rem) * 8, wr = (c - rem) * 8 + F.wave; const int qb = WQ_TAIL[t], qe = WQ_TAIL[t + 1];
    for (int i = 0; i < WQ_IPW; ++i) { const int q = qb + wr + i * nw; if (q < qe) wq_item(F, q, scr); }
}

template <bool F32SRC>
__device__ __forceinline__ void norm_phase(Frame& F, int li, int which, const void* hlv, float* hcx, int red_ks, const float* red_gate) {
    const float* hl = (const float*)hlv; const bf16* hb = (const bf16*)hlv;
    const float* gain = INP(F, 6) + (size_t)(li * 2 + which) * DM;
    const float* modv = (const float*)(WSP(F) + WS_MODV) + (size_t)li * 3 * 12288;
    bf16* A = (bf16*)(WSP(F) + WS_A);
    LAS float* Gv = (LAS float*)F.lds; LAS float* Sv = Gv + 3 * DM;
    for (int i = F.tid; i < 3 * DM; i += 512) { const int grp = i >> 11, d = i & (DM - 1); const float* sh = modv + grp * 12288 + (which * 3) * DM;
        Gv[i] = gain[d] * (1.0f + sh[DM + d]); Sv[i] = sh[d]; }
    __syncthreads();
    const int gw = F.vcu * 8 + F.wave, NGW = F.G * 8; const int lane = F.lane;
    int r = gw;
    if constexpr (F32SRC) {
    for (; r + 3 * NGW < ML; r += 4 * NGW) {
        f32x4 v[4][8]; float q[4] = {0.f, 0.f, 0.f, 0.f};
#pragma unroll
        for (int i = 0; i < 4; ++i) { const float* sp = hl + (size_t)(r + i * NGW) * DM + 4 * lane;
#pragma unroll
            for (int j = 0; j < 8; ++j) v[i][j] = *(const f32x4*)(sp + 256 * j); }
#pragma unroll
        for (int i = 0; i < 4; ++i)
#pragma unroll
            for (int j = 0; j < 8; ++j) q[i] += (v[i][j].x * v[i][j].x + v[i][j].y * v[i][j].y) + (v[i][j].z * v[i][j].z + v[i][j].w * v[i][j].w);
#pragma unroll
        for (int i = 0; i < 4; ++i) { const int ri = r + i * NGW; const float rs = rsqrtf(wave_sum(q[i]) * (1.0f / DM) + 1e-6f); const int go = (ri < SEQ ? 0 : 1) * DM;
#pragma unroll
            for (int j = 0; j < 8; ++j) { const int d = 4 * lane + 256 * j;
                const f32x4 a = v[i][j] * rs * *(const LAS f32x4*)(Gv + go + d) + *(const LAS f32x4*)(Sv + go + d);
                v2u o; o.x = pk2(a.x, a.y); o.y = pk2(a.z, a.w);
                *(v2u*)(A + (size_t)ri * DM + d) = o; } }
    }
    } else {
    for (; r + 3 * NGW < ML; r += 4 * NGW) {
        v4u w[4][4]; float q[4];
#pragma unroll
        for (int i = 0; i < 4; ++i) { const bf16* sp = hb + (size_t)(r + i * NGW) * DM + 8 * lane;
#pragma unroll
            for (int j = 0; j < 4; ++j) w[i][j] = *(const v4u*)(sp + 512 * j); }
        asm volatile("" ::: "memory");
#pragma unroll
        for (int i = 0; i < 4; ++i) { float a = 0.f;
#pragma unroll
            for (int j = 0; j < 4; ++j) { const v4u t = w[i][j];
                a += (bflo(t.x) * bflo(t.x) + bfhi(t.x) * bfhi(t.x)) + (bflo(t.y) * bflo(t.y) + bfhi(t.y) * bfhi(t.y)) + (bflo(t.z) * bflo(t.z) + bfhi(t.z) * bfhi(t.z)) + (bflo(t.w) * bflo(t.w) + bfhi(t.w) * bfhi(t.w)); }
            q[i] = a; }
#pragma unroll
        for (int i = 0; i < 4; ++i) { const int ri = r + i * NGW; const float rs = rsqrtf(wave_sum(q[i]) * (1.0f / DM) + 1e-6f); const int go = (ri < SEQ ? 0 : 1) * DM;
#pragma unroll
            for (int j = 0; j < 4; ++j) { const int d = 8 * lane + 512 * j; const v4u t = w[i][j];
                const f32x4 x0 = f32x4{bflo(t.x), bfhi(t.x), bflo(t.y), bfhi(t.y)}, x1 = f32x4{bflo(t.z), bfhi(t.z), bflo(t.w), bfhi(t.w)};
                const f32x4 a0 = x0 * rs * *(const LAS f32x4*)(Gv + go + d) + *(const LAS f32x4*)(Sv + go + d);
                const f32x4 a1 = x1 * rs * *(const LAS f32x4*)(Gv + go + d + 4) + *(const LAS f32x4*)(Sv + go + d + 4);
                v4u o; o.x = pk2(a0.x, a0.y); o.y = pk2(a0.z, a0.w); o.z = pk2(a1.x, a1.y); o.w = pk2(a1.z, a1.w);
                *(v4u*)(A + (size_t)ri * DM + d) = o; } }
    }
    }
    if (F.G == 256 && r >= ML) {
        const int cr = F.vcu * 2 + (F.wave >> 2), qo = 4 * lane + 512 * (F.wave & 3);
        float* hrow = hcx + (size_t)cr * DM + qo;
        f32x4 v0 = *(const f32x4*)hrow, v1 = *(const f32x4*)(hrow + 256);
        if (red_ks > 0) {
            const float* sl = (const float*)(WSP(F) + WS_SLAB) + (size_t)cr * DM + qo;
            f32x4 t0[11], t1[11];
#pragma unroll
            for (int k = 0; k < 11; ++k) { const bool on = k < red_ks; const size_t ko = (size_t)(on ? k : 0) * (MC * DM); t0[k] = *(const f32x4*)(sl + ko); t1[k] = *(const f32x4*)(sl + ko + 256); }
            f32x4 s0 = t0[0], s1 = t1[0];
#pragma unroll
            for (int k = 1; k < 11; ++k) if (k < red_ks) { s0 += t0[k]; s1 += t1[k]; }
            v0 += *(const f32x4*)(red_gate + qo) * s0; v1 += *(const f32x4*)(red_gate + qo + 256) * s1;
            *(f32x4*)hrow = v0; *(f32x4*)(hrow + 256) = v1;
        }
        const float ssq = wave_sum((v0.x * v0.x + v0.y * v0.y) + (v0.z * v0.z + v0.w * v0.w) + (v1.x * v1.x + v1.y * v1.y) + (v1.z * v1.z + v1.w * v1.w));
        LAS float* red = (LAS float*)(F.lds + 49152);
        if (lane == 0) red[F.wave] = ssq;
        __syncthreads();
        const int w0 = F.wave & 4; const float rstd = rsqrtf(((red[w0] + red[w0 + 1]) + (red[w0 + 2] + red[w0 + 3])) * (1.0f / DM) + 1e-6f);
        const f32x4 a0 = v0 * rstd * *(const LAS f32x4*)(Gv + 2 * DM + qo) + *(const LAS f32x4*)(Sv + 2 * DM + qo);
        const f32x4 a1 = v1 * rstd * *(const LAS f32x4*)(Gv + 2 * DM + qo + 256) + *(const LAS f32x4*)(Sv + 2 * DM + qo + 256);
        v2u o0, o1; o0.x = pk2(a0.x, a0.y); o0.y = pk2(a0.z, a0.w); o1.x = pk2(a1.x, a1.y); o1.y = pk2(a1.z, a1.w);
        *(v2u*)(A + (size_t)(ML + cr) * DM + qo) = o0; *(v2u*)(A + (size_t)(ML + cr) * DM + qo + 256) = o1;
    } else
    for (; r < MT; r += NGW) {
        const int go = (r < SEQ ? 0 : (r < ML ? 1 : 2)) * DM;
        f32x4 v[8]; float ss = 0.f;
        if (!F32SRC && r < ML) {
#pragma unroll
            for (int j = 0; j < 8; ++j) { const v2u t = *(const v2u*)(hb + (size_t)r * DM + 4 * lane + 256 * j); v[j] = f32x4{bflo(t.x), bfhi(t.x), bflo(t.y), bfhi(t.y)}; }
        } else { const float* src = r < ML ? hl + (size_t)r * DM : hcx + (size_t)(r - ML) * DM;
#pragma unroll
            for (int j = 0; j < 8; ++j) v[j] = *(const f32x4*)(src + 4 * lane + 256 * j); }
        if (r >= ML && red_ks > 0) {
            const float* sl = (const float*)(WSP(F) + WS_SLAB) + (size_t)(r - ML) * DM + 4 * lane;
#pragma unroll
            for (int j = 0; j < 8; j += 2) { f32x4 t0[11], t1[11];
#pragma unroll
                for (int k = 0; k < 11; ++k) { const bool on = k < red_ks; const size_t ko = (size_t)(on ? k : 0) * (MC * DM);
                    t0[k] = *(const f32x4*)(sl + ko + 256 * j); t1[k] = *(const f32x4*)(sl + ko + 256 * (j + 1)); }
                f32x4 s0 = t0[0], s1 = t1[0];
#pragma unroll
                for (int k = 1; k < 11; ++k) if (k < red_ks) { s0 += t0[k]; s1 += t1[k]; }
                v[j] += *(const f32x4*)(red_gate + 4 * lane + 256 * j) * s0; v[j + 1] += *(const f32x4*)(red_gate + 4 * lane + 256 * (j + 1)) * s1;
                *(f32x4*)(hcx + (size_t)(r - ML) * DM + 4 * lane + 256 * j) = v[j]; *(f32x4*)(hcx + (size_t)(r - ML) * DM + 4 * lane + 256 * (j + 1)) = v[j + 1]; }
        }
#pragma unroll
        for (int j = 0; j < 8; ++j) ss += (v[j].x * v[j].x + v[j].y * v[j].y) + (v[j].z * v[j].z + v[j].w * v[j].w);
        const float rstd = rsqrtf(wave_sum(ss) * (1.0f / DM) + 1e-6f);
#pragma unroll
        for (int j = 0; j < 8; ++j) { const int d = 4 * lane + 256 * j;
            const f32x4 a = v[j] * rstd * *(const LAS f32x4*)(Gv + go + d) + *(const LAS f32x4*)(Sv + go + d);
            v2u o; o.x = pk2(a.x, a.y); o.y = pk2(a.z, a.w);
            *(v2u*)(A + (size_t)r * DM + d) = o; }
    }
    __syncthreads();
}

__device__ __forceinline__ void prep_even_row(bf16* P, bf16* QR, int r, bool lat, int lane, const v4u (&w6)[6], const f32x4 (&rw)[4], const float (&g0)[8], const float (&g1)[8]) {
    float cs[8], sn[8];
#pragma unroll
    for (int e = 0; e < 8; e += 2) { cs[e] = lat ? rw[e >> 1].x : 1.f; sn[e] = lat ? rw[e >> 1].y : 0.f; cs[e + 1] = lat ? rw[e >> 1].z : 1.f; sn[e + 1] = lat ? rw[e >> 1].w : 0.f; }
    bf16* prow = P + (size_t)r * EVN;
#pragma unroll
    for (int j = 0; j < 6; ++j) {
        const int ch = j * 64 + lane; const v4u w = w6[j];
        float x[8] = {bflo(w.x), bfhi(w.x), bflo(w.y), bfhi(w.y), bflo(w.z), bfhi(w.z), bflo(w.w), bfhi(w.w)};
        float ss = 0.f;
#pragma unroll
        for (int e = 0; e < 8; ++e) ss += x[e] * x[e];
        ss += __shfl_xor(ss, 1); ss += __shfl_xor(ss, 2); ss += __shfl_xor(ss, 4);
        const float rstd = rsqrtf(ss * (1.0f / 64.0f) + 1e-6f);
        float y[8], yr[8];
#pragma unroll
        for (int e = 0; e < 8; ++e) y[e] = x[e] * rstd * (j < 3 ? g0[e] * 0.18033688011112042f : g1[e]);
#pragma unroll
        for (int e = 0; e < 8; ++e) { const float yp = __shfl_xor(y[e], 2); yr[e] = (lane & 2) ? (y[e] * cs[e] + yp * sn[e]) : (y[e] * cs[e] - yp * sn[e]); }
        v4u on, orr;
        on.x = pk2(y[0], y[1]); on.y = pk2(y[2], y[3]); on.z = pk2(y[4], y[5]); on.w = pk2(y[6], y[7]);
        orr.x = pk2(yr[0], yr[1]); orr.y = pk2(yr[2], yr[3]); orr.z = pk2(yr[4], yr[5]); orr.w = pk2(yr[6], yr[7]);
        if (j < 3) { *(v4u*)(prow + ch * 8) = on; if (lat) *(v4u*)(QR + (size_t)r * 1536 + ch * 8) = orr; }
        else       { *(v4u*)(prow + ch * 8) = lat ? orr : on; }
    }
}
__device__ __forceinline__ void prep_even(Frame& F, int lj) {
    bf16* P = (bf16*)(WSP(F) + WS_P); bf16* QR = (bf16*)(WSP(F) + WS_QR);
    const float* gq = INP(F, 11) + (size_t)lj * 128; const float* rope = (const float*)(WSP(F) + WS_ROPE);
    const int gw = F.vcu * 8 + F.wave, NGW = F.G * 8; const int lane = F.lane;
    const int d0 = (lane & 7) * 8;
    float g0[8], g1[8];
#pragma unroll
    for (int e = 0; e < 8; ++e) { g0[e] = gq[d0 + e]; g1[e] = gq[64 + d0 + e]; }
    for (int r = gw; r < MT; r += 2 * NGW) {
        const int r1 = r + NGW; const bool has1 = r1 < MT; const int r1c = has1 ? r1 : r;
        v4u wa[6], wb[6]; f32x4 ra[4], rb[4];
        const int ta = r & (SEQ - 1), tb = r1c & (SEQ - 1);
        const int pa = ((lane >> 2) & 1) ? (ta & 63) : (ta >> 6), pb = ((lane >> 2) & 1) ? (tb & 63) : (tb >> 6);
#pragma unroll
        for (int j = 0; j < 6; ++j) { wa[j] = *(const v4u*)(P + (size_t)r * EVN + (j * 64 + lane) * 8); wb[j] = *(const v4u*)(P + (size_t)r1c * EVN + (j * 64 + lane) * 8); }
#pragma unroll
        for (int e = 0; e < 4; ++e) { ra[e] = *(const f32x4*)(rope + (size_t)((pa & 127) * 16 + (lane & 1) * 8) * 2 + e * 4); rb[e] = *(const f32x4*)(rope + (size_t)((pb & 127) * 16 + (lane & 1) * 8) * 2 + e * 4); }
        asm volatile("" ::: "memory");
        prep_even_row(P, QR, r, r < ML, lane, wa, ra, g0, g1);
        if (has1) prep_even_row(P, QR, r1, r1 < ML, lane, wb, rb, g0, g1);
    }
}

struct OddRow { v4u gb[2], gc[2][3], hh[2][3]; };
__device__ __forceinline__ void prep_odd_load(OddRow& R, const bf16* P, int r, int lane) {
    const bool lat = r < ML; const int t = lat ? (r & (SEQ - 1)) : ((r - ML) & (CTXL - 1)); const int n = lat ? SEQ : CTXL;
    const bf16* prow = P + (size_t)r * ODN;
#pragma unroll
    for (int j = 0; j < 2; ++j) { const int c0 = (j * 64 + lane) * 8; R.gb[j] = *(const v4u*)(prow + c0);
#pragma unroll
        for (int jj = 0; jj < 3; ++jj) { const int tt = t + jj - 1; const bool ok = tt >= 0 && tt < n; const bf16* pr = prow + (ok ? (ptrdiff_t)(jj - 1) * ODN : 0);
            R.gc[j][jj] = *(const v4u*)(pr + 1024 + c0); R.hh[j][jj] = *(const v4u*)(pr + 2048 + c0); } }
}
__device__ __forceinline__ void prep_odd_row(const OddRow& R, bf16* P, bf16* MIX, const float* cw, int r, int lane, const float (&g0)[8], const float (&g1)[8]) {
    const bool lat = r < ML; const int t = lat ? (r & (SEQ - 1)) : ((r - ML) & (CTXL - 1)); const int n = lat ? SEQ : CTXL;
    bf16* prow = P + (size_t)r * ODN;
#pragma unroll
    for (int j = 0; j < 2; ++j) {
        const int c0 = (j * 64 + lane) * 8;
        float accv[8];
#pragma unroll
        for (int e = 0; e < 8; ++e) accv[e] = 0.f;
#pragma unroll
        for (int jj = 0; jj < 3; ++jj) {
            const int tt = t + jj - 1; const float m = (tt >= 0 && tt < n) ? 1.f : 0.f;
            const v4u a = R.gc[j][jj], b = R.hh[j][jj];
            const f32x4 w0 = *(const f32x4*)(cw + jj * 1024 + c0) * m, w1 = *(const f32x4*)(cw + jj * 1024 + c0 + 4) * m;
            accv[0] += bflo(a.x) * bflo(b.x) * w0.x; accv[1] += bfhi(a.x) * bfhi(b.x) * w0.y; accv[2] += bflo(a.y) * bflo(b.y) * w0.z; accv[3] += bfhi(a.y) * bfhi(b.y) * w0.w;
            accv[4] += bflo(a.z) * bflo(b.z) * w1.x; accv[5] += bfhi(a.z) * bfhi(b.z) * w1.y; accv[6] += bflo(a.w) * bflo(b.w) * w1.z; accv[7] += bfhi(a.w) * bfhi(b.w) * w1.w;
        }
        const v4u gb = R.gb[j];
        v4u o; o.x = pk2(bflo(gb.x) * accv[0], bfhi(gb.x) * accv[1]); o.y = pk2(bflo(gb.y) * accv[2], bfhi(gb.y) * accv[3]);
        o.z = pk2(bflo(gb.z) * accv[4], bfhi(gb.z) * accv[5]); o.w = pk2(bflo(gb.w) * accv[6], bfhi(gb.w) * accv[7]);
        *(v4u*)(MIX + (size_t)r * DM + c0) = o;
    }
}
__device__ __forceinline__ void prep_odd(Frame& F, int lj) {
    const bf16* P = (const bf16*)(WSP(F) + WS_P); bf16* MIX = (bf16*)(WSP(F) + WS_MIX);
    const float* cw = INP(F, 17) + (size_t)lj * 3 * 1024;
    const int gw = F.vcu * 8 + F.wave, NGW = F.G * 8; const int lane = F.lane;
    f32x4 wt[2][3][2];
#pragma unroll
    for (int j = 0; j < 2; ++j)
#pragma unroll
        for (int jj = 0; jj < 3; ++jj) { const int c0 = (j * 64 + lane) * 8; wt[j][jj][0] = *(const f32x4*)(cw + jj * 1024 + c0); wt[j][jj][1] = *(const f32x4*)(cw + jj * 1024 + c0 + 4); }
    for (int g = gw; g < MT / 4; g += NGW) {
        const int r0 = 4 * g; const bool lat = r0 < ML; const int t0 = lat ? (r0 & (SEQ - 1)) : ((r0 - ML) & (CTXL - 1)); const int n = lat ? SEQ : CTXL;
        const bf16* pb = P + (size_t)r0 * ODN;
        v4u gb[4][2], gc[6][2], hh[6][2];
#pragma unroll
        for (int i = 0; i < 6; ++i) { const int tt = t0 + i - 1; const bool ok = tt >= 0 && tt < n; const bf16* pr = pb + (ok ? (ptrdiff_t)(i - 1) * ODN : 0);
#pragma unroll
            for (int j = 0; j < 2; ++j) { const int c0 = (j * 64 + lane) * 8; gc[i][j] = *(const v4u*)(pr + 1024 + c0); hh[i][j] = *(const v4u*)(pr + 2048 + c0); } }
#pragma unroll
        for (int i = 0; i < 4; ++i)
#pragma unroll
            for (int j = 0; j < 2; ++j) gb[i][j] = *(const v4u*)(pb + (size_t)i * ODN + (j * 64 + lane) * 8);
        asm volatile("" ::: "memory");
#pragma unroll
        for (int i = 0; i < 4; ++i)
#pragma unroll
            for (int j = 0; j < 2; ++j) { const int c0 = (j * 64 + lane) * 8;
                float accv[8];
#pragma unroll
                for (int e = 0; e < 8; ++e) accv[e] = 0.f;
#pragma unroll
                for (int jj = 0; jj < 3; ++jj) { const int tt = t0 + i + jj - 1; const float m = (tt >= 0 && tt < n) ? 1.f : 0.f;
                    const v4u a = gc[i + jj][j], b = hh[i + jj][j]; const f32x4 w0 = wt[j][jj][0] * m, w1 = wt[j][jj][1] * m;
                    accv[0] += bflo(a.x) * bflo(b.x) * w0.x; accv[1] += bfhi(a.x) * bfhi(b.x) * w0.y; accv[2] += bflo(a.y) * bflo(b.y) * w0.z; accv[3] += bfhi(a.y) * bfhi(b.y) * w0.w;
                    accv[4] += bflo(a.z) * bflo(b.z) * w1.x; accv[5] += bfhi(a.z) * bfhi(b.z) * w1.y; accv[6] += bflo(a.w) * bflo(b.w) * w1.z; accv[7] += bfhi(a.w) * bfhi(b.w) * w1.w; }
                const v4u q = gb[i][j];
                v4u o; o.x = pk2(bflo(q.x) * accv[0], bfhi(q.x) * accv[1]); o.y = pk2(bflo(q.y) * accv[2], bfhi(q.y) * accv[3]);
                o.z = pk2(bflo(q.z) * accv[4], bfhi(q.z) * accv[5]); o.w = pk2(bflo(q.w) * accv[6], bfhi(q.w) * accv[7]);
                *(v4u*)(MIX + (size_t)(r0 + i) * DM + c0) = o; }
    }
}

struct EvenTileRow { int ctx0, lat0; __device__ __forceinline__ int operator()(int j) const { return j < 4 ? ctx0 + 64 * j : lat0 + 64 * (j - 4); } };
__device__ __forceinline__ void even_attn_unit(Frame& F, int lj, int b, int h, int qrow0, bool is_ctx, unsigned& sacc) {
    const bf16* P = (const bf16*)(WSP(F) + WS_P); const bf16* QR = (const bf16*)(WSP(F) + WS_QR); bf16* MIX = (bf16*)(WSP(F) + WS_MIX);
    const int lane = F.lane, r32 = lane & 31, hi = lane >> 5, wq = F.wave & 3, comp = F.wave >> 2;
    EvenTileRow trow{ML + b * CTXL, b * SEQ};
    att::f32x16 o[4]; float rli[16];
    att::attn_dual_stag<EVN, 1536, EVN>(P + (size_t)qrow0 * EVN + h * 128, QR + (size_t)(is_ctx ? 0 : qrow0) * 1536 + h * 128, is_ctx ? 1000 : 4,
                                        P + 1536 + h * 128, P + 3072 + h * 128, trow, is_ctx ? 4 : 132, (char*)F.ldsg, o, rli, sacc);
    __syncthreads();
    LAS float* xch = (LAS float*)F.lds + (size_t)wq * 4096 + lane;
    if (comp == 1) {
#pragma unroll
        for (int d = 0; d < 4; ++d)
#pragma unroll
            for (int r = 0; r < 16; ++r) xch[(d * 16 + r) * 64] = o[d][r] * rli[r];
    }
    __syncthreads();
    if (comp == 0) {
        const float lam = ((const float*)(WSP(F) + WS_LAM))[lj];
        const float cfac = 1.0f - (lj == 0 ? LAM_INIT0 : LAM_INIT1);
        const float* gsub = INP(F, 13) + (size_t)lj * 128;
        float ssq[16];
#pragma unroll
        for (int r = 0; r < 16; ++r) ssq[r] = 0.f;
#pragma unroll
        for (int d = 0; d < 4; ++d)
#pragma unroll
            for (int r = 0; r < 16; ++r) { const float v = o[d][r] * rli[r] - lam * xch[(d * 16 + r) * 64]; o[d][r] = v; ssq[r] += v * v; }
#pragma unroll
        for (int r = 0; r < 16; ++r) { float s = ssq[r]; s += __shfl_xor(s, 1); s += __shfl_xor(s, 2); s += __shfl_xor(s, 4); s += __shfl_xor(s, 8); s += __shfl_xor(s, 16);
            ssq[r] = rsqrtf(s * (1.0f / 128.0f) + 1e-6f) * cfac; }
        int r32s = r32; asm volatile("" : "+v"(r32s));
#pragma unroll
        for (int d = 0; d < 4; ++d) { const float g = gsub[32 * d + r32s];
#pragma unroll
            for (int r = 0; r < 16; ++r) MIX[(size_t)(qrow0 + wq * 32 + att::crow(r, hi)) * DM + h * 128 + 32 * d + r32s] = (bf16)f2bf(o[d][r] * ssq[r] * g); }
    }
}

__device__ __forceinline__ void fft_unit(Frame& F, int b, int cp) {
    LAS unsigned char* Vl = F.lds;
    LAS unsigned char* Yl = F.lds + 69632;
    const bf16* P = (const bf16*)(WSP(F) + WS_P); bf16* MIX = (bf16*)(WSP(F) + WS_MIX);
    const bf16* FA1 = (const bf16*)(WSP(F) + WS_FA1); const bf16* FA2 = (const bf16*)(WSP(F) + WS_FA2);
    const int lane = F.lane, l15 = lane & 15, lq = lane >> 4;
    v2u wl[16];
    const bf16* FT = (const bf16*)(WSP(F) + WS_FT) + (size_t)(b * 256 + cp) * 8192 * 4;
#pragma unroll
    for (int jj = 0; jj < 16; ++jj) wl[jj] = *(const v2u*)(FT + (size_t)(F.tid + 512 * jj) * 4);
#pragma unroll
    for (int jj = 0; jj < 16; ++jj) { const int t = F.tid + 512 * jj; const v2u w = wl[jj];
        const int t1 = t >> 7, t2 = t & 127;
        *(LAS bf16*)(Vl + (2 * t2 + 0) * 272 + (t1) * 2) = (bf16)(w.x & 0xffffu);       *(LAS bf16*)(Vl + (2 * t2 + 0) * 272 + (64 + t1) * 2) = (bf16)(w.x >> 16);
        *(LAS bf16*)(Vl + (2 * t2 + 1) * 272 + (t1) * 2) = (bf16)(w.y & 0xffffu);       *(LAS bf16*)(Vl + (2 * t2 + 1) * 272 + (64 + t1) * 2) = (bf16)(w.y >> 16); }
    __syncthreads();
    {
        const int mt = F.wave & 3, nt0 = (F.wave >> 2) * 8;
        bf16x8 aR[4], aI[4];
#pragma unroll
        for (int ks = 0; ks < 4; ++ks) { aR[ks] = *(const bf16x8*)(FA1 + (size_t)(16 * mt + l15) * 128 + 32 * ks + 8 * lq); aI[ks] = *(const bf16x8*)(FA1 + (size_t)(64 + 16 * mt + l15) * 128 + 32 * ks + 8 * lq); }
        for (int nt = nt0; nt < nt0 + 8; ++nt) {
            f32x4 accR = {0.f, 0.f, 0.f, 0.f}, accI = accR;
#pragma unroll
            for (int ks = 0; ks < 4; ++ks) { const bf16x8 bf = *(const LAS bf16x8*)(Vl + (16 * nt + l15) * 272 + (32 * ks + 8 * lq) * 2);
                accR = __builtin_amdgcn_mfma_f32_16x16x32_bf16(aR[ks], bf, accR, 0, 0, 0); accI = __builtin_amdgcn_mfma_f32_16x16x32_bf16(aI[ks], bf, accI, 0, 0, 0); }
            const int n1 = 16 * nt + l15, t2 = n1 >> 1, cc = n1 & 1;
#pragma unroll
            for (int r = 0; r < 4; ++r) { const int k1 = 16 * mt + lq * 4 + r; const float ph = (float)((t2 * k1) & 8191) * (1.0f / 8192.0f); const float cs = hw_cos(ph), sn = hw_sin(ph);
                const float yr = accR[r] * cs + accI[r] * sn, yi = accI[r] * cs - accR[r] * sn; const int n2 = k1 * 2 + cc;
                *(LAS bf16*)(Yl + n2 * 528 + t2 * 2) = (bf16)f2bf(yr); *(LAS bf16*)(Yl + n2 * 528 + (128 + t2) * 2) = (bf16)f2bf(yi); }
        }
    }
    __syncthreads();
    {
        const int mt = F.wave;
        bf16x8 a2[8];
#pragma unroll
        for (int ks = 0; ks < 8; ++ks) a2[ks] = *(const bf16x8*)(FA2 + (size_t)(16 * mt + l15) * 256 + 32 * ks + 8 * lq);
        for (int nt = 0; nt < 8; ++nt) {
            f32x4 acc = {0.f, 0.f, 0.f, 0.f};
#pragma unroll
            for (int ks = 0; ks < 8; ++ks) { const bf16x8 bf = *(const LAS bf16x8*)(Yl + (16 * nt + l15) * 528 + (32 * ks + 8 * lq) * 2); acc = __builtin_amdgcn_mfma_f32_16x16x32_bf16(a2[ks], bf, acc, 0, 0, 0); }
            const int n2 = 16 * nt + l15, k1 = n2 >> 1, cc = n2 & 1;
#pragma unroll
            for (int r = 0; r < 4; ++r) { const int k2 = 16 * mt + lq * 4 + r; const int tok = k1 + 64 * k2; const unsigned me = f2bf(acc[r] * (1.0f / 1024.0f)); const unsigned other = (unsigned)__shfl_xor((int)me, 1);
                if (cc == 0) *(unsigned*)(MIX + (size_t)(b * SEQ + tok) * DM + 1536 + 2 * cp) = me | (other << 16); }
        }
    }
    __syncthreads();
}
__device__ __forceinline__ void ctx_dft_unit(Frame& F, int b, int cb) {
    LAS unsigned char* Vc = F.lds;
    const bf16* P = (const bf16*)(WSP(F) + WS_P); bf16* MIX = (bf16*)(WSP(F) + WS_MIX); const bf16* FA3 = (const bf16*)(WSP(F) + WS_FA3);
    const int lane = F.lane, l15 = lane & 15, lq = lane >> 4;
    { const int t = F.tid >> 1, half = F.tid & 1; const bf16* src = P + (size_t)(ML + b * CTXL + t) * EVN + 4608 + 32 * cb + 16 * half;
      const v4u w0 = *(const v4u*)src, w1 = *(const v4u*)(src + 8);
      const unsigned ww[8] = {w0.x, w0.y, w0.z, w0.w, w1.x, w1.y, w1.z, w1.w};
#pragma unroll
      for (int i = 0; i < 8; ++i) { const int cl = half * 8 + i; *(LAS bf16*)(Vc + cl * 1040 + t * 2) = (bf16)(ww[i] & 0xffffu); *(LAS bf16*)(Vc + cl * 1040 + (256 + t) * 2) = (bf16)(ww[i] >> 16); } }
    __syncthreads();
#pragma unroll 1
    for (int mi = 0; mi < 2; ++mi) { const int mt = F.wave * 2 + mi; f32x4 acc = {0.f, 0.f, 0.f, 0.f};
#pragma unroll 4
        for (int ks = 0; ks < 16; ++ks) { const bf16x8 a = *(const bf16x8*)(FA3 + (size_t)(16 * mt + l15) * 512 + 32 * ks + 8 * lq); const bf16x8 bf = *(const LAS bf16x8*)(Vc + l15 * 1040 + (32 * ks + 8 * lq) * 2);
            acc = __builtin_amdgcn_mfma_f32_16x16x32_bf16(a, bf, acc, 0, 0, 0); }
#pragma unroll
        for (int r = 0; r < 4; ++r) { const int k = 16 * mt + lq * 4 + r; MIX[(size_t)(ML + b * CTXL + k) * DM + 1536 + 16 * cb + l15] = (bf16)f2bf(acc[r] * 0.005524271728019903f); } }
    __syncthreads();
}
__device__ __forceinline__ void mixer_even(Frame& F, int lj) {
    unsigned sacc = 0;
#if STAMP == 1
    const unsigned long long sm0_ = __builtin_amdgcn_s_memtime(), sr0_ = __builtin_amdgcn_s_memrealtime(); __builtin_amdgcn_s_waitcnt(0xC07F);
#endif
#if STAMP == 40 || STAMP == 41
    const unsigned tA_ = (unsigned)__builtin_amdgcn_s_memrealtime();
#endif
    if (MXM & 1) {
        for (int uu = F.vcu; uu < ((DUP & 1) ? 2 : 1) * (1536 + 48); uu += F.G) { const int u = (DUP & 1) ? uu % (1536 + 48) : uu; const bool is_ctx = u >= 1536;
            const int pair = is_ctx ? (u - 1536) >> 1 : (u >> 6), qb = is_ctx ? (u & 1) : (u & 63); const int b = pair / 12, h = pair % 12;
            even_attn_unit(F, lj, b, h, is_ctx ? ML + b * CTXL + qb * 128 : b * SEQ + qb * 128, is_ctx, sacc); __syncthreads(); } }
#if STAMP && STAMP < 6
    if (lj == (STAMP_LJ) && blockIdx.x == 0) {
#if STAMP == 1
        const unsigned long long sm1_ = __builtin_amdgcn_s_memtime(), sr1_ = __builtin_amdgcn_s_memrealtime(); __builtin_amdgcn_s_waitcnt(0xC07F);
        sacc = (unsigned)(((sm1_ - sm0_) * 100ull) / (sr1_ - sr0_));
#endif
        if (F.wave == ((STAMP == 3) ? 4 : 0) && F.lane == 0) __hip_atomic_store((GAS unsigned*)(WSP(F) + WS_LAM + 1024), sacc, RLX_AGENT);
    }
#endif
#if STAMP == 40 || STAMP == 41
    const unsigned tB_ = (unsigned)__builtin_amdgcn_s_memrealtime();
#endif
    if ((MXM & 12) == 12) {
        gu32* cnt = (gu32*)(WSP(F) + WS_CTL) + CW_FFT + lj;
        for (;;) {
            if (F.tid == 0) F.MISC[20] = __hip_atomic_fetch_add(cnt, 1u, RLX_AGENT);
            __syncthreads();
            const int u = (int)F.MISC[20];
            if (u >= 512 + 64) break;
            if (u < 512) fft_unit(F, u >> 8, u & 255); else { ctx_dft_unit(F, (u - 512) >> 5, (u - 512) & 31); __syncthreads(); }
        }
    }
#if STAMP == 40 || STAMP == 41
    { const unsigned tC_ = (unsigned)__builtin_amdgcn_s_memrealtime(); if (F.tid == 0) F.MISC[16] += (STAMP == 40) ? tB_ - tA_ : tC_ - tB_; }
#endif
}

struct OddTileRow { int ctx0, lat0; __device__ __forceinline__ int operator()(int j) const { return j < 4 ? ctx0 + 64 * j : lat0 + 64 * (j - 4); } };
struct NaMask {
    int R0, rw, cq, rs, cs, hi; const LAS float* bt; bool off;
    __device__ __forceinline__ bool skip(int j) const { if (off || j < 4) return false; const int kr = R0 + j - 4; return __builtin_amdgcn_readfirstlane((int)(kr < rs || kr >= rs + 8)) != 0; }
    __device__ __forceinline__ void operator()(att::f32x16& p0, att::f32x16& p1, int j) const {
        if (off || j < 4) return;
        const int kr = R0 + j - 4;
        if (kr < rs || kr >= rs + 8) {
#pragma unroll
            for (int r = 0; r < 16; ++r) { p0[r] = -1e30f; p1[r] = -1e30f; }
            return; }
        int cq_ = cq, hi_ = hi; asm volatile("" : "+v"(cq_), "+v"(hi_));
        int cs_ = cq_ - 8; cs_ = cs_ < 0 ? 0 : (cs_ > 48 ? 48 : cs_);
        const int rowoff = (kr - rw + 7) * 31 + 15 - cq_;
#pragma unroll
        for (int r = 0; r < 16; ++r) { const int c0 = att::crow(r, hi_), c1 = 32 + c0; const int cs = cs_;
            const bool ok0 = c0 >= cs && c0 < cs + 16, ok1 = c1 >= cs && c1 < cs + 16;
            const float b0 = bt[ok0 ? rowoff + c0 : 0], b1 = bt[ok1 ? rowoff + c1 : 0];
            p0[r] = ok0 ? p0[r] + b0 : -1e30f; p1[r] = ok1 ? p1[r] + b1 : -1e30f;
            if ((r & 7) == 7) __builtin_amdgcn_sched_barrier(0); }
    }
};
__device__ __forceinline__ void odd_attn_unit(Frame& F, int lj, int b, int h, int rb, bool is_ctx, bool fill_bt) {
    const bf16* P = (const bf16*)(WSP(F) + WS_P); bf16* MIX = (bf16*)(WSP(F) + WS_MIX);
    const int lane = F.lane, r32 = lane & 31, hi = lane >> 5, wid = F.wave;
    const int qrow0 = is_ctx ? ML + b * CTXL : b * SEQ + rb * 256;
    int R0 = 4 * rb - 4; R0 = R0 < 0 ? 0 : (R0 > 116 ? 116 : R0);
    OddTileRow trow{ML + b * CTXL, b * SEQ + R0 * 64};
    LAS float* bt = (LAS float*)(F.lds + att::LDS_BT_OFF);
    if (!is_ctx && fill_bt) { const float* rpb = INP(F, 18) + (size_t)(lj * 8 + h) * 465; for (int t = F.tid; t < 465; t += 512) bt[t] = rpb[t] * 1.4426950408889634f; }
    NaMask mk; mk.R0 = R0; mk.rw = 4 * rb + (wid >> 1); mk.cq = 32 * (wid & 1) + r32; mk.hi = hi; mk.bt = bt; mk.off = is_ctx;
    { int rs = mk.rw - 4; rs = rs < 0 ? 0 : (rs > 120 ? 120 : rs); mk.rs = rs; int cs = mk.cq - 8; cs = cs < 0 ? 0 : (cs > 48 ? 48 : cs); mk.cs = cs; }
    att::f32x16 o[4]; float rli[16];
    att::attn_core<128, ODN, ODN, ODN, 1, false, true>(P + (size_t)qrow0 * ODN + 3072 + h * 128, (const bf16*)nullptr, 1000,
                        P + 4096 + h * 128, P + 5120 + h * 128, trow, is_ctx ? 4 : 16, mk, (char*)F.ldsg, o, rli);
#pragma unroll
    for (int d = 0; d < 4; ++d)
#pragma unroll
        for (int r = 0; r < 16; ++r) MIX[(size_t)(qrow0 + wid * 32 + att::crow(r, hi)) * DM + 1024 + h * 128 + 32 * d + r32] = (bf16)f2bf(o[d][r] * rli[r]);
}
__device__ __forceinline__ void mixer_odd(Frame& F, int lj, bool with_ctx) {
    const int nun = 512 + (with_ctx ? 16 : 0);
    int last_h = -1;
    if (MXM & 1) for (int uu = F.vcu; uu < ((DUP & 2) ? 2 : 1) * nun; uu += F.G) { const int u = (DUP & 2) ? uu % nun : uu; const bool is_ctx = u >= 512; const int pair = is_ctx ? u - 512 : (u >> 5), rb = is_ctx ? 0 : (u & 31);
        odd_attn_unit(F, lj, pair >> 3, pair & 7, rb, is_ctx, (pair & 7) != last_h); if (!is_ctx) last_h = pair & 7; __syncthreads(); }
}

#if STAMP >= 6
constexpr bool seam_sel(int ph) {
    if (STAMP == 50) return ph == 3;
    if (STAMP >= 20) return ph == STAMP - 20;
    if (STAMP == 13 || STAMP == 14) return false;
    return STAMP == 6 ? true : STAMP == 7 ? (ph == 1) : STAMP == 8 ? (ph == 3) : STAMP == 9 ? (ph == 6) : STAMP == 10 ? (ph == 4 || ph == 7) : STAMP == 11 ? (ph == 0 || ph == 5) : (ph == 8);
}
#endif
__global__ void __launch_bounds__(512, 2) mk_fwd(Args args) {
    extern __shared__ __attribute__((aligned(16))) unsigned char lds[];
    Frame F;
    F.lds = (LAS unsigned char*)lds; F.ldsg = lds;
    F.MISC = (volatile LAS unsigned*)(F.lds + MISC_OFF);
    F.tid = threadIdx.x; F.lane = F.tid & 63; F.wave = __builtin_amdgcn_readfirstlane(F.tid >> 6);
    F.G = gridDim.x; { const int bx = blockIdx.x; F.vcu = (F.G % 8 == 0) ? (bx % 8) * (F.G / 8) + bx / 8 : bx; }
    F.ap = (ArgsP)__builtin_amdgcn_kernarg_segment_ptr();
    F.ws = (GAS unsigned char*)args.ws; F.out = (GAS float*)args.out; F.ctl = (gu32*)(F.ws + WS_CTL);
    for (int u = F.tid; u < (LDS_BYTES - MISC_OFF) / 4; u += 512) ((LAS unsigned*)(F.lds + MISC_OFF))[u] = 0u;
    __syncthreads();
    XcdBarrier bar = xcd_barrier_post((unsigned*)(F.ctl + CW_BAR), F.MISC + 8);
#if STAMP >= 20
    if (F.tid == 0) F.MISC[17] = (unsigned)__builtin_amdgcn_s_memrealtime();
#endif
    const int lo = args.ph_lo, hi = args.ph_hi;
#define IN(k) (lo <= (k) && (k) < hi)
#if STAMP >= 6
#define SEAMC(k, cat) do { if (IN(k) && IN((k) + 1)) { const unsigned long long tb0_ = __builtin_amdgcn_s_memrealtime(); xcd_barrier(bar); const unsigned long long tb1_ = __builtin_amdgcn_s_memrealtime(); \
        if (F.tid == 0) { if (STAMP >= 20) { F.MISC[16] += (seam_sel(cat) && (STAMP != 50 || (((k) & 8) != 0))) ? (unsigned)tb1_ - F.MISC[17] : 0u; F.MISC[17] = (unsigned)tb1_; } else F.MISC[16] += seam_sel(cat) ? (unsigned)(tb1_ - tb0_) : 0u; } } } while (0)
#else
#define SEAMC(k, cat) do { if (IN(k) && IN((k) + 1)) xcd_barrier(bar); } while (0)
#endif
    if (IN(0) && (PHM & 1)) { Frame L = site(F); p0_modvec(L); __syncthreads(); p0_tables(L); p0_copy_ctx(L); p0_fold(L); __syncthreads(); p0_weights(L); __syncthreads(); }
    SEAMC(0, 8);
    for (int li = 0; li < DEPTH; ++li) {
        const int pb = 1 + 8 * li, lj = li >> 1; const bool even = (li & 1) == 0;
        if (IN(pb + 0) && (PHM & 2)) { Frame L = site(F); const float* rg = (const float*)(WSP(L) + WS_MODV) + (size_t)((li - 1) * 3 + 2) * 12288 + 5 * DM;
            if (li == 0) norm_phase<true>(L, li, 0, INP(L, 0), (float*)(WSP(L) + WS_HC), 0, rg); else norm_phase<false>(L, li, 0, WSP(L) + WS_HB, (float*)(WSP(L) + WS_HC), 11, rg);
            if (DUP & 32) { if (li == 0) norm_phase<true>(L, li, 0, INP(L, 0), (float*)(WSP(L) + WS_HC), 0, nullptr); else norm_phase<false>(L, li, 0, WSP(L) + WS_HB, (float*)(WSP(L) + WS_HC), 0, nullptr); } }
        SEAMC(pb + 0, 0);
        if (IN(pb + 1) && (PHM & 4)) { Frame L = site(F);
            const int N = even ? EVN : ODN;
            const bf16* Bt = even ? (const bf16*)(WSP(L) + WS_WIN_E + (size_t)lj * SZ_WIN_E) : (const bf16*)(WSP(L) + WS_WIN_O + (size_t)lj * SZ_WIN_O);
            pg8::Gemm g{(const bf16*)(WSP(L) + WS_A), Bt, MT, N, DM}; pg8::StaticOrder S; S.init(MT, N, L.G, (int)blockIdx.x);
            if (even) {
                pg8::EpiEvenIn E{(bf16*)(WSP(L) + WS_P), (bf16*)(WSP(L) + WS_QR), N, INP(L, 11) + (size_t)lj * 128, (const float*)(WSP(L) + WS_ROPE), (LAS float*)(L.lds + pg8::STAGE_BYTES), (bf16*)(WSP(L) + WS_FT)};
                pg8::gemm_phase<pg8::EpiEvenIn, pg8::StaticOrder, PG8_ALIGN, PG8_SP2>(L.lds, g, S, E);
            } else {
            pg8::EpiOddIn E{(bf16*)(WSP(L) + WS_P), N, INP(L, 16) + (size_t)lj * 256, (LAS float*)(L.lds + pg8::STAGE_BYTES)};
            pg8::gemm_phase<pg8::EpiOddIn, pg8::StaticOrder, PG8_ALIGN, PG8_SP2>(L.lds, g, S, E);
            }
            wq_tail(L, 2 * li, (MT / 256) * (N / 256));
        }
        SEAMC(pb + 1, 1);
        if (IN(pb + 3)) { Frame L = site(F); if (even) { if (PHM & 32) mixer_even(L, lj); } else {
#if STAMP == 13 || STAMP == 14
            if (F.tid == 0) F.MISC[18] = (unsigned)__builtin_amdgcn_s_memrealtime();
#endif
            if (PHM & 16) prep_odd(L, lj);
#if STAMP == 14
            if (F.tid == 0) F.MISC[16] += (unsigned)__builtin_amdgcn_s_memrealtime() - F.MISC[18];
#endif
#if STAMP == 13
            if (F.tid == 0) F.MISC[18] = (unsigned)__builtin_amdgcn_s_memrealtime();
#endif
            if (PHM & 64) mixer_odd(L, lj, li != DEPTH - 1);
#if STAMP == 13
            if (F.tid == 0) F.MISC[16] += (unsigned)__builtin_amdgcn_s_memrealtime() - F.MISC[18];
#endif
            } }
        SEAMC(pb + 3, 3);
        if (IN(pb + 4) && (PHM & 128)) { Frame L = site(F);
            const bf16* Bt = even ? (const bf16*)(WSP(L) + WS_WOUT_E + (size_t)lj * SZ_WOUT) : (const bf16*)(WSP(L) + WS_WOUT_O + (size_t)lj * SZ_WOUT);
            const float* modl = (const float*)(WSP(L) + WS_MODV) + (size_t)li * 3 * 12288;
            pg8::Gemm g{(const bf16*)(WSP(L) + WS_MIX), Bt, MT, DM, DM}; pg8::SplitOrder<8> S; S.init(ML, DM, DM, L.G, (int)blockIdx.x, li != 3);
            if (li == 0) {
                pg8::EpiGate<true> E{(const void*)INP(L, 0), (void*)(WSP(L) + WS_HB), (float*)(WSP(L) + WS_SLAB), modl + 2 * DM, 0};
                pg8::gemm_phase<pg8::EpiGate<true>, pg8::SplitOrder<8>, PG8_ALIGN, PG8_SP2>(L.lds, g, S, E);
            } else {
                pg8::EpiGate<false> E{(const void*)(WSP(L) + WS_HB), (void*)(WSP(L) + WS_HB), (float*)(WSP(L) + WS_SLAB), modl + 2 * DM, 0};
                pg8::gemm_phase<pg8::EpiGate<false>, pg8::SplitOrder<8>, PG8_ALIGN, PG8_SP2>(L.lds, g, S, E);
            }
        }
        SEAMC(pb + 4, 4);
        if (IN(pb + 5) && (PHM & 2)) { Frame L = site(F); norm_phase<false>(L, li, 1, WSP(L) + WS_HB, (float*)(WSP(L) + WS_HC), li == 3 ? 0 : 8, (const float*)(WSP(L) + WS_MODV) + (size_t)(li * 3 + 2) * 12288 + 2 * DM); if (DUP & 32) norm_phase<false>(L, li, 1, WSP(L) + WS_HB, (float*)(WSP(L) + WS_HC), 0, nullptr); }
        SEAMC(pb + 5, 5);
        if (IN(pb + 6) && (PHM & 256)) { Frame L = site(F);
            const int Mr = li == 3 ? ML : MT;
            pg8::Gemm g{(const bf16*)(WSP(L) + WS_A), (const bf16*)(WSP(L) + WS_WFI + (size_t)li * SZ_WFI), Mr, 2 * FH, DM}; pg8::StaticOrder S; S.init(Mr, 2 * FH, L.G, (int)blockIdx.x);
            pg8::EpiSwiglu E{(bf16*)(WSP(L) + WS_HID), FH};
            for (int rep = 0; rep < ((DUP & 4) ? 2 : 1); ++rep)
            pg8::gemm_phase<pg8::EpiSwiglu, pg8::StaticOrder, PG8_ALIGN, PG8_SP2>(L.lds, g, S, E);
            if (li < 3) wq_tail(L, 2 * li + 1, (Mr / 256) * (2 * FH / 256));
        }
        SEAMC(pb + 6, 6);
        if (IN(pb + 7) && (PHM & 512)) { Frame L = site(F);
            const float* modl = (const float*)(WSP(L) + WS_MODV) + (size_t)li * 3 * 12288;
            pg8::Gemm g{(const bf16*)(WSP(L) + WS_HID), (const bf16*)(WSP(L) + WS_WFO + (size_t)li * SZ_WFO), MT, DM, FH}; pg8::SplitOrder<11> S; S.init(ML, DM, FH, L.G, (int)blockIdx.x, li != 3);
            pg8::EpiGate<false> E{(const void*)(WSP(L) + WS_HB), li == 3 ? (void*)OUTP(L) : (void*)(WSP(L) + WS_HB), (float*)(WSP(L) + WS_SLAB), modl + 5 * DM, li == 3 ? 1 : 0};
            pg8::gemm_phase<pg8::EpiGate<false>, pg8::SplitOrder<11>, PG8_ALIGN, PG8_SP2>(L.lds, g, S, E);
        }
        SEAMC(pb + 7, 7);
    }
#if STAMP >= 6
    if (STAMP >= 20 && F.tid == 0) { if (seam_sel(7)) F.MISC[16] += (unsigned)__builtin_amdgcn_s_memrealtime() - F.MISC[17]; if (blockIdx.x != 0) F.MISC[16] = 0u; else F.MISC[16] *= F.G; }
    if (F.tid == 0) __hip_atomic_fetch_add((GAS unsigned*)(F.ctl + 2048), (unsigned)F.MISC[16], RLX_AGENT);
    __syncthreads(); xcd_barrier(bar);
    if (blockIdx.x == 0 && F.wave == 0) {
        const unsigned v = __hip_atomic_load((GAS unsigned*)(F.ctl + 2048), RLX_AGENT);
        const unsigned long long ticks = (unsigned long long)v / F.G;
        const unsigned long long t0 = __builtin_amdgcn_s_memrealtime();
        while (__builtin_amdgcn_s_memrealtime() - t0 < ticks) __builtin_amdgcn_s_sleep(64);
    }
#elif STAMP
    if (blockIdx.x == 0 && F.wave == 0) {
        const unsigned v = __hip_atomic_load((GAS unsigned*)(F.ws + WS_LAM + 1024), RLX_AGENT);
        const unsigned long long ticks = (STAMP == 1) ? (unsigned long long)v * 100ull : ((unsigned long long)v * 100ull) >> 10;
        const unsigned long long t0 = __builtin_amdgcn_s_memrealtime();
        while (__builtin_amdgcn_s_memrealtime() - t0 < ticks) __builtin_amdgcn_s_sleep(64);
    }
#endif
#undef IN
#undef SEAMC
}

extern "C" void kernel_launch(void* const* d_in, const int* in_sizes, int n_in, void* d_out, int out_size, void* d_ws, size_t ws_size, hipStream_t stream) {
    static int grid = 0;
    if (grid == 0) {
        if (n_in != 19 || in_sizes[0] != ML * DM || out_size != ML * DM || ws_size < WS_END) { fprintf(stderr, "kernel_launch: shape mismatch (n_in %d, in0 %d, out %d, ws %zu < %zu); nothing launched\n", n_in, n_in > 0 ? in_sizes[0] : -1, out_size, ws_size, (size_t)WS_END); grid = -1; return; }
        int dev = 0, cus = 0, per_cu = 0;
        if (hipGetDevice(&dev) != hipSuccess || hipDeviceGetAttribute(&cus, hipDeviceAttributeMultiprocessorCount, dev) != hipSuccess) { fprintf(stderr, "kernel_launch: device query failed\n"); grid = -1; return; }
        if (hipFuncSetAttribute((const void*)mk_fwd, hipFuncAttributeMaxDynamicSharedMemorySize, LDS_BYTES) != hipSuccess) { fprintf(stderr, "kernel_launch: hipFuncSetAttribute failed\n"); grid = -1; return; }
        if (hipOccupancyMaxActiveBlocksPerMultiprocessor(&per_cu, (const void*)mk_fwd, 512, LDS_BYTES) != hipSuccess || per_cu < 1) fprintf(stderr, "kernel_launch: note: occupancy query reports %d workgroups per CU\n", per_cu);
        (void)hipGetLastError();
        grid = cus;
    }
    if (grid < 0) return;
    if (hipMemsetAsync((char*)d_ws + WS_CTL, 0, CTL_ZERO_BYTES, stream) != hipSuccess) { fprintf(stderr, "kernel_launch: memset failed\n"); return; }
    Args a{};
    for (int i = 0; i < 19; ++i) a.in[i] = (const float*)d_in[i];
    a.out = (float*)d_out; a.ws = (unsigned char*)d_ws;
    constexpr int NL = MK_N_LAUNCHES;
    for (int l = 0; l < NL; ++l) {
        a.ph_lo = (NL == 1) ? 0 : l; a.ph_hi = (NL == 1) ? NPH : l + 1;
        hipLaunchKernelGGL(mk_fwd, dim3(grid), dim3(512), LDS_BYTES, stream, a);
        const hipError_t le = hipPeekAtLastError();
        if (le != hipSuccess) { fprintf(stderr, "kernel_launch: launch %d failed: %s\n", l, hipGetErrorName(le)); break; }
    }
}
```
